# Optimizing an MI355X kernel written in HIP

```python
import jax, jax.numpy as jnp
from jax import lax
import numpy as np

D_MODEL = 1024
BATCH = 8
SEQ = 4096
DEPTH = 4

GRID_W = 64
PLE_DIM = 256
EPS = 1e-6
GLA_HEADS = 4
GLA_DK = 128
GLA_DV = 256
GLA_KEY = GLA_HEADS * GLA_DK
GLA_VAL = GLA_HEADS * GLA_DV
GLA_RANK = 16
GLA_TAU = 16.0
GLA_CHUNK = 64
ATTN_HEADS = 8
ATTN_KV_HEADS = 2
HEAD_DIM = 128
ATTN_Q = ATTN_HEADS * HEAD_DIM
ATTN_KV = ATTN_KV_HEADS * HEAD_DIM
Q_BLOCK = 128
ROPE_THETA = 10000.0
ROPE_AXIS_DIM = HEAD_DIM // 2
FFN_HIDDEN = -(-8 * D_MODEL // (3 * 256)) * 256
IN_SPLITS = (GLA_KEY, GLA_KEY, GLA_VAL, GLA_VAL, GLA_RANK, GLA_RANK,
             ATTN_Q, ATTN_KV, ATTN_KV, D_MODEL, D_MODEL)
IN_WIDTH = sum(IN_SPLITS)

kernel_name = "hybrid_gla_axialrope_gqa_encoder"


def rms_norm(x, g):
    xf = x.astype(jnp.float32)
    y = xf * lax.rsqrt(jnp.mean(xf * xf, axis=-1, keepdims=True) + EPS)
    return (y * g.astype(jnp.float32)).astype(x.dtype)


def axial_rope_tables(seq_len):
    rows = seq_len // GRID_W
    row = jnp.repeat(jnp.arange(rows, dtype=jnp.float32), GRID_W)
    col = jnp.tile(jnp.arange(GRID_W, dtype=jnp.float32), rows)
    inv = ROPE_THETA ** (-jnp.arange(0, ROPE_AXIS_DIM, 2, dtype=jnp.float32) / ROPE_AXIS_DIM)
    ang = jnp.stack([row[:, None] * inv, col[:, None] * inv], axis=1)
    return jnp.cos(ang), jnp.sin(ang)


def apply_axial_rope(x, cos, sin):
    b, s, h, d = x.shape
    xr = x.astype(jnp.float32).reshape(b, s, h, 2, 2, d // 4)
    c = cos[None, :, None]
    sn = sin[None, :, None]
    x1, x2 = xr[..., 0, :], xr[..., 1, :]
    out = jnp.stack([x1 * c - x2 * sn, x2 * c + x1 * sn], axis=-2)
    return out.reshape(b, s, h, d).astype(x.dtype)


def gla_chunked(q, k, v, log_a):
    b, s, h, dk = q.shape
    dv = v.shape[-1]
    n = s // GLA_CHUNK
    c = GLA_CHUNK

    def chunks(t):
        return t.reshape(b, n, c, h, t.shape[-1]).transpose(1, 0, 3, 2, 4)

    q, k, v, la = chunks(q), chunks(k), chunks(v), chunks(log_a)
    cum = jnp.cumsum(la, axis=3)
    last = cum[:, :, :, -1:, :]
    q_dec = q * jnp.exp(cum)
    k_intra = k * jnp.exp(-cum)
    k_state = k * jnp.exp(last - cum)
    mask = jnp.tril(jnp.ones((c, c), dtype=bool))
    scores = jnp.where(mask, jnp.einsum('nbhid,nbhjd->nbhij', q_dec, k_intra), 0.0)
    o_intra = jnp.einsum('nbhij,nbhjv->nbhiv', scores, v)

    def step(state, xs):
        qd, ks, vc, lst = xs
        o = jnp.einsum('bhid,bhdv->bhiv', qd, state)
        state = state * jnp.exp(lst[:, :, 0, :])[..., None] + jnp.einsum('bhjd,bhjv->bhdv', ks, vc)
        return state, o

    s0 = jnp.zeros((b, h, dk, dv), jnp.float32)
    _, o_inter = lax.scan(step, s0, (q_dec, k_state, v, last))
    o = o_intra + o_inter
    return o.transpose(1, 0, 3, 2, 4).reshape(b, s, h, dv)


def gqa_attention(q, k, v):
    b, s, hq, hd = q.shape
    hkv = k.shape[2]
    g = hq // hkv
    nb = s // Q_BLOCK
    qb = q.reshape(b, nb, Q_BLOCK, hkv, g, hd).transpose(1, 0, 2, 3, 4, 5)
    scale = hd ** -0.5

    def block(qblk):
        sc = jnp.einsum('bqkgd,bskd->bkgqs', qblk, k).astype(jnp.float32) * scale
        pr = jax.nn.softmax(sc, axis=-1).astype(v.dtype)
        return jnp.einsum('bkgqs,bskd->bqkgd', pr, v)

    out = lax.map(block, qb)
    return out.transpose(1, 0, 2, 3, 4, 5).reshape(b, s, hq * hd)


def hybrid_layer(h, p_i, cos, sin, g_mix_pre, w_in, w_alpha_up, b_alpha, g_gla_out,
                 g_q_norm, g_k_norm, w_o_gla, w_o_attn, w_out, g_mix_post,
                 g_ffn_pre, w_ffn_in, w_ffn_out, g_ffn_post, w_ple_proj, w_ple_gate, g_ple_post):
    b, s, _ = h.shape
    f32 = jnp.float32
    u = rms_norm(h, g_mix_pre)
    offsets = np.cumsum(IN_SPLITS)[:-1].tolist()
    (gq, gk, gv, gg, ra_f, ra_b, aq, ak, av, gate_a, gate_b) = jnp.split(u @ w_in, offsets, axis=-1)

    qh = gq.astype(f32).reshape(b, s, GLA_HEADS, GLA_DK) * (GLA_DK ** -0.5)
    kh = gk.astype(f32).reshape(b, s, GLA_HEADS, GLA_DK)
    vh = gv.astype(f32).reshape(b, s, GLA_HEADS, GLA_DV)
    la_f = (jax.nn.log_sigmoid(ra_f.astype(f32) @ w_alpha_up[0].astype(f32) + b_alpha[0].astype(f32))
            / GLA_TAU).reshape(b, s, GLA_HEADS, GLA_DK)
    la_b = (jax.nn.log_sigmoid(ra_b.astype(f32) @ w_alpha_up[1].astype(f32) + b_alpha[1].astype(f32))
            / GLA_TAU).reshape(b, s, GLA_HEADS, GLA_DK)
    o_f = gla_chunked(qh, kh, vh, la_f)
    o_b = gla_chunked(qh[:, ::-1], kh[:, ::-1], vh[:, ::-1], la_b[:, ::-1])[:, ::-1]
    o_gla = rms_norm(o_f + o_b, g_gla_out).reshape(b, s, GLA_VAL).astype(h.dtype)
    branch_a = (o_gla * jax.nn.silu(gg)) @ w_o_gla

    q = apply_axial_rope(rms_norm(aq.reshape(b, s, ATTN_HEADS, HEAD_DIM), g_q_norm), cos, sin)
    k = apply_axial_rope(rms_norm(ak.reshape(b, s, ATTN_KV_HEADS, HEAD_DIM), g_k_norm), cos, sin)
    v = av.reshape(b, s, ATTN_KV_HEADS, HEAD_DIM)
    branch_b = gqa_attention(q, k, v) @ w_o_attn

    mixed = jax.nn.sigmoid(gate_a) * branch_a + jax.nn.sigmoid(gate_b) * branch_b
    h = h + rms_norm(mixed @ w_out, g_mix_post)

    gate, up = jnp.split(rms_norm(h, g_ffn_pre) @ w_ffn_in, 2, axis=-1)
    h = h + rms_norm((jax.nn.silu(gate) * up) @ w_ffn_out, g_ffn_post)

    e = p_i @ w_ple_proj
    h = h + rms_norm(jax.nn.sigmoid(h @ w_ple_gate) * e, g_ple_post)
    return h


def setup_inputs(seed: int = 0) -> dict:
    key = jax.random.key(seed)
    ks = jax.random.split(key, 24)
    f32 = jnp.float32

    def w(k, shape, fan_in):
        return jax.random.normal(k, shape, f32) * (fan_in ** -0.5)

    def gain(k, shape):
        return 1.0 + 0.05 * jax.random.normal(k, shape, f32)

    return {
        "x": jax.random.normal(ks[0], (BATCH, SEQ, D_MODEL), f32),
        "p": jax.random.normal(ks[1], (DEPTH, BATCH, SEQ, PLE_DIM), f32),
        "g_mix_pre": gain(ks[2], (DEPTH, D_MODEL)),
        "w_in": w(ks[3], (DEPTH, D_MODEL, IN_WIDTH), D_MODEL),
        "w_alpha_up": w(ks[4], (DEPTH, 2, GLA_RANK, GLA_KEY), GLA_RANK),
        "b_alpha": 1.0 + 0.1 * jax.random.normal(ks[5], (DEPTH, 2, GLA_KEY), f32),
        "g_gla_out": gain(ks[6], (DEPTH, GLA_DV)),
        "g_q_norm": gain(ks[7], (DEPTH, HEAD_DIM)),
        "g_k_norm": gain(ks[8], (DEPTH, HEAD_DIM)),
        "w_o_gla": w(ks[9], (DEPTH, GLA_VAL, D_MODEL), GLA_VAL),
        "w_o_attn": w(ks[10], (DEPTH, ATTN_Q, D_MODEL), ATTN_Q),
        "w_out": w(ks[11], (DEPTH, D_MODEL, D_MODEL), D_MODEL),
        "g_mix_post": gain(ks[12], (DEPTH, D_MODEL)),
        "g_ffn_pre": gain(ks[13], (DEPTH, D_MODEL)),
        "w_ffn_in": w(ks[14], (DEPTH, D_MODEL, 2 * FFN_HIDDEN), D_MODEL),
        "w_ffn_out": w(ks[15], (DEPTH, FFN_HIDDEN, D_MODEL), FFN_HIDDEN),
        "g_ffn_post": gain(ks[16], (DEPTH, D_MODEL)),
        "w_ple_proj": w(ks[17], (DEPTH, PLE_DIM, D_MODEL), PLE_DIM),
        "w_ple_gate": w(ks[18], (DEPTH, D_MODEL, D_MODEL), D_MODEL),
        "g_ple_post": gain(ks[19], (DEPTH, D_MODEL)),
    }


def reference(x, p, g_mix_pre, w_in, w_alpha_up, b_alpha, g_gla_out, g_q_norm, g_k_norm,
              w_o_gla, w_o_attn, w_out, g_mix_post, g_ffn_pre, w_ffn_in, w_ffn_out,
              g_ffn_post, w_ple_proj, w_ple_gate, g_ple_post):
    cos, sin = axial_rope_tables(x.shape[1])
    h = x
    for i in range(DEPTH):
        h = hybrid_layer(h, p[i], cos, sin, g_mix_pre[i], w_in[i], w_alpha_up[i], b_alpha[i],
                         g_gla_out[i], g_q_norm[i], g_k_norm[i], w_o_gla[i], w_o_attn[i],
                         w_out[i], g_mix_post[i], g_ffn_pre[i], w_ffn_in[i], w_ffn_out[i],
                         g_ffn_post[i], w_ple_proj[i], w_ple_gate[i], g_ple_post[i])
    return h
```

```cpp
#include <hip/hip_runtime.h>
#include <hip/hip_bf16.h>
#include <hip/hip_cooperative_groups.h>
#include <cstdio>
#include <cstdint>
namespace cg = cooperative_groups;
#ifndef MK_DEBUG
#define MK_DEBUG 0
#endif
#ifndef MK_PER_PHASE
#define MK_PER_PHASE 0
#endif
__device__ __forceinline__ int opaque_tid() { int t = threadIdx.x; asm volatile("" : "+v"(t)); return t; }
constexpr int TOK = 32768, DM = 1024, SEQ = 4096, NBATCH = 8, DEPTH = 4, INW = 6688, FFH = 2816, PLE = 256;
constexpr int NA_REAL = 3104, NA_PAD = 3328, NB_COLS = 3584;
constexpr float EPS = 1e-6f;
constexpr size_t MiB = 1048576;
constexpr size_t W_INA = 0, W_INB = W_INA + (size_t)NA_PAD * DM * 2, W_OGLA = W_INB + (size_t)NB_COLS * DM * 2, W_OATT = W_OGLA + 2 * MiB, W_OUT = W_OATT + 2 * MiB,
                 W_PG = W_OUT + 2 * MiB, W_FIN = W_PG + 2 * MiB, W_FOUT = W_FIN + (size_t)2 * FFH * DM * 2, W_PP = W_FOUT + (size_t)FFH * DM * 2, W_END = W_PP + (size_t)DM * PLE * 2;
constexpr size_t WS_CTL = 0, WS_W = 4096, WS_R = (WS_W + W_END + 4095) / 4096 * 4096;
constexpr size_t R_Q = 0, R_K = 64 * MiB, R_V = 80 * MiB, R_GA = 96 * MiB, R_GB = 160 * MiB, R_BYTES = 224 * MiB;
constexpr size_t R_GQ = 0, R_GK = 32 * MiB, R_GV = 64 * MiB, R_RA = 128 * MiB;
constexpr size_t WS_GG = WS_R + R_BYTES, WS_OF = WS_GG + 64 * MiB, WS_OB = WS_OF + 64 * MiB, WS_XA = WS_OB + 64 * MiB, WS_PB = WS_XA + 64 * MiB, WS_END = WS_PB + 16 * MiB;
constexpr int NPH_LAYER = 13, NPHASES = 1 + NPH_LAYER * DEPTH;
constexpr int LDS_BYTES = 131072 + 1024;
namespace pg8 {
#define PG8_LAS __attribute__((address_space(3)))
typedef unsigned short bf16_t;
typedef short bf16x8 __attribute__((ext_vector_type(8)));
typedef float f32x4 __attribute__((ext_vector_type(4)));
typedef unsigned u32x4 __attribute__((ext_vector_type(4)));
constexpr int BM = 256, BK = 64, HALF = 128, HTB = HALF * BK * 2  , STAGE_BYTES = 8 * HTB, NXCD = 8, WGM = 8;

__host__ __device__ __forceinline__ int lds_byte(int r, int c) { const int st = (r >> 4) * 2 + (c >> 5), rr = r & 15, cc = c & 31, ob = rr * 64 + cc * 2; return st * 1024 + (ob ^ (((ob >> 9) & 1) << 5)); }
__host__ __device__ __forceinline__ void stage_rc(int b, int& R, int& C) { const int st = b / 1024, sb = b % 1024, swz = sb ^ (((sb >> 9) & 1) << 5); R = (st >> 1) * 16 + swz / 64; C = (st & 1) * 32 + (swz % 64) / 2; }
__host__ __device__ __forceinline__ int perm32(int rho) { const int n = rho >> 4, i = rho & 15; return 8 * (i >> 2) + 4 * n + (i & 3); }

struct Unit { int pm, pn; };
struct Gemm { const bf16_t* A; const bf16_t* Bt; int M, N, K; };

struct StaticOrder {
    int nM, nN, nwg, G, c;
    __host__ __device__ void init(int M, int N, int G_, int c_) { nM = M / BM; nN = N / BM; nwg = nM * nN; G = G_; c = c_; }
    __host__ __device__ bool next(int i, Unit& u) const {
        const long L = (long)i * G + c; if (L >= nwg) return false;
        int wgid = (int)L; { const int q = nwg / NXCD, r = nwg % NXCD, xcd = wgid % NXCD, off = wgid / NXCD; wgid = (xcd < r ? xcd * (q + 1) : r * (q + 1) + (xcd - r) * q) + off; }
        const int nig = WGM * nN, gid = wgid / nig, fm = gid * WGM, gsz = (nM - fm) < WGM ? (nM - fm) : WGM;
        u.pm = fm + ((wgid % nig) % gsz); u.pn = (wgid % nig) / gsz; return true;
    }
    __device__ __forceinline__ void a_ready(const Unit&) const {}
    __device__ __forceinline__ void done(const Unit&) const {}
};
typedef __bf16 bf16x2_t __attribute__((ext_vector_type(2)));
typedef float f32x2_t __attribute__((ext_vector_type(2)));
__device__ __forceinline__ unsigned cvt_pk_bf16(float lo, float hi) { const f32x2_t f = {lo, hi}; const bf16x2_t v = __builtin_convertvector(f, bf16x2_t); return __builtin_bit_cast(unsigned, v); }
__device__ __forceinline__ float bf_lo(unsigned w) { return __builtin_bit_cast(float, w << 16); }
__device__ __forceinline__ float bf_hi(unsigned w) { return __builtin_bit_cast(float, w & 0xffff0000u); }
__device__ __forceinline__ float sigmoidf_(float x) { return __builtin_amdgcn_rcpf(1.0f + __expf(-x)); }
enum { EM_ROUTE_A = 0, EM_ROUTE_B = 1, EM_GATE1 = 2, EM_GATE2 = 3, EM_PLAIN = 4, EM_SWIGLU = 5, EM_PLE2 = 6 };
struct Epi {
    static constexpr bool PERM = true, AFTER_DRAIN = false;
    int mode; unsigned char* rbase; unsigned char* ggbase; bf16_t* out; const bf16_t* aux; unsigned* dbgmark;
    __device__ __forceinline__ void operator()(const f32x4 (&acc)[2][2][4][2], const Unit& u, int wr, int wc, int fr, int fq) const {
        const int row0 = u.pm * BM + wr * 64 + fr, lc0 = wc * 32 + 8 * fq;
#if MK_DEBUG
#endif
        if (mode == EM_SWIGLU) {
#pragma unroll
            for (int ai = 0; ai < 2; ++ai)
#pragma unroll
                for (int m = 0; m < 4; ++m) { const size_t row = (size_t)(row0 + ai * HALF + m * 16);
                    float o[8];
#pragma unroll
                    for (int n = 0; n < 2; ++n)
#pragma unroll
                        for (int j = 0; j < 4; ++j) { const float g = acc[ai][0][m][n][j], up = acc[ai][1][m][n][j]; o[4 * n + j] = g * sigmoidf_(g) * up; }
                    u32x4 w; w.x = cvt_pk_bf16(o[0], o[1]); w.y = cvt_pk_bf16(o[2], o[3]); w.z = cvt_pk_bf16(o[4], o[5]); w.w = cvt_pk_bf16(o[6], o[7]);
                    *(u32x4*)(out + row * 2816 + u.pn * 128 + lc0) = w; }
            return;
        }
        bf16_t* base = out; int ld = 1024, ct = u.pn * BM; bool is_ra = false;
        if (mode == EM_ROUTE_A) { const int pn = u.pn;
            if (pn < 2) { base = (bf16_t*)(rbase + R_GQ); ld = 512; ct = pn * 256; }
            else if (pn < 4) { base = (bf16_t*)(rbase + R_GK); ld = 512; ct = (pn - 2) * 256; }
            else if (pn < 8) { base = (bf16_t*)(rbase + R_GV); ld = 1024; ct = (pn - 4) * 256; }
            else if (pn < 12) { base = (bf16_t*)ggbase; ld = 1024; ct = (pn - 8) * 256; }
            else is_ra = true;
        } else if (mode == EM_ROUTE_B) { const int pn = u.pn;
            if (pn < 4) { base = (bf16_t*)(rbase + R_Q); ld = 1024; ct = pn * 256; }
            else if (pn == 4) { base = (bf16_t*)(rbase + R_K); ld = 256; ct = 0; }
            else if (pn == 5) { base = (bf16_t*)(rbase + R_V); ld = 256; ct = 0; }
            else if (pn < 10) { base = (bf16_t*)(rbase + R_GA); ld = 1024; ct = (pn - 6) * 256; }
            else { base = (bf16_t*)(rbase + R_GB); ld = 1024; ct = (pn - 10) * 256; }
        }
        if (is_ra) {
            if (wc == 0) { float* ra = (float*)(rbase + R_RA);
#pragma unroll
                for (int ai = 0; ai < 2; ++ai)
#pragma unroll
                    for (int m = 0; m < 4; ++m) { const size_t row = (size_t)(row0 + ai * HALF + m * 16);
                        *(f32x4*)(ra + row * 32 + 8 * fq) = acc[ai][0][m][0]; *(f32x4*)(ra + row * 32 + 8 * fq + 4) = acc[ai][0][m][1]; } }
            return;
        }
#pragma unroll
        for (int ai = 0; ai < 2; ++ai)
#pragma unroll
            for (int m = 0; m < 4; ++m) { const size_t row = (size_t)(row0 + ai * HALF + m * 16);
#pragma unroll
                for (int bj = 0; bj < 2; ++bj) { const int col = ct + bj * HALF + lc0;
                    float o[8];
#pragma unroll
                    for (int n = 0; n < 2; ++n)
#pragma unroll
                        for (int j = 0; j < 4; ++j) o[4 * n + j] = acc[ai][bj][m][n][j];
                    if (mode == EM_GATE1 || mode == EM_GATE2 || mode == EM_PLE2) {
                        const u32x4 a = *(const u32x4*)(aux + row * 1024 + col);
                        const float av[8] = {bf_lo(a.x), bf_hi(a.x), bf_lo(a.y), bf_hi(a.y), bf_lo(a.z), bf_hi(a.z), bf_lo(a.w), bf_hi(a.w)};
                        if (mode == EM_PLE2) {
#pragma unroll
                            for (int j = 0; j < 8; ++j) o[j] = sigmoidf_(o[j]) * av[j];
                        } else {
#pragma unroll
                            for (int j = 0; j < 8; ++j) o[j] = sigmoidf_(av[j]) * o[j];
                            if (mode == EM_GATE2) { const u32x4 p = *(const u32x4*)(base + row * ld + col);
                                o[0] += bf_lo(p.x); o[1] += bf_hi(p.x); o[2] += bf_lo(p.y); o[3] += bf_hi(p.y); o[4] += bf_lo(p.z); o[5] += bf_hi(p.z); o[6] += bf_lo(p.w); o[7] += bf_hi(p.w); }
                        }
                    }
                    u32x4 w; w.x = cvt_pk_bf16(o[0], o[1]); w.y = cvt_pk_bf16(o[2], o[3]); w.z = cvt_pk_bf16(o[4], o[5]); w.w = cvt_pk_bf16(o[6], o[7]);
                    *(u32x4*)(base + row * ld + col) = w;
#if MK_DEBUG
                    if (dbgmark && ai == 0 && m == 0 && bj == 0 && wr == 0 && wc == 0 && fr == 0 && fq == 0) { unsigned* mk = dbgmark + (u.pm * 32 + u.pn) * 4; const unsigned long long ad = (unsigned long long)(base + row * ld + col);
                        mk[0] = (unsigned)ad; mk[1] = (unsigned)(ad >> 32); mk[2] = w.x; mk[3] = 1u; }
#endif
                    } }
    }
};
template <class Epi, class Sched, bool ALIGN_EPI = false, bool SP2 = false>
__device__ __forceinline__ void gemm_phase(PG8_LAS unsigned char* lds, const Gemm g, const Sched& S, const Epi& E) {
    const int tid = opaque_tid(), wid = __builtin_amdgcn_readfirstlane(tid >> 6), lane = tid & 63, wr = wid >> 2, wc = wid & 3, fr = lane & 15, fq = lane >> 4;
    const int K = g.K, nt = K / BK;
    unsigned voffA[2], voffB[2];
#pragma unroll
    for (int i = 0; i < 2; ++i) { int R, C; stage_rc(tid * 16 + i * 8192, R, C); const int Rb = Epi::PERM ? ((R & ~31) + perm32(R & 31)) : R;
        voffA[i] = (unsigned)(R * K + C) * 2u; voffB[i] = (unsigned)(Rb * K + C) * 2u; }
    const size_t kstep = (size_t)(BK * 2);
    const size_t hstep = (size_t)HALF * K * 2;
    const size_t tstep = 2 * hstep;
    const unsigned ldsw = (unsigned)wid * 1024u;
    const int aoff = lds_byte(wr * 64 + fr, fq * 8), boff = lds_byte(wc * 32 + fr, fq * 8);
#define PG8_SA(b, h) (((b) * 2 + (h)) * HTB)
#define PG8_SB(b, h) ((4 + (b) * 2 + (h)) * HTB)
#define PG8_STAGE(bufoff, gbase, voff) do { _Pragma("unroll") for (int _i = 0; _i < 2; ++_i) \
        __builtin_amdgcn_global_load_lds((const unsigned*)((const char*)(gbase) + (voff)[_i]), (PG8_LAS unsigned*)(lds + (bufoff) + ldsw + _i * 8192), 16, 0, 0); } while (0)
#define PG8_LDA(dst, b, h) do { _Pragma("unroll") for (int m = 0; m < 4; ++m) _Pragma("unroll") for (int k = 0; k < 2; ++k) dst[m][k] = *(const PG8_LAS bf16x8*)(lds + PG8_SA(b, h) + aoff + m * 2048 + k * 1024); } while (0)
#define PG8_LDB(dst, b, h) do { _Pragma("unroll") for (int n = 0; n < 2; ++n) _Pragma("unroll") for (int k = 0; k < 2; ++k) dst[n][k] = *(const PG8_LAS bf16x8*)(lds + PG8_SB(b, h) + boff + n * 2048 + k * 1024); } while (0)
#define PG8_MMA(ai, bj, At, Bt) do { __builtin_amdgcn_s_setprio(1); _Pragma("unroll") for (int m = 0; m < 4; ++m) _Pragma("unroll") for (int n = 0; n < 2; ++n) _Pragma("unroll") for (int k = 0; k < 2; ++k) \
        acc[ai][bj][m][n] = __builtin_amdgcn_mfma_f32_16x16x32_bf16(Bt[n][k], At[m][k], acc[ai][bj][m][n], 0, 0, 0); __builtin_amdgcn_s_setprio(0); } while (0)
#define PG8_WAIT_V(n) asm volatile("s_waitcnt vmcnt(" #n ")" ::: "memory")
#define PG8_WAIT_L(n) asm volatile("s_waitcnt lgkmcnt(" #n ")" ::: "memory")
#define PG8_BAR __builtin_amdgcn_s_barrier()
#define PG8_SCHED __builtin_amdgcn_sched_barrier(0)
    Unit cur, nxt; int ui = 0;
    if (!S.next(0, cur)) return;
    f32x4 acc[2][2][4][2];
#pragma unroll
    for (int a = 0; a < 2; ++a)
#pragma unroll
        for (int b = 0; b < 2; ++b)
#pragma unroll
            for (int m = 0; m < 4; ++m)
#pragma unroll
                for (int n = 0; n < 2; ++n) acc[a][b][m][n] = (f32x4){0.f, 0.f, 0.f, 0.f};
    bf16x8 At[4][2], B0[2][2], B1[2][2];
    const char* cA = (const char*)g.A + (size_t)cur.pm * tstep; const char* cB = (const char*)g.Bt + (size_t)cur.pn * tstep;
    S.a_ready(cur);
    if constexpr (SP2) {
        PG8_STAGE(PG8_SB(0, 0), cB, voffB); PG8_STAGE(PG8_SB(0, 1), cB + hstep, voffB); PG8_STAGE(PG8_SA(0, 0), cA, voffA); PG8_STAGE(PG8_SA(0, 1), cA + hstep, voffA);
        if (wr == 1) PG8_BAR;
        PG8_WAIT_V(2); PG8_BAR;
        PG8_STAGE(PG8_SB(1, 0), cB + kstep, voffB); PG8_STAGE(PG8_SA(1, 0), cA + kstep, voffA); PG8_STAGE(PG8_SB(1, 1), cB + hstep + kstep, voffB);
        PG8_WAIT_V(6); PG8_BAR;
    } else {
        PG8_STAGE(PG8_SB(0, 0), cB, voffB); PG8_STAGE(PG8_SA(0, 0), cA, voffA); PG8_STAGE(PG8_SB(0, 1), cB + hstep, voffB); PG8_STAGE(PG8_SA(0, 1), cA + hstep, voffA);
        if (wr == 1) PG8_BAR;
        PG8_WAIT_V(4); PG8_BAR;
        PG8_STAGE(PG8_SB(1, 0), cB + kstep, voffB); PG8_STAGE(PG8_SA(1, 0), cA + kstep, voffA); PG8_STAGE(PG8_SB(1, 1), cB + hstep + kstep, voffB);
        PG8_WAIT_V(6); PG8_BAR;
    }
    for (;;) {
        const bool has_next = S.next(ui + 1, nxt);
        const char* nA = has_next ? (const char*)g.A + (size_t)nxt.pm * tstep : cA; const char* nB = has_next ? (const char*)g.Bt + (size_t)nxt.pn * tstep : cB;
        for (int t = 0; t < nt; t += 2) {
            const bool last = (t == nt - 2);
            const char* a1 = cA + (size_t)(t + 1) * kstep;
            const char* a2 = last ? nA : cA + (size_t)(t + 2) * kstep; const char* b2 = last ? nB : cB + (size_t)(t + 2) * kstep;
            const char* a3 = a2 + kstep; const char* b3 = b2 + kstep;
            if (last && has_next) S.a_ready(nxt);
            if constexpr (SP2) {
            PG8_LDB(B0, 0, 0); PG8_LDB(B1, 0, 1); PG8_SCHED; PG8_LDA(At, 0, 0); PG8_STAGE(PG8_SA(1, 1), a1 + hstep, voffA);
            PG8_WAIT_V(8); PG8_WAIT_L(0); PG8_BAR; PG8_MMA(0, 0, At, B0); PG8_MMA(0, 1, At, B1); PG8_BAR; PG8_SCHED;
            PG8_LDA(At, 0, 1); PG8_STAGE(PG8_SB(0, 0), b2, voffB); PG8_STAGE(PG8_SB(0, 1), b2 + hstep, voffB); PG8_STAGE(PG8_SA(0, 0), a2, voffA);
            PG8_WAIT_V(8); PG8_WAIT_L(0); PG8_BAR; PG8_MMA(1, 0, At, B0); PG8_MMA(1, 1, At, B1); PG8_BAR; PG8_SCHED;
            PG8_LDB(B0, 1, 0); PG8_LDB(B1, 1, 1); PG8_SCHED; PG8_LDA(At, 1, 0); PG8_STAGE(PG8_SA(0, 1), a2 + hstep, voffA);
            PG8_WAIT_V(8); PG8_WAIT_L(0); PG8_BAR; PG8_MMA(0, 0, At, B0); PG8_MMA(0, 1, At, B1); PG8_BAR; PG8_SCHED;
            PG8_LDA(At, 1, 1); PG8_STAGE(PG8_SB(1, 0), b3, voffB); PG8_STAGE(PG8_SB(1, 1), b3 + hstep, voffB); PG8_STAGE(PG8_SA(1, 0), a3, voffA);
            PG8_WAIT_V(8); PG8_WAIT_L(0); PG8_BAR; PG8_MMA(1, 0, At, B0); PG8_MMA(1, 1, At, B1); PG8_BAR; PG8_SCHED;
            } else {
            PG8_LDB(B0, 0, 0); PG8_SCHED; PG8_LDA(At, 0, 0); PG8_STAGE(PG8_SA(1, 1), a1 + hstep, voffA);
            PG8_WAIT_L(8); PG8_BAR; PG8_WAIT_L(0); PG8_MMA(0, 0, At, B0); PG8_BAR; PG8_SCHED;
            PG8_LDB(B1, 0, 1); PG8_STAGE(PG8_SB(0, 0), b2, voffB);
            PG8_BAR; PG8_WAIT_L(0); PG8_MMA(0, 1, At, B1); PG8_BAR;
            PG8_LDA(At, 0, 1); PG8_STAGE(PG8_SA(0, 0), a2, voffA);
            PG8_BAR; PG8_WAIT_L(0); PG8_MMA(1, 0, At, B0); PG8_BAR; PG8_SCHED;
            PG8_STAGE(PG8_SB(0, 1), b2 + hstep, voffB);
            PG8_WAIT_V(6); PG8_BAR; PG8_MMA(1, 1, At, B1); PG8_BAR;
            PG8_LDB(B0, 1, 0); PG8_SCHED; PG8_LDA(At, 1, 0); PG8_STAGE(PG8_SA(0, 1), a2 + hstep, voffA);
            PG8_WAIT_L(8); PG8_BAR; PG8_WAIT_L(0); PG8_MMA(0, 0, At, B0); PG8_BAR; PG8_SCHED;
            PG8_LDB(B1, 1, 1); PG8_STAGE(PG8_SB(1, 0), b3, voffB);
            PG8_BAR; PG8_WAIT_L(0); PG8_MMA(0, 1, At, B1); PG8_BAR;
            PG8_LDA(At, 1, 1); PG8_STAGE(PG8_SA(1, 0), a3, voffA);
            PG8_BAR; PG8_WAIT_L(0); PG8_MMA(1, 0, At, B0); PG8_BAR; PG8_SCHED;
            PG8_STAGE(PG8_SB(1, 1), b3 + hstep, voffB);
            PG8_WAIT_V(6); PG8_BAR; PG8_MMA(1, 1, At, B1); PG8_BAR;
            }
        }
        if constexpr (ALIGN_EPI) { if (wr == 0) PG8_BAR; }
        if constexpr (!Epi::AFTER_DRAIN) { E(acc, cur, wr, wc, fr, fq); S.done(cur); }
        if (!has_next) break;
#pragma unroll
        for (int a = 0; a < 2; ++a)
#pragma unroll
            for (int b = 0; b < 2; ++b)
#pragma unroll
                for (int m = 0; m < 4; ++m)
#pragma unroll
                    for (int n = 0; n < 2; ++n) acc[a][b][m][n] = (f32x4){0.f, 0.f, 0.f, 0.f};
        cur = nxt; cA = nA; cB = nB; ++ui;
        if constexpr (ALIGN_EPI) { if (wr == 1) PG8_BAR; }
    }
    PG8_WAIT_V(0);
    if constexpr (!ALIGN_EPI) { if (wr == 0) PG8_BAR; }
    PG8_BAR;
    if constexpr (Epi::AFTER_DRAIN) { E.fused(acc, cur, wr, wc, fr, fq, lds, wid, lane); S.done(cur); }
#undef PG8_SA
#undef PG8_SB
#undef PG8_STAGE
#undef PG8_LDA
#undef PG8_LDB
#undef PG8_MMA
#undef PG8_WAIT_V
#undef PG8_WAIT_L
#undef PG8_BAR
#undef PG8_SCHED
}
}
namespace attn {
using bf16 = __hip_bfloat16;
constexpr int   D = 128, NW = 8, QBLK = 32, KVBLK = 64;
constexpr float SCALE = 0.088388347648318440f;
constexpr float THR = 8.f;
constexpr int SDEPTH = 2;
constexpr int LDQ = 1024, LDK = 256, LDO = 1024;
constexpr size_t SHM_V = KVBLK * D * 2, SHM_K = KVBLK * D * 2, SHM_ATTN = 2 * SHM_V + 2 * SHM_K + NW * 64 * 4;
using bf16x8 = __attribute__((ext_vector_type(8))) short;
using s16x4  = __attribute__((ext_vector_type(4))) short;
using f32x16 = __attribute__((ext_vector_type(16))) float;
using f32x8  = __attribute__((ext_vector_type(8))) float;
using u32x4  = __attribute__((ext_vector_type(4))) unsigned;
#define KSWZ(row, colB) ((row) * 256 + ((colB) ^ (((row) & 7) << 4)))
#define SBAR() __builtin_amdgcn_sched_barrier(0)
__device__ __forceinline__ int crow(int r, int hi) { return (r & 3) + 8 * (r >> 2) + 4 * hi; }
__device__ __forceinline__ unsigned cvtpk(float lo, float hi) {
  unsigned r; asm volatile("v_cvt_pk_bf16_f32 %0, %1, %2" : "=v"(r) : "v"(lo), "v"(hi)); return r;
}
template <typename TIn> struct Stage;
template <> struct Stage<bf16>  { using T = bf16x8;
  __device__ static __forceinline__ T ld8(const bf16* p) { return *reinterpret_cast<const bf16x8*>(p); }
  __device__ static __forceinline__ bf16x8 tobf(T x) { return x; } };
template <> struct Stage<float> { using T = f32x8;
  __device__ static __forceinline__ T ld8(const float* p) { return *reinterpret_cast<const f32x8*>(p); }
  __device__ static __forceinline__ bf16x8 tobf(T x) {
    u32x4 w = {cvtpk(x[0], x[1]), cvtpk(x[2], x[3]), cvtpk(x[4], x[5]), cvtpk(x[6], x[7])}; return *reinterpret_cast<bf16x8*>(&w); } };

__device__ __forceinline__ void partialSM(f32x16& p0, f32x16& p1, float& m_reg, float& mn, float& alpha) {
  constexpr float C = SCALE * 1.4426950408889634f;
  float pmax = p0[0]; for (int r = 1; r < 16; ++r) pmax = fmaxf(pmax, p0[r]); for (int r = 0; r < 16; ++r) pmax = fmaxf(pmax, p1[r]);
  { auto rr = __builtin_amdgcn_permlane32_swap(__float_as_uint(pmax), __float_as_uint(pmax), false, false);
    pmax = fmaxf(__uint_as_float(rr[0]), __uint_as_float(rr[1])); }
  if (__builtin_expect(__all(pmax - m_reg <= THR / SCALE), 1)) { mn = m_reg; alpha = 1.f; }
  else { mn = fmaxf(m_reg, pmax); alpha = __builtin_amdgcn_exp2f((m_reg - mn) * C); m_reg = mn; }
  float mnC = -mn * C;
  for (int r = 0; r < 16; ++r) p0[r] = fmaf(p0[r], C, mnC); for (int r = 0; r < 16; ++r) p1[r] = fmaf(p1[r], C, mnC);
  for (int r = 0; r < 16; ++r) p0[r] = __builtin_amdgcn_exp2f(p0[r]);
}
__device__ __forceinline__ void finishSM(f32x16& p0, f32x16& p1, float alpha, float& l_reg, bf16x8& pa0, bf16x8& pa1, bf16x8& pa2, bf16x8& pa3) {
  for (int r = 0; r < 16; ++r) p1[r] = __builtin_amdgcn_exp2f(p1[r]);
  float ps = 0; for (int r = 0; r < 16; ++r) ps += p0[r]; for (int r = 0; r < 16; ++r) ps += p1[r];
  { auto rr = __builtin_amdgcn_permlane32_swap(__float_as_uint(ps), __float_as_uint(ps), false, false);
    ps = __uint_as_float(rr[0]) + __uint_as_float(rr[1]); }
  l_reg = l_reg * alpha + ps;
#define PK4(P, BASE, OUT) do { unsigned a0 = cvtpk(P[BASE + 0], P[BASE + 1]), a1 = cvtpk(P[BASE + 2], P[BASE + 3]);   \
    unsigned b0 = cvtpk(P[BASE + 4], P[BASE + 5]), b1 = cvtpk(P[BASE + 6], P[BASE + 7]);                              \
    auto r0 = __builtin_amdgcn_permlane32_swap(a0, b0, false, false); auto r1 = __builtin_amdgcn_permlane32_swap(a1, b1, false, false); \
    u32x4 w = {r0[0], r1[0], r0[1], r1[1]}; OUT = *reinterpret_cast<bf16x8*>(&w); } while (0)
  PK4(p0, 0, pa0); PK4(p0, 8, pa1); PK4(p1, 0, pa2); PK4(p1, 8, pa3);
#undef PK4
}
__device__ __forceinline__ void qkt(f32x16& p0, f32x16& p1, const bf16* Ks, const bf16x8* qr, int r32, int hi) {
  p0 = f32x16{}; p1 = f32x16{};
  for (int d0 = 0; d0 < 8; ++d0) { int cb = (d0 * 16 + hi * 8) * 2;
    bf16x8 b0 = *reinterpret_cast<const bf16x8*>((const char*)Ks + KSWZ(r32, cb));
    bf16x8 b1 = *reinterpret_cast<const bf16x8*>((const char*)Ks + KSWZ(32 + r32, cb));
    p0 = __builtin_amdgcn_mfma_f32_32x32x16_bf16(b0, qr[d0], p0, 0, 0, 0);
    p1 = __builtin_amdgcn_mfma_f32_32x32x16_bf16(b1, qr[d0], p1, 0, 0, 0); }
}
__device__ __forceinline__ int v_st(int k, int c) { const int kk = (k & ~0xC) | ((k & 4) << 1) | ((k & 8) >> 1); return ((kk >> 3) * 4 + (c >> 5)) * 512 + ((kk & 7) * 32 + (c & 31)) * 2; }
__device__ __forceinline__ int v_rd_base(int lane) { return ((lane & 3) << 3) | (((lane >> 2) & 3) << 6) | (((lane >> 4) & 1) << 5) | (((lane >> 5) & 1) << 8); }
constexpr int v_rd_off(int d0, int ks, int half) { return d0 * 512 + ks * 4096 + half * 2048; }
template <int OFF> __device__ __forceinline__ s16x4 tr_read(int vb) {
  s16x4 r; asm volatile("ds_read_b64_tr_b16 %0, %1 offset:%2" : "=&v"(r) : "v"(vb), "i"(OFF) : "memory"); return r;
}
template <int D0> __device__ __forceinline__ void pv_one(f32x16& od, int vb, bf16x8 pa0, bf16x8 pa1, bf16x8 pa2, bf16x8 pa3) {
  const s16x4 l0 = tr_read<v_rd_off(D0, 0, 0)>(vb), h0 = tr_read<v_rd_off(D0, 0, 1)>(vb), l1 = tr_read<v_rd_off(D0, 1, 0)>(vb), h1 = tr_read<v_rd_off(D0, 1, 1)>(vb);
  const s16x4 l2 = tr_read<v_rd_off(D0, 2, 0)>(vb), h2 = tr_read<v_rd_off(D0, 2, 1)>(vb), l3 = tr_read<v_rd_off(D0, 3, 0)>(vb), h3 = tr_read<v_rd_off(D0, 3, 1)>(vb);
  asm volatile("s_waitcnt lgkmcnt(0)" ::: "memory"); SBAR();
#define PK(L, H) (bf16x8){L[0], L[1], L[2], L[3], H[0], H[1], H[2], H[3]}
  od = __builtin_amdgcn_mfma_f32_32x32x16_bf16(pa0, PK(l0, h0), od, 0, 0, 0);
  od = __builtin_amdgcn_mfma_f32_32x32x16_bf16(pa1, PK(l1, h1), od, 0, 0, 0);
  od = __builtin_amdgcn_mfma_f32_32x32x16_bf16(pa2, PK(l2, h2), od, 0, 0, 0);
  od = __builtin_amdgcn_mfma_f32_32x32x16_bf16(pa3, PK(l3, h3), od, 0, 0, 0);
#undef PK
}
__device__ __forceinline__ void pv_d0(f32x16* o, int vb, bf16x8 pa0, bf16x8 pa1, bf16x8 pa2, bf16x8 pa3) {
  pv_one<0>(o[0], vb, pa0, pa1, pa2, pa3); pv_one<1>(o[1], vb, pa0, pa1, pa2, pa3); pv_one<2>(o[2], vb, pa0, pa1, pa2, pa3); pv_one<3>(o[3], vb, pa0, pa1, pa2, pa3);
}

template <typename TQ>
__device__ __forceinline__ void attn_dense_body(const TQ* Qb, const bf16* Kh, const bf16* Vh,
                                                unsigned short* Ob, int seq, char* lds) {
  using St = Stage<bf16>; using SQ = Stage<TQ>;
  const int tid = opaque_tid(), wid = tid >> 6, lane = tid & 63, r32 = lane & 31, hi = lane >> 5;
  bf16* V_lds = (bf16*)lds; bf16* K_lds = (bf16*)(lds + 2 * SHM_V);
  float* ws = (float*)(lds + 2 * SHM_V + 2 * SHM_K) + wid * 64; float* li_l = ws; float* al_l = ws + 32;
  float m_reg = -1e30f, l_reg = 0; f32x16 o[4] = {}; bf16x8 qr[8];
  const TQ* Qw = Qb + (long)(wid * QBLK + r32) * LDQ + hi * 8;
#pragma unroll
  for (int d0 = 0; d0 < 8; ++d0) qr[d0] = SQ::tobf(SQ::ld8(Qw + d0 * 16));
  const int sr = tid >> 4, sc = (tid & 15) * 8, vst0 = v_st(sr, sc), vst1 = v_st(32 + sr, sc);
  const int vb0 = (int)(uintptr_t)V_lds + v_rd_base(lane);
  struct { typename St::T vs0, vs1, ks0, ks1; } sr_[SDEPTH];
#define SLOAD(i, k0) do { sr_[i].vs0 = St::ld8(&Vh[(long)((k0) + sr) * LDK + sc]); sr_[i].vs1 = St::ld8(&Vh[(long)((k0) + 32 + sr) * LDK + sc]); \
    sr_[i].ks0 = St::ld8(&Kh[(long)((k0) + sr) * LDK + sc]); sr_[i].ks1 = St::ld8(&Kh[(long)((k0) + 32 + sr) * LDK + sc]); } while (0)
#define SWRITE(b, i) do { *(bf16x8*)((char*)V_lds + (b) * SHM_V + vst0) = St::tobf(sr_[i].vs0);          \
    *(bf16x8*)((char*)V_lds + (b) * SHM_V + vst1) = St::tobf(sr_[i].vs1); int kc = sc * 2;               \
    *(bf16x8*)((char*)K_lds + (b) * SHM_K + KSWZ(sr, kc)) = St::tobf(sr_[i].ks0);                       \
    *(bf16x8*)((char*)K_lds + (b) * SHM_K + KSWZ(32 + sr, kc)) = St::tobf(sr_[i].ks1); } while (0)
#define SWAIT() do { if constexpr (SDEPTH == 2) asm volatile("s_waitcnt vmcnt(4)" ::: "memory"); else asm volatile("s_waitcnt vmcnt(0)" ::: "memory"); } while (0)
#define RESC(a) do { if (__any((a) < 1.f)) { if (hi == 0) al_l[r32] = (a); asm volatile("s_waitcnt lgkmcnt(0)" ::: "memory"); \
    for (int d = 0; d < 4; ++d) for (int r = 0; r < 16; ++r) o[d][r] *= al_l[crow(r, hi)]; } } while (0)
  f32x16 pA0, pA1, pB0, pB1; float mnA, mnB, alA, alB; bf16x8 pa0, pa1, pa2, pa3; const int NT = seq / KVBLK;
  constexpr int SE = 0, SO = SDEPTH - 1;
  SLOAD(SE, 0); asm volatile("s_waitcnt vmcnt(0)" ::: "memory"); SWRITE(0, SE); __syncthreads();
  qkt(pA0, pA1, K_lds, qr, r32, hi); partialSM(pA0, pA1, m_reg, mnA, alA);
  SLOAD(SO, KVBLK); if constexpr (SDEPTH == 2) { if (2 < NT) SLOAD(SE, 2 * KVBLK); }
  SWAIT(); SWRITE(1, SO); __syncthreads();
  for (int j = 1; j + 1 < NT; j += 2) {
    SBAR(); qkt(pB0, pB1, (bf16*)((char*)K_lds + SHM_K), qr, r32, hi);
    finishSM(pA0, pA1, alA, l_reg, pa0, pa1, pa2, pa3); SBAR();
    SLOAD(SO, (j + SDEPTH) * KVBLK); SBAR();
    pv_d0(o, vb0, pa0, pa1, pa2, pa3); partialSM(pB0, pB1, m_reg, mnB, alB);
    __syncthreads(); SWAIT(); SWRITE(0, SE);
    RESC(alB); __syncthreads();
    SBAR(); qkt(pA0, pA1, K_lds, qr, r32, hi);
    finishSM(pB0, pB1, alB, l_reg, pa0, pa1, pa2, pa3); SBAR();
    if (SDEPTH == 1 || j + 3 < NT) SLOAD(SE, (j + 1 + SDEPTH) * KVBLK); SBAR();
    pv_d0(o, vb0 + (int)SHM_V, pa0, pa1, pa2, pa3); partialSM(pA0, pA1, m_reg, mnA, alA);
    __syncthreads(); SWAIT(); SWRITE(1, SO);
    RESC(alA); __syncthreads();
  }
  SBAR(); qkt(pB0, pB1, (bf16*)((char*)K_lds + SHM_K), qr, r32, hi);
  finishSM(pA0, pA1, alA, l_reg, pa0, pa1, pa2, pa3); SBAR();
  pv_d0(o, vb0, pa0, pa1, pa2, pa3); partialSM(pB0, pB1, m_reg, mnB, alB);
  __syncthreads(); RESC(alB);
  finishSM(pB0, pB1, alB, l_reg, pa0, pa1, pa2, pa3); SBAR();
  pv_d0(o, vb0 + (int)SHM_V, pa0, pa1, pa2, pa3);
  if (hi == 0) li_l[r32] = l_reg; asm volatile("s_waitcnt lgkmcnt(0)" ::: "memory");
  float rli[16];
#pragma unroll
  for (int r = 0; r < 16; ++r) rli[r] = __builtin_amdgcn_rcpf(li_l[crow(r, hi)]);
  unsigned short* Ow = Ob + (long)(wid * QBLK) * LDO;
#pragma unroll
  for (int r = 0; r < 16; ++r) { int orow = crow(r, hi);
    for (int d0 = 0; d0 < 4; ++d0) Ow[(long)orow * LDO + d0 * 32 + r32] = (unsigned short)(cvtpk(o[d0][r] * rli[r], 0.f) & 0xffffu); }
#undef SLOAD
#undef SWRITE
#undef SWAIT
#undef RESC
}
}
#define LAS __attribute__((address_space(3)))
typedef unsigned short bf16_t;
typedef float f32x4 __attribute__((ext_vector_type(4)));
typedef float f32x2 __attribute__((ext_vector_type(2)));
typedef unsigned u32x4 __attribute__((ext_vector_type(4)));
typedef unsigned u32x2 __attribute__((ext_vector_type(2)));
typedef short bf16x8 __attribute__((ext_vector_type(8)));
typedef short s16x4 __attribute__((ext_vector_type(4)));
#define LDS_WAIT() asm volatile("s_waitcnt lgkmcnt(0)" ::: "memory")
using pg8::cvt_pk_bf16; using pg8::bf_lo; using pg8::bf_hi; using pg8::sigmoidf_;

__device__ __forceinline__ float wave_sum(float v) {
#pragma unroll
    for (int o = 1; o < 64; o <<= 1) v += __shfl_xor(v, o);
    return v;
}

__device__ __forceinline__ void transpose_item(const float* __restrict__ W, int ldW, int K, int src_n0, int k0, bf16_t* WT, int dst_row0, LAS float* scr, int lane) {
#pragma unroll 8
    for (int i = 0; i < 32; ++i) { const int kk = 2 * i + (lane >> 5); scr[kk * 33 + (lane & 31)] = W[(size_t)(k0 + kk) * ldW + src_n0 + (lane & 31)]; }
    LDS_WAIT(); asm volatile("" ::: "memory");
    const int c = lane & 7;
#pragma unroll
    for (int j = 0; j < 4; ++j) { const int n = (lane >> 3) + 8 * j; const LAS float* s = scr + (8 * c) * 33 + n;
        u32x4 o; o.x = cvt_pk_bf16(s[0 * 33], s[1 * 33]); o.y = cvt_pk_bf16(s[2 * 33], s[3 * 33]); o.z = cvt_pk_bf16(s[4 * 33], s[5 * 33]); o.w = cvt_pk_bf16(s[6 * 33], s[7 * 33]);
        *(u32x4*)(WT + (size_t)(dst_row0 + n) * K + k0 + 8 * c) = o; }
    LDS_WAIT(); asm volatile("" ::: "memory");
}

struct Args { const float* in[20]; float* out; unsigned char* ws; int ph_lo, ph_hi; };
typedef const __attribute__((address_space(4))) Args* KA;

__device__ __forceinline__ void prep_layer(KA a, int L, LAS unsigned char* lds, int gw, int NGW, int wave, int lane) {
    LAS float* scr = (LAS float*)(lds + wave * 8448);
    unsigned char* wsW = a->ws + WS_W;
    const float* w_in = a->in[3] + (size_t)L * DM * INW;
    const float* w_ogla = a->in[9] + (size_t)L * DM * DM; const float* w_oatt = a->in[10] + (size_t)L * DM * DM; const float* w_out = a->in[11] + (size_t)L * DM * DM;
    const float* w_fin = a->in[14] + (size_t)L * DM * 2 * FFH; const float* w_fout = a->in[15] + (size_t)L * FFH * DM;
    const float* w_pp = a->in[17] + (size_t)L * PLE * DM; const float* w_pg = a->in[18] + (size_t)L * DM * DM;
    constexpr int I_A = 16 * 97, I_B = 16 * 112, I_SQ = 16 * 32, I_FI = 16 * 176, I_FO = 44 * 32, I_PP = 4 * 32;
    constexpr int NITEMS = I_A + I_B + 4 * I_SQ + I_FI + I_FO + I_PP;
    for (int it = gw; it < NITEMS; it += NGW) {
        int r = it;
        if (r < I_A) { const int kb = r / 97, nb = r % 97; transpose_item(w_in, INW, DM, 32 * nb, 64 * kb, (bf16_t*)(wsW + W_INA), 32 * nb, scr, lane); continue; } r -= I_A;
        if (r < I_B) { const int kb = r / 112, nb = r % 112; transpose_item(w_in, INW, DM, NA_REAL + 32 * nb, 64 * kb, (bf16_t*)(wsW + W_INB), 32 * nb, scr, lane); continue; } r -= I_B;
        if (r < 4 * I_SQ) { const int which = r / I_SQ, q = r % I_SQ, kb = q / 32, nb = q % 32;
            const float* src = which == 0 ? w_ogla : which == 1 ? w_oatt : which == 2 ? w_out : w_pg;
            const size_t dsto = which == 0 ? W_OGLA : which == 1 ? W_OATT : which == 2 ? W_OUT : W_PG;
            transpose_item(src, DM, DM, 32 * nb, 64 * kb, (bf16_t*)(wsW + dsto), 32 * nb, scr, lane); continue; } r -= 4 * I_SQ;
        if (r < I_FI) { const int kb = r / 176, nb = r % 176; const int n0 = 32 * nb; const int j = n0 < FFH ? n0 : n0 - FFH; const int dst = (j >> 7) * 256 + (n0 < FFH ? 0 : 128) + (j & 127);
            transpose_item(w_fin, 2 * FFH, DM, n0, 64 * kb, (bf16_t*)(wsW + W_FIN), dst, scr, lane); continue; } r -= I_FI;
        if (r < I_FO) { const int kb = r / 32, nb = r % 32; transpose_item(w_fout, DM, FFH, 32 * nb, 64 * kb, (bf16_t*)(wsW + W_FOUT), 32 * nb, scr, lane); continue; } r -= I_FO;
        { const int kb = r / 32, nb = r % 32; transpose_item(w_pp, DM, PLE, 32 * nb, 64 * kb, (bf16_t*)(wsW + W_PP), 32 * nb, scr, lane); }
    }
    { u32x4* z = (u32x4*)(wsW + W_INA + (size_t)NA_REAL * DM * 2); const int nz = (NA_PAD - NA_REAL) * DM * 2 / 16;
      for (int i = gw * 64 + lane; i < nz; i += NGW * 64) z[i] = (u32x4){0u, 0u, 0u, 0u}; }
    { const float* p = a->in[1] + (size_t)L * TOK * PLE; bf16_t* pb = (bf16_t*)(a->ws + WS_PB); const int n8 = TOK * PLE / 8;
      for (int i = gw * 64 + lane; i < n8; i += NGW * 64) { const f32x4 x0 = *(const f32x4*)(p + (size_t)i * 8), x1 = *(const f32x4*)(p + (size_t)i * 8 + 4);
          u32x4 o; o.x = cvt_pk_bf16(x0[0], x0[1]); o.y = cvt_pk_bf16(x0[2], x0[3]); o.z = cvt_pk_bf16(x1[0], x1[1]); o.w = cvt_pk_bf16(x1[2], x1[3]); *(u32x4*)(pb + (size_t)i * 8) = o; } }
}

__device__ __forceinline__ void row_pass(const float* hin, float* hout, const bf16_t* y, const float* __restrict__ gpost, const float* __restrict__ gpre, bf16_t* xa, int xmode, int gw, int NGW, int lane) {
    for (int m = gw; m < TOK; m += NGW) {
        f32x4 v[4];
#pragma unroll
        for (int j = 0; j < 4; ++j) v[j] = ((const f32x4*)(hin + (size_t)m * DM))[lane + 64 * j];
        if (y) {
            f32x4 yv[4]; float ss = 0.f;
#pragma unroll
            for (int j = 0; j < 4; ++j) { const u32x2 w = ((const u32x2*)(y + (size_t)m * DM))[lane + 64 * j]; yv[j] = (f32x4){bf_lo(w.x), bf_hi(w.x), bf_lo(w.y), bf_hi(w.y)};
                ss += (yv[j][0] * yv[j][0] + yv[j][1] * yv[j][1]) + (yv[j][2] * yv[j][2] + yv[j][3] * yv[j][3]); }
            const float rs = rsqrtf(wave_sum(ss) * (1.0f / DM) + EPS);
#pragma unroll
            for (int j = 0; j < 4; ++j) { const f32x4 g = ((const f32x4*)gpost)[lane + 64 * j]; v[j] = v[j] + yv[j] * rs * g; }
        }
#pragma unroll
        for (int j = 0; j < 4; ++j) ((f32x4*)(hout + (size_t)m * DM))[lane + 64 * j] = v[j];
        if (xmode != 0) {
            float r2 = 1.0f;
            if (xmode == 1) { float ss = 0.f;
#pragma unroll
                for (int j = 0; j < 4; ++j) ss += (v[j][0] * v[j][0] + v[j][1] * v[j][1]) + (v[j][2] * v[j][2] + v[j][3] * v[j][3]);
                r2 = rsqrtf(wave_sum(ss) * (1.0f / DM) + EPS); }
#pragma unroll
            for (int j = 0; j < 4; ++j) { f32x4 o = v[j] * r2; if (xmode == 1) o = o * ((const f32x4*)gpre)[lane + 64 * j];
                u32x2 w; w.x = cvt_pk_bf16(o[0], o[1]); w.y = cvt_pk_bf16(o[2], o[3]); ((u32x2*)(xa + (size_t)m * DM))[lane + 64 * j] = w; }
        }
    }
}

__device__ __forceinline__ void qk_norm_rope(unsigned char* rbase, const float* __restrict__ gq, const float* __restrict__ gk, int gw, int NGW, int lane) {
    const int axis = lane >> 5, j = lane & 31, i1 = axis * 64 + j, i2 = i1 + 32;
    const float inv = __builtin_amdgcn_exp2f(-(float)j * (13.287712379549449f / 32.0f));
    const float gq1 = gq[i1], gq2 = gq[i2], gk1 = gk[i1], gk2 = gk[i2];
    for (int it = gw; it < TOK * 10; it += NGW) {
        const int t = it / 10, hs = it % 10;
        bf16_t* p = hs < 8 ? (bf16_t*)(rbase + R_Q) + (size_t)t * 1024 + hs * 128 : (bf16_t*)(rbase + R_K) + (size_t)t * 256 + (hs - 8) * 128;
        const float g1 = hs < 8 ? gq1 : gk1, g2 = hs < 8 ? gq2 : gk2;
        float x1 = bf_lo((unsigned)p[i1]), x2 = bf_lo((unsigned)p[i2]);
        const float rs = rsqrtf(wave_sum(x1 * x1 + x2 * x2) * (1.0f / 128.0f) + EPS);
        x1 = x1 * rs * g1; x2 = x2 * rs * g2;
        const int s = t & (SEQ - 1); const float pos = (float)(axis == 0 ? (s >> 6) : (s & 63));
        const float rev = pos * inv * 0.15915494309189535f;
        const float rf = __builtin_amdgcn_fractf(rev); const float c = __builtin_amdgcn_cosf(rf), sn = __builtin_amdgcn_sinf(rf);
        const float o1 = x1 * c - x2 * sn, o2 = x2 * c + x1 * sn;
        p[i1] = (bf16_t)(cvt_pk_bf16(o1, 0.f) & 0xffffu); p[i2] = (bf16_t)(cvt_pk_bf16(o2, 0.f) & 0xffffu);
    }
}

__device__ __forceinline__ void gla_post(bf16_t* of, const bf16_t* ob, const bf16_t* gg, const float* __restrict__ g, int gw, int NGW, int lane) {
    const f32x4 gv = ((const f32x4*)g)[lane];
    for (int it = gw; it < TOK * 4; it += NGW) {
        const size_t off = (size_t)it * 256 + 4 * lane;
        const u32x2 a = *(const u32x2*)(of + off), b = *(const u32x2*)(ob + off), c = *(const u32x2*)(gg + off);
        f32x4 o = (f32x4){bf_lo(a.x) + bf_lo(b.x), bf_hi(a.x) + bf_hi(b.x), bf_lo(a.y) + bf_lo(b.y), bf_hi(a.y) + bf_hi(b.y)};
        const float rs = rsqrtf(wave_sum((o[0] * o[0] + o[1] * o[1]) + (o[2] * o[2] + o[3] * o[3])) * (1.0f / 256.0f) + EPS);
        const f32x4 gt = (f32x4){bf_lo(c.x), bf_hi(c.x), bf_lo(c.y), bf_hi(c.y)};
#pragma unroll
        for (int k = 0; k < 4; ++k) o[k] = o[k] * rs * gv[k] * (gt[k] * sigmoidf_(gt[k]));
        u32x2 w; w.x = cvt_pk_bf16(o[0], o[1]); w.y = cvt_pk_bf16(o[2], o[3]); *(u32x2*)(of + off) = w;
    }
}
constexpr int GL_QD = 0, GL_KI = 17408, GL_KST = 34816, GL_VT = 53248, GL_STT = 62464, GL_EL = 79872, GL_RA = 80384, GL_TOT = 84480, GL_END = 88576;
constexpr int GS_Q = 272, GS_T = 144;
__device__ __forceinline__ void gla_unit(KA a, int L, int b, int h, int dir, int vs, LAS unsigned char* lds) {
    const int tid = opaque_tid(), lane = tid & 63, w = __builtin_amdgcn_readfirstlane(tid >> 6);
    unsigned char* rbase = a->ws + WS_R;
    const bf16_t* GQ = (const bf16_t*)(rbase + R_GQ); const bf16_t* GK = (const bf16_t*)(rbase + R_GK); const bf16_t* GV = (const bf16_t*)(rbase + R_GV); const float* RA = (const float*)(rbase + R_RA);
    bf16_t* O = (bf16_t*)(a->ws + (dir ? WS_OB : WS_OF));
    float wu0[16], wu1[16];
    { const float* wu = a->in[4] + ((size_t)(L * 2 + dir) * 16) * 512 + h * 128 + 2 * lane;
#pragma unroll
      for (int j = 0; j < 16; ++j) { const f32x2 t = *(const f32x2*)(wu + (size_t)j * 512); wu0[j] = t.x; wu1[j] = t.y; } }
    const f32x2 bias = *(const f32x2*)(a->in[5] + (size_t)(L * 2 + dir) * 512 + h * 128 + 2 * lane);
    f32x4 st[4];
#pragma unroll
    for (int nb = 0; nb < 4; ++nb) st[nb] = (f32x4){0.f, 0.f, 0.f, 0.f};
    for (int i = tid; i < 17408 / 4; i += 512) ((LAS unsigned*)(lds + GL_STT))[i] = 0u;
    const int li = lane & 15, kq = lane >> 4, ib = w & 3, dh = w >> 2;
    const int vrow = tid >> 3, vc8 = tid & 7;
    unsigned qv[8], kv[8]; u32x4 vv; f32x2 rav;
#define GLA_LOAD(ci_) do { const size_t t0_ = (size_t)b * SEQ + (size_t)(ci_) * 64; \
        _Pragma("unroll") for (int r = 0; r < 8; ++r) { qv[r] = *(const unsigned*)(GQ + (t0_ + 8 * w + r) * 512 + h * 128 + 2 * lane); kv[r] = *(const unsigned*)(GK + (t0_ + 8 * w + r) * 512 + h * 128 + 2 * lane); } \
        vv = *(const u32x4*)(GV + (t0_ + vrow) * 1024 + h * 256 + vs * 64 + vc8 * 8); rav = *(const f32x2*)(RA + (t0_ + vrow) * 32 + dir * 16 + 2 * vc8); } while (0)
    GLA_LOAD(dir ? 63 : 0);
    for (int c = 0; c < 64; ++c) {
        const int ci = dir ? 63 - c : c; const size_t t0 = (size_t)b * SEQ + (size_t)ci * 64;
        *(LAS f32x2*)(lds + GL_RA + vrow * 64 + vc8 * 8) = rav;
        { const unsigned short e0 = vv.x & 0xffff, e1 = vv.x >> 16, e2 = vv.y & 0xffff, e3 = vv.y >> 16, e4 = vv.z & 0xffff, e5 = vv.z >> 16, e6 = vv.w & 0xffff, e7 = vv.w >> 16;
          LAS unsigned char* vt = lds + GL_VT + (vc8 * 8) * GS_T + vrow * 2;
          *(LAS unsigned short*)(vt + 0 * GS_T) = e0; *(LAS unsigned short*)(vt + 1 * GS_T) = e1; *(LAS unsigned short*)(vt + 2 * GS_T) = e2; *(LAS unsigned short*)(vt + 3 * GS_T) = e3;
          *(LAS unsigned short*)(vt + 4 * GS_T) = e4; *(LAS unsigned short*)(vt + 5 * GS_T) = e5; *(LAS unsigned short*)(vt + 6 * GS_T) = e6; *(LAS unsigned short*)(vt + 7 * GS_T) = e7; }
        unsigned qc[8], kc[8];
#pragma unroll
        for (int r = 0; r < 8; ++r) { qc[r] = qv[r]; kc[r] = kv[r]; }
        __syncthreads();
        if (c + 1 < 64) GLA_LOAD(dir ? 62 - c : c + 1);
        float la0[8], la1[8];
#pragma unroll
        for (int r = 0; r < 8; ++r) {
            const LAS f32x4* rr = (const LAS f32x4*)(lds + GL_RA + (8 * w + r) * 64);
            float x0 = bias.x, x1 = bias.y;
#pragma unroll
            for (int q4 = 0; q4 < 4; ++q4) { const f32x4 t = rr[q4];
#pragma unroll
                for (int e = 0; e < 4; ++e) { x0 = fmaf(t[e], wu0[4 * q4 + e], x0); x1 = fmaf(t[e], wu1[4 * q4 + e], x1); } }
            la0[r] = (fminf(x0, 0.f) - __logf(1.0f + __expf(-fabsf(x0)))) * (1.0f / 16.0f);
            la1[r] = (fminf(x1, 0.f) - __logf(1.0f + __expf(-fabsf(x1)))) * (1.0f / 16.0f);
        }
        if (dir == 0) {
#pragma unroll
            for (int r = 1; r < 8; ++r) { la0[r] += la0[r - 1]; la1[r] += la1[r - 1]; }
        } else {
#pragma unroll
            for (int r = 6; r >= 0; --r) { la0[r] += la0[r + 1]; la1[r] += la1[r + 1]; }
        }
        *(LAS f32x2*)(lds + GL_TOT + w * 512 + lane * 8) = (f32x2){dir == 0 ? la0[7] : la0[0], dir == 0 ? la1[7] : la1[0]};
        __syncthreads();
        float off0 = 0.f, off1 = 0.f, last0 = 0.f, last1 = 0.f;
#pragma unroll
        for (int g = 0; g < 8; ++g) { const f32x2 t = *(const LAS f32x2*)(lds + GL_TOT + g * 512 + lane * 8); last0 += t.x; last1 += t.y;
            const bool before = dir == 0 ? (g < w) : (g > w); if (before) { off0 += t.x; off1 += t.y; } }
        unsigned ks0[4], ks1[4];
#pragma unroll
        for (int r = 0; r < 8; ++r) {
            const float c0 = la0[r] + off0, c1 = la1[r] + off1;
            const float q0 = bf_lo(qc[r]), q1 = bf_hi(qc[r]), k0 = bf_lo(kc[r]), k1 = bf_hi(kc[r]);
            const float eq0 = __expf(c0) * 0.088388347648318440f, eq1 = __expf(c1) * 0.088388347648318440f;
            const int row = 8 * w + r;
            *(LAS unsigned*)(lds + GL_QD + row * GS_Q + lane * 4) = cvt_pk_bf16(q0 * eq0, q1 * eq1);
            *(LAS unsigned*)(lds + GL_KI + row * GS_Q + lane * 4) = cvt_pk_bf16(k0 * __expf(-c0), k1 * __expf(-c1));
            const float s0 = k0 * __expf(last0 - c0), s1 = k1 * __expf(last1 - c1);
            if (r & 1) { ks0[r >> 1] = cvt_pk_bf16(__builtin_bit_cast(float, ks0[r >> 1]), s0); ks1[r >> 1] = cvt_pk_bf16(__builtin_bit_cast(float, ks1[r >> 1]), s1); }
            else { ks0[r >> 1] = __builtin_bit_cast(unsigned, s0); ks1[r >> 1] = __builtin_bit_cast(unsigned, s1); }
        }
        *(LAS u32x4*)(lds + GL_KST + (2 * lane) * GS_T + w * 16) = (u32x4){ks0[0], ks0[1], ks0[2], ks0[3]};
        *(LAS u32x4*)(lds + GL_KST + (2 * lane + 1) * GS_T + w * 16) = (u32x4){ks1[0], ks1[1], ks1[2], ks1[3]};
        if (w == 0) *(LAS f32x2*)(lds + GL_EL + lane * 8) = (f32x2){__expf(last0), __expf(last1)};
        __syncthreads();
        bf16x8 qf[4];
#pragma unroll
        for (int kk = 0; kk < 4; ++kk) qf[kk] = *(const LAS bf16x8*)(lds + GL_QD + (16 * ib + li) * GS_Q + kk * 64 + kq * 16);
        unsigned pk[4][2];
#pragma unroll
        for (int sb = 0; sb < 4; ++sb) {
            f32x4 sacc = (f32x4){0.f, 0.f, 0.f, 0.f};
#pragma unroll
            for (int kk = 0; kk < 4; ++kk) { const bf16x8 kf = *(const LAS bf16x8*)(lds + GL_KI + (16 * sb + li) * GS_Q + kk * 64 + kq * 16);
                sacc = __builtin_amdgcn_mfma_f32_16x16x32_bf16(kf, qf[kk], sacc, 0, 0, 0); }
            const int irow = 16 * ib + li;
#pragma unroll
            for (int j = 0; j < 4; ++j) { const int srow = 16 * sb + 4 * kq + j; const bool keep = dir == 0 ? (srow <= irow) : (srow >= irow); sacc[j] = keep ? sacc[j] : 0.f; }
            pk[sb][0] = cvt_pk_bf16(sacc[0], sacc[1]); pk[sb][1] = cvt_pk_bf16(sacc[2], sacc[3]);
        }
#pragma unroll
        for (int d2 = 0; d2 < 2; ++d2) { const int db = 2 * dh + d2;
            f32x4 oacc = (f32x4){0.f, 0.f, 0.f, 0.f};
#pragma unroll
            for (int kk = 0; kk < 4; ++kk) { const bf16x8 sf = *(const LAS bf16x8*)(lds + GL_STT + (16 * db + li) * GS_Q + kk * 64 + kq * 16);
                oacc = __builtin_amdgcn_mfma_f32_16x16x32_bf16(sf, qf[kk], oacc, 0, 0, 0); }
#pragma unroll
            for (int kc2 = 0; kc2 < 2; ++kc2) {
                const s16x4 lo = *(const LAS s16x4*)(lds + GL_VT + (16 * db + li) * GS_T + (32 * kc2 + 4 * kq) * 2);
                const s16x4 hi4 = *(const LAS s16x4*)(lds + GL_VT + (16 * db + li) * GS_T + (32 * kc2 + 16 + 4 * kq) * 2);
                const bf16x8 vf = (bf16x8){lo[0], lo[1], lo[2], lo[3], hi4[0], hi4[1], hi4[2], hi4[3]};
                const u32x4 pw = (u32x4){pk[2 * kc2][0], pk[2 * kc2][1], pk[2 * kc2 + 1][0], pk[2 * kc2 + 1][1]};
                oacc = __builtin_amdgcn_mfma_f32_16x16x32_bf16(vf, __builtin_bit_cast(bf16x8, pw), oacc, 0, 0, 0); }
            u32x2 ow; ow.x = cvt_pk_bf16(oacc[0], oacc[1]); ow.y = cvt_pk_bf16(oacc[2], oacc[3]);
            *(u32x2*)(O + (t0 + 16 * ib + li) * 1024 + h * 256 + vs * 64 + 16 * db + 4 * kq) = ow;
        }
        { const f32x4 el = *(const LAS f32x4*)(lds + GL_EL + (16 * w + 4 * kq) * 4);
#pragma unroll
          for (int nb = 0; nb < 4; ++nb) st[nb] = st[nb] * el;
#pragma unroll
          for (int kc2 = 0; kc2 < 2; ++kc2) { const bf16x8 af = *(const LAS bf16x8*)(lds + GL_KST + (16 * w + li) * GS_T + kc2 * 64 + kq * 16);
#pragma unroll
              for (int nb = 0; nb < 4; ++nb) { const bf16x8 bfv = *(const LAS bf16x8*)(lds + GL_VT + (16 * nb + li) * GS_T + kc2 * 64 + kq * 16);
                  st[nb] = __builtin_amdgcn_mfma_f32_16x16x32_bf16(af, bfv, st[nb], 0, 0, 0); } } }
        __syncthreads();
#pragma unroll
        for (int nb = 0; nb < 4; ++nb) { u32x2 sw; sw.x = cvt_pk_bf16(st[nb][0], st[nb][1]); sw.y = cvt_pk_bf16(st[nb][2], st[nb][3]);
            *(LAS u32x2*)(lds + GL_STT + (16 * nb + li) * GS_Q + (16 * w + 4 * kq) * 2) = sw; }
    }
#undef GLA_LOAD
    __syncthreads();
}
#ifndef PH_MASK
#define PH_MASK 0x3fff
#endif
#define EN(k) (((PH_MASK) >> (k)) & 1)
__global__ void __launch_bounds__(512) hybrid_fwd(Args a_) {
    extern __shared__ __attribute__((aligned(16))) unsigned char lds_raw[];
    LAS unsigned char* lds = (LAS unsigned char*)lds_raw;
    cg::grid_group grid = cg::this_grid();
    const int ph_lo = a_.ph_lo, ph_hi = a_.ph_hi;
    for (int ph = ph_lo; ph < ph_hi; ++ph) {
        const int tid = opaque_tid(), lane = tid & 63, wave = __builtin_amdgcn_readfirstlane(tid >> 6);
        int bx = blockIdx.x, G = gridDim.x; asm volatile("" : "+s"(bx), "+s"(G));
        const int vcu = (G % 8 == 0) ? (bx % 8) * (G / 8) + bx / 8 : bx;
        const int gw = vcu * 8 + wave, NGW = G * 8;
        KA a = (KA)__builtin_amdgcn_kernarg_segment_ptr(); asm volatile("" : "+s"(a));
        unsigned char* ws = a->ws; unsigned char* rbase = ws + WS_R; unsigned char* wsW = ws + WS_W;
        bf16_t* XA = (bf16_t*)(ws + WS_XA); bf16_t* OF = (bf16_t*)(ws + WS_OF); bf16_t* OB = (bf16_t*)(ws + WS_OB); bf16_t* GG = (bf16_t*)(ws + WS_GG); bf16_t* PB = (bf16_t*)(ws + WS_PB);
        float* H = a->out;
        if (ph == 0) { if (EN(13)) {
            prep_layer(a, 0, lds, gw, NGW, wave, lane);
            row_pass(a->in[0], H, nullptr, nullptr, a->in[2], XA, 1, gw, NGW, lane); }
        } else {
            const int L = (ph - 1) / NPH_LAYER, k = (ph - 1) % NPH_LAYER;
            int ngemm = 0; pg8::Gemm g0{}, g1{}; pg8::Epi e0{}, e1{};
            e0.rbase = rbase; e0.ggbase = ws + WS_GG; e1.rbase = rbase; e1.ggbase = ws + WS_GG;
            switch (k) {
            case 0: if (!EN(0)) break; ngemm = 1; g0 = pg8::Gemm{XA, (const bf16_t*)(wsW + W_INA), TOK, NA_PAD, DM}; e0.mode = pg8::EM_ROUTE_A; break;
            case 1: if (!EN(1)) break; for (int u = vcu; u < 256; u += G) gla_unit(a, L, u >> 5, (u >> 3) & 3, (u >> 2) & 1, u & 3, lds); break;
            case 2: if (!EN(2)) break; gla_post(OF, OB, GG, a->in[6] + (size_t)L * 256, gw, NGW, lane);
                    ngemm = 1; g0 = pg8::Gemm{XA, (const bf16_t*)(wsW + W_INB), TOK, NB_COLS, DM}; e0.mode = pg8::EM_ROUTE_B; break;
            case 3: if (!EN(3)) break; qk_norm_rope(rbase, a->in[7] + (size_t)L * 128, a->in[8] + (size_t)L * 128, gw, NGW, lane); break;
            case 4: if (!EN(4)) break; for (int u = vcu; u < 1024; u += G) { const int qb = u & 15, hg = (u >> 4) & 3, kvh = (u >> 6) & 1, b = u >> 7, hq = kvh * 4 + hg;
                        bf16_t* Qb = (bf16_t*)(rbase + R_Q) + ((size_t)b * SEQ + (size_t)qb * 256) * 1024 + hq * 128;
                        const bf16_t* Kh = (const bf16_t*)(rbase + R_K) + (size_t)b * SEQ * 256 + kvh * 128; const bf16_t* Vh = (const bf16_t*)(rbase + R_V) + (size_t)b * SEQ * 256 + kvh * 128;
                        attn::attn_dense_body<attn::bf16>((const attn::bf16*)Qb, (const attn::bf16*)Kh, (const attn::bf16*)Vh, Qb, SEQ, (char*)lds_raw);
                        __syncthreads(); }
                    break;
            case 5: if (!EN(5)) break; ngemm = 2; g0 = pg8::Gemm{OF, (const bf16_t*)(wsW + W_OGLA), TOK, DM, DM}; e0.mode = pg8::EM_GATE1; e0.out = OB; e0.aux = (const bf16_t*)(rbase + R_GA);
                    g1 = pg8::Gemm{(const bf16_t*)(rbase + R_Q), (const bf16_t*)(wsW + W_OATT), TOK, DM, DM}; e1.mode = pg8::EM_GATE2; e1.out = OB; e1.aux = (const bf16_t*)(rbase + R_GB); break;
            case 6: if (!EN(6)) break; ngemm = 1; g0 = pg8::Gemm{OB, (const bf16_t*)(wsW + W_OUT), TOK, DM, DM}; e0.mode = pg8::EM_PLAIN; e0.out = OF; break;
            case 7: if (!EN(7)) break; row_pass(H, H, OF, a->in[12] + (size_t)L * DM, a->in[13] + (size_t)L * DM, XA, 1, gw, NGW, lane); break;
            case 8: if (!EN(8)) break; ngemm = 1; g0 = pg8::Gemm{XA, (const bf16_t*)(wsW + W_FIN), TOK, 2 * FFH, DM}; e0.mode = pg8::EM_SWIGLU; e0.out = (bf16_t*)rbase; break;
            case 9: if (!EN(9)) break; ngemm = 1; g0 = pg8::Gemm{(const bf16_t*)rbase, (const bf16_t*)(wsW + W_FOUT), TOK, DM, FFH}; e0.mode = pg8::EM_PLAIN; e0.out = OF; break;
            case 10: if (!EN(10)) break; row_pass(H, H, OF, a->in[16] + (size_t)L * DM, nullptr, XA, 2, gw, NGW, lane); break;
            case 11: if (!EN(11)) break; ngemm = 2; g0 = pg8::Gemm{PB, (const bf16_t*)(wsW + W_PP), TOK, DM, PLE}; e0.mode = pg8::EM_PLAIN; e0.out = (bf16_t*)rbase;
                     g1 = pg8::Gemm{XA, (const bf16_t*)(wsW + W_PG), TOK, DM, DM}; e1.mode = pg8::EM_PLE2; e1.out = OF; e1.aux = (const bf16_t*)rbase; break;
            default: if (!EN(12)) break; row_pass(H, H, OF, a->in[19] + (size_t)L * DM, L + 1 < DEPTH ? a->in[2] + (size_t)(L + 1) * DM : nullptr, XA, L + 1 < DEPTH ? 1 : 0, gw, NGW, lane);
                     if (L + 1 < DEPTH) prep_layer(a, L + 1, lds, gw, NGW, wave, lane);
                     break;
            }
            for (int gi = 0; gi < ngemm; ++gi) {
                const pg8::Gemm g = gi == 0 ? g0 : g1; const pg8::Epi E = gi == 0 ? e0 : e1;
                pg8::StaticOrder S; S.init(g.M, g.N, G, bx);
                pg8::gemm_phase<pg8::Epi, pg8::StaticOrder, true, true>(lds, g, S, E);
            }
        }
        if (ph + 1 < ph_hi) grid.sync();
    }
}

#if MK_DEBUG
struct DbgReg { unsigned long long off, bytes; int type, pad; };
struct DbgArgs { DbgReg r[3]; int scanH, ph, pass, pad; };
__global__ void __launch_bounds__(256) dbg_scan(unsigned char* ws, const float* out, DbgArgs d) {
    unsigned* nanw = (unsigned*)(ws + WS_CTL); unsigned long long* sums = (unsigned long long*)(ws + WS_CTL + 512 + d.pass * 512);
    unsigned long long s = 0; unsigned bad = 0;
#pragma unroll
    for (int ri = 0; ri < 3; ++ri) {
        const size_t n16 = d.r[ri].bytes / 16; const u32x4* p = (const u32x4*)(ws + d.r[ri].off); const int type = d.r[ri].type;
        for (size_t i = (size_t)blockIdx.x * 256 + threadIdx.x; i < n16; i += (size_t)gridDim.x * 256) {
            const u32x4 v = p[i]; s += (unsigned long long)v.x + v.y + v.z + v.w;
#pragma unroll
            for (int k = 0; k < 4; ++k) { const unsigned w = v[k]; if ((type == 0 && (w & 0x7f80u) == 0x7f80u) || (type <= 1 && (w & 0x7f800000u) == 0x7f800000u)) bad = 1; }
        }
    }
    if (d.scanH) { const size_t no = (size_t)TOK * DM / 4; const u32x4* q = (const u32x4*)out;
        for (size_t i = (size_t)blockIdx.x * 256 + threadIdx.x; i < no; i += (size_t)gridDim.x * 256) {
            const u32x4 v = q[i]; s += (unsigned long long)v.x + v.y + v.z + v.w;
#pragma unroll
            for (int k = 0; k < 4; ++k) if ((v[k] & 0x7f800000u) == 0x7f800000u) bad = 1; } }
    for (int o = 1; o < 64; o <<= 1) { s += __shfl_xor(s, o); bad |= __shfl_xor(bad, o); }
    if ((threadIdx.x & 63) == 0) { atomicAdd(&sums[d.ph], s); if (bad) atomicOr(&nanw[d.ph], 1u); }
}
__global__ void __launch_bounds__(64) dbg_check_gemm_a(unsigned char* ws) {
    unsigned* chk = (unsigned*)(ws + WS_CTL) + 56;
    const int i = blockIdx.x, lane = threadIdx.x;
    const int t = (int)(((long)i * 9973 + 17) % TOK), col = (i * 131 + 5) % NA_REAL;
    const bf16_t* xa = (const bf16_t*)(ws + WS_XA) + (size_t)t * DM; const bf16_t* wt = (const bf16_t*)(ws + WS_W + W_INA) + (size_t)col * DM;
    float acc = 0.f;
    for (int k = lane; k < DM; k += 64) acc += bf_lo((unsigned)xa[k]) * bf_lo((unsigned)wt[k]);
    acc = wave_sum(acc);
    unsigned char* rb = ws + WS_R; float got;
    if (col < 512) got = bf_lo((unsigned)((const bf16_t*)(rb + R_GQ))[(size_t)t * 512 + col]);
    else if (col < 1024) got = bf_lo((unsigned)((const bf16_t*)(rb + R_GK))[(size_t)t * 512 + col - 512]);
    else if (col < 2048) got = bf_lo((unsigned)((const bf16_t*)(rb + R_GV))[(size_t)t * 1024 + col - 1024]);
    else if (col < 3072) got = bf_lo((unsigned)((const bf16_t*)(ws + WS_GG))[(size_t)t * 1024 + col - 2048]);
    else got = ((const float*)(rb + R_RA))[(size_t)t * 32 + col - 3072];
    if (lane == 0) { if (!(fabsf(got - acc) <= 0.03f * fmaxf(1.f, fabsf(acc)))) { atomicOr(chk, fabsf(got) < 1e-9f ? 1u : 2u); if (atomicAdd(chk + 4, 1u) == 0u) { chk[2] = (unsigned)(t & 255) >> 2; chk[3] = (unsigned)(col & 255) >> 3; } } }
    float m = 0.f; const float* ra = (const float*)(rb + R_RA);
    for (int k = lane; k < 2048; k += 64) m = fmaxf(m, fabsf(ra[(size_t)i * 2048 + k]));
    for (int o = 1; o < 64; o <<= 1) m = fmaxf(m, __shfl_xor(m, o));

}
__global__ void __launch_bounds__(64) dbg_check_gemm_b(unsigned char* ws) {
    unsigned* chk = (unsigned*)(ws + WS_CTL) + 57;
    const int i = blockIdx.x, lane = threadIdx.x;
    const int t = (int)(((long)i * 9973 + 17) % TOK), col = (i * 131 + 5) % NB_COLS;
    const bf16_t* xa = (const bf16_t*)(ws + WS_XA) + (size_t)t * DM; const bf16_t* wt = (const bf16_t*)(ws + WS_W + W_INB) + (size_t)col * DM;
    float acc = 0.f;
    for (int k = lane; k < DM; k += 64) acc += bf_lo((unsigned)xa[k]) * bf_lo((unsigned)wt[k]);
    acc = wave_sum(acc);
    unsigned char* rb = ws + WS_R; float got; unsigned bit;
    if (col < 1024) { got = bf_lo((unsigned)((const bf16_t*)(rb + R_Q))[(size_t)t * 1024 + col]); bit = 1u; }
    else if (col < 1280) { got = bf_lo((unsigned)((const bf16_t*)(rb + R_K))[(size_t)t * 256 + col - 1024]); bit = 2u; }
    else if (col < 1536) { got = bf_lo((unsigned)((const bf16_t*)(rb + R_V))[(size_t)t * 256 + col - 1280]); bit = 2u; }
    else if (col < 2560) { got = bf_lo((unsigned)((const bf16_t*)(rb + R_GA))[(size_t)t * 1024 + col - 1536]); bit = 4u; }
    else { got = bf_lo((unsigned)((const bf16_t*)(rb + R_GB))[(size_t)t * 1024 + col - 2560]); bit = 4u; }
    if (lane == 0) { if (!(fabsf(got - acc) <= 0.03f * fmaxf(1.f, fabsf(acc)))) atomicOr(chk, bit); }
}
__global__ void __launch_bounds__(256) dbg_check_gla(unsigned char* ws) {
    unsigned* c58 = (unsigned*)(ws + WS_CTL) + 58; unsigned* c59 = c58 + 1;
    const bf16_t* of = (const bf16_t*)(ws + WS_OF); const bf16_t* ob = (const bf16_t*)(ws + WS_OB);
    unsigned mn = 99u, mx = 0u;
    for (size_t i = (size_t)blockIdx.x * 256 + threadIdx.x; i < (size_t)TOK * DM; i += (size_t)gridDim.x * 256) {
        const unsigned chunk = (unsigned)((i >> 10) & 4095) >> 6;
        if ((of[i] & 0x7f80u) == 0x7f80u) mn = chunk < mn ? chunk : mn;
        if ((ob[i] & 0x7f80u) == 0x7f80u) mx = chunk + 1 > mx ? chunk + 1 : mx;
    }
    if (mn != 99u) atomicMin(c58, mn); if (mx) atomicMax(c59, mx);
}
__global__ void __launch_bounds__(256) dbg_final(unsigned char* ws, float* out) {
    const unsigned* nanw = (const unsigned*)(ws + WS_CTL); const unsigned long long* sa = (const unsigned long long*)(ws + WS_CTL + 512); const unsigned long long* sb = sa + 64;
    int p1 = -1, p2 = -1;
    for (int i = NPHASES - 1; i >= 0; --i) { if (nanw[i]) p1 = i; if (sa[i] != sb[i]) p2 = i; }
    const unsigned chkA = nanw[56], chkB = nanw[57], g0 = nanw[58], g1 = nanw[59];
    if (p1 < 0 && p2 < 0 && chkA == 0 && chkB == 0) return;
    float c1; unsigned e;
    if (chkA | chkB) { c1 = 90.f + (chkA & 7); e = chkB & 7; }
    else if (p1 == 2) { c1 = 10.f + (g0 > 63 ? 70.f : (float)g0); e = g1 / 3; }
    else { c1 = p1 >= 0 ? 10.f + p1 : 40.f + p2; e = p1 >= 0 ? 25 : 30; }
    float code = c1 * 100.f; for (unsigned k = 0; k < e; ++k) code *= 10.f;
    for (size_t i = (size_t)blockIdx.x * 256 + threadIdx.x; i < (size_t)TOK * DM; i += (size_t)gridDim.x * 256) out[i] = i == 0 ? code : 0.f;
}
static DbgArgs dbg_args_for(int ph, int pass) {
    DbgArgs d{}; d.ph = ph; d.pass = pass; int n = 0;
    auto add = [&](size_t off, size_t bytes, int type) { d.r[n].off = off; d.r[n].bytes = bytes; d.r[n].type = type; ++n; };
    if (ph == 0) { add(WS_W, W_END, 0); add(WS_PB, 16 * MiB, 0); add(WS_XA, 64 * MiB, 0); d.scanH = 1; return d; }
    const int k = (ph - 1) % NPH_LAYER;
    switch (k) {
    case 0: add(WS_R, 128 * MiB, 0); add(WS_R + R_RA, 4 * MiB, 1); add(WS_GG, 64 * MiB, 0); break;
    case 1: add(WS_OF, 128 * MiB, 0); break;
    case 2: add(WS_OF, 64 * MiB, 0); add(WS_R, 224 * MiB, 0); break;
    case 3: add(WS_R + R_Q, 80 * MiB, 0); break;
    case 4: add(WS_R + R_Q, 64 * MiB, 0); break;
    case 5: add(WS_OB, 64 * MiB, 0); break;
    case 6: add(WS_OF, 64 * MiB, 0); break;
    case 7: add(WS_XA, 64 * MiB, 0); d.scanH = 1; break;
    case 8: add(WS_R, (size_t)TOK * FFH * 2, 0); break;
    case 9: add(WS_OF, 64 * MiB, 0); break;
    case 10: add(WS_XA, 64 * MiB, 0); d.scanH = 1; break;
    case 11: add(WS_R, 64 * MiB, 0); add(WS_OF, 64 * MiB, 0); break;
    default: add(WS_XA, 64 * MiB, 0); add(WS_W, W_END, 0); add(WS_PB, 16 * MiB, 0); d.scanH = 1; break;
    }
    return d;
}
#endif
extern "C" void kernel_launch(void* const* d_in, const int* in_sizes, int n_in, void* d_out, int out_size, void* d_ws, size_t ws_size, hipStream_t stream) {
    static int grid = 0;
    if (grid == 0) {
        if (n_in != 20 || in_sizes[0] != TOK * DM || out_size != TOK * DM || ws_size < WS_END) {
            fprintf(stderr, "kernel_launch: unexpected shapes (n_in %d, in0 %d, out %d, ws %zu, need %zu); nothing launched\n", n_in, n_in > 0 ? in_sizes[0] : -1, out_size, ws_size, (size_t)WS_END); grid = -1; return; }
        int dev = 0, cus = 0, per_cu = 0;
        if (hipGetDevice(&dev) != hipSuccess || hipDeviceGetAttribute(&cus, hipDeviceAttributeMultiprocessorCount, dev) != hipSuccess) { grid = -1; return; }
        if (hipFuncSetAttribute((const void*)hybrid_fwd, hipFuncAttributeMaxDynamicSharedMemorySize, LDS_BYTES) != hipSuccess) { fprintf(stderr, "kernel_launch: hipFuncSetAttribute failed\n"); grid = -1; return; }
        if (hipOccupancyMaxActiveBlocksPerMultiprocessor(&per_cu, (const void*)hybrid_fwd, 512, LDS_BYTES) != hipSuccess || per_cu < 1) { fprintf(stderr, "kernel_launch: occupancy query says %d\n", per_cu); per_cu = 1; }
        (void)hipGetLastError();
        grid = cus * 1;
        fprintf(stderr, "kernel_launch: grid %d (cus %d, per_cu %d), ws need %zu have %zu\n", grid, cus, per_cu, (size_t)WS_END, ws_size);
    }
    if (grid < 0) return;
    Args a{};
    for (int i = 0; i < 20; ++i) a.in[i] = (const float*)d_in[i];
    a.out = (float*)d_out; a.ws = (unsigned char*)d_ws;
#if MK_DEBUG
    hipMemsetAsync((char*)d_ws + WS_CTL, 0, 4096, stream); hipMemsetAsync((char*)d_ws + WS_CTL + 58 * 4, 0x63, 1, stream);
    for (int pass = 0; pass < 2; ++pass)
        for (int ph = 0; ph < NPHASES; ++ph) { a.ph_lo = ph; a.ph_hi = ph + 1; hipLaunchKernelGGL(hybrid_fwd, dim3(grid), dim3(512), LDS_BYTES, stream, a);
            hipLaunchKernelGGL(dbg_scan, dim3(2048), dim3(256), 0, stream, (unsigned char*)d_ws, (const float*)d_out, dbg_args_for(ph, pass));
            if (pass == 0 && ph == 1) { hipLaunchKernelGGL(dbg_check_gemm_a, dim3(512), dim3(64), 0, stream, (unsigned char*)d_ws); }
            if (pass == 0 && ph == 2) hipLaunchKernelGGL(dbg_check_gla, dim3(2048), dim3(256), 0, stream, (unsigned char*)d_ws);
            if (pass == 0 && ph == 3) hipLaunchKernelGGL(dbg_check_gemm_b, dim3(512), dim3(64), 0, stream, (unsigned char*)d_ws); }
    hipLaunchKernelGGL(dbg_final, dim3(2048), dim3(256), 0, stream, (unsigned char*)d_ws, (float*)d_out);
#elif MK_PER_PHASE
    for (int ph = 0; ph < NPHASES; ++ph) { a.ph_lo = ph; a.ph_hi = ph + 1; hipLaunchKernelGGL(hybrid_fwd, dim3(grid), dim3(512), LDS_BYTES, stream, a); }
#else
    a.ph_lo = 0; a.ph_hi = NPHASES;
    void* args[] = {&a};
    hipError_t e = hipLaunchCooperativeKernel((const void*)hybrid_fwd, dim3(grid), dim3(512), args, LDS_BYTES, stream);
    if (e != hipSuccess) fprintf(stderr, "kernel_launch: cooperative launch failed: %s (grid %d)\n", hipGetErrorString(e), grid);
#endif
}
```

```cpp
#include <hip/hip_runtime.h>
#include <hip/hip_bf16.h>
#include <hip/hip_cooperative_groups.h>
#include <cstdio>
#include <cstdint>
namespace cg = cooperative_groups;
#ifndef MK_DEBUG
#define MK_DEBUG 0
#endif
#ifndef MK_PER_PHASE
#define MK_PER_PHASE 0
#endif
__device__ __forceinline__ int opaque_tid() { int t = threadIdx.x; asm volatile("" : "+v"(t)); return t; }
#define LAS __attribute__((address_space(3)))
constexpr int TOK = 32768, DM = 1024, SEQ = 4096, NBATCH = 8, DEPTH = 4, INW = 6688, FFH = 2816, PLE = 256;
constexpr int NA_REAL = 3104, NA_PAD = 3328, NB_COLS = 3584;
constexpr float EPS = 1e-6f;
constexpr size_t MiB = 1048576;
constexpr size_t W_INA = 0, W_INB = W_INA + (size_t)NA_PAD * DM * 2, W_OGLA = W_INB + (size_t)NB_COLS * DM * 2, W_OATT = W_OGLA + 2 * MiB, W_OUT = W_OATT + 2 * MiB,
                 W_PG = W_OUT + 2 * MiB, W_FIN = W_PG + 2 * MiB, W_FOUT = W_FIN + (size_t)2 * FFH * DM * 2, W_PP = W_FOUT + (size_t)FFH * DM * 2, W_END = W_PP + (size_t)DM * PLE * 2;
constexpr size_t WS_CTL = 0, WS_W = 16384, WS_R = (WS_W + W_END + 4095) / 4096 * 4096;
constexpr size_t R_Q = 0, R_K = 64 * MiB, R_V = 80 * MiB, R_GA = 96 * MiB, R_GB = 160 * MiB, R_BYTES = 224 * MiB;
constexpr size_t R_GQ = 0, R_GK = 32 * MiB, R_GV = 64 * MiB, R_RA = 128 * MiB;
constexpr size_t WS_GG = WS_R + R_BYTES, WS_OF = WS_GG + 64 * MiB, WS_OB = WS_OF + 64 * MiB, WS_XA = WS_OB + 64 * MiB, WS_PB = WS_XA + 64 * MiB, WS_END = WS_PB + 16 * MiB;
constexpr int NPH_LAYER = 13, NPHASES = 1 + NPH_LAYER * DEPTH;
constexpr int LDS_BYTES = 131072 + 1024;
namespace pg8 {
#define PG8_LAS __attribute__((address_space(3)))
typedef unsigned short bf16_t;
typedef short bf16x8 __attribute__((ext_vector_type(8)));
typedef float f32x4 __attribute__((ext_vector_type(4)));
typedef unsigned u32x4 __attribute__((ext_vector_type(4)));
constexpr int BM = 256, BK = 64, HALF = 128, HTB = HALF * BK * 2  , STAGE_BYTES = 8 * HTB, NXCD = 8, WGM = 8;

__host__ __device__ __forceinline__ int lds_byte(int r, int c) { const int st = (r >> 4) * 2 + (c >> 5), rr = r & 15, cc = c & 31, ob = rr * 64 + cc * 2; return st * 1024 + (ob ^ (((ob >> 9) & 1) << 5)); }
__host__ __device__ __forceinline__ void stage_rc(int b, int& R, int& C) { const int st = b / 1024, sb = b % 1024, swz = sb ^ (((sb >> 9) & 1) << 5); R = (st >> 1) * 16 + swz / 64; C = (st & 1) * 32 + (swz % 64) / 2; }
__host__ __device__ __forceinline__ int perm32(int rho) { const int n = rho >> 4, i = rho & 15; return 8 * (i >> 2) + 4 * n + (i & 3); }

struct Unit { int pm, pn; };
struct Gemm { const bf16_t* A; const bf16_t* Bt; int M, N, K; };

struct StaticOrder {
    int nM, nN, nwg, G, c;
    __host__ __device__ void init(int M, int N, int G_, int c_) { nM = M / BM; nN = N / BM; nwg = nM * nN; G = G_; c = c_; }
    __host__ __device__ bool next(int i, Unit& u) const {
        const long L = (long)i * G + c; if (L >= nwg) return false;
        int wgid = (int)L; { const int q = nwg / NXCD, r = nwg % NXCD, xcd = wgid % NXCD, off = wgid / NXCD; wgid = (xcd < r ? xcd * (q + 1) : r * (q + 1) + (xcd - r) * q) + off; }
        const int nig = WGM * nN, gid = wgid / nig, fm = gid * WGM, gsz = (nM - fm) < WGM ? (nM - fm) : WGM;
        u.pm = fm + ((wgid % nig) % gsz); u.pn = (wgid % nig) / gsz; return true;
    }
    __device__ __forceinline__ void a_ready(const Unit&) const {}
    __device__ __forceinline__ void done(const Unit&) const {}
};
typedef __bf16 bf16x2_t __attribute__((ext_vector_type(2)));
typedef float f32x2_t __attribute__((ext_vector_type(2)));
__device__ __forceinline__ unsigned cvt_pk_bf16(float lo, float hi) { const f32x2_t f = {lo, hi}; const bf16x2_t v = __builtin_convertvector(f, bf16x2_t); return __builtin_bit_cast(unsigned, v); }
__device__ __forceinline__ float bf_lo(unsigned w) { return __builtin_bit_cast(float, w << 16); }
__device__ __forceinline__ float bf_hi(unsigned w) { return __builtin_bit_cast(float, w & 0xffff0000u); }
__device__ __forceinline__ float sigmoidf_(float x) { return __builtin_amdgcn_rcpf(1.0f + __expf(-x)); }
enum { EM_ROUTE_A = 0, EM_ROUTE_B = 1, EM_GATE1 = 2, EM_GATE2 = 3, EM_PLAIN = 4, EM_SWIGLU = 5, EM_PLE2 = 6 };
struct Epi {
    static constexpr bool PERM = true, AFTER_DRAIN = false;
    int mode; unsigned char* rbase; unsigned char* ggbase; bf16_t* out; const bf16_t* aux; unsigned* dbgmark;
    __device__ __forceinline__ void operator()(const f32x4 (&acc)[2][2][4][2], const Unit& u, int wr, int wc, int fr, int fq) const {
        const int row0 = u.pm * BM + wr * 64 + fr, lc0 = wc * 32 + 8 * fq;
#if MK_DEBUG
#endif
        if (mode == EM_SWIGLU) {
#pragma unroll
            for (int ai = 0; ai < 2; ++ai)
#pragma unroll
                for (int m = 0; m < 4; ++m) { const size_t row = (size_t)(row0 + ai * HALF + m * 16);
                    float o[8];
#pragma unroll
                    for (int n = 0; n < 2; ++n)
#pragma unroll
                        for (int j = 0; j < 4; ++j) { const float g = acc[ai][0][m][n][j], up = acc[ai][1][m][n][j]; o[4 * n + j] = g * sigmoidf_(g) * up; }
                    u32x4 w; w.x = cvt_pk_bf16(o[0], o[1]); w.y = cvt_pk_bf16(o[2], o[3]); w.z = cvt_pk_bf16(o[4], o[5]); w.w = cvt_pk_bf16(o[6], o[7]);
                    *(u32x4*)(out + row * 2816 + u.pn * 128 + lc0) = w; }
            return;
        }
        bf16_t* base = out; int ld = 1024, ct = u.pn * BM; bool is_ra = false;
        if (mode == EM_ROUTE_A) { const int pn = u.pn;
            if (pn < 2) { base = (bf16_t*)(rbase + R_GQ); ld = 512; ct = pn * 256; }
            else if (pn < 4) { base = (bf16_t*)(rbase + R_GK); ld = 512; ct = (pn - 2) * 256; }
            else if (pn < 8) { base = (bf16_t*)(rbase + R_GV); ld = 1024; ct = (pn - 4) * 256; }
            else if (pn < 12) { base = (bf16_t*)ggbase; ld = 1024; ct = (pn - 8) * 256; }
            else is_ra = true;
        } else if (mode == EM_ROUTE_B) { const int pn = u.pn;
            if (pn < 4) { base = (bf16_t*)(rbase + R_Q); ld = 1024; ct = pn * 256; }
            else if (pn == 4) { base = (bf16_t*)(rbase + R_K); ld = 256; ct = 0; }
            else if (pn == 5) { base = (bf16_t*)(rbase + R_V); ld = 256; ct = 0; }
            else if (pn < 10) { base = (bf16_t*)(rbase + R_GA); ld = 1024; ct = (pn - 6) * 256; }
            else { base = (bf16_t*)(rbase + R_GB); ld = 1024; ct = (pn - 10) * 256; }
        }
        if (is_ra) {
            if (wc == 0) { float* ra = (float*)(rbase + R_RA);
#pragma unroll
                for (int ai = 0; ai < 2; ++ai)
#pragma unroll
                    for (int m = 0; m < 4; ++m) { const size_t row = (size_t)(row0 + ai * HALF + m * 16);
                        *(f32x4*)(ra + row * 32 + 8 * fq) = acc[ai][0][m][0]; *(f32x4*)(ra + row * 32 + 8 * fq + 4) = acc[ai][0][m][1]; } }
            return;
        }
#pragma unroll
        for (int ai = 0; ai < 2; ++ai)
#pragma unroll
            for (int m = 0; m < 4; ++m) { const size_t row = (size_t)(row0 + ai * HALF + m * 16);
#pragma unroll
                for (int bj = 0; bj < 2; ++bj) { const int col = ct + bj * HALF + lc0;
                    float o[8];
#pragma unroll
                    for (int n = 0; n < 2; ++n)
#pragma unroll
                        for (int j = 0; j < 4; ++j) o[4 * n + j] = acc[ai][bj][m][n][j];
                    if (mode == EM_GATE1 || mode == EM_GATE2 || mode == EM_PLE2) {
                        const u32x4 a = *(const u32x4*)(aux + row * 1024 + col);
                        const float av[8] = {bf_lo(a.x), bf_hi(a.x), bf_lo(a.y), bf_hi(a.y), bf_lo(a.z), bf_hi(a.z), bf_lo(a.w), bf_hi(a.w)};
                        if (mode == EM_PLE2) {
#pragma unroll
                            for (int j = 0; j < 8; ++j) o[j] = sigmoidf_(o[j]) * av[j];
                        } else {
#pragma unroll
                            for (int j = 0; j < 8; ++j) o[j] = sigmoidf_(av[j]) * o[j];
                            if (mode == EM_GATE2) { const u32x4 p = *(const u32x4*)(base + row * ld + col);
                                o[0] += bf_lo(p.x); o[1] += bf_hi(p.x); o[2] += bf_lo(p.y); o[3] += bf_hi(p.y); o[4] += bf_lo(p.z); o[5] += bf_hi(p.z); o[6] += bf_lo(p.w); o[7] += bf_hi(p.w); }
                        }
                    }
                    u32x4 w; w.x = cvt_pk_bf16(o[0], o[1]); w.y = cvt_pk_bf16(o[2], o[3]); w.z = cvt_pk_bf16(o[4], o[5]); w.w = cvt_pk_bf16(o[6], o[7]);
                    *(u32x4*)(base + row * ld + col) = w;
#if MK_DEBUG
                    if (dbgmark && ai == 0 && m == 0 && bj == 0 && wr == 0 && wc == 0 && fr == 0 && fq == 0) { unsigned* mk = dbgmark + (u.pm * 32 + u.pn) * 4; const unsigned long long ad = (unsigned long long)(base + row * ld + col);
                        mk[0] = (unsigned)ad; mk[1] = (unsigned)(ad >> 32); mk[2] = w.x; mk[3] = 1u; }
#endif
                    } }
    }
};
template <class Epi, class Sched, bool ALIGN_EPI = false, bool SP2 = false>
__device__ __forceinline__ void gemm_phase(PG8_LAS unsigned char* lds, const Gemm g, const Sched& S, const Epi& E) {
    const int tid = opaque_tid(), wid = __builtin_amdgcn_readfirstlane(tid >> 6), lane = tid & 63, wr = wid >> 2, wc = wid & 3, fr = lane & 15, fq = lane >> 4;
    const int K = g.K, nt = K / BK;
    unsigned voffA[2], voffB[2];
#pragma unroll
    for (int i = 0; i < 2; ++i) { int R, C; stage_rc(tid * 16 + i * 8192, R, C); const int Rb = Epi::PERM ? ((R & ~31) + perm32(R & 31)) : R;
        voffA[i] = (unsigned)(R * K + C) * 2u; voffB[i] = (unsigned)(Rb * K + C) * 2u; }
    const size_t kstep = (size_t)(BK * 2);
    const size_t hstep = (size_t)HALF * K * 2;
    const size_t tstep = 2 * hstep;
    const unsigned ldsw = (unsigned)wid * 1024u;
    const int aoff = lds_byte(wr * 64 + fr, fq * 8), boff = lds_byte(wc * 32 + fr, fq * 8);
#define PG8_SA(b, h) (((b) * 2 + (h)) * HTB)
#define PG8_SB(b, h) ((4 + (b) * 2 + (h)) * HTB)
#define PG8_STAGE(bufoff, gbase, voff) do { _Pragma("unroll") for (int _i = 0; _i < 2; ++_i) \
        __builtin_amdgcn_global_load_lds((const unsigned*)((const char*)(gbase) + (voff)[_i]), (PG8_LAS unsigned*)(lds + (bufoff) + ldsw + _i * 8192), 16, 0, 0); } while (0)
#define PG8_LDA(dst, b, h) do { _Pragma("unroll") for (int m = 0; m < 4; ++m) _Pragma("unroll") for (int k = 0; k < 2; ++k) dst[m][k] = *(const PG8_LAS bf16x8*)(lds + PG8_SA(b, h) + aoff + m * 2048 + k * 1024); } while (0)
#define PG8_LDB(dst, b, h) do { _Pragma("unroll") for (int n = 0; n < 2; ++n) _Pragma("unroll") for (int k = 0; k < 2; ++k) dst[n][k] = *(const PG8_LAS bf16x8*)(lds + PG8_SB(b, h) + boff + n * 2048 + k * 1024); } while (0)
#define PG8_MMA(ai, bj, At, Bt) do { __builtin_amdgcn_s_setprio(1); _Pragma("unroll") for (int m = 0; m < 4; ++m) _Pragma("unroll") for (int n = 0; n < 2; ++n) _Pragma("unroll") for (int k = 0; k < 2; ++k) \
        acc[ai][bj][m][n] = __builtin_amdgcn_mfma_f32_16x16x32_bf16(Bt[n][k], At[m][k], acc[ai][bj][m][n], 0, 0, 0); __builtin_amdgcn_s_setprio(0); } while (0)
#define PG8_WAIT_V(n) asm volatile("s_waitcnt vmcnt(" #n ")" ::: "memory")
#define PG8_WAIT_L(n) asm volatile("s_waitcnt lgkmcnt(" #n ")" ::: "memory")
#define PG8_BAR __builtin_amdgcn_s_barrier()
#define PG8_SCHED __builtin_amdgcn_sched_barrier(0)
    Unit cur, nxt; int ui = 0;
    if (!S.next(0, cur)) return;
    f32x4 acc[2][2][4][2];
#pragma unroll
    for (int a = 0; a < 2; ++a)
#pragma unroll
        for (int b = 0; b < 2; ++b)
#pragma unroll
            for (int m = 0; m < 4; ++m)
#pragma unroll
                for (int n = 0; n < 2; ++n) acc[a][b][m][n] = (f32x4){0.f, 0.f, 0.f, 0.f};
    bf16x8 At[4][2], B0[2][2], B1[2][2];
    const char* cA = (const char*)g.A + (size_t)cur.pm * tstep; const char* cB = (const char*)g.Bt + (size_t)cur.pn * tstep;
    S.a_ready(cur);
    if constexpr (SP2) {
        PG8_STAGE(PG8_SB(0, 0), cB, voffB); PG8_STAGE(PG8_SB(0, 1), cB + hstep, voffB); PG8_STAGE(PG8_SA(0, 0), cA, voffA); PG8_STAGE(PG8_SA(0, 1), cA + hstep, voffA);
        if (wr == 1) PG8_BAR;
        PG8_WAIT_V(2); PG8_BAR;
        PG8_STAGE(PG8_SB(1, 0), cB + kstep, voffB); PG8_STAGE(PG8_SA(1, 0), cA + kstep, voffA); PG8_STAGE(PG8_SB(1, 1), cB + hstep + kstep, voffB);
        PG8_WAIT_V(6); PG8_BAR;
    } else {
        PG8_STAGE(PG8_SB(0, 0), cB, voffB); PG8_STAGE(PG8_SA(0, 0), cA, voffA); PG8_STAGE(PG8_SB(0, 1), cB + hstep, voffB); PG8_STAGE(PG8_SA(0, 1), cA + hstep, voffA);
        if (wr == 1) PG8_BAR;
        PG8_WAIT_V(4); PG8_BAR;
        PG8_STAGE(PG8_SB(1, 0), cB + kstep, voffB); PG8_STAGE(PG8_SA(1, 0), cA + kstep, voffA); PG8_STAGE(PG8_SB(1, 1), cB + hstep + kstep, voffB);
        PG8_WAIT_V(6); PG8_BAR;
    }
    for (;;) {
        const bool has_next = S.next(ui + 1, nxt);
        const char* nA = has_next ? (const char*)g.A + (size_t)nxt.pm * tstep : cA; const char* nB = has_next ? (const char*)g.Bt + (size_t)nxt.pn * tstep : cB;
        for (int t = 0; t < nt; t += 2) {
            const bool last = (t == nt - 2);
            const char* a1 = cA + (size_t)(t + 1) * kstep;
            const char* a2 = last ? nA : cA + (size_t)(t + 2) * kstep; const char* b2 = last ? nB : cB + (size_t)(t + 2) * kstep;
            const char* a3 = a2 + kstep; const char* b3 = b2 + kstep;
            if (last && has_next) S.a_ready(nxt);
            if constexpr (SP2) {
            PG8_LDB(B0, 0, 0); PG8_LDB(B1, 0, 1); PG8_SCHED; PG8_LDA(At, 0, 0); PG8_STAGE(PG8_SA(1, 1), a1 + hstep, voffA);
            PG8_WAIT_V(8); PG8_WAIT_L(0); PG8_BAR; PG8_MMA(0, 0, At, B0); PG8_MMA(0, 1, At, B1); PG8_BAR; PG8_SCHED;
            PG8_LDA(At, 0, 1); PG8_STAGE(PG8_SB(0, 0), b2, voffB); PG8_STAGE(PG8_SB(0, 1), b2 + hstep, voffB); PG8_STAGE(PG8_SA(0, 0), a2, voffA);
            PG8_WAIT_V(8); PG8_WAIT_L(0); PG8_BAR; PG8_MMA(1, 0, At, B0); PG8_MMA(1, 1, At, B1); PG8_BAR; PG8_SCHED;
            PG8_LDB(B0, 1, 0); PG8_LDB(B1, 1, 1); PG8_SCHED; PG8_LDA(At, 1, 0); PG8_STAGE(PG8_SA(0, 1), a2 + hstep, voffA);
            PG8_WAIT_V(8); PG8_WAIT_L(0); PG8_BAR; PG8_MMA(0, 0, At, B0); PG8_MMA(0, 1, At, B1); PG8_BAR; PG8_SCHED;
            PG8_LDA(At, 1, 1); PG8_STAGE(PG8_SB(1, 0), b3, voffB); PG8_STAGE(PG8_SB(1, 1), b3 + hstep, voffB); PG8_STAGE(PG8_SA(1, 0), a3, voffA);
            PG8_WAIT_V(8); PG8_WAIT_L(0); PG8_BAR; PG8_MMA(1, 0, At, B0); PG8_MMA(1, 1, At, B1); PG8_BAR; PG8_SCHED;
            } else {
            PG8_LDB(B0, 0, 0); PG8_SCHED; PG8_LDA(At, 0, 0); PG8_STAGE(PG8_SA(1, 1), a1 + hstep, voffA);
            PG8_WAIT_L(8); PG8_BAR; PG8_WAIT_L(0); PG8_MMA(0, 0, At, B0); PG8_BAR; PG8_SCHED;
            PG8_LDB(B1, 0, 1); PG8_STAGE(PG8_SB(0, 0), b2, voffB);
            PG8_BAR; PG8_WAIT_L(0); PG8_MMA(0, 1, At, B1); PG8_BAR;
            PG8_LDA(At, 0, 1); PG8_STAGE(PG8_SA(0, 0), a2, voffA);
            PG8_BAR; PG8_WAIT_L(0); PG8_MMA(1, 0, At, B0); PG8_BAR; PG8_SCHED;
            PG8_STAGE(PG8_SB(0, 1), b2 + hstep, voffB);
            PG8_WAIT_V(6); PG8_BAR; PG8_MMA(1, 1, At, B1); PG8_BAR;
            PG8_LDB(B0, 1, 0); PG8_SCHED; PG8_LDA(At, 1, 0); PG8_STAGE(PG8_SA(0, 1), a2 + hstep, voffA);
            PG8_WAIT_L(8); PG8_BAR; PG8_WAIT_L(0); PG8_MMA(0, 0, At, B0); PG8_BAR; PG8_SCHED;
            PG8_LDB(B1, 1, 1); PG8_STAGE(PG8_SB(1, 0), b3, voffB);
            PG8_BAR; PG8_WAIT_L(0); PG8_MMA(0, 1, At, B1); PG8_BAR;
            PG8_LDA(At, 1, 1); PG8_STAGE(PG8_SA(1, 0), a3, voffA);
            PG8_BAR; PG8_WAIT_L(0); PG8_MMA(1, 0, At, B0); PG8_BAR; PG8_SCHED;
            PG8_STAGE(PG8_SB(1, 1), b3 + hstep, voffB);
            PG8_WAIT_V(6); PG8_BAR; PG8_MMA(1, 1, At, B1); PG8_BAR;
            }
        }
        if constexpr (ALIGN_EPI) { if (wr == 0) PG8_BAR; }
        if constexpr (!Epi::AFTER_DRAIN) { E(acc, cur, wr, wc, fr, fq); S.done(cur); }
        if (!has_next) break;
#pragma unroll
        for (int a = 0; a < 2; ++a)
#pragma unroll
            for (int b = 0; b < 2; ++b)
#pragma unroll
                for (int m = 0; m < 4; ++m)
#pragma unroll
                    for (int n = 0; n < 2; ++n) acc[a][b][m][n] = (f32x4){0.f, 0.f, 0.f, 0.f};
        cur = nxt; cA = nA; cB = nB; ++ui;
        if constexpr (ALIGN_EPI) { if (wr == 1) PG8_BAR; }
    }
    PG8_WAIT_V(0);
    if constexpr (!ALIGN_EPI) { if (wr == 0) PG8_BAR; }
    PG8_BAR;
    if constexpr (Epi::AFTER_DRAIN) { E.fused(acc, cur, wr, wc, fr, fq, lds, wid, lane); S.done(cur); }
#undef PG8_SA
#undef PG8_SB
#undef PG8_STAGE
#undef PG8_LDA
#undef PG8_LDB
#undef PG8_MMA
#undef PG8_WAIT_V
#undef PG8_WAIT_L
#undef PG8_BAR
#undef PG8_SCHED
}
}
namespace attn {
using bf16 = __hip_bfloat16;
constexpr int   D = 128, NW = 8, QBLK = 32, KVBLK = 64;
constexpr float SCALE = 0.088388347648318440f;
constexpr float THR = 8.f;
constexpr int SDEPTH = 2;
constexpr int LDQ = 1024, LDK = 256, LDO = 1024;
constexpr size_t SHM_V = KVBLK * D * 2, SHM_K = KVBLK * D * 2, SHM_ATTN = 2 * SHM_V + 2 * SHM_K + NW * 64 * 4;
using bf16x8 = __attribute__((ext_vector_type(8))) short;
using s16x4  = __attribute__((ext_vector_type(4))) short;
using f32x16 = __attribute__((ext_vector_type(16))) float;
using f32x8  = __attribute__((ext_vector_type(8))) float;
using u32x4  = __attribute__((ext_vector_type(4))) unsigned;
#define KSWZ(row, colB) ((row) * 256 + ((colB) ^ (((row) & 7) << 4)))
#define SBAR() __builtin_amdgcn_sched_barrier(0)
__device__ __forceinline__ int crow(int r, int hi) { return (r & 3) + 8 * (r >> 2) + 4 * hi; }
__device__ __forceinline__ unsigned cvtpk(float lo, float hi) {
  unsigned r; asm volatile("v_cvt_pk_bf16_f32 %0, %1, %2" : "=v"(r) : "v"(lo), "v"(hi)); return r;
}
template <typename TIn> struct Stage;
template <> struct Stage<bf16>  { using T = bf16x8;
  __device__ static __forceinline__ T ld8(const bf16* p) { return *reinterpret_cast<const bf16x8*>(p); }
  __device__ static __forceinline__ bf16x8 tobf(T x) { return x; } };
template <> struct Stage<float> { using T = f32x8;
  __device__ static __forceinline__ T ld8(const float* p) { return *reinterpret_cast<const f32x8*>(p); }
  __device__ static __forceinline__ bf16x8 tobf(T x) {
    u32x4 w = {cvtpk(x[0], x[1]), cvtpk(x[2], x[3]), cvtpk(x[4], x[5]), cvtpk(x[6], x[7])}; return *reinterpret_cast<bf16x8*>(&w); } };

__device__ __forceinline__ void partialSM(f32x16& p0, f32x16& p1, float& m_reg, float& mn, float& alpha) {
  constexpr float C = SCALE * 1.4426950408889634f;
  float pmax = p0[0]; for (int r = 1; r < 16; ++r) pmax = fmaxf(pmax, p0[r]); for (int r = 0; r < 16; ++r) pmax = fmaxf(pmax, p1[r]);
  { auto rr = __builtin_amdgcn_permlane32_swap(__float_as_uint(pmax), __float_as_uint(pmax), false, false);
    pmax = fmaxf(__uint_as_float(rr[0]), __uint_as_float(rr[1])); }
  if (__builtin_expect(__all(pmax - m_reg <= THR / SCALE), 1)) { mn = m_reg; alpha = 1.f; }
  else { mn = fmaxf(m_reg, pmax); alpha = __builtin_amdgcn_exp2f((m_reg - mn) * C); m_reg = mn; }
  float mnC = -mn * C;
  for (int r = 0; r < 16; ++r) p0[r] = fmaf(p0[r], C, mnC); for (int r = 0; r < 16; ++r) p1[r] = fmaf(p1[r], C, mnC);
  for (int r = 0; r < 16; ++r) p0[r] = __builtin_amdgcn_exp2f(p0[r]);
}
__device__ __forceinline__ void finishSM(f32x16& p0, f32x16& p1, float alpha, float& l_reg, bf16x8& pa0, bf16x8& pa1, bf16x8& pa2, bf16x8& pa3) {
  for (int r = 0; r < 16; ++r) p1[r] = __builtin_amdgcn_exp2f(p1[r]);
  float ps = 0; for (int r = 0; r < 16; ++r) ps += p0[r]; for (int r = 0; r < 16; ++r) ps += p1[r];
  { auto rr = __builtin_amdgcn_permlane32_swap(__float_as_uint(ps), __float_as_uint(ps), false, false);
    ps = __uint_as_float(rr[0]) + __uint_as_float(rr[1]); }
  l_reg = l_reg * alpha + ps;
#define PK4(P, BASE, OUT) do { unsigned a0 = cvtpk(P[BASE + 0], P[BASE + 1]), a1 = cvtpk(P[BASE + 2], P[BASE + 3]);   \
    unsigned b0 = cvtpk(P[BASE + 4], P[BASE + 5]), b1 = cvtpk(P[BASE + 6], P[BASE + 7]);                              \
    auto r0 = __builtin_amdgcn_permlane32_swap(a0, b0, false, false); auto r1 = __builtin_amdgcn_permlane32_swap(a1, b1, false, false); \
    u32x4 w = {r0[0], r1[0], r0[1], r1[1]}; OUT = *reinterpret_cast<bf16x8*>(&w); } while (0)
  PK4(p0, 0, pa0); PK4(p0, 8, pa1); PK4(p1, 0, pa2); PK4(p1, 8, pa3);
#undef PK4
}
__device__ __forceinline__ void qkt(f32x16& p0, f32x16& p1, const bf16* Ks, const bf16x8* qr, int r32, int hi) {
  p0 = f32x16{}; p1 = f32x16{};
  for (int d0 = 0; d0 < 8; ++d0) { int cb = (d0 * 16 + hi * 8) * 2;
    bf16x8 b0 = *reinterpret_cast<const bf16x8*>((const char*)Ks + KSWZ(r32, cb));
    bf16x8 b1 = *reinterpret_cast<const bf16x8*>((const char*)Ks + KSWZ(32 + r32, cb));
    p0 = __builtin_amdgcn_mfma_f32_32x32x16_bf16(b0, qr[d0], p0, 0, 0, 0);
    p1 = __builtin_amdgcn_mfma_f32_32x32x16_bf16(b1, qr[d0], p1, 0, 0, 0); }
}
__device__ __forceinline__ int v_st(int k, int c) { const int kk = (k & ~0xC) | ((k & 4) << 1) | ((k & 8) >> 1); return ((kk >> 3) * 4 + (c >> 5)) * 512 + ((kk & 7) * 32 + (c & 31)) * 2; }
__device__ __forceinline__ int v_rd_base(int lane) { return ((lane & 3) << 3) | (((lane >> 2) & 3) << 6) | (((lane >> 4) & 1) << 5) | (((lane >> 5) & 1) << 8); }
constexpr int v_rd_off(int d0, int ks, int half) { return d0 * 512 + ks * 4096 + half * 2048; }
template <int OFF> __device__ __forceinline__ s16x4 tr_read(int vb) {
  s16x4 r; asm volatile("ds_read_b64_tr_b16 %0, %1 offset:%2" : "=&v"(r) : "v"(vb), "i"(OFF) : "memory"); return r;
}
template <int D0> __device__ __forceinline__ void pv_one(f32x16& od, int vb, bf16x8 pa0, bf16x8 pa1, bf16x8 pa2, bf16x8 pa3) {
  const s16x4 l0 = tr_read<v_rd_off(D0, 0, 0)>(vb), h0 = tr_read<v_rd_off(D0, 0, 1)>(vb), l1 = tr_read<v_rd_off(D0, 1, 0)>(vb), h1 = tr_read<v_rd_off(D0, 1, 1)>(vb);
  const s16x4 l2 = tr_read<v_rd_off(D0, 2, 0)>(vb), h2 = tr_read<v_rd_off(D0, 2, 1)>(vb), l3 = tr_read<v_rd_off(D0, 3, 0)>(vb), h3 = tr_read<v_rd_off(D0, 3, 1)>(vb);
  asm volatile("s_waitcnt lgkmcnt(0)" ::: "memory"); SBAR();
#define PK(L, H) (bf16x8){L[0], L[1], L[2], L[3], H[0], H[1], H[2], H[3]}
  od = __builtin_amdgcn_mfma_f32_32x32x16_bf16(pa0, PK(l0, h0), od, 0, 0, 0);
  od = __builtin_amdgcn_mfma_f32_32x32x16_bf16(pa1, PK(l1, h1), od, 0, 0, 0);
  od = __builtin_amdgcn_mfma_f32_32x32x16_bf16(pa2, PK(l2, h2), od, 0, 0, 0);
  od = __builtin_amdgcn_mfma_f32_32x32x16_bf16(pa3, PK(l3, h3), od, 0, 0, 0);
#undef PK
}
__device__ __forceinline__ void pv_d0(f32x16* o, int vb, bf16x8 pa0, bf16x8 pa1, bf16x8 pa2, bf16x8 pa3) {
  pv_one<0>(o[0], vb, pa0, pa1, pa2, pa3); pv_one<1>(o[1], vb, pa0, pa1, pa2, pa3); pv_one<2>(o[2], vb, pa0, pa1, pa2, pa3); pv_one<3>(o[3], vb, pa0, pa1, pa2, pa3);
}

template <typename TQ>
__device__ __forceinline__ void attn_dense_body(const TQ* Qb, const bf16* Kh, const bf16* Vh,
                                                unsigned short* Ob, int seq, char* lds) {
  using St = Stage<bf16>; using SQ = Stage<TQ>;
  const int tid = opaque_tid(), wid = tid >> 6, lane = tid & 63, r32 = lane & 31, hi = lane >> 5;
  bf16* V_lds = (bf16*)lds; bf16* K_lds = (bf16*)(lds + 2 * SHM_V);
  float* ws = (float*)(lds + 2 * SHM_V + 2 * SHM_K) + wid * 64; float* li_l = ws; float* al_l = ws + 32;
  float m_reg = -1e30f, l_reg = 0; f32x16 o[4] = {}; bf16x8 qr[8];
  const TQ* Qw = Qb + (long)(wid * QBLK + r32) * LDQ + hi * 8;
#pragma unroll
  for (int d0 = 0; d0 < 8; ++d0) qr[d0] = SQ::tobf(SQ::ld8(Qw + d0 * 16));
  const int sr = tid >> 4, sc = (tid & 15) * 8, vst0 = v_st(sr, sc), vst1 = v_st(32 + sr, sc);
  const int vb0 = (int)(uintptr_t)V_lds + v_rd_base(lane);
  struct { typename St::T vs0, vs1, ks0, ks1; } sr_[SDEPTH];
#define SLOAD(i, k0) do { sr_[i].vs0 = St::ld8(&Vh[(long)((k0) + sr) * LDK + sc]); sr_[i].vs1 = St::ld8(&Vh[(long)((k0) + 32 + sr) * LDK + sc]); \
    sr_[i].ks0 = St::ld8(&Kh[(long)((k0) + sr) * LDK + sc]); sr_[i].ks1 = St::ld8(&Kh[(long)((k0) + 32 + sr) * LDK + sc]); } while (0)
#define SWRITE(b, i) do { *(bf16x8*)((char*)V_lds + (b) * SHM_V + vst0) = St::tobf(sr_[i].vs0);          \
    *(bf16x8*)((char*)V_lds + (b) * SHM_V + vst1) = St::tobf(sr_[i].vs1); int kc = sc * 2;               \
    *(bf16x8*)((char*)K_lds + (b) * SHM_K + KSWZ(sr, kc)) = St::tobf(sr_[i].ks0);                       \
    *(bf16x8*)((char*)K_lds + (b) * SHM_K + KSWZ(32 + sr, kc)) = St::tobf(sr_[i].ks1); } while (0)
#define SWAIT() do { if constexpr (SDEPTH == 2) asm volatile("s_waitcnt vmcnt(4)" ::: "memory"); else asm volatile("s_waitcnt vmcnt(0)" ::: "memory"); } while (0)
#define RESC(a) do { if (__any((a) < 1.f)) { if (hi == 0) al_l[r32] = (a); asm volatile("s_waitcnt lgkmcnt(0)" ::: "memory"); \
    for (int d = 0; d < 4; ++d) for (int r = 0; r < 16; ++r) o[d][r] *= al_l[crow(r, hi)]; } } while (0)
  f32x16 pA0, pA1, pB0, pB1; float mnA, mnB, alA, alB; bf16x8 pa0, pa1, pa2, pa3; const int NT = seq / KVBLK;
  constexpr int SE = 0, SO = SDEPTH - 1;
  SLOAD(SE, 0); asm volatile("s_waitcnt vmcnt(0)" ::: "memory"); SWRITE(0, SE); __syncthreads();
  qkt(pA0, pA1, K_lds, qr, r32, hi); partialSM(pA0, pA1, m_reg, mnA, alA);
  SLOAD(SO, KVBLK); if constexpr (SDEPTH == 2) { if (2 < NT) SLOAD(SE, 2 * KVBLK); }
  SWAIT(); SWRITE(1, SO); __syncthreads();
  for (int j = 1; j + 1 < NT; j += 2) {
    SBAR(); qkt(pB0, pB1, (bf16*)((char*)K_lds + SHM_K), qr, r32, hi);
    finishSM(pA0, pA1, alA, l_reg, pa0, pa1, pa2, pa3); SBAR();
    SLOAD(SO, (j + SDEPTH) * KVBLK); SBAR();
    pv_d0(o, vb0, pa0, pa1, pa2, pa3); partialSM(pB0, pB1, m_reg, mnB, alB);
    __syncthreads(); SWAIT(); SWRITE(0, SE);
    RESC(alB); __syncthreads();
    SBAR(); qkt(pA0, pA1, K_lds, qr, r32, hi);
    finishSM(pB0, pB1, alB, l_reg, pa0, pa1, pa2, pa3); SBAR();
    if (SDEPTH == 1 || j + 3 < NT) SLOAD(SE, (j + 1 + SDEPTH) * KVBLK); SBAR();
    pv_d0(o, vb0 + (int)SHM_V, pa0, pa1, pa2, pa3); partialSM(pA0, pA1, m_reg, mnA, alA);
    __syncthreads(); SWAIT(); SWRITE(1, SO);
    RESC(alA); __syncthreads();
  }
  SBAR(); qkt(pB0, pB1, (bf16*)((char*)K_lds + SHM_K), qr, r32, hi);
  finishSM(pA0, pA1, alA, l_reg, pa0, pa1, pa2, pa3); SBAR();
  pv_d0(o, vb0, pa0, pa1, pa2, pa3); partialSM(pB0, pB1, m_reg, mnB, alB);
  __syncthreads(); RESC(alB);
  finishSM(pB0, pB1, alB, l_reg, pa0, pa1, pa2, pa3); SBAR();
  pv_d0(o, vb0 + (int)SHM_V, pa0, pa1, pa2, pa3);
  if (hi == 0) li_l[r32] = l_reg; asm volatile("s_waitcnt lgkmcnt(0)" ::: "memory");
  float rli[16];
#pragma unroll
  for (int r = 0; r < 16; ++r) rli[r] = __builtin_amdgcn_rcpf(li_l[crow(r, hi)]);
  unsigned short* Ow = Ob + (long)(wid * QBLK) * LDO;
#pragma unroll
  for (int r = 0; r < 16; ++r) { int orow = crow(r, hi);
    for (int d0 = 0; d0 < 4; ++d0) Ow[(long)orow * LDO + d0 * 32 + r32] = (unsigned short)(cvtpk(o[d0][r] * rli[r], 0.f) & 0xffffu); }
#undef SLOAD
#undef SWRITE
#undef SWAIT
#undef RESC
}
}
#define XB_TMO      128
#define XB_XCNT(j)  (256  + 64 * (j))
#define XB_XSUB(j)  (1280 + 64 * (j))
#define XB_XGEN(j)  (2304 + 64 * (j))
#define XB_TOP      3328
#define XB_TOPGEN   3392
#define XCD_BAR_WORDS 3456
#define XB_SPIN_CAP (1u << 18)

__device__ __forceinline__ unsigned xb_ld(unsigned* p)              { return __hip_atomic_load(p, __ATOMIC_RELAXED, __HIP_MEMORY_SCOPE_AGENT); }
__device__ __forceinline__ unsigned xb_add(unsigned* p, unsigned v) { return __hip_atomic_fetch_add(p, v, __ATOMIC_RELAXED, __HIP_MEMORY_SCOPE_AGENT); }
__device__ __forceinline__ unsigned xb_xcc_id() { return (unsigned)__builtin_amdgcn_s_getreg((3 << 11) | 20) & 0xFu; }
#define XB_SPIN(cond, bar) do { unsigned _sp = 0; while (cond) { __builtin_amdgcn_s_sleep(1); \
    if ((++_sp & 255u) == 0u) { if (xb_ld(&(bar)[XB_TMO])) break; if (_sp > XB_SPIN_CAP) { atomicAdd(&(bar)[XB_TMO], 1u); break; } } } } while (0)

struct XcdBarrier {
    unsigned* bar; unsigned x;
    volatile LAS unsigned* st;
};

__device__ __forceinline__ XcdBarrier xcd_barrier_post(unsigned* bar, volatile LAS unsigned* st) {
    XcdBarrier b; b.bar = bar; b.x = xb_xcc_id(); b.st = st;
    if (threadIdx.x == 0) (void)xb_add(&bar[XB_XCNT(b.x)], 1u);
    return b;
}
__device__ __forceinline__ void xcd_barrier_complete(unsigned* bar, unsigned x, unsigned& nloc, unsigned& nx) {
    const unsigned G = gridDim.x * gridDim.y * gridDim.z;
    unsigned sum, cnt, mine, sp = 0u;
    for (;;) {
        sum = 0u; cnt = 0u; mine = 0u;
#pragma unroll
        for (unsigned j = 0; j < 16; ++j) { const unsigned c = xb_ld(&bar[XB_XCNT(j)]); sum += c; cnt += (c > 0u) ? 1u : 0u; mine = (j == x) ? c : mine; }
        if (sum == G) break;
        __builtin_amdgcn_s_sleep(1);
        if ((++sp & 255u) == 0u) { if (xb_ld(&bar[XB_TMO])) break; if (sp > XB_SPIN_CAP) { atomicAdd(&bar[XB_TMO], 1u); break; } }
    }
    nloc = mine > 0u ? mine : 1u; nx = cnt > 0u ? cnt : 1u;
}

__device__ __forceinline__ void xcd_barrier(const XcdBarrier& b) {
    asm volatile("s_waitcnt vmcnt(0)" ::: "memory");
    __syncthreads();
    if (threadIdx.x == 0) {
        unsigned* bar = b.bar;
        __builtin_amdgcn_s_waitcnt(0);
        unsigned nloc = b.st[0], nx = b.st[1];
        if (nloc == 0u) { xcd_barrier_complete(bar, b.x, nloc, nx); b.st[0] = nloc; b.st[1] = nx; }
        const unsigned old = xb_add(&bar[XB_XSUB(b.x)], 1u);
        const unsigned gen = old / nloc;
        if (old + 1u == (gen + 1u) * nloc) {
            __builtin_amdgcn_fence(__ATOMIC_RELEASE, "agent");
            asm volatile("s_waitcnt vmcnt(0)" ::: "memory");
            const unsigned og = xb_add(&bar[XB_TOP], 1u);
            const unsigned tg = og / nx;
            if (og + 1u == (tg + 1u) * nx) xb_add(&bar[XB_TOPGEN], 1u);
            else XB_SPIN(xb_ld(&bar[XB_TOPGEN]) == tg, bar);
            __builtin_amdgcn_fence(__ATOMIC_ACQUIRE, "agent");
            xb_add(&bar[XB_XGEN(b.x)], 1u);
            asm volatile("s_waitcnt vmcnt(0)" ::: "memory");
        } else {
            XB_SPIN(xb_ld(&bar[XB_XGEN(b.x)]) == gen, bar);
            __builtin_amdgcn_fence(__ATOMIC_ACQUIRE, "agent");
            asm volatile("s_waitcnt vmcnt(0)" ::: "memory");
        }
    }
    __syncthreads();
}
#define LAS __attribute__((address_space(3)))
typedef unsigned short bf16_t;
typedef float f32x4 __attribute__((ext_vector_type(4)));
typedef float f32x2 __attribute__((ext_vector_type(2)));
typedef unsigned u32x4 __attribute__((ext_vector_type(4)));
typedef unsigned u32x2 __attribute__((ext_vector_type(2)));
typedef short bf16x8 __attribute__((ext_vector_type(8)));
typedef short s16x4 __attribute__((ext_vector_type(4)));
#define LDS_WAIT() asm volatile("s_waitcnt lgkmcnt(0)" ::: "memory")
using pg8::cvt_pk_bf16; using pg8::bf_lo; using pg8::bf_hi; using pg8::sigmoidf_;

__device__ __forceinline__ float wave_sum(float v) {
#pragma unroll
    for (int o = 1; o < 64; o <<= 1) v += __shfl_xor(v, o);
    return v;
}

__device__ __forceinline__ void transpose_item(const float* __restrict__ W, int ldW, int K, int src_n0, int k0, bf16_t* WT, int dst_row0, LAS float* scr, int lane) {
#pragma unroll 8
    for (int i = 0; i < 32; ++i) { const int kk = 2 * i + (lane >> 5); scr[kk * 33 + (lane & 31)] = W[(size_t)(k0 + kk) * ldW + src_n0 + (lane & 31)]; }
    LDS_WAIT(); asm volatile("" ::: "memory");
    const int c = lane & 7;
#pragma unroll
    for (int j = 0; j < 4; ++j) { const int n = (lane >> 3) + 8 * j; const LAS float* s = scr + (8 * c) * 33 + n;
        u32x4 o; o.x = cvt_pk_bf16(s[0 * 33], s[1 * 33]); o.y = cvt_pk_bf16(s[2 * 33], s[3 * 33]); o.z = cvt_pk_bf16(s[4 * 33], s[5 * 33]); o.w = cvt_pk_bf16(s[6 * 33], s[7 * 33]);
        *(u32x4*)(WT + (size_t)(dst_row0 + n) * K + k0 + 8 * c) = o; }
    LDS_WAIT(); asm volatile("" ::: "memory");
}

struct Args { const float* in[20]; float* out; unsigned char* ws; int ph_lo, ph_hi; };
typedef const __attribute__((address_space(4))) Args* KA;

__device__ __forceinline__ void prep_layer(KA a, int L, LAS unsigned char* lds, int gw, int NGW, int wave, int lane) {
    LAS float* scr = (LAS float*)(lds + wave * 8448);
    unsigned char* wsW = a->ws + WS_W;
    const float* w_in = a->in[3] + (size_t)L * DM * INW;
    const float* w_ogla = a->in[9] + (size_t)L * DM * DM; const float* w_oatt = a->in[10] + (size_t)L * DM * DM; const float* w_out = a->in[11] + (size_t)L * DM * DM;
    const float* w_fin = a->in[14] + (size_t)L * DM * 2 * FFH; const float* w_fout = a->in[15] + (size_t)L * FFH * DM;
    const float* w_pp = a->in[17] + (size_t)L * PLE * DM; const float* w_pg = a->in[18] + (size_t)L * DM * DM;
    constexpr int I_A = 16 * 97, I_B = 16 * 112, I_SQ = 16 * 32, I_FI = 16 * 176, I_FO = 44 * 32, I_PP = 4 * 32;
    constexpr int NITEMS = I_A + I_B + 4 * I_SQ + I_FI + I_FO + I_PP;
    for (int it = gw; it < NITEMS; it += NGW) {
        int r = it;
        if (r < I_A) { const int kb = r / 97, nb = r % 97; transpose_item(w_in, INW, DM, 32 * nb, 64 * kb, (bf16_t*)(wsW + W_INA), 32 * nb, scr, lane); continue; } r -= I_A;
        if (r < I_B) { const int kb = r / 112, nb = r % 112; transpose_item(w_in, INW, DM, NA_REAL + 32 * nb, 64 * kb, (bf16_t*)(wsW + W_INB), 32 * nb, scr, lane); continue; } r -= I_B;
        if (r < 4 * I_SQ) { const int which = r / I_SQ, q = r % I_SQ, kb = q / 32, nb = q % 32;
            const float* src = which == 0 ? w_ogla : which == 1 ? w_oatt : which == 2 ? w_out : w_pg;
            const size_t dsto = which == 0 ? W_OGLA : which == 1 ? W_OATT : which == 2 ? W_OUT : W_PG;
            transpose_item(src, DM, DM, 32 * nb, 64 * kb, (bf16_t*)(wsW + dsto), 32 * nb, scr, lane); continue; } r -= 4 * I_SQ;
        if (r < I_FI) { const int kb = r / 176, nb = r % 176; const int n0 = 32 * nb; const int j = n0 < FFH ? n0 : n0 - FFH; const int dst = (j >> 7) * 256 + (n0 < FFH ? 0 : 128) + (j & 127);
            transpose_item(w_fin, 2 * FFH, DM, n0, 64 * kb, (bf16_t*)(wsW + W_FIN), dst, scr, lane); continue; } r -= I_FI;
        if (r < I_FO) { const int kb = r / 32, nb = r % 32; transpose_item(w_fout, DM, FFH, 32 * nb, 64 * kb, (bf16_t*)(wsW + W_FOUT), 32 * nb, scr, lane); continue; } r -= I_FO;
        { const int kb = r / 32, nb = r % 32; transpose_item(w_pp, DM, PLE, 32 * nb, 64 * kb, (bf16_t*)(wsW + W_PP), 32 * nb, scr, lane); }
    }
    { u32x4* z = (u32x4*)(wsW + W_INA + (size_t)NA_REAL * DM * 2); const int nz = (NA_PAD - NA_REAL) * DM * 2 / 16;
      for (int i = gw * 64 + lane; i < nz; i += NGW * 64) z[i] = (u32x4){0u, 0u, 0u, 0u}; }
    { const float* p = a->in[1] + (size_t)L * TOK * PLE; bf16_t* pb = (bf16_t*)(a->ws + WS_PB); const int n8 = TOK * PLE / 8;
      for (int i = gw * 64 + lane; i < n8; i += NGW * 64) { const f32x4 x0 = *(const f32x4*)(p + (size_t)i * 8), x1 = *(const f32x4*)(p + (size_t)i * 8 + 4);
          u32x4 o; o.x = cvt_pk_bf16(x0[0], x0[1]); o.y = cvt_pk_bf16(x0[2], x0[3]); o.z = cvt_pk_bf16(x1[0], x1[1]); o.w = cvt_pk_bf16(x1[2], x1[3]); *(u32x4*)(pb + (size_t)i * 8) = o; } }
}

__device__ __forceinline__ void row_pass(const float* hin, float* hout, const bf16_t* y, const float* __restrict__ gpost, const float* __restrict__ gpre, bf16_t* xa, int xmode, int gw, int NGW, int lane) {
    for (int m = gw; m < TOK; m += NGW) {
        f32x4 v[4];
#pragma unroll
        for (int j = 0; j < 4; ++j) v[j] = ((const f32x4*)(hin + (size_t)m * DM))[lane + 64 * j];
        if (y) {
            f32x4 yv[4]; float ss = 0.f;
#pragma unroll
            for (int j = 0; j < 4; ++j) { const u32x2 w = ((const u32x2*)(y + (size_t)m * DM))[lane + 64 * j]; yv[j] = (f32x4){bf_lo(w.x), bf_hi(w.x), bf_lo(w.y), bf_hi(w.y)};
                ss += (yv[j][0] * yv[j][0] + yv[j][1] * yv[j][1]) + (yv[j][2] * yv[j][2] + yv[j][3] * yv[j][3]); }
            const float rs = rsqrtf(wave_sum(ss) * (1.0f / DM) + EPS);
#pragma unroll
            for (int j = 0; j < 4; ++j) { const f32x4 g = ((const f32x4*)gpost)[lane + 64 * j]; v[j] = v[j] + yv[j] * rs * g; }
        }
#pragma unroll
        for (int j = 0; j < 4; ++j) ((f32x4*)(hout + (size_t)m * DM))[lane + 64 * j] = v[j];
        if (xmode != 0) {
            float r2 = 1.0f;
            if (xmode == 1) { float ss = 0.f;
#pragma unroll
                for (int j = 0; j < 4; ++j) ss += (v[j][0] * v[j][0] + v[j][1] * v[j][1]) + (v[j][2] * v[j][2] + v[j][3] * v[j][3]);
                r2 = rsqrtf(wave_sum(ss) * (1.0f / DM) + EPS); }
#pragma unroll
            for (int j = 0; j < 4; ++j) { f32x4 o = v[j] * r2; if (xmode == 1) o = o * ((const f32x4*)gpre)[lane + 64 * j];
                u32x2 w; w.x = cvt_pk_bf16(o[0], o[1]); w.y = cvt_pk_bf16(o[2], o[3]); ((u32x2*)(xa + (size_t)m * DM))[lane + 64 * j] = w; }
        }
    }
}

__device__ __forceinline__ void qk_norm_rope(unsigned char* rbase, const float* __restrict__ gq, const float* __restrict__ gk, int gw, int NGW, int lane) {
    const int axis = lane >> 5, j = lane & 31, i1 = axis * 64 + j, i2 = i1 + 32;
    const float inv = __builtin_amdgcn_exp2f(-(float)j * (13.287712379549449f / 32.0f));
    const float gq1 = gq[i1], gq2 = gq[i2], gk1 = gk[i1], gk2 = gk[i2];
    for (int it = gw; it < TOK * 10; it += NGW) {
        const int t = it / 10, hs = it % 10;
        bf16_t* p = hs < 8 ? (bf16_t*)(rbase + R_Q) + (size_t)t * 1024 + hs * 128 : (bf16_t*)(rbase + R_K) + (size_t)t * 256 + (hs - 8) * 128;
        const float g1 = hs < 8 ? gq1 : gk1, g2 = hs < 8 ? gq2 : gk2;
        float x1 = bf_lo((unsigned)p[i1]), x2 = bf_lo((unsigned)p[i2]);
        const float rs = rsqrtf(wave_sum(x1 * x1 + x2 * x2) * (1.0f / 128.0f) + EPS);
        x1 = x1 * rs * g1; x2 = x2 * rs * g2;
        const int s = t & (SEQ - 1); const float pos = (float)(axis == 0 ? (s >> 6) : (s & 63));
        const float rev = pos * inv * 0.15915494309189535f;
        const float rf = __builtin_amdgcn_fractf(rev); const float c = __builtin_amdgcn_cosf(rf), sn = __builtin_amdgcn_sinf(rf);
        const float o1 = x1 * c - x2 * sn, o2 = x2 * c + x1 * sn;
        p[i1] = (bf16_t)(cvt_pk_bf16(o1, 0.f) & 0xffffu); p[i2] = (bf16_t)(cvt_pk_bf16(o2, 0.f) & 0xffffu);
    }
}

__device__ __forceinline__ void gla_post(bf16_t* of, const bf16_t* ob, const bf16_t* gg, const float* __restrict__ g, int gw, int NGW, int lane) {
    const f32x4 gv = ((const f32x4*)g)[lane];
    for (int it = gw; it < TOK * 4; it += NGW) {
        const size_t off = (size_t)it * 256 + 4 * lane;
        const u32x2 a = *(const u32x2*)(of + off), b = *(const u32x2*)(ob + off), c = *(const u32x2*)(gg + off);
        f32x4 o = (f32x4){bf_lo(a.x) + bf_lo(b.x), bf_hi(a.x) + bf_hi(b.x), bf_lo(a.y) + bf_lo(b.y), bf_hi(a.y) + bf_hi(b.y)};
        const float rs = rsqrtf(wave_sum((o[0] * o[0] + o[1] * o[1]) + (o[2] * o[2] + o[3] * o[3])) * (1.0f / 256.0f) + EPS);
        const f32x4 gt = (f32x4){bf_lo(c.x), bf_hi(c.x), bf_lo(c.y), bf_hi(c.y)};
#pragma unroll
        for (int k = 0; k < 4; ++k) o[k] = o[k] * rs * gv[k] * (gt[k] * sigmoidf_(gt[k]));
        u32x2 w; w.x = cvt_pk_bf16(o[0], o[1]); w.y = cvt_pk_bf16(o[2], o[3]); *(u32x2*)(of + off) = w;
    }
}
constexpr int GL_QD = 0, GL_KI = 17408, GL_KST = 34816, GL_VT = 53248, GL_STT = 62464, GL_EL = 79872, GL_RA = 80384, GL_TOT = 84480, GL_END = 88576;
constexpr int GS_Q = 272, GS_T = 144;
__device__ __forceinline__ void gla_unit(KA a, int L, int b, int h, int dir, int vs, LAS unsigned char* lds) {
    const int tid = opaque_tid(), lane = tid & 63, w = __builtin_amdgcn_readfirstlane(tid >> 6);
    unsigned char* rbase = a->ws + WS_R;
    const bf16_t* GQ = (const bf16_t*)(rbase + R_GQ); const bf16_t* GK = (const bf16_t*)(rbase + R_GK); const bf16_t* GV = (const bf16_t*)(rbase + R_GV); const float* RA = (const float*)(rbase + R_RA);
    bf16_t* O = (bf16_t*)(a->ws + (dir ? WS_OB : WS_OF));
    float wu0[16], wu1[16];
    { const float* wu = a->in[4] + ((size_t)(L * 2 + dir) * 16) * 512 + h * 128 + 2 * lane;
#pragma unroll
      for (int j = 0; j < 16; ++j) { const f32x2 t = *(const f32x2*)(wu + (size_t)j * 512); wu0[j] = t.x; wu1[j] = t.y; } }
    const f32x2 bias = *(const f32x2*)(a->in[5] + (size_t)(L * 2 + dir) * 512 + h * 128 + 2 * lane);
    f32x4 st[4];
#pragma unroll
    for (int nb = 0; nb < 4; ++nb) st[nb] = (f32x4){0.f, 0.f, 0.f, 0.f};
    for (int i = tid; i < 17408 / 4; i += 512) ((LAS unsigned*)(lds + GL_STT))[i] = 0u;
    const int li = lane & 15, kq = lane >> 4, ib = w & 3, dh = w >> 2;
    const int vrow = tid >> 3, vc8 = tid & 7;
    unsigned qv[8], kv[8]; u32x4 vv; f32x2 rav;
#define GLA_LOAD(ci_) do { const size_t t0_ = (size_t)b * SEQ + (size_t)(ci_) * 64; \
        _Pragma("unroll") for (int r = 0; r < 8; ++r) { qv[r] = *(const unsigned*)(GQ + (t0_ + 8 * w + r) * 512 + h * 128 + 2 * lane); kv[r] = *(const unsigned*)(GK + (t0_ + 8 * w + r) * 512 + h * 128 + 2 * lane); } \
        vv = *(const u32x4*)(GV + (t0_ + vrow) * 1024 + h * 256 + vs * 64 + vc8 * 8); rav = *(const f32x2*)(RA + (t0_ + vrow) * 32 + dir * 16 + 2 * vc8); } while (0)
    GLA_LOAD(dir ? 63 : 0);
    for (int c = 0; c < 64; ++c) {
        const int ci = dir ? 63 - c : c; const size_t t0 = (size_t)b * SEQ + (size_t)ci * 64;
        *(LAS f32x2*)(lds + GL_RA + vrow * 64 + vc8 * 8) = rav;
        { const unsigned short e0 = vv.x & 0xffff, e1 = vv.x >> 16, e2 = vv.y & 0xffff, e3 = vv.y >> 16, e4 = vv.z & 0xffff, e5 = vv.z >> 16, e6 = vv.w & 0xffff, e7 = vv.w >> 16;
          LAS unsigned char* vt = lds + GL_VT + (vc8 * 8) * GS_T + vrow * 2;
          *(LAS unsigned short*)(vt + 0 * GS_T) = e0; *(LAS unsigned short*)(vt + 1 * GS_T) = e1; *(LAS unsigned short*)(vt + 2 * GS_T) = e2; *(LAS unsigned short*)(vt + 3 * GS_T) = e3;
          *(LAS unsigned short*)(vt + 4 * GS_T) = e4; *(LAS unsigned short*)(vt + 5 * GS_T) = e5; *(LAS unsigned short*)(vt + 6 * GS_T) = e6; *(LAS unsigned short*)(vt + 7 * GS_T) = e7; }
        unsigned qc[8], kc[8];
#pragma unroll
        for (int r = 0; r < 8; ++r) { qc[r] = qv[r]; kc[r] = kv[r]; }
        __syncthreads();
        if (c + 1 < 64) GLA_LOAD(dir ? 62 - c : c + 1);
        float la0[8], la1[8];
#pragma unroll
        for (int r = 0; r < 8; ++r) {
            const LAS f32x4* rr = (const LAS f32x4*)(lds + GL_RA + (8 * w + r) * 64);
            float x0 = bias.x, x1 = bias.y;
#pragma unroll
            for (int q4 = 0; q4 < 4; ++q4) { const f32x4 t = rr[q4];
#pragma unroll
                for (int e = 0; e < 4; ++e) { x0 = fmaf(t[e], wu0[4 * q4 + e], x0); x1 = fmaf(t[e], wu1[4 * q4 + e], x1); } }
            la0[r] = (fminf(x0, 0.f) - __logf(1.0f + __expf(-fabsf(x0)))) * (1.0f / 16.0f);
            la1[r] = (fminf(x1, 0.f) - __logf(1.0f + __expf(-fabsf(x1)))) * (1.0f / 16.0f);
        }
        if (dir == 0) {
#pragma unroll
            for (int r = 1; r < 8; ++r) { la0[r] += la0[r - 1]; la1[r] += la1[r - 1]; }
        } else {
#pragma unroll
            for (int r = 6; r >= 0; --r) { la0[r] += la0[r + 1]; la1[r] += la1[r + 1]; }
        }
        *(LAS f32x2*)(lds + GL_TOT + w * 512 + lane * 8) = (f32x2){dir == 0 ? la0[7] : la0[0], dir == 0 ? la1[7] : la1[0]};
        __syncthreads();
        float off0 = 0.f, off1 = 0.f, last0 = 0.f, last1 = 0.f;
#pragma unroll
        for (int g = 0; g < 8; ++g) { const f32x2 t = *(const LAS f32x2*)(lds + GL_TOT + g * 512 + lane * 8); last0 += t.x; last1 += t.y;
            const bool before = dir == 0 ? (g < w) : (g > w); if (before) { off0 += t.x; off1 += t.y; } }
        unsigned ks0[4], ks1[4];
#pragma unroll
        for (int r = 0; r < 8; ++r) {
            const float c0 = la0[r] + off0, c1 = la1[r] + off1;
            const float q0 = bf_lo(qc[r]), q1 = bf_hi(qc[r]), k0 = bf_lo(kc[r]), k1 = bf_hi(kc[r]);
            const float eq0 = __expf(c0) * 0.088388347648318440f, eq1 = __expf(c1) * 0.088388347648318440f;
            const int row = 8 * w + r;
            *(LAS unsigned*)(lds + GL_QD + row * GS_Q + lane * 4) = cvt_pk_bf16(q0 * eq0, q1 * eq1);
            *(LAS unsigned*)(lds + GL_KI + row * GS_Q + lane * 4) = cvt_pk_bf16(k0 * __expf(-c0), k1 * __expf(-c1));
            const float s0 = k0 * __expf(last0 - c0), s1 = k1 * __expf(last1 - c1);
            if (r & 1) { ks0[r >> 1] = cvt_pk_bf16(__builtin_bit_cast(float, ks0[r >> 1]), s0); ks1[r >> 1] = cvt_pk_bf16(__builtin_bit_cast(float, ks1[r >> 1]), s1); }
            else { ks0[r >> 1] = __builtin_bit_cast(unsigned, s0); ks1[r >> 1] = __builtin_bit_cast(unsigned, s1); }
        }
        *(LAS u32x4*)(lds + GL_KST + (2 * lane) * GS_T + w * 16) = (u32x4){ks0[0], ks0[1], ks0[2], ks0[3]};
        *(LAS u32x4*)(lds + GL_KST + (2 * lane + 1) * GS_T + w * 16) = (u32x4){ks1[0], ks1[1], ks1[2], ks1[3]};
        if (w == 0) *(LAS f32x2*)(lds + GL_EL + lane * 8) = (f32x2){__expf(last0), __expf(last1)};
        __syncthreads();
        bf16x8 qf[4];
#pragma unroll
        for (int kk = 0; kk < 4; ++kk) qf[kk] = *(const LAS bf16x8*)(lds + GL_QD + (16 * ib + li) * GS_Q + kk * 64 + kq * 16);
        unsigned pk[4][2];
#pragma unroll
        for (int sb = 0; sb < 4; ++sb) {
            f32x4 sacc = (f32x4){0.f, 0.f, 0.f, 0.f};
#pragma unroll
            for (int kk = 0; kk < 4; ++kk) { const bf16x8 kf = *(const LAS bf16x8*)(lds + GL_KI + (16 * sb + li) * GS_Q + kk * 64 + kq * 16);
                sacc = __builtin_amdgcn_mfma_f32_16x16x32_bf16(kf, qf[kk], sacc, 0, 0, 0); }
            const int irow = 16 * ib + li;
#pragma unroll
            for (int j = 0; j < 4; ++j) { const int srow = 16 * sb + 4 * kq + j; const bool keep = dir == 0 ? (srow <= irow) : (srow >= irow); sacc[j] = keep ? sacc[j] : 0.f; }
            pk[sb][0] = cvt_pk_bf16(sacc[0], sacc[1]); pk[sb][1] = cvt_pk_bf16(sacc[2], sacc[3]);
        }
#pragma unroll
        for (int d2 = 0; d2 < 2; ++d2) { const int db = 2 * dh + d2;
            f32x4 oacc = (f32x4){0.f, 0.f, 0.f, 0.f};
#pragma unroll
            for (int kk = 0; kk < 4; ++kk) { const bf16x8 sf = *(const LAS bf16x8*)(lds + GL_STT + (16 * db + li) * GS_Q + kk * 64 + kq * 16);
                oacc = __builtin_amdgcn_mfma_f32_16x16x32_bf16(sf, qf[kk], oacc, 0, 0, 0); }
#pragma unroll
            for (int kc2 = 0; kc2 < 2; ++kc2) {
                const s16x4 lo = *(const LAS s16x4*)(lds + GL_VT + (16 * db + li) * GS_T + (32 * kc2 + 4 * kq) * 2);
                const s16x4 hi4 = *(const LAS s16x4*)(lds + GL_VT + (16 * db + li) * GS_T + (32 * kc2 + 16 + 4 * kq) * 2);
                const bf16x8 vf = (bf16x8){lo[0], lo[1], lo[2], lo[3], hi4[0], hi4[1], hi4[2], hi4[3]};
                const u32x4 pw = (u32x4){pk[2 * kc2][0], pk[2 * kc2][1], pk[2 * kc2 + 1][0], pk[2 * kc2 + 1][1]};
                oacc = __builtin_amdgcn_mfma_f32_16x16x32_bf16(vf, __builtin_bit_cast(bf16x8, pw), oacc, 0, 0, 0); }
            u32x2 ow; ow.x = cvt_pk_bf16(oacc[0], oacc[1]); ow.y = cvt_pk_bf16(oacc[2], oacc[3]);
            *(u32x2*)(O + (t0 + 16 * ib + li) * 1024 + h * 256 + vs * 64 + 16 * db + 4 * kq) = ow;
        }
        { const f32x4 el = *(const LAS f32x4*)(lds + GL_EL + (16 * w + 4 * kq) * 4);
#pragma unroll
          for (int nb = 0; nb < 4; ++nb) st[nb] = st[nb] * el;
#pragma unroll
          for (int kc2 = 0; kc2 < 2; ++kc2) { const bf16x8 af = *(const LAS bf16x8*)(lds + GL_KST + (16 * w + li) * GS_T + kc2 * 64 + kq * 16);
#pragma unroll
              for (int nb = 0; nb < 4; ++nb) { const bf16x8 bfv = *(const LAS bf16x8*)(lds + GL_VT + (16 * nb + li) * GS_T + kc2 * 64 + kq * 16);
                  st[nb] = __builtin_amdgcn_mfma_f32_16x16x32_bf16(af, bfv, st[nb], 0, 0, 0); } } }
        __syncthreads();
#pragma unroll
        for (int nb = 0; nb < 4; ++nb) { u32x2 sw; sw.x = cvt_pk_bf16(st[nb][0], st[nb][1]); sw.y = cvt_pk_bf16(st[nb][2], st[nb][3]);
            *(LAS u32x2*)(lds + GL_STT + (16 * nb + li) * GS_Q + (16 * w + 4 * kq) * 2) = sw; }
    }
#undef GLA_LOAD
    __syncthreads();
}
#ifndef PH_MASK
#define PH_MASK 0x3fff
#endif
#define EN(k) (((PH_MASK) >> (k)) & 1)
#ifndef PROBE_SYNC_REPS
#define PROBE_SYNC_REPS 1
#endif
#ifndef PROBE_GLA_REPS
#define PROBE_GLA_REPS 1
#endif
__global__ void __launch_bounds__(512) hybrid_fwd(Args a_) {
    extern __shared__ __attribute__((aligned(16))) unsigned char lds_raw[];
    LAS unsigned char* lds = (LAS unsigned char*)lds_raw;
    cg::grid_group grid = cg::this_grid();
    const int ph_lo = a_.ph_lo, ph_hi = a_.ph_hi;
    if (threadIdx.x < 2) ((LAS unsigned*)(lds + 131072))[threadIdx.x] = 0u;
    __syncthreads();
    const XcdBarrier xbar = xcd_barrier_post((unsigned*)(a_.ws + WS_CTL), (volatile LAS unsigned*)(lds + 131072));
    for (int ph = ph_lo; ph < ph_hi; ++ph) {
        const int tid = opaque_tid(), lane = tid & 63, wave = __builtin_amdgcn_readfirstlane(tid >> 6);
        int bx = blockIdx.x, G = gridDim.x; asm volatile("" : "+s"(bx), "+s"(G));
        const int vcu = (G % 8 == 0) ? (bx % 8) * (G / 8) + bx / 8 : bx;
        const int gw = vcu * 8 + wave, NGW = G * 8;
        KA a = (KA)__builtin_amdgcn_kernarg_segment_ptr(); asm volatile("" : "+s"(a));
        unsigned char* ws = a->ws; unsigned char* rbase = ws + WS_R; unsigned char* wsW = ws + WS_W;
        bf16_t* XA = (bf16_t*)(ws + WS_XA); bf16_t* OF = (bf16_t*)(ws + WS_OF); bf16_t* OB = (bf16_t*)(ws + WS_OB); bf16_t* GG = (bf16_t*)(ws + WS_GG); bf16_t* PB = (bf16_t*)(ws + WS_PB);
        float* H = a->out;
        if (ph == 0) { if (EN(13)) {
            prep_layer(a, 0, lds, gw, NGW, wave, lane);
            row_pass(a->in[0], H, nullptr, nullptr, a->in[2], XA, 1, gw, NGW, lane); }
        } else {
            const int L = (ph - 1) / NPH_LAYER, k = (ph - 1) % NPH_LAYER;
            int ngemm = 0; pg8::Gemm g0{}, g1{}; pg8::Epi e0{}, e1{};
            e0.rbase = rbase; e0.ggbase = ws + WS_GG; e1.rbase = rbase; e1.ggbase = ws + WS_GG;
            switch (k) {
            case 0: if (!EN(0)) break; ngemm = 1; g0 = pg8::Gemm{XA, (const bf16_t*)(wsW + W_INA), TOK, NA_PAD, DM}; e0.mode = pg8::EM_ROUTE_A; break;
            case 1: if (!EN(1)) break; for (int rep = 0; rep < PROBE_GLA_REPS; ++rep) for (int u = vcu; u < 256; u += G) gla_unit(a, L, u >> 5, (u >> 3) & 3, (u >> 2) & 1, u & 3, lds); break;
            case 2: if (!EN(2)) break; gla_post(OF, OB, GG, a->in[6] + (size_t)L * 256, gw, NGW, lane);
                    ngemm = 1; g0 = pg8::Gemm{XA, (const bf16_t*)(wsW + W_INB), TOK, NB_COLS, DM}; e0.mode = pg8::EM_ROUTE_B; break;
            case 3: if (!EN(3)) break; qk_norm_rope(rbase, a->in[7] + (size_t)L * 128, a->in[8] + (size_t)L * 128, gw, NGW, lane); break;
            case 4: if (!EN(4)) break; for (int u = vcu; u < 1024; u += G) { const int qb = u & 15, hg = (u >> 4) & 3, kvh = (u >> 6) & 1, b = u >> 7, hq = kvh * 4 + hg;
                        bf16_t* Qb = (bf16_t*)(rbase + R_Q) + ((size_t)b * SEQ + (size_t)qb * 256) * 1024 + hq * 128;
                        const bf16_t* Kh = (const bf16_t*)(rbase + R_K) + (size_t)b * SEQ * 256 + kvh * 128; const bf16_t* Vh = (const bf16_t*)(rbase + R_V) + (size_t)b * SEQ * 256 + kvh * 128;
                        attn::attn_dense_body<attn::bf16>((const attn::bf16*)Qb, (const attn::bf16*)Kh, (const attn::bf16*)Vh, Qb, SEQ, (char*)lds_raw);
                        __syncthreads(); }
                    break;
            case 5: if (!EN(5)) break; ngemm = 2; g0 = pg8::Gemm{OF, (const bf16_t*)(wsW + W_OGLA), TOK, DM, DM}; e0.mode = pg8::EM_GATE1; e0.out = OB; e0.aux = (const bf16_t*)(rbase + R_GA);
                    g1 = pg8::Gemm{(const bf16_t*)(rbase + R_Q), (const bf16_t*)(wsW + W_OATT), TOK, DM, DM}; e1.mode = pg8::EM_GATE2; e1.out = OB; e1.aux = (const bf16_t*)(rbase + R_GB); break;
            case 6: if (!EN(6)) break; ngemm = 1; g0 = pg8::Gemm{OB, (const bf16_t*)(wsW + W_OUT), TOK, DM, DM}; e0.mode = pg8::EM_PLAIN; e0.out = OF; break;
            case 7: if (!EN(7)) break; row_pass(H, H, OF, a->in[12] + (size_t)L * DM, a->in[13] + (size_t)L * DM, XA, 1, gw, NGW, lane); break;
            case 8: if (!EN(8)) break; ngemm = 1; g0 = pg8::Gemm{XA, (const bf16_t*)(wsW + W_FIN), TOK, 2 * FFH, DM}; e0.mode = pg8::EM_SWIGLU; e0.out = (bf16_t*)rbase; break;
            case 9: if (!EN(9)) break; ngemm = 1; g0 = pg8::Gemm{(const bf16_t*)rbase, (const bf16_t*)(wsW + W_FOUT), TOK, DM, FFH}; e0.mode = pg8::EM_PLAIN; e0.out = OF; break;
            case 10: if (!EN(10)) break; row_pass(H, H, OF, a->in[16] + (size_t)L * DM, nullptr, XA, 2, gw, NGW, lane); break;
            case 11: if (!EN(11)) break; ngemm = 2; g0 = pg8::Gemm{PB, (const bf16_t*)(wsW + W_PP), TOK, DM, PLE}; e0.mode = pg8::EM_PLAIN; e0.out = (bf16_t*)rbase;
                     g1 = pg8::Gemm{XA, (const bf16_t*)(wsW + W_PG), TOK, DM, DM}; e1.mode = pg8::EM_PLE2; e1.out = OF; e1.aux = (const bf16_t*)rbase; break;
            default: if (!EN(12)) break; row_pass(H, H, OF, a->in[19] + (size_t)L * DM, L + 1 < DEPTH ? a->in[2] + (size_t)(L + 1) * DM : nullptr, XA, L + 1 < DEPTH ? 1 : 0, gw, NGW, lane);
                     if (L + 1 < DEPTH) prep_layer(a, L + 1, lds, gw, NGW, wave, lane);
                     break;
            }
            for (int gi = 0; gi < ngemm; ++gi) {
                const pg8::Gemm g = gi == 0 ? g0 : g1; const pg8::Epi E = gi == 0 ? e0 : e1;
                pg8::StaticOrder S; S.init(g.M, g.N, G, bx);
                pg8::gemm_phase<pg8::Epi, pg8::StaticOrder, true, true>(lds, g, S, E);
            }
        }
        if (ph + 1 < ph_hi) { if (ph == 0) grid.sync(); else xcd_barrier(xbar); }
    }
}

#if MK_DEBUG
struct DbgReg { unsigned long long off, bytes; int type, pad; };
struct DbgArgs { DbgReg r[3]; int scanH, ph, pass, pad; };
__global__ void __launch_bounds__(256) dbg_scan(unsigned char* ws, const float* out, DbgArgs d) {
    unsigned* nanw = (unsigned*)(ws + WS_CTL); unsigned long long* sums = (unsigned long long*)(ws + WS_CTL + 512 + d.pass * 512);
    unsigned long long s = 0; unsigned bad = 0;
#pragma unroll
    for (int ri = 0; ri < 3; ++ri) {
        const size_t n16 = d.r[ri].bytes / 16; const u32x4* p = (const u32x4*)(ws + d.r[ri].off); const int type = d.r[ri].type;
        for (size_t i = (size_t)blockIdx.x * 256 + threadIdx.x; i < n16; i += (size_t)gridDim.x * 256) {
            const u32x4 v = p[i]; s += (unsigned long long)v.x + v.y + v.z + v.w;
#pragma unroll
            for (int k = 0; k < 4; ++k) { const unsigned w = v[k]; if ((type == 0 && (w & 0x7f80u) == 0x7f80u) || (type <= 1 && (w & 0x7f800000u) == 0x7f800000u)) bad = 1; }
        }
    }
    if (d.scanH) { const size_t no = (size_t)TOK * DM / 4; const u32x4* q = (const u32x4*)out;
        for (size_t i = (size_t)blockIdx.x * 256 + threadIdx.x; i < no; i += (size_t)gridDim.x * 256) {
            const u32x4 v = q[i]; s += (unsigned long long)v.x + v.y + v.z + v.w;
#pragma unroll
            for (int k = 0; k < 4; ++k) if ((v[k] & 0x7f800000u) == 0x7f800000u) bad = 1; } }
    for (int o = 1; o < 64; o <<= 1) { s += __shfl_xor(s, o); bad |= __shfl_xor(bad, o); }
    if ((threadIdx.x & 63) == 0) { atomicAdd(&sums[d.ph], s); if (bad) atomicOr(&nanw[d.ph], 1u); }
}
__global__ void __launch_bounds__(64) dbg_check_gemm_a(unsigned char* ws) {
    unsigned* chk = (unsigned*)(ws + WS_CTL) + 56;
    const int i = blockIdx.x, lane = threadIdx.x;
    const int t = (int)(((long)i * 9973 + 17) % TOK), col = (i * 131 + 5) % NA_REAL;
    const bf16_t* xa = (const bf16_t*)(ws + WS_XA) + (size_t)t * DM; const bf16_t* wt = (const bf16_t*)(ws + WS_W + W_INA) + (size_t)col * DM;
    float acc = 0.f;
    for (int k = lane; k < DM; k += 64) acc += bf_lo((unsigned)xa[k]) * bf_lo((unsigned)wt[k]);
    acc = wave_sum(acc);
    unsigned char* rb = ws + WS_R; float got;
    if (col < 512) got = bf_lo((unsigned)((const bf16_t*)(rb + R_GQ))[(size_t)t * 512 + col]);
    else if (col < 1024) got = bf_lo((unsigned)((const bf16_t*)(rb + R_GK))[(size_t)t * 512 + col - 512]);
    else if (col < 2048) got = bf_lo((unsigned)((const bf16_t*)(rb + R_GV))[(size_t)t * 1024 + col - 1024]);
    else if (col < 3072) got = bf_lo((unsigned)((const bf16_t*)(ws + WS_GG))[(size_t)t * 1024 + col - 2048]);
    else got = ((const float*)(rb + R_RA))[(size_t)t * 32 + col - 3072];
    if (lane == 0) { if (!(fabsf(got - acc) <= 0.03f * fmaxf(1.f, fabsf(acc)))) { atomicOr(chk, fabsf(got) < 1e-9f ? 1u : 2u); if (atomicAdd(chk + 4, 1u) == 0u) { chk[2] = (unsigned)(t & 255) >> 2; chk[3] = (unsigned)(col & 255) >> 3; } } }
    float m = 0.f; const float* ra = (const float*)(rb + R_RA);
    for (int k = lane; k < 2048; k += 64) m = fmaxf(m, fabsf(ra[(size_t)i * 2048 + k]));
    for (int o = 1; o < 64; o <<= 1) m = fmaxf(m, __shfl_xor(m, o));

}
__global__ void __launch_bounds__(64) dbg_check_gemm_b(unsigned char* ws) {
    unsigned* chk = (unsigned*)(ws + WS_CTL) + 57;
    const int i = blockIdx.x, lane = threadIdx.x;
    const int t = (int)(((long)i * 9973 + 17) % TOK), col = (i * 131 + 5) % NB_COLS;
    const bf16_t* xa = (const bf16_t*)(ws + WS_XA) + (size_t)t * DM; const bf16_t* wt = (const bf16_t*)(ws + WS_W + W_INB) + (size_t)col * DM;
    float acc = 0.f;
    for (int k = lane; k < DM; k += 64) acc += bf_lo((unsigned)xa[k]) * bf_lo((unsigned)wt[k]);
    acc = wave_sum(acc);
    unsigned char* rb = ws + WS_R; float got; unsigned bit;
    if (col < 1024) { got = bf_lo((unsigned)((const bf16_t*)(rb + R_Q))[(size_t)t * 1024 + col]); bit = 1u; }
    else if (col < 1280) { got = bf_lo((unsigned)((const bf16_t*)(rb + R_K))[(size_t)t * 256 + col - 1024]); bit = 2u; }
    else if (col < 1536) { got = bf_lo((unsigned)((const bf16_t*)(rb + R_V))[(size_t)t * 256 + col - 1280]); bit = 2u; }
    else if (col < 2560) { got = bf_lo((unsigned)((const bf16_t*)(rb + R_GA))[(size_t)t * 1024 + col - 1536]); bit = 4u; }
    else { got = bf_lo((unsigned)((const bf16_t*)(rb + R_GB))[(size_t)t * 1024 + col - 2560]); bit = 4u; }
    if (lane == 0) { if (!(fabsf(got - acc) <= 0.03f * fmaxf(1.f, fabsf(acc)))) atomicOr(chk, bit); }
}
__global__ void __launch_bounds__(256) dbg_check_gla(unsigned char* ws) {
    unsigned* c58 = (unsigned*)(ws + WS_CTL) + 58; unsigned* c59 = c58 + 1;
    const bf16_t* of = (const bf16_t*)(ws + WS_OF); const bf16_t* ob = (const bf16_t*)(ws + WS_OB);
    unsigned mn = 99u, mx = 0u;
    for (size_t i = (size_t)blockIdx.x * 256 + threadIdx.x; i < (size_t)TOK * DM; i += (size_t)gridDim.x * 256) {
        const unsigned chunk = (unsigned)((i >> 10) & 4095) >> 6;
        if ((of[i] & 0x7f80u) == 0x7f80u) mn = chunk < mn ? chunk : mn;
        if ((ob[i] & 0x7f80u) == 0x7f80u) mx = chunk + 1 > mx ? chunk + 1 : mx;
    }
    if (mn != 99u) atomicMin(c58, mn); if (mx) atomicMax(c59, mx);
}
__global__ void __launch_bounds__(256) dbg_final(unsigned char* ws, float* out) {
    const unsigned* nanw = (const unsigned*)(ws + WS_CTL); const unsigned long long* sa = (const unsigned long long*)(ws + WS_CTL + 512); const unsigned long long* sb = sa + 64;
    int p1 = -1, p2 = -1;
    for (int i = NPHASES - 1; i >= 0; --i) { if (nanw[i]) p1 = i; if (sa[i] != sb[i]) p2 = i; }
    const unsigned chkA = nanw[56], chkB = nanw[57], g0 = nanw[58], g1 = nanw[59];
    if (p1 < 0 && p2 < 0 && chkA == 0 && chkB == 0) return;
    float c1; unsigned e;
    if (chkA | chkB) { c1 = 90.f + (chkA & 7); e = chkB & 7; }
    else if (p1 == 2) { c1 = 10.f + (g0 > 63 ? 70.f : (float)g0); e = g1 / 3; }
    else { c1 = p1 >= 0 ? 10.f + p1 : 40.f + p2; e = p1 >= 0 ? 25 : 30; }
    float code = c1 * 100.f; for (unsigned k = 0; k < e; ++k) code *= 10.f;
    for (size_t i = (size_t)blockIdx.x * 256 + threadIdx.x; i < (size_t)TOK * DM; i += (size_t)gridDim.x * 256) out[i] = i == 0 ? code : 0.f;
}
static DbgArgs dbg_args_for(int ph, int pass) {
    DbgArgs d{}; d.ph = ph; d.pass = pass; int n = 0;
    auto add = [&](size_t off, size_t bytes, int type) { d.r[n].off = off; d.r[n].bytes = bytes; d.r[n].type = type; ++n; };
    if (ph == 0) { add(WS_W, W_END, 0); add(WS_PB, 16 * MiB, 0); add(WS_XA, 64 * MiB, 0); d.scanH = 1; return d; }
    const int k = (ph - 1) % NPH_LAYER;
    switch (k) {
    case 0: add(WS_R, 128 * MiB, 0); add(WS_R + R_RA, 4 * MiB, 1); add(WS_GG, 64 * MiB, 0); break;
    case 1: add(WS_OF, 128 * MiB, 0); break;
    case 2: add(WS_OF, 64 * MiB, 0); add(WS_R, 224 * MiB, 0); break;
    case 3: add(WS_R + R_Q, 80 * MiB, 0); break;
    case 4: add(WS_R + R_Q, 64 * MiB, 0); break;
    case 5: add(WS_OB, 64 * MiB, 0); break;
    case 6: add(WS_OF, 64 * MiB, 0); break;
    case 7: add(WS_XA, 64 * MiB, 0); d.scanH = 1; break;
    case 8: add(WS_R, (size_t)TOK * FFH * 2, 0); break;
    case 9: add(WS_OF, 64 * MiB, 0); break;
    case 10: add(WS_XA, 64 * MiB, 0); d.scanH = 1; break;
    case 11: add(WS_R, 64 * MiB, 0); add(WS_OF, 64 * MiB, 0); break;
    default: add(WS_XA, 64 * MiB, 0); add(WS_W, W_END, 0); add(WS_PB, 16 * MiB, 0); d.scanH = 1; break;
    }
    return d;
}
#endif
extern "C" void kernel_launch(void* const* d_in, const int* in_sizes, int n_in, void* d_out, int out_size, void* d_ws, size_t ws_size, hipStream_t stream) {
    static int grid = 0;
    if (grid == 0) {
        if (n_in != 20 || in_sizes[0] != TOK * DM || out_size != TOK * DM || ws_size < WS_END) {
            fprintf(stderr, "kernel_launch: unexpected shapes (n_in %d, in0 %d, out %d, ws %zu, need %zu); nothing launched\n", n_in, n_in > 0 ? in_sizes[0] : -1, out_size, ws_size, (size_t)WS_END); grid = -1; return; }
        int dev = 0, cus = 0, per_cu = 0;
        if (hipGetDevice(&dev) != hipSuccess || hipDeviceGetAttribute(&cus, hipDeviceAttributeMultiprocessorCount, dev) != hipSuccess) { grid = -1; return; }
        if (hipFuncSetAttribute((const void*)hybrid_fwd, hipFuncAttributeMaxDynamicSharedMemorySize, LDS_BYTES) != hipSuccess) { fprintf(stderr, "kernel_launch: hipFuncSetAttribute failed\n"); grid = -1; return; }
        if (hipOccupancyMaxActiveBlocksPerMultiprocessor(&per_cu, (const void*)hybrid_fwd, 512, LDS_BYTES) != hipSuccess || per_cu < 1) { fprintf(stderr, "kernel_launch: occupancy query says %d\n", per_cu); per_cu = 1; }
        (void)hipGetLastError();
        grid = cus * 1;
        fprintf(stderr, "kernel_launch: grid %d (cus %d, per_cu %d), ws need %zu have %zu\n", grid, cus, per_cu, (size_t)WS_END, ws_size);
    }
    if (grid < 0) return;
    if (hipMemsetAsync((char*)d_ws + WS_CTL, 0, 16384, stream) != hipSuccess) { fprintf(stderr, "kernel_launch: memset failed\n"); return; }
    Args a{};
    for (int i = 0; i < 20; ++i) a.in[i] = (const float*)d_in[i];
    a.out = (float*)d_out; a.ws = (unsigned char*)d_ws;
#if MK_DEBUG
    hipMemsetAsync((char*)d_ws + WS_CTL, 0, 4096, stream); hipMemsetAsync((char*)d_ws + WS_CTL + 58 * 4, 0x63, 1, stream);
    for (int pass = 0; pass < 2; ++pass)
        for (int ph = 0; ph < NPHASES; ++ph) { a.ph_lo = ph; a.ph_hi = ph + 1; hipLaunchKernelGGL(hybrid_fwd, dim3(grid), dim3(512), LDS_BYTES, stream, a);
            hipLaunchKernelGGL(dbg_scan, dim3(2048), dim3(256), 0, stream, (unsigned char*)d_ws, (const float*)d_out, dbg_args_for(ph, pass));
            if (pass == 0 && ph == 1) { hipLaunchKernelGGL(dbg_check_gemm_a, dim3(512), dim3(64), 0, stream, (unsigned char*)d_ws); }
            if (pass == 0 && ph == 2) hipLaunchKernelGGL(dbg_check_gla, dim3(2048), dim3(256), 0, stream, (unsigned char*)d_ws);
            if (pass == 0 && ph == 3) hipLaunchKernelGGL(dbg_check_gemm_b, dim3(512), dim3(64), 0, stream, (unsigned char*)d_ws); }
    hipLaunchKernelGGL(dbg_final, dim3(2048), dim3(256), 0, stream, (unsigned char*)d_ws, (float*)d_out);
#elif MK_PER_PHASE
    for (int ph = 0; ph < NPHASES; ++ph) { a.ph_lo = ph; a.ph_hi = ph + 1; hipLaunchKernelGGL(hybrid_fwd, dim3(grid), dim3(512), LDS_BYTES, stream, a); }
#else
    a.ph_lo = 0; a.ph_hi = NPHASES;
    void* args[] = {&a};
    hipError_t e = hipLaunchCooperativeKernel((const void*)hybrid_fwd, dim3(grid), dim3(512), args, LDS_BYTES, stream);
    if (e != hipSuccess) fprintf(stderr, "kernel_launch: cooperative launch failed: %s (grid %d)\n", hipGetErrorString(e), grid);
#endif
}
```

```cpp
#include <hip/hip_runtime.h>
#include <hip/hip_bf16.h>
#include <hip/hip_cooperative_groups.h>
#include <cstdio>
#include <cstdint>
namespace cg = cooperative_groups;
#ifndef MK_DEBUG
#define MK_DEBUG 0
#endif
#ifndef MK_PER_PHASE
#define MK_PER_PHASE 0
#endif
__device__ __forceinline__ int opaque_tid() { int t = threadIdx.x; asm volatile("" : "+v"(t)); return t; }
#define LAS __attribute__((address_space(3)))
constexpr int TOK = 32768, DM = 1024, SEQ = 4096, NBATCH = 8, DEPTH = 4, INW = 6688, FFH = 2816, PLE = 256;
constexpr int NA_REAL = 3104, NA_PAD = 3328, NB_COLS = 3584;
constexpr float EPS = 1e-6f;
constexpr size_t MiB = 1048576;
constexpr size_t W_INA = 0, W_INB = W_INA + (size_t)NA_PAD * DM * 2, W_OGLA = W_INB + (size_t)NB_COLS * DM * 2, W_OATT = W_OGLA + 2 * MiB, W_OUT = W_OATT + 2 * MiB,
                 W_PG = W_OUT + 2 * MiB, W_FIN = W_PG + 2 * MiB, W_FOUT = W_FIN + (size_t)2 * FFH * DM * 2, W_PP = W_FOUT + (size_t)FFH * DM * 2, W_END = W_PP + (size_t)DM * PLE * 2;
constexpr size_t WS_CTL = 0, WS_W = 16384, WS_R = (WS_W + W_END + 4095) / 4096 * 4096;
constexpr size_t R_Q = 0, R_K = 64 * MiB, R_V = 80 * MiB, R_GA = 96 * MiB, R_GB = 160 * MiB, R_BYTES = 224 * MiB;
constexpr size_t R_GQ = 0, R_GK = 32 * MiB, R_GV = 64 * MiB, R_RA = 128 * MiB;
constexpr size_t WS_HB = WS_R + R_BYTES,   WS_GG_UNUSED = 0, WS_OF = WS_HB + 64 * MiB, WS_OB = WS_OF + 64 * MiB, WS_XA = WS_OB + 64 * MiB, WS_PB = WS_XA + 64 * MiB, WS_END = WS_PB + 16 * MiB;
constexpr int NPH_LAYER = 13, NPHASES = 1 + NPH_LAYER * DEPTH;
constexpr int LDS_BYTES = 131072 + 1024;
namespace pg8 {
#define PG8_LAS __attribute__((address_space(3)))
typedef unsigned short bf16_t;
typedef short bf16x8 __attribute__((ext_vector_type(8)));
typedef float f32x4 __attribute__((ext_vector_type(4)));
typedef unsigned u32x4 __attribute__((ext_vector_type(4)));
constexpr int BM = 256, BK = 64, HALF = 128, HTB = HALF * BK * 2  , STAGE_BYTES = 8 * HTB, NXCD = 8, WGM = 8;

__host__ __device__ __forceinline__ int lds_byte(int r, int c) { const int st = (r >> 4) * 2 + (c >> 5), rr = r & 15, cc = c & 31, ob = rr * 64 + cc * 2; return st * 1024 + (ob ^ (((ob >> 9) & 1) << 5)); }
__host__ __device__ __forceinline__ void stage_rc(int b, int& R, int& C) { const int st = b / 1024, sb = b % 1024, swz = sb ^ (((sb >> 9) & 1) << 5); R = (st >> 1) * 16 + swz / 64; C = (st & 1) * 32 + (swz % 64) / 2; }
__host__ __device__ __forceinline__ int perm32(int rho) { const int n = rho >> 4, i = rho & 15; return 8 * (i >> 2) + 4 * n + (i & 3); }

struct Unit { int pm, pn; };
struct Gemm { const bf16_t* A; const bf16_t* Bt; int M, N, K; };

struct StaticOrder {
    int nM, nN, nwg, G, c;
    __host__ __device__ void init(int M, int N, int G_, int c_) { nM = M / BM; nN = N / BM; nwg = nM * nN; G = G_; c = c_; }
    __host__ __device__ bool next(int i, Unit& u) const {
        const long L = (long)i * G + c; if (L >= nwg) return false;
        int wgid = (int)L; { const int q = nwg / NXCD, r = nwg % NXCD, xcd = wgid % NXCD, off = wgid / NXCD; wgid = (xcd < r ? xcd * (q + 1) : r * (q + 1) + (xcd - r) * q) + off; }
        const int nig = WGM * nN, gid = wgid / nig, fm = gid * WGM, gsz = (nM - fm) < WGM ? (nM - fm) : WGM;
        u.pm = fm + ((wgid % nig) % gsz); u.pn = (wgid % nig) / gsz; return true;
    }
    __device__ __forceinline__ void a_ready(const Unit&) const {}
    __device__ __forceinline__ void done(const Unit&) const {}
};
typedef __bf16 bf16x2_t __attribute__((ext_vector_type(2)));
typedef float f32x2_t __attribute__((ext_vector_type(2)));
__device__ __forceinline__ unsigned cvt_pk_bf16(float lo, float hi) { const f32x2_t f = {lo, hi}; const bf16x2_t v = __builtin_convertvector(f, bf16x2_t); return __builtin_bit_cast(unsigned, v); }
__device__ __forceinline__ float bf_lo(unsigned w) { return __builtin_bit_cast(float, w << 16); }
__device__ __forceinline__ float bf_hi(unsigned w) { return __builtin_bit_cast(float, w & 0xffff0000u); }
__device__ __forceinline__ float sigmoidf_(float x) { return __builtin_amdgcn_rcpf(1.0f + __expf(-x)); }
enum { EM_ROUTE_A = 0, EM_ROUTE_B = 1, EM_GATE1 = 2, EM_GATE2 = 3, EM_PLAIN = 4, EM_SWIGLU = 5, EM_PLE2 = 6 };
struct Epi {
    static constexpr bool PERM = true, AFTER_DRAIN = false;
    int mode; unsigned char* rbase; unsigned char* ggbase; bf16_t* out; const bf16_t* aux; unsigned* dbgmark;
    __device__ __forceinline__ void operator()(const f32x4 (&acc)[2][2][4][2], const Unit& u, int wr, int wc, int fr, int fq) const {
        const int row0 = u.pm * BM + wr * 64 + fr, lc0 = wc * 32 + 8 * fq;
#if MK_DEBUG
#endif
        if (mode == EM_SWIGLU) {
#pragma unroll
            for (int ai = 0; ai < 2; ++ai)
#pragma unroll
                for (int m = 0; m < 4; ++m) { const size_t row = (size_t)(row0 + ai * HALF + m * 16);
                    float o[8];
#pragma unroll
                    for (int n = 0; n < 2; ++n)
#pragma unroll
                        for (int j = 0; j < 4; ++j) { const float g = acc[ai][0][m][n][j], up = acc[ai][1][m][n][j]; o[4 * n + j] = g * sigmoidf_(g) * up; }
                    u32x4 w; w.x = cvt_pk_bf16(o[0], o[1]); w.y = cvt_pk_bf16(o[2], o[3]); w.z = cvt_pk_bf16(o[4], o[5]); w.w = cvt_pk_bf16(o[6], o[7]);
                    *(u32x4*)(out + row * 2816 + u.pn * 128 + lc0) = w; }
            return;
        }
        bf16_t* base = out; int ld = 1024, ct = u.pn * BM; bool is_ra = false;
        if (mode == EM_ROUTE_A) { const int pn = u.pn;
            if (pn < 2) { base = (bf16_t*)(rbase + R_GQ); ld = 512; ct = pn * 256; }
            else if (pn < 4) { base = (bf16_t*)(rbase + R_GK); ld = 512; ct = (pn - 2) * 256; }
            else if (pn < 8) { base = (bf16_t*)(rbase + R_GV); ld = 1024; ct = (pn - 4) * 256; }
            else if (pn < 12) { base = (bf16_t*)ggbase; ld = 1024; ct = (pn - 8) * 256; }
            else is_ra = true;
        } else if (mode == EM_ROUTE_B) { const int pn = u.pn;
            if (pn < 4) { base = (bf16_t*)(rbase + R_Q); ld = 1024; ct = pn * 256; }
            else if (pn == 4) { base = (bf16_t*)(rbase + R_K); ld = 256; ct = 0; }
            else if (pn == 5) { base = (bf16_t*)(rbase + R_V); ld = 256; ct = 0; }
            else if (pn < 10) { base = (bf16_t*)(rbase + R_GA); ld = 1024; ct = (pn - 6) * 256; }
            else { base = (bf16_t*)(rbase + R_GB); ld = 1024; ct = (pn - 10) * 256; }
        }
        if (is_ra) {
            if (wc == 0) { float* ra = (float*)(rbase + R_RA);
#pragma unroll
                for (int ai = 0; ai < 2; ++ai)
#pragma unroll
                    for (int m = 0; m < 4; ++m) { const size_t row = (size_t)(row0 + ai * HALF + m * 16);
                        *(f32x4*)(ra + row * 32 + 8 * fq) = acc[ai][0][m][0]; *(f32x4*)(ra + row * 32 + 8 * fq + 4) = acc[ai][0][m][1]; } }
            return;
        }
#pragma unroll
        for (int ai = 0; ai < 2; ++ai)
#pragma unroll
            for (int m = 0; m < 4; ++m) { const size_t row = (size_t)(row0 + ai * HALF + m * 16);
#pragma unroll
                for (int bj = 0; bj < 2; ++bj) { const int col = ct + bj * HALF + lc0;
                    float o[8];
#pragma unroll
                    for (int n = 0; n < 2; ++n)
#pragma unroll
                        for (int j = 0; j < 4; ++j) o[4 * n + j] = acc[ai][bj][m][n][j];
                    if (mode == EM_GATE1 || mode == EM_GATE2 || mode == EM_PLE2) {
                        const u32x4 a = *(const u32x4*)(aux + row * 1024 + col);
                        const float av[8] = {bf_lo(a.x), bf_hi(a.x), bf_lo(a.y), bf_hi(a.y), bf_lo(a.z), bf_hi(a.z), bf_lo(a.w), bf_hi(a.w)};
                        if (mode == EM_PLE2) {
#pragma unroll
                            for (int j = 0; j < 8; ++j) o[j] = sigmoidf_(o[j]) * av[j];
                        } else {
#pragma unroll
                            for (int j = 0; j < 8; ++j) o[j] = sigmoidf_(av[j]) * o[j];
                            if (mode == EM_GATE2) { const u32x4 p = *(const u32x4*)(base + row * ld + col);
                                o[0] += bf_lo(p.x); o[1] += bf_hi(p.x); o[2] += bf_lo(p.y); o[3] += bf_hi(p.y); o[4] += bf_lo(p.z); o[5] += bf_hi(p.z); o[6] += bf_lo(p.w); o[7] += bf_hi(p.w); }
                        }
                    }
                    u32x4 w; w.x = cvt_pk_bf16(o[0], o[1]); w.y = cvt_pk_bf16(o[2], o[3]); w.z = cvt_pk_bf16(o[4], o[5]); w.w = cvt_pk_bf16(o[6], o[7]);
                    *(u32x4*)(base + row * ld + col) = w;
#if MK_DEBUG
                    if (dbgmark && ai == 0 && m == 0 && bj == 0 && wr == 0 && wc == 0 && fr == 0 && fq == 0) { unsigned* mk = dbgmark + (u.pm * 32 + u.pn) * 4; const unsigned long long ad = (unsigned long long)(base + row * ld + col);
                        mk[0] = (unsigned)ad; mk[1] = (unsigned)(ad >> 32); mk[2] = w.x; mk[3] = 1u; }
#endif
                    } }
    }
};
template <class Epi, class Sched, bool ALIGN_EPI = false, bool SP2 = false>
__device__ __forceinline__ void gemm_phase(PG8_LAS unsigned char* lds, const Gemm g, const Sched& S, const Epi& E) {
    const int tid = opaque_tid(), wid = __builtin_amdgcn_readfirstlane(tid >> 6), lane = tid & 63, wr = wid >> 2, wc = wid & 3, fr = lane & 15, fq = lane >> 4;
    const int K = g.K, nt = K / BK;
    unsigned voffA[2], voffB[2];
#pragma unroll
    for (int i = 0; i < 2; ++i) { int R, C; stage_rc(tid * 16 + i * 8192, R, C); const int Rb = Epi::PERM ? ((R & ~31) + perm32(R & 31)) : R;
        voffA[i] = (unsigned)(R * K + C) * 2u; voffB[i] = (unsigned)(Rb * K + C) * 2u; }
    const size_t kstep = (size_t)(BK * 2);
    const size_t hstep = (size_t)HALF * K * 2;
    const size_t tstep = 2 * hstep;
    const unsigned ldsw = (unsigned)wid * 1024u;
    const int aoff = lds_byte(wr * 64 + fr, fq * 8), boff = lds_byte(wc * 32 + fr, fq * 8);
#define PG8_SA(b, h) (((b) * 2 + (h)) * HTB)
#define PG8_SB(b, h) ((4 + (b) * 2 + (h)) * HTB)
#define PG8_STAGE(bufoff, gbase, voff) do { _Pragma("unroll") for (int _i = 0; _i < 2; ++_i) \
        __builtin_amdgcn_global_load_lds((const unsigned*)((const char*)(gbase) + (voff)[_i]), (PG8_LAS unsigned*)(lds + (bufoff) + ldsw + _i * 8192), 16, 0, 0); } while (0)
#define PG8_LDA(dst, b, h) do { _Pragma("unroll") for (int m = 0; m < 4; ++m) _Pragma("unroll") for (int k = 0; k < 2; ++k) dst[m][k] = *(const PG8_LAS bf16x8*)(lds + PG8_SA(b, h) + aoff + m * 2048 + k * 1024); } while (0)
#define PG8_LDB(dst, b, h) do { _Pragma("unroll") for (int n = 0; n < 2; ++n) _Pragma("unroll") for (int k = 0; k < 2; ++k) dst[n][k] = *(const PG8_LAS bf16x8*)(lds + PG8_SB(b, h) + boff + n * 2048 + k * 1024); } while (0)
#define PG8_MMA(ai, bj, At, Bt) do { __builtin_amdgcn_s_setprio(1); _Pragma("unroll") for (int m = 0; m < 4; ++m) _Pragma("unroll") for (int n = 0; n < 2; ++n) _Pragma("unroll") for (int k = 0; k < 2; ++k) \
        acc[ai][bj][m][n] = __builtin_amdgcn_mfma_f32_16x16x32_bf16(Bt[n][k], At[m][k], acc[ai][bj][m][n], 0, 0, 0); __builtin_amdgcn_s_setprio(0); } while (0)
#define PG8_WAIT_V(n) asm volatile("s_waitcnt vmcnt(" #n ")" ::: "memory")
#define PG8_WAIT_L(n) asm volatile("s_waitcnt lgkmcnt(" #n ")" ::: "memory")
#define PG8_BAR __builtin_amdgcn_s_barrier()
#define PG8_SCHED __builtin_amdgcn_sched_barrier(0)
    Unit cur, nxt; int ui = 0;
    if (!S.next(0, cur)) return;
    f32x4 acc[2][2][4][2];
#pragma unroll
    for (int a = 0; a < 2; ++a)
#pragma unroll
        for (int b = 0; b < 2; ++b)
#pragma unroll
            for (int m = 0; m < 4; ++m)
#pragma unroll
                for (int n = 0; n < 2; ++n) acc[a][b][m][n] = (f32x4){0.f, 0.f, 0.f, 0.f};
    bf16x8 At[4][2], B0[2][2], B1[2][2];
    const char* cA = (const char*)g.A + (size_t)cur.pm * tstep; const char* cB = (const char*)g.Bt + (size_t)cur.pn * tstep;
    S.a_ready(cur);
    if constexpr (SP2) {
        PG8_STAGE(PG8_SB(0, 0), cB, voffB); PG8_STAGE(PG8_SB(0, 1), cB + hstep, voffB); PG8_STAGE(PG8_SA(0, 0), cA, voffA); PG8_STAGE(PG8_SA(0, 1), cA + hstep, voffA);
        if (wr == 1) PG8_BAR;
        PG8_WAIT_V(2); PG8_BAR;
        PG8_STAGE(PG8_SB(1, 0), cB + kstep, voffB); PG8_STAGE(PG8_SA(1, 0), cA + kstep, voffA); PG8_STAGE(PG8_SB(1, 1), cB + hstep + kstep, voffB);
        PG8_WAIT_V(6); PG8_BAR;
    } else {
        PG8_STAGE(PG8_SB(0, 0), cB, voffB); PG8_STAGE(PG8_SA(0, 0), cA, voffA); PG8_STAGE(PG8_SB(0, 1), cB + hstep, voffB); PG8_STAGE(PG8_SA(0, 1), cA + hstep, voffA);
        if (wr == 1) PG8_BAR;
        PG8_WAIT_V(4); PG8_BAR;
        PG8_STAGE(PG8_SB(1, 0), cB + kstep, voffB); PG8_STAGE(PG8_SA(1, 0), cA + kstep, voffA); PG8_STAGE(PG8_SB(1, 1), cB + hstep + kstep, voffB);
        PG8_WAIT_V(6); PG8_BAR;
    }
    for (;;) {
        const bool has_next = S.next(ui + 1, nxt);
        const char* nA = has_next ? (const char*)g.A + (size_t)nxt.pm * tstep : cA; const char* nB = has_next ? (const char*)g.Bt + (size_t)nxt.pn * tstep : cB;
        for (int t = 0; t < nt; t += 2) {
            const bool last = (t == nt - 2);
            const char* a1 = cA + (size_t)(t + 1) * kstep;
            const char* a2 = last ? nA : cA + (size_t)(t + 2) * kstep; const char* b2 = last ? nB : cB + (size_t)(t + 2) * kstep;
            const char* a3 = a2 + kstep; const char* b3 = b2 + kstep;
            if (last && has_next) S.a_ready(nxt);
            if constexpr (SP2) {
            PG8_LDB(B0, 0, 0); PG8_LDB(B1, 0, 1); PG8_SCHED; PG8_LDA(At, 0, 0); PG8_STAGE(PG8_SA(1, 1), a1 + hstep, voffA);
            PG8_WAIT_V(8); PG8_WAIT_L(0); PG8_BAR; PG8_MMA(0, 0, At, B0); PG8_MMA(0, 1, At, B1); PG8_BAR; PG8_SCHED;
            PG8_LDA(At, 0, 1); PG8_STAGE(PG8_SB(0, 0), b2, voffB); PG8_STAGE(PG8_SB(0, 1), b2 + hstep, voffB); PG8_STAGE(PG8_SA(0, 0), a2, voffA);
            PG8_WAIT_V(8); PG8_WAIT_L(0); PG8_BAR; PG8_MMA(1, 0, At, B0); PG8_MMA(1, 1, At, B1); PG8_BAR; PG8_SCHED;
            PG8_LDB(B0, 1, 0); PG8_LDB(B1, 1, 1); PG8_SCHED; PG8_LDA(At, 1, 0); PG8_STAGE(PG8_SA(0, 1), a2 + hstep, voffA);
            PG8_WAIT_V(8); PG8_WAIT_L(0); PG8_BAR; PG8_MMA(0, 0, At, B0); PG8_MMA(0, 1, At, B1); PG8_BAR; PG8_SCHED;
            PG8_LDA(At, 1, 1); PG8_STAGE(PG8_SB(1, 0), b3, voffB); PG8_STAGE(PG8_SB(1, 1), b3 + hstep, voffB); PG8_STAGE(PG8_SA(1, 0), a3, voffA);
            PG8_WAIT_V(8); PG8_WAIT_L(0); PG8_BAR; PG8_MMA(1, 0, At, B0); PG8_MMA(1, 1, At, B1); PG8_BAR; PG8_SCHED;
            } else {
            PG8_LDB(B0, 0, 0); PG8_SCHED; PG8_LDA(At, 0, 0); PG8_STAGE(PG8_SA(1, 1), a1 + hstep, voffA);
            PG8_WAIT_L(8); PG8_BAR; PG8_WAIT_L(0); PG8_MMA(0, 0, At, B0); PG8_BAR; PG8_SCHED;
            PG8_LDB(B1, 0, 1); PG8_STAGE(PG8_SB(0, 0), b2, voffB);
            PG8_BAR; PG8_WAIT_L(0); PG8_MMA(0, 1, At, B1); PG8_BAR;
            PG8_LDA(At, 0, 1); PG8_STAGE(PG8_SA(0, 0), a2, voffA);
            PG8_BAR; PG8_WAIT_L(0); PG8_MMA(1, 0, At, B0); PG8_BAR; PG8_SCHED;
            PG8_STAGE(PG8_SB(0, 1), b2 + hstep, voffB);
            PG8_WAIT_V(6); PG8_BAR; PG8_MMA(1, 1, At, B1); PG8_BAR;
            PG8_LDB(B0, 1, 0); PG8_SCHED; PG8_LDA(At, 1, 0); PG8_STAGE(PG8_SA(0, 1), a2 + hstep, voffA);
            PG8_WAIT_L(8); PG8_BAR; PG8_WAIT_L(0); PG8_MMA(0, 0, At, B0); PG8_BAR; PG8_SCHED;
            PG8_LDB(B1, 1, 1); PG8_STAGE(PG8_SB(1, 0), b3, voffB);
            PG8_BAR; PG8_WAIT_L(0); PG8_MMA(0, 1, At, B1); PG8_BAR;
            PG8_LDA(At, 1, 1); PG8_STAGE(PG8_SA(1, 0), a3, voffA);
            PG8_BAR; PG8_WAIT_L(0); PG8_MMA(1, 0, At, B0); PG8_BAR; PG8_SCHED;
            PG8_STAGE(PG8_SB(1, 1), b3 + hstep, voffB);
            PG8_WAIT_V(6); PG8_BAR; PG8_MMA(1, 1, At, B1); PG8_BAR;
            }
        }
        if constexpr (ALIGN_EPI) { if (wr == 0) PG8_BAR; }
        if constexpr (!Epi::AFTER_DRAIN) { E(acc, cur, wr, wc, fr, fq); S.done(cur); }
        if (!has_next) break;
#pragma unroll
        for (int a = 0; a < 2; ++a)
#pragma unroll
            for (int b = 0; b < 2; ++b)
#pragma unroll
                for (int m = 0; m < 4; ++m)
#pragma unroll
                    for (int n = 0; n < 2; ++n) acc[a][b][m][n] = (f32x4){0.f, 0.f, 0.f, 0.f};
        cur = nxt; cA = nA; cB = nB; ++ui;
        if constexpr (ALIGN_EPI) { if (wr == 1) PG8_BAR; }
    }
    PG8_WAIT_V(0);
    if constexpr (!ALIGN_EPI) { if (wr == 0) PG8_BAR; }
    PG8_BAR;
    if constexpr (Epi::AFTER_DRAIN) { E.fused(acc, cur, wr, wc, fr, fq, lds, wid, lane); S.done(cur); }
#undef PG8_SA
#undef PG8_SB
#undef PG8_STAGE
#undef PG8_LDA
#undef PG8_LDB
#undef PG8_MMA
#undef PG8_WAIT_V
#undef PG8_WAIT_L
#undef PG8_BAR
#undef PG8_SCHED
}
}
namespace attn {
using bf16 = __hip_bfloat16;
constexpr int   D = 128, NW = 8, QBLK = 32, KVBLK = 64;
constexpr float SCALE = 0.088388347648318440f;
constexpr float THR = 8.f;
constexpr int SDEPTH = 2;
constexpr int LDQ = 1024, LDK = 256, LDO = 1024;
constexpr size_t SHM_V = KVBLK * D * 2, SHM_K = KVBLK * D * 2, SHM_ATTN = 2 * SHM_V + 2 * SHM_K + NW * 64 * 4;
using bf16x8 = __attribute__((ext_vector_type(8))) short;
using s16x4  = __attribute__((ext_vector_type(4))) short;
using f32x16 = __attribute__((ext_vector_type(16))) float;
using f32x8  = __attribute__((ext_vector_type(8))) float;
using u32x4  = __attribute__((ext_vector_type(4))) unsigned;
#define KSWZ(row, colB) ((row) * 256 + ((colB) ^ (((row) & 7) << 4)))
#define SBAR() __builtin_amdgcn_sched_barrier(0)
__device__ __forceinline__ int crow(int r, int hi) { return (r & 3) + 8 * (r >> 2) + 4 * hi; }
__device__ __forceinline__ unsigned cvtpk(float lo, float hi) {
  unsigned r; asm volatile("v_cvt_pk_bf16_f32 %0, %1, %2" : "=v"(r) : "v"(lo), "v"(hi)); return r;
}
template <typename TIn> struct Stage;
template <> struct Stage<bf16>  { using T = bf16x8;
  __device__ static __forceinline__ T ld8(const bf16* p) { return *reinterpret_cast<const bf16x8*>(p); }
  __device__ static __forceinline__ bf16x8 tobf(T x) { return x; } };
template <> struct Stage<float> { using T = f32x8;
  __device__ static __forceinline__ T ld8(const float* p) { return *reinterpret_cast<const f32x8*>(p); }
  __device__ static __forceinline__ bf16x8 tobf(T x) {
    u32x4 w = {cvtpk(x[0], x[1]), cvtpk(x[2], x[3]), cvtpk(x[4], x[5]), cvtpk(x[6], x[7])}; return *reinterpret_cast<bf16x8*>(&w); } };

__device__ __forceinline__ void partialSM(f32x16& p0, f32x16& p1, float& m_reg, float& mn, float& alpha) {
  constexpr float C = SCALE * 1.4426950408889634f;
  float pmax = p0[0]; for (int r = 1; r < 16; ++r) pmax = fmaxf(pmax, p0[r]); for (int r = 0; r < 16; ++r) pmax = fmaxf(pmax, p1[r]);
  { auto rr = __builtin_amdgcn_permlane32_swap(__float_as_uint(pmax), __float_as_uint(pmax), false, false);
    pmax = fmaxf(__uint_as_float(rr[0]), __uint_as_float(rr[1])); }
  if (__builtin_expect(__all(pmax - m_reg <= THR / SCALE), 1)) { mn = m_reg; alpha = 1.f; }
  else { mn = fmaxf(m_reg, pmax); alpha = __builtin_amdgcn_exp2f((m_reg - mn) * C); m_reg = mn; }
  float mnC = -mn * C;
  for (int r = 0; r < 16; ++r) p0[r] = fmaf(p0[r], C, mnC); for (int r = 0; r < 16; ++r) p1[r] = fmaf(p1[r], C, mnC);
  for (int r = 0; r < 16; ++r) p0[r] = __builtin_amdgcn_exp2f(p0[r]);
}
__device__ __forceinline__ void finishSM(f32x16& p0, f32x16& p1, float alpha, float& l_reg, bf16x8& pa0, bf16x8& pa1, bf16x8& pa2, bf16x8& pa3) {
  for (int r = 0; r < 16; ++r) p1[r] = __builtin_amdgcn_exp2f(p1[r]);
  float ps = 0; for (int r = 0; r < 16; ++r) ps += p0[r]; for (int r = 0; r < 16; ++r) ps += p1[r];
  { auto rr = __builtin_amdgcn_permlane32_swap(__float_as_uint(ps), __float_as_uint(ps), false, false);
    ps = __uint_as_float(rr[0]) + __uint_as_float(rr[1]); }
  l_reg = l_reg * alpha + ps;
#define PK4(P, BASE, OUT) do { unsigned a0 = cvtpk(P[BASE + 0], P[BASE + 1]), a1 = cvtpk(P[BASE + 2], P[BASE + 3]);   \
    unsigned b0 = cvtpk(P[BASE + 4], P[BASE + 5]), b1 = cvtpk(P[BASE + 6], P[BASE + 7]);                              \
    auto r0 = __builtin_amdgcn_permlane32_swap(a0, b0, false, false); auto r1 = __builtin_amdgcn_permlane32_swap(a1, b1, false, false); \
    u32x4 w = {r0[0], r1[0], r0[1], r1[1]}; OUT = *reinterpret_cast<bf16x8*>(&w); } while (0)
  PK4(p0, 0, pa0); PK4(p0, 8, pa1); PK4(p1, 0, pa2); PK4(p1, 8, pa3);
#undef PK4
}
__device__ __forceinline__ void qkt(f32x16& p0, f32x16& p1, const bf16* Ks, const bf16x8* qr, int r32, int hi) {
  p0 = f32x16{}; p1 = f32x16{};
  for (int d0 = 0; d0 < 8; ++d0) { int cb = (d0 * 16 + hi * 8) * 2;
    bf16x8 b0 = *reinterpret_cast<const bf16x8*>((const char*)Ks + KSWZ(r32, cb));
    bf16x8 b1 = *reinterpret_cast<const bf16x8*>((const char*)Ks + KSWZ(32 + r32, cb));
    p0 = __builtin_amdgcn_mfma_f32_32x32x16_bf16(b0, qr[d0], p0, 0, 0, 0);
    p1 = __builtin_amdgcn_mfma_f32_32x32x16_bf16(b1, qr[d0], p1, 0, 0, 0); }
}
__device__ __forceinline__ int v_st(int k, int c) { const int kk = (k & ~0xC) | ((k & 4) << 1) | ((k & 8) >> 1); return ((kk >> 3) * 4 + (c >> 5)) * 512 + ((kk & 7) * 32 + (c & 31)) * 2; }
__device__ __forceinline__ int v_rd_base(int lane) { return ((lane & 3) << 3) | (((lane >> 2) & 3) << 6) | (((lane >> 4) & 1) << 5) | (((lane >> 5) & 1) << 8); }
constexpr int v_rd_off(int d0, int ks, int half) { return d0 * 512 + ks * 4096 + half * 2048; }
template <int OFF> __device__ __forceinline__ s16x4 tr_read(int vb) {
  s16x4 r; asm volatile("ds_read_b64_tr_b16 %0, %1 offset:%2" : "=&v"(r) : "v"(vb), "i"(OFF) : "memory"); return r;
}
template <int D0> __device__ __forceinline__ void pv_one(f32x16& od, int vb, bf16x8 pa0, bf16x8 pa1, bf16x8 pa2, bf16x8 pa3) {
  const s16x4 l0 = tr_read<v_rd_off(D0, 0, 0)>(vb), h0 = tr_read<v_rd_off(D0, 0, 1)>(vb), l1 = tr_read<v_rd_off(D0, 1, 0)>(vb), h1 = tr_read<v_rd_off(D0, 1, 1)>(vb);
  const s16x4 l2 = tr_read<v_rd_off(D0, 2, 0)>(vb), h2 = tr_read<v_rd_off(D0, 2, 1)>(vb), l3 = tr_read<v_rd_off(D0, 3, 0)>(vb), h3 = tr_read<v_rd_off(D0, 3, 1)>(vb);
  asm volatile("s_waitcnt lgkmcnt(0)" ::: "memory"); SBAR();
#define PK(L, H) (bf16x8){L[0], L[1], L[2], L[3], H[0], H[1], H[2], H[3]}
  od = __builtin_amdgcn_mfma_f32_32x32x16_bf16(pa0, PK(l0, h0), od, 0, 0, 0);
  od = __builtin_amdgcn_mfma_f32_32x32x16_bf16(pa1, PK(l1, h1), od, 0, 0, 0);
  od = __builtin_amdgcn_mfma_f32_32x32x16_bf16(pa2, PK(l2, h2), od, 0, 0, 0);
  od = __builtin_amdgcn_mfma_f32_32x32x16_bf16(pa3, PK(l3, h3), od, 0, 0, 0);
#undef PK
}
__device__ __forceinline__ void pv_d0(f32x16* o, int vb, bf16x8 pa0, bf16x8 pa1, bf16x8 pa2, bf16x8 pa3) {
  pv_one<0>(o[0], vb, pa0, pa1, pa2, pa3); pv_one<1>(o[1], vb, pa0, pa1, pa2, pa3); pv_one<2>(o[2], vb, pa0, pa1, pa2, pa3); pv_one<3>(o[3], vb, pa0, pa1, pa2, pa3);
}

template <typename TQ>
__device__ __forceinline__ void attn_dense_body(const TQ* Qb, const bf16* Kh, const bf16* Vh,
                                                unsigned short* Ob, int seq, char* lds) {
  using St = Stage<bf16>; using SQ = Stage<TQ>;
  const int tid = opaque_tid(), wid = tid >> 6, lane = tid & 63, r32 = lane & 31, hi = lane >> 5;
  bf16* V_lds = (bf16*)lds; bf16* K_lds = (bf16*)(lds + 2 * SHM_V);
  float* ws = (float*)(lds + 2 * SHM_V + 2 * SHM_K) + wid * 64; float* li_l = ws; float* al_l = ws + 32;
  float m_reg = -1e30f, l_reg = 0; f32x16 o[4] = {}; bf16x8 qr[8];
  const TQ* Qw = Qb + (long)(wid * QBLK + r32) * LDQ + hi * 8;
#pragma unroll
  for (int d0 = 0; d0 < 8; ++d0) qr[d0] = SQ::tobf(SQ::ld8(Qw + d0 * 16));
  const int sr = tid >> 4, sc = (tid & 15) * 8, vst0 = v_st(sr, sc), vst1 = v_st(32 + sr, sc);
  const int vb0 = (int)(uintptr_t)V_lds + v_rd_base(lane);
  struct { typename St::T vs0, vs1, ks0, ks1; } sr_[SDEPTH];
#define SLOAD(i, k0) do { sr_[i].vs0 = St::ld8(&Vh[(long)((k0) + sr) * LDK + sc]); sr_[i].vs1 = St::ld8(&Vh[(long)((k0) + 32 + sr) * LDK + sc]); \
    sr_[i].ks0 = St::ld8(&Kh[(long)((k0) + sr) * LDK + sc]); sr_[i].ks1 = St::ld8(&Kh[(long)((k0) + 32 + sr) * LDK + sc]); } while (0)
#define SWRITE(b, i) do { *(bf16x8*)((char*)V_lds + (b) * SHM_V + vst0) = St::tobf(sr_[i].vs0);          \
    *(bf16x8*)((char*)V_lds + (b) * SHM_V + vst1) = St::tobf(sr_[i].vs1); int kc = sc * 2;               \
    *(bf16x8*)((char*)K_lds + (b) * SHM_K + KSWZ(sr, kc)) = St::tobf(sr_[i].ks0);                       \
    *(bf16x8*)((char*)K_lds + (b) * SHM_K + KSWZ(32 + sr, kc)) = St::tobf(sr_[i].ks1); } while (0)
#define SWAIT() do { if constexpr (SDEPTH == 2) asm volatile("s_waitcnt vmcnt(4)" ::: "memory"); else asm volatile("s_waitcnt vmcnt(0)" ::: "memory"); } while (0)
#define RESC(a) do { if (__any((a) < 1.f)) { if (hi == 0) al_l[r32] = (a); asm volatile("s_waitcnt lgkmcnt(0)" ::: "memory"); \
    for (int d = 0; d < 4; ++d) for (int r = 0; r < 16; ++r) o[d][r] *= al_l[crow(r, hi)]; } } while (0)
  f32x16 pA0, pA1, pB0, pB1; float mnA, mnB, alA, alB; bf16x8 pa0, pa1, pa2, pa3; const int NT = seq / KVBLK;
  constexpr int SE = 0, SO = SDEPTH - 1;
  SLOAD(SE, 0); asm volatile("s_waitcnt vmcnt(0)" ::: "memory"); SWRITE(0, SE); __syncthreads();
  qkt(pA0, pA1, K_lds, qr, r32, hi); partialSM(pA0, pA1, m_reg, mnA, alA);
  SLOAD(SO, KVBLK); if constexpr (SDEPTH == 2) { if (2 < NT) SLOAD(SE, 2 * KVBLK); }
  SWAIT(); SWRITE(1, SO); __syncthreads();
  for (int j = 1; j + 1 < NT; j += 2) {
    SBAR(); qkt(pB0, pB1, (bf16*)((char*)K_lds + SHM_K), qr, r32, hi);
    finishSM(pA0, pA1, alA, l_reg, pa0, pa1, pa2, pa3); SBAR();
    SLOAD(SO, (j + SDEPTH) * KVBLK); SBAR();
    pv_d0(o, vb0, pa0, pa1, pa2, pa3); partialSM(pB0, pB1, m_reg, mnB, alB);
    __syncthreads(); SWAIT(); SWRITE(0, SE);
    RESC(alB); __syncthreads();
    SBAR(); qkt(pA0, pA1, K_lds, qr, r32, hi);
    finishSM(pB0, pB1, alB, l_reg, pa0, pa1, pa2, pa3); SBAR();
    if (SDEPTH == 1 || j + 3 < NT) SLOAD(SE, (j + 1 + SDEPTH) * KVBLK); SBAR();
    pv_d0(o, vb0 + (int)SHM_V, pa0, pa1, pa2, pa3); partialSM(pA0, pA1, m_reg, mnA, alA);
    __syncthreads(); SWAIT(); SWRITE(1, SO);
    RESC(alA); __syncthreads();
  }
  SBAR(); qkt(pB0, pB1, (bf16*)((char*)K_lds + SHM_K), qr, r32, hi);
  finishSM(pA0, pA1, alA, l_reg, pa0, pa1, pa2, pa3); SBAR();
  pv_d0(o, vb0, pa0, pa1, pa2, pa3); partialSM(pB0, pB1, m_reg, mnB, alB);
  __syncthreads(); RESC(alB);
  finishSM(pB0, pB1, alB, l_reg, pa0, pa1, pa2, pa3); SBAR();
  pv_d0(o, vb0 + (int)SHM_V, pa0, pa1, pa2, pa3);
  if (hi == 0) li_l[r32] = l_reg; asm volatile("s_waitcnt lgkmcnt(0)" ::: "memory");
  float rli[16];
#pragma unroll
  for (int r = 0; r < 16; ++r) rli[r] = __builtin_amdgcn_rcpf(li_l[crow(r, hi)]);
  unsigned short* Ow = Ob + (long)(wid * QBLK) * LDO;
#pragma unroll
  for (int r = 0; r < 16; ++r) { int orow = crow(r, hi);
    for (int d0 = 0; d0 < 4; ++d0) Ow[(long)orow * LDO + d0 * 32 + r32] = (unsigned short)(cvtpk(o[d0][r] * rli[r], 0.f) & 0xffffu); }
#undef SLOAD
#undef SWRITE
#undef SWAIT
#undef RESC
}
}
#define XB_TMO      128
#define XB_XCNT(j)  (256  + 64 * (j))
#define XB_XSUB(j)  (1280 + 64 * (j))
#define XB_XGEN(j)  (2304 + 64 * (j))
#define XB_TOP      3328
#define XB_TOPGEN   3392
#define XCD_BAR_WORDS 3456
#define XB_SPIN_CAP (1u << 18)

__device__ __forceinline__ unsigned xb_ld(unsigned* p)              { return __hip_atomic_load(p, __ATOMIC_RELAXED, __HIP_MEMORY_SCOPE_AGENT); }
__device__ __forceinline__ unsigned xb_add(unsigned* p, unsigned v) { return __hip_atomic_fetch_add(p, v, __ATOMIC_RELAXED, __HIP_MEMORY_SCOPE_AGENT); }
__device__ __forceinline__ unsigned xb_xcc_id() { return (unsigned)__builtin_amdgcn_s_getreg((3 << 11) | 20) & 0xFu; }
#define XB_SPIN(cond, bar) do { unsigned _sp = 0; while (cond) { __builtin_amdgcn_s_sleep(1); \
    if ((++_sp & 255u) == 0u) { if (xb_ld(&(bar)[XB_TMO])) break; if (_sp > XB_SPIN_CAP) { atomicAdd(&(bar)[XB_TMO], 1u); break; } } } } while (0)

struct XcdBarrier {
    unsigned* bar; unsigned x;
    volatile LAS unsigned* st;
};

__device__ __forceinline__ XcdBarrier xcd_barrier_post(unsigned* bar, volatile LAS unsigned* st) {
    XcdBarrier b; b.bar = bar; b.x = xb_xcc_id(); b.st = st;
    if (threadIdx.x == 0) (void)xb_add(&bar[XB_XCNT(b.x)], 1u);
    return b;
}
__device__ __forceinline__ void xcd_barrier_complete(unsigned* bar, unsigned x, unsigned& nloc, unsigned& nx) {
    const unsigned G = gridDim.x * gridDim.y * gridDim.z;
    unsigned sum, cnt, mine, sp = 0u;
    for (;;) {
        sum = 0u; cnt = 0u; mine = 0u;
#pragma unroll
        for (unsigned j = 0; j < 16; ++j) { const unsigned c = xb_ld(&bar[XB_XCNT(j)]); sum += c; cnt += (c > 0u) ? 1u : 0u; mine = (j == x) ? c : mine; }
        if (sum == G) break;
        __builtin_amdgcn_s_sleep(1);
        if ((++sp & 255u) == 0u) { if (xb_ld(&bar[XB_TMO])) break; if (sp > XB_SPIN_CAP) { atomicAdd(&bar[XB_TMO], 1u); break; } }
    }
    nloc = mine > 0u ? mine : 1u; nx = cnt > 0u ? cnt : 1u;
}

__device__ __forceinline__ void xcd_barrier(const XcdBarrier& b) {
    asm volatile("s_waitcnt vmcnt(0)" ::: "memory");
    __syncthreads();
    if (threadIdx.x == 0) {
        unsigned* bar = b.bar;
        __builtin_amdgcn_s_waitcnt(0);
        unsigned nloc = b.st[0], nx = b.st[1];
        if (nloc == 0u) { xcd_barrier_complete(bar, b.x, nloc, nx); b.st[0] = nloc; b.st[1] = nx; }
        const unsigned old = xb_add(&bar[XB_XSUB(b.x)], 1u);
        const unsigned gen = old / nloc;
        if (old + 1u == (gen + 1u) * nloc) {
            __builtin_amdgcn_fence(__ATOMIC_RELEASE, "agent");
            asm volatile("s_waitcnt vmcnt(0)" ::: "memory");
            const unsigned og = xb_add(&bar[XB_TOP], 1u);
            const unsigned tg = og / nx;
            if (og + 1u == (tg + 1u) * nx) xb_add(&bar[XB_TOPGEN], 1u);
            else XB_SPIN(xb_ld(&bar[XB_TOPGEN]) == tg, bar);
            __builtin_amdgcn_fence(__ATOMIC_ACQUIRE, "agent");
            xb_add(&bar[XB_XGEN(b.x)], 1u);
            asm volatile("s_waitcnt vmcnt(0)" ::: "memory");
        } else {
            XB_SPIN(xb_ld(&bar[XB_XGEN(b.x)]) == gen, bar);
            __builtin_amdgcn_fence(__ATOMIC_ACQUIRE, "agent");
            asm volatile("s_waitcnt vmcnt(0)" ::: "memory");
        }
    }
    __syncthreads();
}
#define LAS __attribute__((address_space(3)))
typedef unsigned short bf16_t;
typedef float f32x4 __attribute__((ext_vector_type(4)));
typedef float f32x2 __attribute__((ext_vector_type(2)));
typedef unsigned u32x4 __attribute__((ext_vector_type(4)));
typedef unsigned u32x2 __attribute__((ext_vector_type(2)));
typedef short bf16x8 __attribute__((ext_vector_type(8)));
typedef short s16x4 __attribute__((ext_vector_type(4)));
#define LDS_WAIT() asm volatile("s_waitcnt lgkmcnt(0)" ::: "memory")
using pg8::cvt_pk_bf16; using pg8::bf_lo; using pg8::bf_hi; using pg8::sigmoidf_;

__device__ __forceinline__ float wave_sum(float v) {
#pragma unroll
    for (int o = 1; o < 64; o <<= 1) v += __shfl_xor(v, o);
    return v;
}

__device__ __forceinline__ void transpose_item(const float* __restrict__ W, int ldW, int K, int src_n0, int k0, bf16_t* WT, int dst_row0, LAS float* scr, int lane) {
#pragma unroll 8
    for (int i = 0; i < 32; ++i) { const int kk = 2 * i + (lane >> 5); scr[kk * 33 + (lane & 31)] = W[(size_t)(k0 + kk) * ldW + src_n0 + (lane & 31)]; }
    LDS_WAIT(); asm volatile("" ::: "memory");
    const int c = lane & 7;
#pragma unroll
    for (int j = 0; j < 4; ++j) { const int n = (lane >> 3) + 8 * j; const LAS float* s = scr + (8 * c) * 33 + n;
        u32x4 o; o.x = cvt_pk_bf16(s[0 * 33], s[1 * 33]); o.y = cvt_pk_bf16(s[2 * 33], s[3 * 33]); o.z = cvt_pk_bf16(s[4 * 33], s[5 * 33]); o.w = cvt_pk_bf16(s[6 * 33], s[7 * 33]);
        *(u32x4*)(WT + (size_t)(dst_row0 + n) * K + k0 + 8 * c) = o; }
    LDS_WAIT(); asm volatile("" ::: "memory");
}

struct Args { const float* in[20]; float* out; unsigned char* ws; int ph_lo, ph_hi; };
typedef const __attribute__((address_space(4))) Args* KA;

__device__ __forceinline__ void prep_layer(KA a, int L, LAS unsigned char* lds, int gw, int NGW, int wave, int lane) {
    LAS float* scr = (LAS float*)(lds + wave * 8448);
    unsigned char* wsW = a->ws + WS_W;
    const float* w_in = a->in[3] + (size_t)L * DM * INW;
    const float* w_ogla = a->in[9] + (size_t)L * DM * DM; const float* w_oatt = a->in[10] + (size_t)L * DM * DM; const float* w_out = a->in[11] + (size_t)L * DM * DM;
    const float* w_fin = a->in[14] + (size_t)L * DM * 2 * FFH; const float* w_fout = a->in[15] + (size_t)L * FFH * DM;
    const float* w_pp = a->in[17] + (size_t)L * PLE * DM; const float* w_pg = a->in[18] + (size_t)L * DM * DM;
    constexpr int I_A = 16 * 97, I_B = 16 * 112, I_SQ = 16 * 32, I_FI = 16 * 176, I_FO = 44 * 32, I_PP = 4 * 32;
    constexpr int NITEMS = I_A + I_B + 4 * I_SQ + I_FI + I_FO + I_PP;
    for (int it = gw; it < NITEMS; it += NGW) {
        int r = it;
        if (r < I_A) { const int kb = r / 97, nb = r % 97; transpose_item(w_in, INW, DM, 32 * nb, 64 * kb, (bf16_t*)(wsW + W_INA), 32 * nb, scr, lane); continue; } r -= I_A;
        if (r < I_B) { const int kb = r / 112, nb = r % 112; transpose_item(w_in, INW, DM, NA_REAL + 32 * nb, 64 * kb, (bf16_t*)(wsW + W_INB), 32 * nb, scr, lane); continue; } r -= I_B;
        if (r < 4 * I_SQ) { const int which = r / I_SQ, q = r % I_SQ, kb = q / 32, nb = q % 32;
            const float* src = which == 0 ? w_ogla : which == 1 ? w_oatt : which == 2 ? w_out : w_pg;
            const size_t dsto = which == 0 ? W_OGLA : which == 1 ? W_OATT : which == 2 ? W_OUT : W_PG;
            transpose_item(src, DM, DM, 32 * nb, 64 * kb, (bf16_t*)(wsW + dsto), 32 * nb, scr, lane); continue; } r -= 4 * I_SQ;
        if (r < I_FI) { const int kb = r / 176, nb = r % 176; const int n0 = 32 * nb; const int j = n0 < FFH ? n0 : n0 - FFH; const int dst = (j >> 7) * 256 + (n0 < FFH ? 0 : 128) + (j & 127);
            transpose_item(w_fin, 2 * FFH, DM, n0, 64 * kb, (bf16_t*)(wsW + W_FIN), dst, scr, lane); continue; } r -= I_FI;
        if (r < I_FO) { const int kb = r / 32, nb = r % 32; transpose_item(w_fout, DM, FFH, 32 * nb, 64 * kb, (bf16_t*)(wsW + W_FOUT), 32 * nb, scr, lane); continue; } r -= I_FO;
        { const int kb = r / 32, nb = r % 32; transpose_item(w_pp, DM, PLE, 32 * nb, 64 * kb, (bf16_t*)(wsW + W_PP), 32 * nb, scr, lane); }
    }
    { u32x4* z = (u32x4*)(wsW + W_INA + (size_t)NA_REAL * DM * 2); const int nz = (NA_PAD - NA_REAL) * DM * 2 / 16;
      for (int i = gw * 64 + lane; i < nz; i += NGW * 64) z[i] = (u32x4){0u, 0u, 0u, 0u}; }
    { const float* p = a->in[1] + (size_t)L * TOK * PLE; bf16_t* pb = (bf16_t*)(a->ws + WS_PB); const int n8 = TOK * PLE / 8;
      for (int i = gw * 64 + lane; i < n8; i += NGW * 64) { const f32x4 x0 = *(const f32x4*)(p + (size_t)i * 8), x1 = *(const f32x4*)(p + (size_t)i * 8 + 4);
          u32x4 o; o.x = cvt_pk_bf16(x0[0], x0[1]); o.y = cvt_pk_bf16(x0[2], x0[3]); o.z = cvt_pk_bf16(x1[0], x1[1]); o.w = cvt_pk_bf16(x1[2], x1[3]); *(u32x4*)(pb + (size_t)i * 8) = o; } }
}

template <bool IN_F32, bool OUT_F32>
__device__ __forceinline__ void row_pass(const void* hin, void* hout, const bf16_t* y, const float* __restrict__ gpost, const float* __restrict__ gpre, bf16_t* xa, int gw, int NGW, int lane) {
    for (int m = gw; m < TOK; m += NGW) {
        f32x4 v[4];
#pragma unroll
        for (int j = 0; j < 4; ++j) {
            if (IN_F32) v[j] = ((const f32x4*)((const float*)hin + (size_t)m * DM))[lane + 64 * j];
            else { const u32x2 w = ((const u32x2*)((const bf16_t*)hin + (size_t)m * DM))[lane + 64 * j]; v[j] = (f32x4){bf_lo(w.x), bf_hi(w.x), bf_lo(w.y), bf_hi(w.y)}; } }
        if (y) {
            f32x4 yv[4]; float ss = 0.f;
#pragma unroll
            for (int j = 0; j < 4; ++j) { const u32x2 w = ((const u32x2*)(y + (size_t)m * DM))[lane + 64 * j]; yv[j] = (f32x4){bf_lo(w.x), bf_hi(w.x), bf_lo(w.y), bf_hi(w.y)};
                ss += (yv[j][0] * yv[j][0] + yv[j][1] * yv[j][1]) + (yv[j][2] * yv[j][2] + yv[j][3] * yv[j][3]); }
            const float rs = rsqrtf(wave_sum(ss) * (1.0f / DM) + EPS);
#pragma unroll
            for (int j = 0; j < 4; ++j) { const f32x4 g = ((const f32x4*)gpost)[lane + 64 * j]; v[j] = v[j] + yv[j] * rs * g; }
        }
#pragma unroll
        for (int j = 0; j < 4; ++j) {
            if (OUT_F32) ((f32x4*)((float*)hout + (size_t)m * DM))[lane + 64 * j] = v[j];
            else { u32x2 w; w.x = cvt_pk_bf16(v[j][0], v[j][1]); w.y = cvt_pk_bf16(v[j][2], v[j][3]); ((u32x2*)((bf16_t*)hout + (size_t)m * DM))[lane + 64 * j] = w; } }
        if (gpre) {
            float ss = 0.f;
#pragma unroll
            for (int j = 0; j < 4; ++j) ss += (v[j][0] * v[j][0] + v[j][1] * v[j][1]) + (v[j][2] * v[j][2] + v[j][3] * v[j][3]);
            const float r2 = rsqrtf(wave_sum(ss) * (1.0f / DM) + EPS);
#pragma unroll
            for (int j = 0; j < 4; ++j) { const f32x4 o = v[j] * r2 * ((const f32x4*)gpre)[lane + 64 * j];
                u32x2 w; w.x = cvt_pk_bf16(o[0], o[1]); w.y = cvt_pk_bf16(o[2], o[3]); ((u32x2*)(xa + (size_t)m * DM))[lane + 64 * j] = w; }
        }
    }
}

__device__ __forceinline__ void qk_norm_rope(unsigned char* rbase, const float* __restrict__ gq, const float* __restrict__ gk, int gw, int NGW, int lane) {
    const int axis = lane >> 5, j = lane & 31, i1 = axis * 64 + j, i2 = i1 + 32;
    const float inv = __builtin_amdgcn_exp2f(-(float)j * (13.287712379549449f / 32.0f));
    const float gq1 = gq[i1], gq2 = gq[i2], gk1 = gk[i1], gk2 = gk[i2];
    for (int it = gw; it < TOK * 10; it += NGW) {
        const int t = it / 10, hs = it % 10;
        bf16_t* p = hs < 8 ? (bf16_t*)(rbase + R_Q) + (size_t)t * 1024 + hs * 128 : (bf16_t*)(rbase + R_K) + (size_t)t * 256 + (hs - 8) * 128;
        const float g1 = hs < 8 ? gq1 : gk1, g2 = hs < 8 ? gq2 : gk2;
        float x1 = bf_lo((unsigned)p[i1]), x2 = bf_lo((unsigned)p[i2]);
        const float rs = rsqrtf(wave_sum(x1 * x1 + x2 * x2) * (1.0f / 128.0f) + EPS);
        x1 = x1 * rs * g1; x2 = x2 * rs * g2;
        const int s = t & (SEQ - 1); const float pos = (float)(axis == 0 ? (s >> 6) : (s & 63));
        const float rev = pos * inv * 0.15915494309189535f;
        const float rf = __builtin_amdgcn_fractf(rev); const float c = __builtin_amdgcn_cosf(rf), sn = __builtin_amdgcn_sinf(rf);
        const float o1 = x1 * c - x2 * sn, o2 = x2 * c + x1 * sn;
        p[i1] = (bf16_t)(cvt_pk_bf16(o1, 0.f) & 0xffffu); p[i2] = (bf16_t)(cvt_pk_bf16(o2, 0.f) & 0xffffu);
    }
}

__device__ __forceinline__ void gla_post(bf16_t* of, const bf16_t* ob, const bf16_t* gg, const float* __restrict__ g, int gw, int NGW, int lane) {
    const f32x4 gv = ((const f32x4*)g)[lane];
    for (int it = gw; it < TOK * 4; it += NGW) {
        const size_t off = (size_t)it * 256 + 4 * lane;
        const u32x2 a = *(const u32x2*)(of + off), b = *(const u32x2*)(ob + off), c = *(const u32x2*)(gg + off);
        f32x4 o = (f32x4){bf_lo(a.x) + bf_lo(b.x), bf_hi(a.x) + bf_hi(b.x), bf_lo(a.y) + bf_lo(b.y), bf_hi(a.y) + bf_hi(b.y)};
        const float rs = rsqrtf(wave_sum((o[0] * o[0] + o[1] * o[1]) + (o[2] * o[2] + o[3] * o[3])) * (1.0f / 256.0f) + EPS);
        const f32x4 gt = (f32x4){bf_lo(c.x), bf_hi(c.x), bf_lo(c.y), bf_hi(c.y)};
#pragma unroll
        for (int k = 0; k < 4; ++k) o[k] = o[k] * rs * gv[k] * (gt[k] * sigmoidf_(gt[k]));
        u32x2 w; w.x = cvt_pk_bf16(o[0], o[1]); w.y = cvt_pk_bf16(o[2], o[3]); *(u32x2*)(of + off) = w;
    }
}
constexpr int GL_QD = 0, GL_KI = 17408, GL_KST = 34816, GL_VT = 53248, GL_STT = 62464, GL_EL = 79872, GL_RA = 80384, GL_TOT = 84480, GL_END = 88576;
constexpr int GS_Q = 272, GS_T = 144;
__device__ __forceinline__ void gla_unit(KA a, int L, int b, int h, int dir, int vs, LAS unsigned char* lds) {
    const int tid = opaque_tid(), lane = tid & 63, w = __builtin_amdgcn_readfirstlane(tid >> 6);
    unsigned char* rbase = a->ws + WS_R;
    const bf16_t* GQ = (const bf16_t*)(rbase + R_GQ); const bf16_t* GK = (const bf16_t*)(rbase + R_GK); const bf16_t* GV = (const bf16_t*)(rbase + R_GV); const float* RA = (const float*)(rbase + R_RA);
    bf16_t* O = (bf16_t*)(a->ws + (dir ? WS_OB : WS_OF));
    f32x2 wu[16];
    { const float* wup = a->in[4] + ((size_t)(L * 2 + dir) * 16) * 512 + h * 128 + 2 * lane;
#pragma unroll
      for (int j = 0; j < 16; ++j) wu[j] = *(const f32x2*)(wup + (size_t)j * 512); }
    const f32x2 bias = *(const f32x2*)(a->in[5] + (size_t)(L * 2 + dir) * 512 + h * 128 + 2 * lane);
    f32x4 st[4];
#pragma unroll
    for (int nb = 0; nb < 4; ++nb) st[nb] = (f32x4){0.f, 0.f, 0.f, 0.f};
    for (int i = tid; i < 17408 / 4; i += 512) ((LAS unsigned*)(lds + GL_STT))[i] = 0u;
    const int li = lane & 15, kq = lane >> 4, ib = w & 3, dh = w >> 2;
    const int vrow = tid >> 3, vc8 = tid & 7;
    unsigned qv[8], kv[8]; u32x4 vv; f32x2 rav;
#define GLA_LOAD(ci_) do { const size_t t0_ = (size_t)b * SEQ + (size_t)(ci_) * 64; \
        _Pragma("unroll") for (int r = 0; r < 8; ++r) { qv[r] = *(const unsigned*)(GQ + (t0_ + 8 * w + r) * 512 + h * 128 + 2 * lane); kv[r] = *(const unsigned*)(GK + (t0_ + 8 * w + r) * 512 + h * 128 + 2 * lane); } \
        vv = *(const u32x4*)(GV + (t0_ + vrow) * 1024 + h * 256 + vs * 64 + vc8 * 8); rav = *(const f32x2*)(RA + (t0_ + vrow) * 32 + dir * 16 + 2 * vc8); } while (0)
    GLA_LOAD(dir ? 63 : 0);
    for (int c = 0; c < 64; ++c) {
        const int ci = dir ? 63 - c : c; const size_t t0 = (size_t)b * SEQ + (size_t)ci * 64;
        *(LAS f32x2*)(lds + GL_RA + vrow * 64 + vc8 * 8) = rav;
        { const unsigned short e0 = vv.x & 0xffff, e1 = vv.x >> 16, e2 = vv.y & 0xffff, e3 = vv.y >> 16, e4 = vv.z & 0xffff, e5 = vv.z >> 16, e6 = vv.w & 0xffff, e7 = vv.w >> 16;
          LAS unsigned char* vt = lds + GL_VT + (vc8 * 8) * GS_T + vrow * 2;
          *(LAS unsigned short*)(vt + 0 * GS_T) = e0; *(LAS unsigned short*)(vt + 1 * GS_T) = e1; *(LAS unsigned short*)(vt + 2 * GS_T) = e2; *(LAS unsigned short*)(vt + 3 * GS_T) = e3;
          *(LAS unsigned short*)(vt + 4 * GS_T) = e4; *(LAS unsigned short*)(vt + 5 * GS_T) = e5; *(LAS unsigned short*)(vt + 6 * GS_T) = e6; *(LAS unsigned short*)(vt + 7 * GS_T) = e7; }
        unsigned qc[8], kc[8];
#pragma unroll
        for (int r = 0; r < 8; ++r) { qc[r] = qv[r]; kc[r] = kv[r]; }
        __syncthreads();
        if (c + 1 < 64) GLA_LOAD(dir ? 62 - c : c + 1);
        float la0[8], la1[8];
#pragma unroll
        for (int r = 0; r < 8; ++r) {
            const LAS f32x4* rr = (const LAS f32x4*)(lds + GL_RA + (8 * w + r) * 64);
            f32x2 x = bias;
#pragma unroll
            for (int q4 = 0; q4 < 4; ++q4) { const f32x4 t = rr[q4];
#pragma unroll
                for (int e = 0; e < 4; ++e) x = __builtin_elementwise_fma((f32x2){t[e], t[e]}, wu[4 * q4 + e], x); }
            const f32x2 xl = x * 1.4426950408889634f;
            la0[r] = (fminf(xl.x, 0.f) - __builtin_amdgcn_logf(1.0f + __builtin_amdgcn_exp2f(-fabsf(xl.x)))) * (1.0f / 16.0f);
            la1[r] = (fminf(xl.y, 0.f) - __builtin_amdgcn_logf(1.0f + __builtin_amdgcn_exp2f(-fabsf(xl.y)))) * (1.0f / 16.0f);
        }
        if (dir == 0) {
#pragma unroll
            for (int r = 1; r < 8; ++r) { la0[r] += la0[r - 1]; la1[r] += la1[r - 1]; }
        } else {
#pragma unroll
            for (int r = 6; r >= 0; --r) { la0[r] += la0[r + 1]; la1[r] += la1[r + 1]; }
        }
        *(LAS f32x2*)(lds + GL_TOT + w * 512 + lane * 8) = (f32x2){dir == 0 ? la0[7] : la0[0], dir == 0 ? la1[7] : la1[0]};
        __syncthreads();
        float off0 = 0.f, off1 = 0.f, last0 = 0.f, last1 = 0.f;
#pragma unroll
        for (int g = 0; g < 8; ++g) { const f32x2 t = *(const LAS f32x2*)(lds + GL_TOT + g * 512 + lane * 8); last0 += t.x; last1 += t.y;
            const bool before = dir == 0 ? (g < w) : (g > w); if (before) { off0 += t.x; off1 += t.y; } }
        const float el0 = __builtin_amdgcn_exp2f(last0), el1 = __builtin_amdgcn_exp2f(last1);
        unsigned ks0[4], ks1[4];
#pragma unroll
        for (int r = 0; r < 8; ++r) {
            const float c0 = la0[r] + off0, c1 = la1[r] + off1;
            const float q0 = bf_lo(qc[r]), q1 = bf_hi(qc[r]), k0 = bf_lo(kc[r]), k1 = bf_hi(kc[r]);
            const float eq0 = __builtin_amdgcn_exp2f(c0) * 0.088388347648318440f, eq1 = __builtin_amdgcn_exp2f(c1) * 0.088388347648318440f;
            const int row = 8 * w + r;
            const float ki0 = k0 * __builtin_amdgcn_exp2f(-c0), ki1 = k1 * __builtin_amdgcn_exp2f(-c1);
            *(LAS unsigned*)(lds + GL_QD + row * GS_Q + lane * 4) = cvt_pk_bf16(q0 * eq0, q1 * eq1);
            *(LAS unsigned*)(lds + GL_KI + row * GS_Q + lane * 4) = cvt_pk_bf16(ki0, ki1);
            const float s0 = ki0 * el0, s1 = ki1 * el1;
            if (r & 1) { ks0[r >> 1] = cvt_pk_bf16(__builtin_bit_cast(float, ks0[r >> 1]), s0); ks1[r >> 1] = cvt_pk_bf16(__builtin_bit_cast(float, ks1[r >> 1]), s1); }
            else { ks0[r >> 1] = __builtin_bit_cast(unsigned, s0); ks1[r >> 1] = __builtin_bit_cast(unsigned, s1); }
        }
        *(LAS u32x4*)(lds + GL_KST + (2 * lane) * GS_T + w * 16) = (u32x4){ks0[0], ks0[1], ks0[2], ks0[3]};
        *(LAS u32x4*)(lds + GL_KST + (2 * lane + 1) * GS_T + w * 16) = (u32x4){ks1[0], ks1[1], ks1[2], ks1[3]};
        if (w == 0) *(LAS f32x2*)(lds + GL_EL + lane * 8) = (f32x2){el0, el1};
        __syncthreads();
        bf16x8 qf[4];
#pragma unroll
        for (int kk = 0; kk < 4; ++kk) qf[kk] = *(const LAS bf16x8*)(lds + GL_QD + (16 * ib + li) * GS_Q + kk * 64 + kq * 16);
        unsigned pk[4][2];
#pragma unroll
        for (int sb = 0; sb < 4; ++sb) {
            if (dir == 0 ? (sb > ib) : (sb < ib)) { pk[sb][0] = 0u; pk[sb][1] = 0u; continue; }
            f32x4 sacc = (f32x4){0.f, 0.f, 0.f, 0.f};
#pragma unroll
            for (int kk = 0; kk < 4; ++kk) { const bf16x8 kf = *(const LAS bf16x8*)(lds + GL_KI + (16 * sb + li) * GS_Q + kk * 64 + kq * 16);
                sacc = __builtin_amdgcn_mfma_f32_16x16x32_bf16(kf, qf[kk], sacc, 0, 0, 0); }
            const int irow = 16 * ib + li;
#pragma unroll
            for (int j = 0; j < 4; ++j) { const int srow = 16 * sb + 4 * kq + j; const bool keep = dir == 0 ? (srow <= irow) : (srow >= irow); sacc[j] = keep ? sacc[j] : 0.f; }
            pk[sb][0] = cvt_pk_bf16(sacc[0], sacc[1]); pk[sb][1] = cvt_pk_bf16(sacc[2], sacc[3]);
        }
#pragma unroll
        for (int d2 = 0; d2 < 2; ++d2) { const int db = 2 * dh + d2;
            f32x4 oacc = (f32x4){0.f, 0.f, 0.f, 0.f};
#pragma unroll
            for (int kk = 0; kk < 4; ++kk) { const bf16x8 sf = *(const LAS bf16x8*)(lds + GL_STT + (16 * db + li) * GS_Q + kk * 64 + kq * 16);
                oacc = __builtin_amdgcn_mfma_f32_16x16x32_bf16(sf, qf[kk], oacc, 0, 0, 0); }
#pragma unroll
            for (int kc2 = 0; kc2 < 2; ++kc2) {
                const s16x4 lo = *(const LAS s16x4*)(lds + GL_VT + (16 * db + li) * GS_T + (32 * kc2 + 4 * kq) * 2);
                const s16x4 hi4 = *(const LAS s16x4*)(lds + GL_VT + (16 * db + li) * GS_T + (32 * kc2 + 16 + 4 * kq) * 2);
                const bf16x8 vf = (bf16x8){lo[0], lo[1], lo[2], lo[3], hi4[0], hi4[1], hi4[2], hi4[3]};
                const u32x4 pw = (u32x4){pk[2 * kc2][0], pk[2 * kc2][1], pk[2 * kc2 + 1][0], pk[2 * kc2 + 1][1]};
                oacc = __builtin_amdgcn_mfma_f32_16x16x32_bf16(vf, __builtin_bit_cast(bf16x8, pw), oacc, 0, 0, 0); }
            u32x2 ow; ow.x = cvt_pk_bf16(oacc[0], oacc[1]); ow.y = cvt_pk_bf16(oacc[2], oacc[3]);
            *(u32x2*)(O + (t0 + 16 * ib + li) * 1024 + h * 256 + vs * 64 + 16 * db + 4 * kq) = ow;
        }
        { const f32x4 el = *(const LAS f32x4*)(lds + GL_EL + (16 * w + 4 * kq) * 4);
#pragma unroll
          for (int nb = 0; nb < 4; ++nb) st[nb] = st[nb] * el;
#pragma unroll
          for (int kc2 = 0; kc2 < 2; ++kc2) { const bf16x8 af = *(const LAS bf16x8*)(lds + GL_KST + (16 * w + li) * GS_T + kc2 * 64 + kq * 16);
#pragma unroll
              for (int nb = 0; nb < 4; ++nb) { const bf16x8 bfv = *(const LAS bf16x8*)(lds + GL_VT + (16 * nb + li) * GS_T + kc2 * 64 + kq * 16);
                  st[nb] = __builtin_amdgcn_mfma_f32_16x16x32_bf16(af, bfv, st[nb], 0, 0, 0); } } }
        __syncthreads();
#pragma unroll
        for (int nb = 0; nb < 4; ++nb) { u32x2 sw; sw.x = cvt_pk_bf16(st[nb][0], st[nb][1]); sw.y = cvt_pk_bf16(st[nb][2], st[nb][3]);
            *(LAS u32x2*)(lds + GL_STT + (16 * nb + li) * GS_Q + (16 * w + 4 * kq) * 2) = sw; }
    }
#undef GLA_LOAD
    __syncthreads();
}
#ifndef PH_MASK
#define PH_MASK 0x3fff
#endif
#define EN(k) (((PH_MASK) >> (k)) & 1)
#ifndef PROBE_SYNC_REPS
#define PROBE_SYNC_REPS 1
#endif
#ifndef PROBE_GLA_REPS
#define PROBE_GLA_REPS 1
#endif
__global__ void __launch_bounds__(512) hybrid_fwd(Args a_) {
    extern __shared__ __attribute__((aligned(16))) unsigned char lds_raw[];
    LAS unsigned char* lds = (LAS unsigned char*)lds_raw;
    cg::grid_group grid = cg::this_grid();
    const int ph_lo = a_.ph_lo, ph_hi = a_.ph_hi;
    if (threadIdx.x < 2) ((LAS unsigned*)(lds + 131072))[threadIdx.x] = 0u;
    __syncthreads();
    const XcdBarrier xbar = xcd_barrier_post((unsigned*)(a_.ws + WS_CTL), (volatile LAS unsigned*)(lds + 131072));
    for (int ph = ph_lo; ph < ph_hi; ++ph) {
        const int tid = opaque_tid(), lane = tid & 63, wave = __builtin_amdgcn_readfirstlane(tid >> 6);
        int bx = blockIdx.x, G = gridDim.x; asm volatile("" : "+s"(bx), "+s"(G));
        const int vcu = (G % 8 == 0) ? (bx % 8) * (G / 8) + bx / 8 : bx;
        const int gw = vcu * 8 + wave, NGW = G * 8;
        KA a = (KA)__builtin_amdgcn_kernarg_segment_ptr(); asm volatile("" : "+s"(a));
        unsigned char* ws = a->ws; unsigned char* rbase = ws + WS_R; unsigned char* wsW = ws + WS_W;
        bf16_t* XA = (bf16_t*)(ws + WS_XA); bf16_t* OF = (bf16_t*)(ws + WS_OF); bf16_t* OB = (bf16_t*)(ws + WS_OB); bf16_t* GG = (bf16_t*)a->out; bf16_t* HB = (bf16_t*)(ws + WS_HB); bf16_t* PB = (bf16_t*)(ws + WS_PB);
        if (ph == 0) { if (EN(13)) {
            prep_layer(a, 0, lds, gw, NGW, wave, lane);
            row_pass<true, false>(a->in[0], HB, nullptr, nullptr, a->in[2], XA, gw, NGW, lane); }
        } else {
            const int L = (ph - 1) / NPH_LAYER, k = (ph - 1) % NPH_LAYER;
            int ngemm = 0; pg8::Gemm g0{}, g1{}; pg8::Epi e0{}, e1{};
            e0.rbase = rbase; e0.ggbase = (unsigned char*)a->out; e1.rbase = rbase; e1.ggbase = (unsigned char*)a->out;
            switch (k) {
            case 0: if (!EN(0)) break; ngemm = 1; g0 = pg8::Gemm{XA, (const bf16_t*)(wsW + W_INA), TOK, NA_PAD, DM}; e0.mode = pg8::EM_ROUTE_A; break;
            case 1: if (!EN(1)) break; for (int rep = 0; rep < PROBE_GLA_REPS; ++rep) for (int u = vcu; u < 256; u += G) gla_unit(a, L, u >> 5, (u >> 3) & 3, (u >> 2) & 1, u & 3, lds); break;
            case 2: if (!EN(2)) break; gla_post(OF, OB, GG, a->in[6] + (size_t)L * 256, gw, NGW, lane);
                    ngemm = 1; g0 = pg8::Gemm{XA, (const bf16_t*)(wsW + W_INB), TOK, NB_COLS, DM}; e0.mode = pg8::EM_ROUTE_B; break;
            case 3: if (!EN(3)) break; qk_norm_rope(rbase, a->in[7] + (size_t)L * 128, a->in[8] + (size_t)L * 128, gw, NGW, lane); break;
            case 4: if (!EN(4)) break; for (int u = vcu; u < 1024; u += G) { const int qb = u & 15, hg = (u >> 4) & 3, kvh = (u >> 6) & 1, b = u >> 7, hq = kvh * 4 + hg;
                        bf16_t* Qb = (bf16_t*)(rbase + R_Q) + ((size_t)b * SEQ + (size_t)qb * 256) * 1024 + hq * 128;
                        const bf16_t* Kh = (const bf16_t*)(rbase + R_K) + (size_t)b * SEQ * 256 + kvh * 128; const bf16_t* Vh = (const bf16_t*)(rbase + R_V) + (size_t)b * SEQ * 256 + kvh * 128;
                        attn::attn_dense_body<attn::bf16>((const attn::bf16*)Qb, (const attn::bf16*)Kh, (const attn::bf16*)Vh, Qb, SEQ, (char*)lds_raw);
                        __syncthreads(); }
                    break;
            case 5: if (!EN(5)) break; ngemm = 2; g0 = pg8::Gemm{OF, (const bf16_t*)(wsW + W_OGLA), TOK, DM, DM}; e0.mode = pg8::EM_GATE1; e0.out = OB; e0.aux = (const bf16_t*)(rbase + R_GA);
                    g1 = pg8::Gemm{(const bf16_t*)(rbase + R_Q), (const bf16_t*)(wsW + W_OATT), TOK, DM, DM}; e1.mode = pg8::EM_GATE2; e1.out = OB; e1.aux = (const bf16_t*)(rbase + R_GB); break;
            case 6: if (!EN(6)) break; ngemm = 1; g0 = pg8::Gemm{OB, (const bf16_t*)(wsW + W_OUT), TOK, DM, DM}; e0.mode = pg8::EM_PLAIN; e0.out = OF; break;
            case 7: if (!EN(7)) break; row_pass<false, false>(HB, HB, OF, a->in[12] + (size_t)L * DM, a->in[13] + (size_t)L * DM, XA, gw, NGW, lane); break;
            case 8: if (!EN(8)) break; ngemm = 1; g0 = pg8::Gemm{XA, (const bf16_t*)(wsW + W_FIN), TOK, 2 * FFH, DM}; e0.mode = pg8::EM_SWIGLU; e0.out = (bf16_t*)rbase; break;
            case 9: if (!EN(9)) break; ngemm = 1; g0 = pg8::Gemm{(const bf16_t*)rbase, (const bf16_t*)(wsW + W_FOUT), TOK, DM, FFH}; e0.mode = pg8::EM_PLAIN; e0.out = OF; break;
            case 10: if (!EN(10)) break; row_pass<false, false>(HB, HB, OF, a->in[16] + (size_t)L * DM, nullptr, nullptr, gw, NGW, lane); break;
            case 11: if (!EN(11)) break; ngemm = 2; g0 = pg8::Gemm{PB, (const bf16_t*)(wsW + W_PP), TOK, DM, PLE}; e0.mode = pg8::EM_PLAIN; e0.out = (bf16_t*)rbase;
                     g1 = pg8::Gemm{HB, (const bf16_t*)(wsW + W_PG), TOK, DM, DM}; e1.mode = pg8::EM_PLE2; e1.out = OF; e1.aux = (const bf16_t*)rbase; break;
            default: if (!EN(12)) break; if (L + 1 < DEPTH) row_pass<false, false>(HB, HB, OF, a->in[19] + (size_t)L * DM, a->in[2] + (size_t)(L + 1) * DM, XA, gw, NGW, lane);
                     else row_pass<false, true>(HB, a->out, OF, a->in[19] + (size_t)L * DM, nullptr, nullptr, gw, NGW, lane);
                     if (L + 1 < DEPTH) prep_layer(a, L + 1, lds, gw, NGW, wave, lane);
                     break;
            }
            for (int gi = 0; gi < ngemm; ++gi) {
                const pg8::Gemm g = gi == 0 ? g0 : g1; const pg8::Epi E = gi == 0 ? e0 : e1;
                pg8::StaticOrder S; S.init(g.M, g.N, G, bx);
                pg8::gemm_phase<pg8::Epi, pg8::StaticOrder, true, true>(lds, g, S, E);
            }
        }
        if (ph + 1 < ph_hi) { if (ph == 0) grid.sync(); else xcd_barrier(xbar); }
    }
}

#if MK_DEBUG
struct DbgReg { unsigned long long off, bytes; int type, pad; };
struct DbgArgs { DbgReg r[3]; int scanH, ph, pass, pad; };
__global__ void __launch_bounds__(256) dbg_scan(unsigned char* ws, const float* out, DbgArgs d) {
    unsigned* nanw = (unsigned*)(ws + WS_CTL); unsigned long long* sums = (unsigned long long*)(ws + WS_CTL + 512 + d.pass * 512);
    unsigned long long s = 0; unsigned bad = 0;
#pragma unroll
    for (int ri = 0; ri < 3; ++ri) {
        const size_t n16 = d.r[ri].bytes / 16; const u32x4* p = (const u32x4*)(ws + d.r[ri].off); const int type = d.r[ri].type;
        for (size_t i = (size_t)blockIdx.x * 256 + threadIdx.x; i < n16; i += (size_t)gridDim.x * 256) {
            const u32x4 v = p[i]; s += (unsigned long long)v.x + v.y + v.z + v.w;
#pragma unroll
            for (int k = 0; k < 4; ++k) { const unsigned w = v[k]; if ((type == 0 && (w & 0x7f80u) == 0x7f80u) || (type <= 1 && (w & 0x7f800000u) == 0x7f800000u)) bad = 1; }
        }
    }
    if (d.scanH) { const size_t no = (size_t)TOK * DM / 4; const u32x4* q = (const u32x4*)out;
        for (size_t i = (size_t)blockIdx.x * 256 + threadIdx.x; i < no; i += (size_t)gridDim.x * 256) {
            const u32x4 v = q[i]; s += (unsigned long long)v.x + v.y + v.z + v.w;
#pragma unroll
            for (int k = 0; k < 4; ++k) if ((v[k] & 0x7f800000u) == 0x7f800000u) bad = 1; } }
    for (int o = 1; o < 64; o <<= 1) { s += __shfl_xor(s, o); bad |= __shfl_xor(bad, o); }
    if ((threadIdx.x & 63) == 0) { atomicAdd(&sums[d.ph], s); if (bad) atomicOr(&nanw[d.ph], 1u); }
}
__global__ void __launch_bounds__(64) dbg_check_gemm_a(unsigned char* ws) {
    unsigned* chk = (unsigned*)(ws + WS_CTL) + 56;
    const int i = blockIdx.x, lane = threadIdx.x;
    const int t = (int)(((long)i * 9973 + 17) % TOK), col = (i * 131 + 5) % NA_REAL;
    const bf16_t* xa = (const bf16_t*)(ws + WS_XA) + (size_t)t * DM; const bf16_t* wt = (const bf16_t*)(ws + WS_W + W_INA) + (size_t)col * DM;
    float acc = 0.f;
    for (int k = lane; k < DM; k += 64) acc += bf_lo((unsigned)xa[k]) * bf_lo((unsigned)wt[k]);
    acc = wave_sum(acc);
    unsigned char* rb = ws + WS_R; float got;
    if (col < 512) got = bf_lo((unsigned)((const bf16_t*)(rb + R_GQ))[(size_t)t * 512 + col]);
    else if (col < 1024) got = bf_lo((unsigned)((const bf16_t*)(rb + R_GK))[(size_t)t * 512 + col - 512]);
    else if (col < 2048) got = bf_lo((unsigned)((const bf16_t*)(rb + R_GV))[(size_t)t * 1024 + col - 1024]);
    else if (col < 3072) got = bf_lo((unsigned)((const bf16_t*)(ws + WS_GG))[(size_t)t * 1024 + col - 2048]);
    else got = ((const float*)(rb + R_RA))[(size_t)t * 32 + col - 3072];
    if (lane == 0) { if (!(fabsf(got - acc) <= 0.03f * fmaxf(1.f, fabsf(acc)))) { atomicOr(chk, fabsf(got) < 1e-9f ? 1u : 2u); if (atomicAdd(chk + 4, 1u) == 0u) { chk[2] = (unsigned)(t & 255) >> 2; chk[3] = (unsigned)(col & 255) >> 3; } } }
    float m = 0.f; const float* ra = (const float*)(rb + R_RA);
    for (int k = lane; k < 2048; k += 64) m = fmaxf(m, fabsf(ra[(size_t)i * 2048 + k]));
    for (int o = 1; o < 64; o <<= 1) m = fmaxf(m, __shfl_xor(m, o));

}
__global__ void __launch_bounds__(64) dbg_check_gemm_b(unsigned char* ws) {
    unsigned* chk = (unsigned*)(ws + WS_CTL) + 57;
    const int i = blockIdx.x, lane = threadIdx.x;
    const int t = (int)(((long)i * 9973 + 17) % TOK), col = (i * 131 + 5) % NB_COLS;
    const bf16_t* xa = (const bf16_t*)(ws + WS_XA) + (size_t)t * DM; const bf16_t* wt = (const bf16_t*)(ws + WS_W + W_INB) + (size_t)col * DM;
    float acc = 0.f;
    for (int k = lane; k < DM; k += 64) acc += bf_lo((unsigned)xa[k]) * bf_lo((unsigned)wt[k]);
    acc = wave_sum(acc);
    unsigned char* rb = ws + WS_R; float got; unsigned bit;
    if (col < 1024) { got = bf_lo((unsigned)((const bf16_t*)(rb + R_Q))[(size_t)t * 1024 + col]); bit = 1u; }
    else if (col < 1280) { got = bf_lo((unsigned)((const bf16_t*)(rb + R_K))[(size_t)t * 256 + col - 1024]); bit = 2u; }
    else if (col < 1536) { got = bf_lo((unsigned)((const bf16_t*)(rb + R_V))[(size_t)t * 256 + col - 1280]); bit = 2u; }
    else if (col < 2560) { got = bf_lo((unsigned)((const bf16_t*)(rb + R_GA))[(size_t)t * 1024 + col - 1536]); bit = 4u; }
    else { got = bf_lo((unsigned)((const bf16_t*)(rb + R_GB))[(size_t)t * 1024 + col - 2560]); bit = 4u; }
    if (lane == 0) { if (!(fabsf(got - acc) <= 0.03f * fmaxf(1.f, fabsf(acc)))) atomicOr(chk, bit); }
}
__global__ void __launch_bounds__(256) dbg_check_gla(unsigned char* ws) {
    unsigned* c58 = (unsigned*)(ws + WS_CTL) + 58; unsigned* c59 = c58 + 1;
    const bf16_t* of = (const bf16_t*)(ws + WS_OF); const bf16_t* ob = (const bf16_t*)(ws + WS_OB);
    unsigned mn = 99u, mx = 0u;
    for (size_t i = (size_t)blockIdx.x * 256 + threadIdx.x; i < (size_t)TOK * DM; i += (size_t)gridDim.x * 256) {
        const unsigned chunk = (unsigned)((i >> 10) & 4095) >> 6;
        if ((of[i] & 0x7f80u) == 0x7f80u) mn = chunk < mn ? chunk : mn;
        if ((ob[i] & 0x7f80u) == 0x7f80u) mx = chunk + 1 > mx ? chunk + 1 : mx;
    }
    if (mn != 99u) atomicMin(c58, mn); if (mx) atomicMax(c59, mx);
}
__global__ void __launch_bounds__(256) dbg_final(unsigned char* ws, float* out) {
    const unsigned* nanw = (const unsigned*)(ws + WS_CTL); const unsigned long long* sa = (const unsigned long long*)(ws + WS_CTL + 512); const unsigned long long* sb = sa + 64;
    int p1 = -1, p2 = -1;
    for (int i = NPHASES - 1; i >= 0; --i) { if (nanw[i]) p1 = i; if (sa[i] != sb[i]) p2 = i; }
    const unsigned chkA = nanw[56], chkB = nanw[57], g0 = nanw[58], g1 = nanw[59];
    if (p1 < 0 && p2 < 0 && chkA == 0 && chkB == 0) return;
    float c1; unsigned e;
    if (chkA | chkB) { c1 = 90.f + (chkA & 7); e = chkB & 7; }
    else if (p1 == 2) { c1 = 10.f + (g0 > 63 ? 70.f : (float)g0); e = g1 / 3; }
    else { c1 = p1 >= 0 ? 10.f + p1 : 40.f + p2; e = p1 >= 0 ? 25 : 30; }
    float code = c1 * 100.f; for (unsigned k = 0; k < e; ++k) code *= 10.f;
    for (size_t i = (size_t)blockIdx.x * 256 + threadIdx.x; i < (size_t)TOK * DM; i += (size_t)gridDim.x * 256) out[i] = i == 0 ? code : 0.f;
}
static DbgArgs dbg_args_for(int ph, int pass) {
    DbgArgs d{}; d.ph = ph; d.pass = pass; int n = 0;
    auto add = [&](size_t off, size_t bytes, int type) { d.r[n].off = off; d.r[n].bytes = bytes; d.r[n].type = type; ++n; };
    if (ph == 0) { add(WS_W, W_END, 0); add(WS_PB, 16 * MiB, 0); add(WS_XA, 64 * MiB, 0); d.scanH = 1; return d; }
    const int k = (ph - 1) % NPH_LAYER;
    switch (k) {
    case 0: add(WS_R, 128 * MiB, 0); add(WS_R + R_RA, 4 * MiB, 1); add(WS_GG, 64 * MiB, 0); break;
    case 1: add(WS_OF, 128 * MiB, 0); break;
    case 2: add(WS_OF, 64 * MiB, 0); add(WS_R, 224 * MiB, 0); break;
    case 3: add(WS_R + R_Q, 80 * MiB, 0); break;
    case 4: add(WS_R + R_Q, 64 * MiB, 0); break;
    case 5: add(WS_OB, 64 * MiB, 0); break;
    case 6: add(WS_OF, 64 * MiB, 0); break;
    case 7: add(WS_XA, 64 * MiB, 0); d.scanH = 1; break;
    case 8: add(WS_R, (size_t)TOK * FFH * 2, 0); break;
    case 9: add(WS_OF, 64 * MiB, 0); break;
    case 10: add(WS_XA, 64 * MiB, 0); d.scanH = 1; break;
    case 11: add(WS_R, 64 * MiB, 0); add(WS_OF, 64 * MiB, 0); break;
    default: add(WS_XA, 64 * MiB, 0); add(WS_W, W_END, 0); add(WS_PB, 16 * MiB, 0); d.scanH = 1; break;
    }
    return d;
}
#endif
extern "C" void kernel_launch(void* const* d_in, const int* in_sizes, int n_in, void* d_out, int out_size, void* d_ws, size_t ws_size, hipStream_t stream) {
    static int grid = 0;
    if (grid == 0) {
        if (n_in != 20 || in_sizes[0] != TOK * DM || out_size != TOK * DM || ws_size < WS_END) {
            fprintf(stderr, "kernel_launch: unexpected shapes (n_in %d, in0 %d, out %d, ws %zu, need %zu); nothing launched\n", n_in, n_in > 0 ? in_sizes[0] : -1, out_size, ws_size, (size_t)WS_END); grid = -1; return; }
        int dev = 0, cus = 0, per_cu = 0;
        if (hipGetDevice(&dev) != hipSuccess || hipDeviceGetAttribute(&cus, hipDeviceAttributeMultiprocessorCount, dev) != hipSuccess) { grid = -1; return; }
        if (hipFuncSetAttribute((const void*)hybrid_fwd, hipFuncAttributeMaxDynamicSharedMemorySize, LDS_BYTES) != hipSuccess) { fprintf(stderr, "kernel_launch: hipFuncSetAttribute failed\n"); grid = -1; return; }
        if (hipOccupancyMaxActiveBlocksPerMultiprocessor(&per_cu, (const void*)hybrid_fwd, 512, LDS_BYTES) != hipSuccess || per_cu < 1) { fprintf(stderr, "kernel_launch: occupancy query says %d\n", per_cu); per_cu = 1; }
        (void)hipGetLastError();
        grid = cus * 1;
        fprintf(stderr, "kernel_launch: grid %d (cus %d, per_cu %d), ws need %zu have %zu\n", grid, cus, per_cu, (size_t)WS_END, ws_size);
    }
    if (grid < 0) return;
    if (hipMemsetAsync((char*)d_ws + WS_CTL, 0, 16384, stream) != hipSuccess) { fprintf(stderr, "kernel_launch: memset failed\n"); return; }
    Args a{};
    for (int i = 0; i < 20; ++i) a.in[i] = (const float*)d_in[i];
    a.out = (float*)d_out; a.ws = (unsigned char*)d_ws;
#if MK_DEBUG
    hipMemsetAsync((char*)d_ws + WS_CTL, 0, 4096, stream); hipMemsetAsync((char*)d_ws + WS_CTL + 58 * 4, 0x63, 1, stream);
    for (int pass = 0; pass < 2; ++pass)
        for (int ph = 0; ph < NPHASES; ++ph) { a.ph_lo = ph; a.ph_hi = ph + 1; hipLaunchKernelGGL(hybrid_fwd, dim3(grid), dim3(512), LDS_BYTES, stream, a);
            hipLaunchKernelGGL(dbg_scan, dim3(2048), dim3(256), 0, stream, (unsigned char*)d_ws, (const float*)d_out, dbg_args_for(ph, pass));
            if (pass == 0 && ph == 1) { hipLaunchKernelGGL(dbg_check_gemm_a, dim3(512), dim3(64), 0, stream, (unsigned char*)d_ws); }
            if (pass == 0 && ph == 2) hipLaunchKernelGGL(dbg_check_gla, dim3(2048), dim3(256), 0, stream, (unsigned char*)d_ws);
            if (pass == 0 && ph == 3) hipLaunchKernelGGL(dbg_check_gemm_b, dim3(512), dim3(64), 0, stream, (unsigned char*)d_ws); }
    hipLaunchKernelGGL(dbg_final, dim3(2048), dim3(256), 0, stream, (unsigned char*)d_ws, (float*)d_out);
#elif MK_PER_PHASE
    for (int ph = 0; ph < NPHASES; ++ph) { a.ph_lo = ph; a.ph_hi = ph + 1; hipLaunchKernelGGL(hybrid_fwd, dim3(grid), dim3(512), LDS_BYTES, stream, a); }
#else
    a.ph_lo = 0; a.ph_hi = NPHASES;
    void* args[] = {&a};
    hipError_t e = hipLaunchCooperativeKernel((const void*)hybrid_fwd, dim3(grid), dim3(512), args, LDS_BYTES, stream);
    if (e != hipSuccess) fprintf(stderr, "kernel_launch: cooperative launch failed: %s (grid %d)\n", hipGetErrorString(e), grid);
#endif
}
```

```cpp
#include <hip/hip_runtime.h>
#include <hip/hip_bf16.h>
#include <hip/hip_cooperative_groups.h>
#include <cstdio>
#include <cstdint>
namespace cg = cooperative_groups;
#ifndef MK_DEBUG
#define MK_DEBUG 0
#endif
#ifndef MK_PER_PHASE
#define MK_PER_PHASE 0
#endif
__device__ __forceinline__ int opaque_tid() { int t = threadIdx.x; asm volatile("" : "+v"(t)); return t; }
#define LAS __attribute__((address_space(3)))
constexpr int TOK = 32768, DM = 1024, SEQ = 4096, NBATCH = 8, DEPTH = 4, INW = 6688, FFH = 2816, PLE = 256;
constexpr int NA_REAL = 3104, NA_PAD = 3328, NB_COLS = 3584;
constexpr float EPS = 1e-6f;
constexpr size_t MiB = 1048576;
constexpr size_t W_INA = 0, W_INB = W_INA + (size_t)NA_PAD * DM * 2, W_OGLA = W_INB + (size_t)NB_COLS * DM * 2, W_OATT = W_OGLA + 2 * MiB, W_OUT = W_OATT + 2 * MiB,
                 W_PG = W_OUT + 2 * MiB, W_FIN = W_PG + 2 * MiB, W_FOUT = W_FIN + (size_t)2 * FFH * DM * 2, W_PP = W_FOUT + (size_t)FFH * DM * 2, W_END = W_PP + (size_t)DM * PLE * 2;
constexpr size_t WS_CTL = 0, WS_W = 16384, WS_R = (WS_W + W_END + 4095) / 4096 * 4096;
constexpr size_t R_Q = 0, R_K = 64 * MiB, R_V = 80 * MiB, R_GA = 96 * MiB, R_GB = 160 * MiB, R_BYTES = 224 * MiB;
constexpr size_t R_GQ = 0, R_GK = 32 * MiB, R_GV = 64 * MiB, R_RA = 128 * MiB;
constexpr size_t WS_HB = WS_R + R_BYTES,   WS_GG_UNUSED = 0, WS_OF = WS_HB + 64 * MiB, WS_OB = WS_OF + 64 * MiB, WS_XA = WS_OB + 64 * MiB, WS_PB = WS_XA + 64 * MiB, WS_END = WS_PB + 16 * MiB;
constexpr int NPH_LAYER = 13, NPHASES = 1 + NPH_LAYER * DEPTH;
constexpr int LDS_BYTES = 131072 + 1024 + 8192;
namespace pg8 {
#define PG8_LAS __attribute__((address_space(3)))
typedef unsigned short bf16_t;
typedef short bf16x8 __attribute__((ext_vector_type(8)));
typedef float f32x4 __attribute__((ext_vector_type(4)));
typedef unsigned u32x4 __attribute__((ext_vector_type(4)));
constexpr int BM = 256, BK = 64, HALF = 128, HTB = HALF * BK * 2  , STAGE_BYTES = 8 * HTB, NXCD = 8, WGM = 8;

__host__ __device__ __forceinline__ int lds_byte(int r, int c) { const int st = (r >> 4) * 2 + (c >> 5), rr = r & 15, cc = c & 31, ob = rr * 64 + cc * 2; return st * 1024 + (ob ^ (((ob >> 9) & 1) << 5)); }
__host__ __device__ __forceinline__ void stage_rc(int b, int& R, int& C) { const int st = b / 1024, sb = b % 1024, swz = sb ^ (((sb >> 9) & 1) << 5); R = (st >> 1) * 16 + swz / 64; C = (st & 1) * 32 + (swz % 64) / 2; }
__host__ __device__ __forceinline__ int perm32(int rho) { const int n = rho >> 4, i = rho & 15; return 8 * (i >> 2) + 4 * n + (i & 3); }

struct Unit { int pm, pn; };
struct Gemm { const bf16_t* A; const bf16_t* Bt; int M, N, K; };

struct StaticOrder {
    int nM, nN, nwg, G, c;
    __host__ __device__ void init(int M, int N, int G_, int c_) { nM = M / BM; nN = N / BM; nwg = nM * nN; G = G_; c = c_; }
    __host__ __device__ bool next(int i, Unit& u) const {
        const long L = (long)i * G + c; if (L >= nwg) return false;
        int wgid = (int)L; { const int q = nwg / NXCD, r = nwg % NXCD, xcd = wgid % NXCD, off = wgid / NXCD; wgid = (xcd < r ? xcd * (q + 1) : r * (q + 1) + (xcd - r) * q) + off; }
        const int nig = WGM * nN, gid = wgid / nig, fm = gid * WGM, gsz = (nM - fm) < WGM ? (nM - fm) : WGM;
        u.pm = fm + ((wgid % nig) % gsz); u.pn = (wgid % nig) / gsz; return true;
    }
    __device__ __forceinline__ void a_ready(const Unit&) const {}
    __device__ __forceinline__ void done(const Unit&) const {}
};
typedef __bf16 bf16x2_t __attribute__((ext_vector_type(2)));
typedef float f32x2_t __attribute__((ext_vector_type(2)));
__device__ __forceinline__ unsigned cvt_pk_bf16(float lo, float hi) { const f32x2_t f = {lo, hi}; const bf16x2_t v = __builtin_convertvector(f, bf16x2_t); return __builtin_bit_cast(unsigned, v); }
__device__ __forceinline__ float bf_lo(unsigned w) { return __builtin_bit_cast(float, w << 16); }
__device__ __forceinline__ float bf_hi(unsigned w) { return __builtin_bit_cast(float, w & 0xffff0000u); }
__device__ __forceinline__ float sigmoidf_(float x) { return __builtin_amdgcn_rcpf(1.0f + __expf(-x)); }
enum { EM_ROUTE_A = 0, EM_ROUTE_B = 1, EM_GATE1 = 2, EM_GATE2 = 3, EM_PLAIN = 4, EM_SWIGLU = 5, EM_PLE2 = 6 };
struct Epi {
    static constexpr bool PERM = true, AFTER_DRAIN = false;
    int mode; unsigned char* rbase; unsigned char* ggbase; bf16_t* out; const bf16_t* aux; unsigned* dbgmark; const float* gqn; const float* gkn; PG8_LAS float* xlds;
    __device__ __forceinline__ void operator()(const f32x4 (&acc)[2][2][4][2], const Unit& u, int wr, int wc, int fr, int fq) const {
        const int row0 = u.pm * BM + wr * 64 + fr, lc0 = wc * 32 + 8 * fq;
#if MK_DEBUG
#endif
        if (mode == EM_SWIGLU) {
#pragma unroll
            for (int ai = 0; ai < 2; ++ai)
#pragma unroll
                for (int m = 0; m < 4; ++m) { const size_t row = (size_t)(row0 + ai * HALF + m * 16);
                    float o[8];
#pragma unroll
                    for (int n = 0; n < 2; ++n)
#pragma unroll
                        for (int j = 0; j < 4; ++j) { const float g = acc[ai][0][m][n][j], up = acc[ai][1][m][n][j]; o[4 * n + j] = g * sigmoidf_(g) * up; }
                    u32x4 w; w.x = cvt_pk_bf16(o[0], o[1]); w.y = cvt_pk_bf16(o[2], o[3]); w.z = cvt_pk_bf16(o[4], o[5]); w.w = cvt_pk_bf16(o[6], o[7]);
                    *(u32x4*)(out + row * 2816 + u.pn * 128 + lc0) = w; }
            return;
        }
        if (mode == EM_ROUTE_B && u.pn <= 4) {
            const bool isk = u.pn == 4; const float* g = isk ? gkn : gqn;
            bf16_t* qb = (bf16_t*)(rbase + (isk ? R_K : R_Q)); const int ldq = isk ? 256 : 1024, ctq = isk ? 0 : u.pn * 256;
            const int axis = wc >> 1, jb = 16 * (wc & 1) + 4 * fq;
            const f32x4 g1 = *(const f32x4*)(g + axis * 64 + jb), g2 = *(const f32x4*)(g + axis * 64 + 32 + jb);
            float inv[4];
#pragma unroll
            for (int e = 0; e < 4; ++e) inv[e] = __builtin_amdgcn_exp2f(-(float)(jb + e) * (13.287712379549449f / 32.0f)) * 0.15915494309189535f;
            const int rit = wr * 64 + fr;
#pragma unroll
            for (int ai = 0; ai < 2; ++ai)
#pragma unroll
                for (int m = 0; m < 4; ++m)
#pragma unroll
                    for (int bj = 0; bj < 2; ++bj) { const f32x4 a0 = acc[ai][bj][m][0], a1 = acc[ai][bj][m][1];
                        float ss = (a0[0] * a0[0] + a0[1] * a0[1]) + (a0[2] * a0[2] + a0[3] * a0[3]) + (a1[0] * a1[0] + a1[1] * a1[1]) + (a1[2] * a1[2] + a1[3] * a1[3]);
                        ss += __shfl_xor(ss, 16); ss += __shfl_xor(ss, 32);
                        if (fq == 0) xlds[((ai * HALF + m * 16 + rit) * 2 + bj) * 4 + wc] = ss; }
            asm volatile("s_waitcnt lgkmcnt(0)" ::: "memory"); __builtin_amdgcn_s_barrier(); asm volatile("" ::: "memory");
#pragma unroll
            for (int ai = 0; ai < 2; ++ai)
#pragma unroll
                for (int m = 0; m < 4; ++m) { const size_t row = (size_t)(row0 + ai * HALF + m * 16); const int sp = (int)row & 4095; const float pos = (float)(axis == 0 ? (sp >> 6) : (sp & 63));
                    float cs[4], sn[4];
#pragma unroll
                    for (int e = 0; e < 4; ++e) { const float rf = __builtin_amdgcn_fractf(pos * inv[e]); cs[e] = __builtin_amdgcn_cosf(rf); sn[e] = __builtin_amdgcn_sinf(rf); }
#pragma unroll
                    for (int bj = 0; bj < 2; ++bj) { const f32x4 pp = *(const PG8_LAS f32x4*)(xlds + ((ai * HALF + m * 16 + rit) * 2 + bj) * 4);
                        const float rs = rsqrtf(((pp[0] + pp[1]) + (pp[2] + pp[3])) * (1.0f / 128.0f) + 1e-6f);
                        const f32x4 x1 = acc[ai][bj][m][0] * rs * g1, x2 = acc[ai][bj][m][1] * rs * g2;
                        float o1[4], o2[4];
#pragma unroll
                        for (int e = 0; e < 4; ++e) { o1[e] = x1[e] * cs[e] - x2[e] * sn[e]; o2[e] = x2[e] * cs[e] + x1[e] * sn[e]; }
                        bf16_t* dst = qb + row * ldq + ctq + bj * HALF + axis * 64 + jb;
                        typedef unsigned u32x2e __attribute__((ext_vector_type(2)));
                        u32x2e w1, w2; w1.x = cvt_pk_bf16(o1[0], o1[1]); w1.y = cvt_pk_bf16(o1[2], o1[3]); w2.x = cvt_pk_bf16(o2[0], o2[1]); w2.y = cvt_pk_bf16(o2[2], o2[3]);
                        *(u32x2e*)dst = w1; *(u32x2e*)(dst + 32) = w2; } }
            return;
        }
        bf16_t* base = out; int ld = 1024, ct = u.pn * BM; bool is_ra = false;
        if (mode == EM_ROUTE_A) { const int pn = u.pn;
            if (pn < 2) { base = (bf16_t*)(rbase + R_GQ); ld = 512; ct = pn * 256; }
            else if (pn < 4) { base = (bf16_t*)(rbase + R_GK); ld = 512; ct = (pn - 2) * 256; }
            else if (pn < 8) { base = (bf16_t*)(rbase + R_GV); ld = 1024; ct = (pn - 4) * 256; }
            else if (pn < 12) { base = (bf16_t*)ggbase; ld = 1024; ct = (pn - 8) * 256; }
            else is_ra = true;
        } else if (mode == EM_ROUTE_B) { const int pn = u.pn;
            if (pn < 4) { base = (bf16_t*)(rbase + R_Q); ld = 1024; ct = pn * 256; }
            else if (pn == 4) { base = (bf16_t*)(rbase + R_K); ld = 256; ct = 0; }
            else if (pn == 5) { base = (bf16_t*)(rbase + R_V); ld = 256; ct = 0; }
            else if (pn < 10) { base = (bf16_t*)(rbase + R_GA); ld = 1024; ct = (pn - 6) * 256; }
            else { base = (bf16_t*)(rbase + R_GB); ld = 1024; ct = (pn - 10) * 256; }
        }
        if (is_ra) {
            if (wc == 0) { float* ra = (float*)(rbase + R_RA);
#pragma unroll
                for (int ai = 0; ai < 2; ++ai)
#pragma unroll
                    for (int m = 0; m < 4; ++m) { const size_t row = (size_t)(row0 + ai * HALF + m * 16);
                        *(f32x4*)(ra + row * 32 + 8 * fq) = acc[ai][0][m][0]; *(f32x4*)(ra + row * 32 + 8 * fq + 4) = acc[ai][0][m][1]; } }
            return;
        }
#pragma unroll
        for (int ai = 0; ai < 2; ++ai)
#pragma unroll
            for (int m = 0; m < 4; ++m) { const size_t row = (size_t)(row0 + ai * HALF + m * 16);
#pragma unroll
                for (int bj = 0; bj < 2; ++bj) { const int col = ct + bj * HALF + lc0;
                    float o[8];
#pragma unroll
                    for (int n = 0; n < 2; ++n)
#pragma unroll
                        for (int j = 0; j < 4; ++j) o[4 * n + j] = acc[ai][bj][m][n][j];
                    if (mode == EM_GATE1 || mode == EM_GATE2 || mode == EM_PLE2) {
                        const u32x4 a = *(const u32x4*)(aux + row * 1024 + col);
                        const float av[8] = {bf_lo(a.x), bf_hi(a.x), bf_lo(a.y), bf_hi(a.y), bf_lo(a.z), bf_hi(a.z), bf_lo(a.w), bf_hi(a.w)};
                        if (mode == EM_PLE2) {
#pragma unroll
                            for (int j = 0; j < 8; ++j) o[j] = sigmoidf_(o[j]) * av[j];
                        } else {
#pragma unroll
                            for (int j = 0; j < 8; ++j) o[j] = sigmoidf_(av[j]) * o[j];
                            if (mode == EM_GATE2) { const u32x4 p = *(const u32x4*)(base + row * ld + col);
                                o[0] += bf_lo(p.x); o[1] += bf_hi(p.x); o[2] += bf_lo(p.y); o[3] += bf_hi(p.y); o[4] += bf_lo(p.z); o[5] += bf_hi(p.z); o[6] += bf_lo(p.w); o[7] += bf_hi(p.w); }
                        }
                    }
                    u32x4 w; w.x = cvt_pk_bf16(o[0], o[1]); w.y = cvt_pk_bf16(o[2], o[3]); w.z = cvt_pk_bf16(o[4], o[5]); w.w = cvt_pk_bf16(o[6], o[7]);
                    *(u32x4*)(base + row * ld + col) = w;
#if MK_DEBUG
                    if (dbgmark && ai == 0 && m == 0 && bj == 0 && wr == 0 && wc == 0 && fr == 0 && fq == 0) { unsigned* mk = dbgmark + (u.pm * 32 + u.pn) * 4; const unsigned long long ad = (unsigned long long)(base + row * ld + col);
                        mk[0] = (unsigned)ad; mk[1] = (unsigned)(ad >> 32); mk[2] = w.x; mk[3] = 1u; }
#endif
                    } }
    }
};
template <class Epi, class Sched, bool ALIGN_EPI = false, bool SP2 = false>
__device__ __forceinline__ void gemm_phase(PG8_LAS unsigned char* lds, const Gemm g, const Sched& S, const Epi& E) {
    const int tid = opaque_tid(), wid = __builtin_amdgcn_readfirstlane(tid >> 6), lane = tid & 63, wr = wid >> 2, wc = wid & 3, fr = lane & 15, fq = lane >> 4;
    const int K = g.K, nt = K / BK;
    unsigned voffA[2], voffB[2];
#pragma unroll
    for (int i = 0; i < 2; ++i) { int R, C; stage_rc(tid * 16 + i * 8192, R, C); const int Rb = Epi::PERM ? ((R & ~31) + perm32(R & 31)) : R;
        voffA[i] = (unsigned)(R * K + C) * 2u; voffB[i] = (unsigned)(Rb * K + C) * 2u; }
    const size_t kstep = (size_t)(BK * 2);
    const size_t hstep = (size_t)HALF * K * 2;
    const size_t tstep = 2 * hstep;
    const unsigned ldsw = (unsigned)wid * 1024u;
    const int aoff = lds_byte(wr * 64 + fr, fq * 8), boff = lds_byte(wc * 32 + fr, fq * 8);
#define PG8_SA(b, h) (((b) * 2 + (h)) * HTB)
#define PG8_SB(b, h) ((4 + (b) * 2 + (h)) * HTB)
#define PG8_STAGE(bufoff, gbase, voff) do { _Pragma("unroll") for (int _i = 0; _i < 2; ++_i) \
        __builtin_amdgcn_global_load_lds((const unsigned*)((const char*)(gbase) + (voff)[_i]), (PG8_LAS unsigned*)(lds + (bufoff) + ldsw + _i * 8192), 16, 0, 0); } while (0)
#define PG8_LDA(dst, b, h) do { _Pragma("unroll") for (int m = 0; m < 4; ++m) _Pragma("unroll") for (int k = 0; k < 2; ++k) dst[m][k] = *(const PG8_LAS bf16x8*)(lds + PG8_SA(b, h) + aoff + m * 2048 + k * 1024); } while (0)
#define PG8_LDB(dst, b, h) do { _Pragma("unroll") for (int n = 0; n < 2; ++n) _Pragma("unroll") for (int k = 0; k < 2; ++k) dst[n][k] = *(const PG8_LAS bf16x8*)(lds + PG8_SB(b, h) + boff + n * 2048 + k * 1024); } while (0)
#define PG8_MMA(ai, bj, At, Bt) do { __builtin_amdgcn_s_setprio(1); _Pragma("unroll") for (int m = 0; m < 4; ++m) _Pragma("unroll") for (int n = 0; n < 2; ++n) _Pragma("unroll") for (int k = 0; k < 2; ++k) \
        acc[ai][bj][m][n] = __builtin_amdgcn_mfma_f32_16x16x32_bf16(Bt[n][k], At[m][k], acc[ai][bj][m][n], 0, 0, 0); __builtin_amdgcn_s_setprio(0); } while (0)
#define PG8_WAIT_V(n) asm volatile("s_waitcnt vmcnt(" #n ")" ::: "memory")
#define PG8_WAIT_L(n) asm volatile("s_waitcnt lgkmcnt(" #n ")" ::: "memory")
#define PG8_BAR __builtin_amdgcn_s_barrier()
#define PG8_SCHED __builtin_amdgcn_sched_barrier(0)
    Unit cur, nxt; int ui = 0;
    if (!S.next(0, cur)) return;
    f32x4 acc[2][2][4][2];
#pragma unroll
    for (int a = 0; a < 2; ++a)
#pragma unroll
        for (int b = 0; b < 2; ++b)
#pragma unroll
            for (int m = 0; m < 4; ++m)
#pragma unroll
                for (int n = 0; n < 2; ++n) acc[a][b][m][n] = (f32x4){0.f, 0.f, 0.f, 0.f};
    bf16x8 At[4][2], B0[2][2], B1[2][2];
    const char* cA = (const char*)g.A + (size_t)cur.pm * tstep; const char* cB = (const char*)g.Bt + (size_t)cur.pn * tstep;
    S.a_ready(cur);
    if constexpr (SP2) {
        PG8_STAGE(PG8_SB(0, 0), cB, voffB); PG8_STAGE(PG8_SB(0, 1), cB + hstep, voffB); PG8_STAGE(PG8_SA(0, 0), cA, voffA); PG8_STAGE(PG8_SA(0, 1), cA + hstep, voffA);
        if (wr == 1) PG8_BAR;
        PG8_WAIT_V(2); PG8_BAR;
        PG8_STAGE(PG8_SB(1, 0), cB + kstep, voffB); PG8_STAGE(PG8_SA(1, 0), cA + kstep, voffA); PG8_STAGE(PG8_SB(1, 1), cB + hstep + kstep, voffB);
        PG8_WAIT_V(6); PG8_BAR;
    } else {
        PG8_STAGE(PG8_SB(0, 0), cB, voffB); PG8_STAGE(PG8_SA(0, 0), cA, voffA); PG8_STAGE(PG8_SB(0, 1), cB + hstep, voffB); PG8_STAGE(PG8_SA(0, 1), cA + hstep, voffA);
        if (wr == 1) PG8_BAR;
        PG8_WAIT_V(4); PG8_BAR;
        PG8_STAGE(PG8_SB(1, 0), cB + kstep, voffB); PG8_STAGE(PG8_SA(1, 0), cA + kstep, voffA); PG8_STAGE(PG8_SB(1, 1), cB + hstep + kstep, voffB);
        PG8_WAIT_V(6); PG8_BAR;
    }
    for (;;) {
        const bool has_next = S.next(ui + 1, nxt);
        const char* nA = has_next ? (const char*)g.A + (size_t)nxt.pm * tstep : cA; const char* nB = has_next ? (const char*)g.Bt + (size_t)nxt.pn * tstep : cB;
        for (int t = 0; t < nt; t += 2) {
            const bool last = (t == nt - 2);
            const char* a1 = cA + (size_t)(t + 1) * kstep;
            const char* a2 = last ? nA : cA + (size_t)(t + 2) * kstep; const char* b2 = last ? nB : cB + (size_t)(t + 2) * kstep;
            const char* a3 = a2 + kstep; const char* b3 = b2 + kstep;
            if (last && has_next) S.a_ready(nxt);
            if constexpr (SP2) {
            PG8_LDB(B0, 0, 0); PG8_LDB(B1, 0, 1); PG8_SCHED; PG8_LDA(At, 0, 0); PG8_STAGE(PG8_SA(1, 1), a1 + hstep, voffA);
            PG8_WAIT_V(8); PG8_WAIT_L(0); PG8_BAR; PG8_MMA(0, 0, At, B0); PG8_MMA(0, 1, At, B1); PG8_BAR; PG8_SCHED;
            PG8_LDA(At, 0, 1); PG8_STAGE(PG8_SB(0, 0), b2, voffB); PG8_STAGE(PG8_SB(0, 1), b2 + hstep, voffB); PG8_STAGE(PG8_SA(0, 0), a2, voffA);
            PG8_WAIT_V(8); PG8_WAIT_L(0); PG8_BAR; PG8_MMA(1, 0, At, B0); PG8_MMA(1, 1, At, B1); PG8_BAR; PG8_SCHED;
            PG8_LDB(B0, 1, 0); PG8_LDB(B1, 1, 1); PG8_SCHED; PG8_LDA(At, 1, 0); PG8_STAGE(PG8_SA(0, 1), a2 + hstep, voffA);
            PG8_WAIT_V(8); PG8_WAIT_L(0); PG8_BAR; PG8_MMA(0, 0, At, B0); PG8_MMA(0, 1, At, B1); PG8_BAR; PG8_SCHED;
            PG8_LDA(At, 1, 1); PG8_STAGE(PG8_SB(1, 0), b3, voffB); PG8_STAGE(PG8_SB(1, 1), b3 + hstep, voffB); PG8_STAGE(PG8_SA(1, 0), a3, voffA);
            PG8_WAIT_V(8); PG8_WAIT_L(0); PG8_BAR; PG8_MMA(1, 0, At, B0); PG8_MMA(1, 1, At, B1); PG8_BAR; PG8_SCHED;
            } else {
            PG8_LDB(B0, 0, 0); PG8_SCHED; PG8_LDA(At, 0, 0); PG8_STAGE(PG8_SA(1, 1), a1 + hstep, voffA);
            PG8_WAIT_L(8); PG8_BAR; PG8_WAIT_L(0); PG8_MMA(0, 0, At, B0); PG8_BAR; PG8_SCHED;
            PG8_LDB(B1, 0, 1); PG8_STAGE(PG8_SB(0, 0), b2, voffB);
            PG8_BAR; PG8_WAIT_L(0); PG8_MMA(0, 1, At, B1); PG8_BAR;
            PG8_LDA(At, 0, 1); PG8_STAGE(PG8_SA(0, 0), a2, voffA);
            PG8_BAR; PG8_WAIT_L(0); PG8_MMA(1, 0, At, B0); PG8_BAR; PG8_SCHED;
            PG8_STAGE(PG8_SB(0, 1), b2 + hstep, voffB);
            PG8_WAIT_V(6); PG8_BAR; PG8_MMA(1, 1, At, B1); PG8_BAR;
            PG8_LDB(B0, 1, 0); PG8_SCHED; PG8_LDA(At, 1, 0); PG8_STAGE(PG8_SA(0, 1), a2 + hstep, voffA);
            PG8_WAIT_L(8); PG8_BAR; PG8_WAIT_L(0); PG8_MMA(0, 0, At, B0); PG8_BAR; PG8_SCHED;
            PG8_LDB(B1, 1, 1); PG8_STAGE(PG8_SB(1, 0), b3, voffB);
            PG8_BAR; PG8_WAIT_L(0); PG8_MMA(0, 1, At, B1); PG8_BAR;
            PG8_LDA(At, 1, 1); PG8_STAGE(PG8_SA(1, 0), a3, voffA);
            PG8_BAR; PG8_WAIT_L(0); PG8_MMA(1, 0, At, B0); PG8_BAR; PG8_SCHED;
            PG8_STAGE(PG8_SB(1, 1), b3 + hstep, voffB);
            PG8_WAIT_V(6); PG8_BAR; PG8_MMA(1, 1, At, B1); PG8_BAR;
            }
        }
        if constexpr (ALIGN_EPI) { if (wr == 0) PG8_BAR; }
        if constexpr (!Epi::AFTER_DRAIN) { E(acc, cur, wr, wc, fr, fq); S.done(cur); }
        if (!has_next) break;
#pragma unroll
        for (int a = 0; a < 2; ++a)
#pragma unroll
            for (int b = 0; b < 2; ++b)
#pragma unroll
                for (int m = 0; m < 4; ++m)
#pragma unroll
                    for (int n = 0; n < 2; ++n) acc[a][b][m][n] = (f32x4){0.f, 0.f, 0.f, 0.f};
        cur = nxt; cA = nA; cB = nB; ++ui;
        if constexpr (ALIGN_EPI) { if (wr == 1) PG8_BAR; }
    }
    PG8_WAIT_V(0);
    if constexpr (!ALIGN_EPI) { if (wr == 0) PG8_BAR; }
    PG8_BAR;
    if constexpr (Epi::AFTER_DRAIN) { E.fused(acc, cur, wr, wc, fr, fq, lds, wid, lane); S.done(cur); }
#undef PG8_SA
#undef PG8_SB
#undef PG8_STAGE
#undef PG8_LDA
#undef PG8_LDB
#undef PG8_MMA
#undef PG8_WAIT_V
#undef PG8_WAIT_L
#undef PG8_BAR
#undef PG8_SCHED
}
}
namespace attn {
using bf16 = __hip_bfloat16;
constexpr int   D = 128, NW = 8, QBLK = 32, KVBLK = 64;
constexpr float SCALE = 0.088388347648318440f;
constexpr float THR = 8.f;
constexpr int SDEPTH = 2;
constexpr int LDQ = 1024, LDK = 256, LDO = 1024;
constexpr size_t SHM_V = KVBLK * D * 2, SHM_K = KVBLK * D * 2, SHM_ATTN = 2 * SHM_V + 2 * SHM_K + NW * 64 * 4;
using bf16x8 = __attribute__((ext_vector_type(8))) short;
using s16x4  = __attribute__((ext_vector_type(4))) short;
using f32x16 = __attribute__((ext_vector_type(16))) float;
using f32x8  = __attribute__((ext_vector_type(8))) float;
using u32x4  = __attribute__((ext_vector_type(4))) unsigned;
#define KSWZ(row, colB) ((row) * 256 + ((colB) ^ (((row) & 7) << 4)))
#define SBAR() __builtin_amdgcn_sched_barrier(0)
__device__ __forceinline__ int crow(int r, int hi) { return (r & 3) + 8 * (r >> 2) + 4 * hi; }
__device__ __forceinline__ unsigned cvtpk(float lo, float hi) {
  unsigned r; asm volatile("v_cvt_pk_bf16_f32 %0, %1, %2" : "=v"(r) : "v"(lo), "v"(hi)); return r;
}
template <typename TIn> struct Stage;
template <> struct Stage<bf16>  { using T = bf16x8;
  __device__ static __forceinline__ T ld8(const bf16* p) { return *reinterpret_cast<const bf16x8*>(p); }
  __device__ static __forceinline__ bf16x8 tobf(T x) { return x; } };
template <> struct Stage<float> { using T = f32x8;
  __device__ static __forceinline__ T ld8(const float* p) { return *reinterpret_cast<const f32x8*>(p); }
  __device__ static __forceinline__ bf16x8 tobf(T x) {
    u32x4 w = {cvtpk(x[0], x[1]), cvtpk(x[2], x[3]), cvtpk(x[4], x[5]), cvtpk(x[6], x[7])}; return *reinterpret_cast<bf16x8*>(&w); } };

__device__ __forceinline__ void partialSM(f32x16& p0, f32x16& p1, float& m_reg, float& mn, float& alpha) {
  constexpr float C = SCALE * 1.4426950408889634f;
  float pmax = p0[0]; for (int r = 1; r < 16; ++r) pmax = fmaxf(pmax, p0[r]); for (int r = 0; r < 16; ++r) pmax = fmaxf(pmax, p1[r]);
  { auto rr = __builtin_amdgcn_permlane32_swap(__float_as_uint(pmax), __float_as_uint(pmax), false, false);
    pmax = fmaxf(__uint_as_float(rr[0]), __uint_as_float(rr[1])); }
  if (__builtin_expect(__all(pmax - m_reg <= THR / SCALE), 1)) { mn = m_reg; alpha = 1.f; }
  else { mn = fmaxf(m_reg, pmax); alpha = __builtin_amdgcn_exp2f((m_reg - mn) * C); m_reg = mn; }
  float mnC = -mn * C;
  for (int r = 0; r < 16; ++r) p0[r] = fmaf(p0[r], C, mnC); for (int r = 0; r < 16; ++r) p1[r] = fmaf(p1[r], C, mnC);
  for (int r = 0; r < 16; ++r) p0[r] = __builtin_amdgcn_exp2f(p0[r]);
}
__device__ __forceinline__ void finishSM(f32x16& p0, f32x16& p1, float alpha, float& l_reg, bf16x8& pa0, bf16x8& pa1, bf16x8& pa2, bf16x8& pa3) {
  for (int r = 0; r < 16; ++r) p1[r] = __builtin_amdgcn_exp2f(p1[r]);
  float ps = 0; for (int r = 0; r < 16; ++r) ps += p0[r]; for (int r = 0; r < 16; ++r) ps += p1[r];
  { auto rr = __builtin_amdgcn_permlane32_swap(__float_as_uint(ps), __float_as_uint(ps), false, false);
    ps = __uint_as_float(rr[0]) + __uint_as_float(rr[1]); }
  l_reg = l_reg * alpha + ps;
#define PK4(P, BASE, OUT) do { unsigned a0 = cvtpk(P[BASE + 0], P[BASE + 1]), a1 = cvtpk(P[BASE + 2], P[BASE + 3]);   \
    unsigned b0 = cvtpk(P[BASE + 4], P[BASE + 5]), b1 = cvtpk(P[BASE + 6], P[BASE + 7]);                              \
    auto r0 = __builtin_amdgcn_permlane32_swap(a0, b0, false, false); auto r1 = __builtin_amdgcn_permlane32_swap(a1, b1, false, false); \
    u32x4 w = {r0[0], r1[0], r0[1], r1[1]}; OUT = *reinterpret_cast<bf16x8*>(&w); } while (0)
  PK4(p0, 0, pa0); PK4(p0, 8, pa1); PK4(p1, 0, pa2); PK4(p1, 8, pa3);
#undef PK4
}
__device__ __forceinline__ void qkt(f32x16& p0, f32x16& p1, const bf16* Ks, const bf16x8* qr, int r32, int hi) {
  p0 = f32x16{}; p1 = f32x16{};
  for (int d0 = 0; d0 < 8; ++d0) { int cb = (d0 * 16 + hi * 8) * 2;
    bf16x8 b0 = *reinterpret_cast<const bf16x8*>((const char*)Ks + KSWZ(r32, cb));
    bf16x8 b1 = *reinterpret_cast<const bf16x8*>((const char*)Ks + KSWZ(32 + r32, cb));
    p0 = __builtin_amdgcn_mfma_f32_32x32x16_bf16(b0, qr[d0], p0, 0, 0, 0);
    p1 = __builtin_amdgcn_mfma_f32_32x32x16_bf16(b1, qr[d0], p1, 0, 0, 0); }
}
__device__ __forceinline__ int v_st(int k, int c) { const int kk = (k & ~0xC) | ((k & 4) << 1) | ((k & 8) >> 1); return ((kk >> 3) * 4 + (c >> 5)) * 512 + ((kk & 7) * 32 + (c & 31)) * 2; }
__device__ __forceinline__ int v_rd_base(int lane) { return ((lane & 3) << 3) | (((lane >> 2) & 3) << 6) | (((lane >> 4) & 1) << 5) | (((lane >> 5) & 1) << 8); }
constexpr int v_rd_off(int d0, int ks, int half) { return d0 * 512 + ks * 4096 + half * 2048; }
template <int OFF> __device__ __forceinline__ s16x4 tr_read(int vb) {
  s16x4 r; asm volatile("ds_read_b64_tr_b16 %0, %1 offset:%2" : "=&v"(r) : "v"(vb), "i"(OFF) : "memory"); return r;
}
template <int D0> __device__ __forceinline__ void pv_one(f32x16& od, int vb, bf16x8 pa0, bf16x8 pa1, bf16x8 pa2, bf16x8 pa3) {
  const s16x4 l0 = tr_read<v_rd_off(D0, 0, 0)>(vb), h0 = tr_read<v_rd_off(D0, 0, 1)>(vb), l1 = tr_read<v_rd_off(D0, 1, 0)>(vb), h1 = tr_read<v_rd_off(D0, 1, 1)>(vb);
  const s16x4 l2 = tr_read<v_rd_off(D0, 2, 0)>(vb), h2 = tr_read<v_rd_off(D0, 2, 1)>(vb), l3 = tr_read<v_rd_off(D0, 3, 0)>(vb), h3 = tr_read<v_rd_off(D0, 3, 1)>(vb);
  asm volatile("s_waitcnt lgkmcnt(0)" ::: "memory"); SBAR();
#define PK(L, H) (bf16x8){L[0], L[1], L[2], L[3], H[0], H[1], H[2], H[3]}
  od = __builtin_amdgcn_mfma_f32_32x32x16_bf16(pa0, PK(l0, h0), od, 0, 0, 0);
  od = __builtin_amdgcn_mfma_f32_32x32x16_bf16(pa1, PK(l1, h1), od, 0, 0, 0);
  od = __builtin_amdgcn_mfma_f32_32x32x16_bf16(pa2, PK(l2, h2), od, 0, 0, 0);
  od = __builtin_amdgcn_mfma_f32_32x32x16_bf16(pa3, PK(l3, h3), od, 0, 0, 0);
#undef PK
}
__device__ __forceinline__ void pv_d0(f32x16* o, int vb, bf16x8 pa0, bf16x8 pa1, bf16x8 pa2, bf16x8 pa3) {
  pv_one<0>(o[0], vb, pa0, pa1, pa2, pa3); pv_one<1>(o[1], vb, pa0, pa1, pa2, pa3); pv_one<2>(o[2], vb, pa0, pa1, pa2, pa3); pv_one<3>(o[3], vb, pa0, pa1, pa2, pa3);
}

template <typename TQ>
__device__ __forceinline__ void attn_dense_body(const TQ* Qb, const bf16* Kh, const bf16* Vh,
                                                unsigned short* Ob, int seq, char* lds) {
  using St = Stage<bf16>; using SQ = Stage<TQ>;
  const int tid = opaque_tid(), wid = tid >> 6, lane = tid & 63, r32 = lane & 31, hi = lane >> 5;
  bf16* V_lds = (bf16*)lds; bf16* K_lds = (bf16*)(lds + 2 * SHM_V);
  float* ws = (float*)(lds + 2 * SHM_V + 2 * SHM_K) + wid * 64; float* li_l = ws; float* al_l = ws + 32;
  float m_reg = -1e30f, l_reg = 0; f32x16 o[4] = {}; bf16x8 qr[8];
  const TQ* Qw = Qb + (long)(wid * QBLK + r32) * LDQ + hi * 8;
#pragma unroll
  for (int d0 = 0; d0 < 8; ++d0) qr[d0] = SQ::tobf(SQ::ld8(Qw + d0 * 16));
  const int sr = tid >> 4, sc = (tid & 15) * 8, vst0 = v_st(sr, sc), vst1 = v_st(32 + sr, sc);
  const int vb0 = (int)(uintptr_t)V_lds + v_rd_base(lane);
  struct { typename St::T vs0, vs1, ks0, ks1; } sr_[SDEPTH];
#define SLOAD(i, k0) do { sr_[i].vs0 = St::ld8(&Vh[(long)((k0) + sr) * LDK + sc]); sr_[i].vs1 = St::ld8(&Vh[(long)((k0) + 32 + sr) * LDK + sc]); \
    sr_[i].ks0 = St::ld8(&Kh[(long)((k0) + sr) * LDK + sc]); sr_[i].ks1 = St::ld8(&Kh[(long)((k0) + 32 + sr) * LDK + sc]); } while (0)
#define SWRITE(b, i) do { *(bf16x8*)((char*)V_lds + (b) * SHM_V + vst0) = St::tobf(sr_[i].vs0);          \
    *(bf16x8*)((char*)V_lds + (b) * SHM_V + vst1) = St::tobf(sr_[i].vs1); int kc = sc * 2;               \
    *(bf16x8*)((char*)K_lds + (b) * SHM_K + KSWZ(sr, kc)) = St::tobf(sr_[i].ks0);                       \
    *(bf16x8*)((char*)K_lds + (b) * SHM_K + KSWZ(32 + sr, kc)) = St::tobf(sr_[i].ks1); } while (0)
#define SWAIT() do { if constexpr (SDEPTH == 2) asm volatile("s_waitcnt vmcnt(4)" ::: "memory"); else asm volatile("s_waitcnt vmcnt(0)" ::: "memory"); } while (0)
#define RESC(a) do { if (__any((a) < 1.f)) { if (hi == 0) al_l[r32] = (a); asm volatile("s_waitcnt lgkmcnt(0)" ::: "memory"); \
    for (int d = 0; d < 4; ++d) for (int r = 0; r < 16; ++r) o[d][r] *= al_l[crow(r, hi)]; } } while (0)
  f32x16 pA0, pA1, pB0, pB1; float mnA, mnB, alA, alB; bf16x8 pa0, pa1, pa2, pa3; const int NT = seq / KVBLK;
  constexpr int SE = 0, SO = SDEPTH - 1;
  SLOAD(SE, 0); asm volatile("s_waitcnt vmcnt(0)" ::: "memory"); SWRITE(0, SE); __syncthreads();
  qkt(pA0, pA1, K_lds, qr, r32, hi); partialSM(pA0, pA1, m_reg, mnA, alA);
  SLOAD(SO, KVBLK); if constexpr (SDEPTH == 2) { if (2 < NT) SLOAD(SE, 2 * KVBLK); }
  SWAIT(); SWRITE(1, SO); __syncthreads();
  for (int j = 1; j + 1 < NT; j += 2) {
    SBAR(); qkt(pB0, pB1, (bf16*)((char*)K_lds + SHM_K), qr, r32, hi);
    finishSM(pA0, pA1, alA, l_reg, pa0, pa1, pa2, pa3); SBAR();
    SLOAD(SO, (j + SDEPTH) * KVBLK); SBAR();
    pv_d0(o, vb0, pa0, pa1, pa2, pa3); partialSM(pB0, pB1, m_reg, mnB, alB);
    __syncthreads(); SWAIT(); SWRITE(0, SE);
    RESC(alB); __syncthreads();
    SBAR(); qkt(pA0, pA1, K_lds, qr, r32, hi);
    finishSM(pB0, pB1, alB, l_reg, pa0, pa1, pa2, pa3); SBAR();
    if (SDEPTH == 1 || j + 3 < NT) SLOAD(SE, (j + 1 + SDEPTH) * KVBLK); SBAR();
    pv_d0(o, vb0 + (int)SHM_V, pa0, pa1, pa2, pa3); partialSM(pA0, pA1, m_reg, mnA, alA);
    __syncthreads(); SWAIT(); SWRITE(1, SO);
    RESC(alA); __syncthreads();
  }
  SBAR(); qkt(pB0, pB1, (bf16*)((char*)K_lds + SHM_K), qr, r32, hi);
  finishSM(pA0, pA1, alA, l_reg, pa0, pa1, pa2, pa3); SBAR();
  pv_d0(o, vb0, pa0, pa1, pa2, pa3); partialSM(pB0, pB1, m_reg, mnB, alB);
  __syncthreads(); RESC(alB);
  finishSM(pB0, pB1, alB, l_reg, pa0, pa1, pa2, pa3); SBAR();
  pv_d0(o, vb0 + (int)SHM_V, pa0, pa1, pa2, pa3);
  if (hi == 0) li_l[r32] = l_reg; asm volatile("s_waitcnt lgkmcnt(0)" ::: "memory");
  float rli[16];
#pragma unroll
  for (int r = 0; r < 16; ++r) rli[r] = __builtin_amdgcn_rcpf(li_l[crow(r, hi)]);
  unsigned short* Ow = Ob + (long)(wid * QBLK) * LDO;
#pragma unroll
  for (int r = 0; r < 16; ++r) { int orow = crow(r, hi);
    for (int d0 = 0; d0 < 4; ++d0) Ow[(long)orow * LDO + d0 * 32 + r32] = (unsigned short)(cvtpk(o[d0][r] * rli[r], 0.f) & 0xffffu); }
#undef SLOAD
#undef SWRITE
#undef SWAIT
#undef RESC
}
}
#define XB_TMO      128
#define XB_XCNT(j)  (256  + 64 * (j))
#define XB_XSUB(j)  (1280 + 64 * (j))
#define XB_XGEN(j)  (2304 + 64 * (j))
#define XB_TOP      3328
#define XB_TOPGEN   3392
#define XCD_BAR_WORDS 3456
#define XB_SPIN_CAP (1u << 18)

__device__ __forceinline__ unsigned xb_ld(unsigned* p)              { return __hip_atomic_load(p, __ATOMIC_RELAXED, __HIP_MEMORY_SCOPE_AGENT); }
__device__ __forceinline__ unsigned xb_add(unsigned* p, unsigned v) { return __hip_atomic_fetch_add(p, v, __ATOMIC_RELAXED, __HIP_MEMORY_SCOPE_AGENT); }
__device__ __forceinline__ unsigned xb_xcc_id() { return (unsigned)__builtin_amdgcn_s_getreg((3 << 11) | 20) & 0xFu; }
#define XB_SPIN(cond, bar) do { unsigned _sp = 0; while (cond) { __builtin_amdgcn_s_sleep(1); \
    if ((++_sp & 255u) == 0u) { if (xb_ld(&(bar)[XB_TMO])) break; if (_sp > XB_SPIN_CAP) { atomicAdd(&(bar)[XB_TMO], 1u); break; } } } } while (0)

struct XcdBarrier {
    unsigned* bar; unsigned x;
    volatile LAS unsigned* st;
};

__device__ __forceinline__ XcdBarrier xcd_barrier_post(unsigned* bar, volatile LAS unsigned* st) {
    XcdBarrier b; b.bar = bar; b.x = xb_xcc_id(); b.st = st;
    if (threadIdx.x == 0) (void)xb_add(&bar[XB_XCNT(b.x)], 1u);
    return b;
}
__device__ __forceinline__ void xcd_barrier_complete(unsigned* bar, unsigned x, unsigned& nloc, unsigned& nx) {
    const unsigned G = gridDim.x * gridDim.y * gridDim.z;
    unsigned sum, cnt, mine, sp = 0u;
    for (;;) {
        sum = 0u; cnt = 0u; mine = 0u;
#pragma unroll
        for (unsigned j = 0; j < 16; ++j) { const unsigned c = xb_ld(&bar[XB_XCNT(j)]); sum += c; cnt += (c > 0u) ? 1u : 0u; mine = (j == x) ? c : mine; }
        if (sum == G) break;
        __builtin_amdgcn_s_sleep(1);
        if ((++sp & 255u) == 0u) { if (xb_ld(&bar[XB_TMO])) break; if (sp > XB_SPIN_CAP) { atomicAdd(&bar[XB_TMO], 1u); break; } }
    }
    nloc = mine > 0u ? mine : 1u; nx = cnt > 0u ? cnt : 1u;
}

__device__ __forceinline__ void xcd_barrier(const XcdBarrier& b) {
    asm volatile("s_waitcnt vmcnt(0)" ::: "memory");
    __syncthreads();
    if (threadIdx.x == 0) {
        unsigned* bar = b.bar;
        __builtin_amdgcn_s_waitcnt(0);
        unsigned nloc = b.st[0], nx = b.st[1];
        if (nloc == 0u) { xcd_barrier_complete(bar, b.x, nloc, nx); b.st[0] = nloc; b.st[1] = nx; }
        const unsigned old = xb_add(&bar[XB_XSUB(b.x)], 1u);
        const unsigned gen = old / nloc;
        if (old + 1u == (gen + 1u) * nloc) {
            __builtin_amdgcn_fence(__ATOMIC_RELEASE, "agent");
            asm volatile("s_waitcnt vmcnt(0)" ::: "memory");
            const unsigned og = xb_add(&bar[XB_TOP], 1u);
            const unsigned tg = og / nx;
            if (og + 1u == (tg + 1u) * nx) xb_add(&bar[XB_TOPGEN], 1u);
            else XB_SPIN(xb_ld(&bar[XB_TOPGEN]) == tg, bar);
            __builtin_amdgcn_fence(__ATOMIC_ACQUIRE, "agent");
            xb_add(&bar[XB_XGEN(b.x)], 1u);
            asm volatile("s_waitcnt vmcnt(0)" ::: "memory");
        } else {
            XB_SPIN(xb_ld(&bar[XB_XGEN(b.x)]) == gen, bar);
            __builtin_amdgcn_fence(__ATOMIC_ACQUIRE, "agent");
            asm volatile("s_waitcnt vmcnt(0)" ::: "memory");
        }
    }
    __syncthreads();
}
#define LAS __attribute__((address_space(3)))
typedef unsigned short bf16_t;
typedef float f32x4 __attribute__((ext_vector_type(4)));
typedef float f32x2 __attribute__((ext_vector_type(2)));
typedef unsigned u32x4 __attribute__((ext_vector_type(4)));
typedef unsigned u32x2 __attribute__((ext_vector_type(2)));
typedef short bf16x8 __attribute__((ext_vector_type(8)));
typedef short s16x4 __attribute__((ext_vector_type(4)));
#define LDS_WAIT() asm volatile("s_waitcnt lgkmcnt(0)" ::: "memory")
using pg8::cvt_pk_bf16; using pg8::bf_lo; using pg8::bf_hi; using pg8::sigmoidf_;

__device__ __forceinline__ float wave_sum(float v) {
#pragma unroll
    for (int o = 1; o < 64; o <<= 1) v += __shfl_xor(v, o);
    return v;
}

__device__ __forceinline__ void transpose_item(const float* __restrict__ W, int ldW, int K, int src_n0, int k0, bf16_t* WT, int dst_row0, LAS float* scr, int lane, int pmode = -1) {
#pragma unroll 8
    for (int i = 0; i < 32; ++i) { const int kk = 2 * i + (lane >> 5); scr[kk * 33 + (lane & 31)] = W[(size_t)(k0 + kk) * ldW + src_n0 + (lane & 31)]; }
    LDS_WAIT(); asm volatile("" ::: "memory");
    const int c = lane & 7;
#pragma unroll
    for (int j = 0; j < 4; ++j) { const int n = (lane >> 3) + 8 * j; const LAS float* s = scr + (8 * c) * 33 + n;
        u32x4 o; o.x = cvt_pk_bf16(s[0 * 33], s[1 * 33]); o.y = cvt_pk_bf16(s[2 * 33], s[3 * 33]); o.z = cvt_pk_bf16(s[4 * 33], s[5 * 33]); o.w = cvt_pk_bf16(s[6 * 33], s[7 * 33]);
        const int nn = pmode < 0 ? n : 32 * (2 * (pmode >> 1) + (n >> 4)) + 8 * ((n >> 2) & 3) + 4 * (pmode & 1) + (n & 3);
        *(u32x4*)(WT + (size_t)(dst_row0 + nn) * K + k0 + 8 * c) = o; }
    LDS_WAIT(); asm volatile("" ::: "memory");
}

struct Args { const float* in[20]; float* out; unsigned char* ws; int ph_lo, ph_hi; };
typedef const __attribute__((address_space(4))) Args* KA;

__device__ __forceinline__ void prep_layer(KA a, int L, LAS unsigned char* lds, int gw, int NGW, int wave, int lane) {
    LAS float* scr = (LAS float*)(lds + wave * 8448);
    unsigned char* wsW = a->ws + WS_W;
    const float* w_in = a->in[3] + (size_t)L * DM * INW;
    const float* w_ogla = a->in[9] + (size_t)L * DM * DM; const float* w_oatt = a->in[10] + (size_t)L * DM * DM; const float* w_out = a->in[11] + (size_t)L * DM * DM;
    const float* w_fin = a->in[14] + (size_t)L * DM * 2 * FFH; const float* w_fout = a->in[15] + (size_t)L * FFH * DM;
    const float* w_pp = a->in[17] + (size_t)L * PLE * DM; const float* w_pg = a->in[18] + (size_t)L * DM * DM;
    constexpr int I_A = 16 * 97, I_B = 16 * 112, I_SQ = 16 * 32, I_FI = 16 * 176, I_FO = 44 * 32, I_PP = 4 * 32;
    constexpr int NITEMS = I_A + I_B + 4 * I_SQ + I_FI + I_FO + I_PP;
    for (int it = gw; it < NITEMS; it += NGW) {
        int r = it;
        if (r < I_A) { const int kb = r / 97, nb = r % 97; transpose_item(w_in, INW, DM, 32 * nb, 64 * kb, (bf16_t*)(wsW + W_INA), 32 * nb, scr, lane); continue; } r -= I_A;
        if (r < I_B) { const int kb = r / 112, nb = r % 112; const int d0 = (32 * nb) & 127;
            if (nb < 40) transpose_item(w_in, INW, DM, NA_REAL + 32 * nb, 64 * kb, (bf16_t*)(wsW + W_INB), 32 * nb - d0, scr, lane, (d0 >> 6) * 2 + ((d0 >> 5) & 1));
            else transpose_item(w_in, INW, DM, NA_REAL + 32 * nb, 64 * kb, (bf16_t*)(wsW + W_INB), 32 * nb, scr, lane);
            continue; } r -= I_B;
        if (r < 4 * I_SQ) { const int which = r / I_SQ, q = r % I_SQ, kb = q / 32, nb = q % 32;
            const float* src = which == 0 ? w_ogla : which == 1 ? w_oatt : which == 2 ? w_out : w_pg;
            const size_t dsto = which == 0 ? W_OGLA : which == 1 ? W_OATT : which == 2 ? W_OUT : W_PG;
            transpose_item(src, DM, DM, 32 * nb, 64 * kb, (bf16_t*)(wsW + dsto), 32 * nb, scr, lane); continue; } r -= 4 * I_SQ;
        if (r < I_FI) { const int kb = r / 176, nb = r % 176; const int n0 = 32 * nb; const int j = n0 < FFH ? n0 : n0 - FFH; const int dst = (j >> 7) * 256 + (n0 < FFH ? 0 : 128) + (j & 127);
            transpose_item(w_fin, 2 * FFH, DM, n0, 64 * kb, (bf16_t*)(wsW + W_FIN), dst, scr, lane); continue; } r -= I_FI;
        if (r < I_FO) { const int kb = r / 32, nb = r % 32; transpose_item(w_fout, DM, FFH, 32 * nb, 64 * kb, (bf16_t*)(wsW + W_FOUT), 32 * nb, scr, lane); continue; } r -= I_FO;
        { const int kb = r / 32, nb = r % 32; transpose_item(w_pp, DM, PLE, 32 * nb, 64 * kb, (bf16_t*)(wsW + W_PP), 32 * nb, scr, lane); }
    }
    { u32x4* z = (u32x4*)(wsW + W_INA + (size_t)NA_REAL * DM * 2); const int nz = (NA_PAD - NA_REAL) * DM * 2 / 16;
      for (int i = gw * 64 + lane; i < nz; i += NGW * 64) z[i] = (u32x4){0u, 0u, 0u, 0u}; }
    { const float* p = a->in[1] + (size_t)L * TOK * PLE; bf16_t* pb = (bf16_t*)(a->ws + WS_PB); const int n8 = TOK * PLE / 8;
      for (int i = gw * 64 + lane; i < n8; i += NGW * 64) { const f32x4 x0 = *(const f32x4*)(p + (size_t)i * 8), x1 = *(const f32x4*)(p + (size_t)i * 8 + 4);
          u32x4 o; o.x = cvt_pk_bf16(x0[0], x0[1]); o.y = cvt_pk_bf16(x0[2], x0[3]); o.z = cvt_pk_bf16(x1[0], x1[1]); o.w = cvt_pk_bf16(x1[2], x1[3]); *(u32x4*)(pb + (size_t)i * 8) = o; } }
}

template <bool IN_F32, bool OUT_F32>
__device__ __forceinline__ void row_pass(const void* hin, void* hout, const bf16_t* y, const float* __restrict__ gpost, const float* __restrict__ gpre, bf16_t* xa, int gw, int NGW, int lane) {
    for (int m = gw; m < TOK; m += NGW) {
        f32x4 v[4];
#pragma unroll
        for (int j = 0; j < 4; ++j) {
            if (IN_F32) v[j] = ((const f32x4*)((const float*)hin + (size_t)m * DM))[lane + 64 * j];
            else { const u32x2 w = ((const u32x2*)((const bf16_t*)hin + (size_t)m * DM))[lane + 64 * j]; v[j] = (f32x4){bf_lo(w.x), bf_hi(w.x), bf_lo(w.y), bf_hi(w.y)}; } }
        if (y) {
            f32x4 yv[4]; float ss = 0.f;
#pragma unroll
            for (int j = 0; j < 4; ++j) { const u32x2 w = ((const u32x2*)(y + (size_t)m * DM))[lane + 64 * j]; yv[j] = (f32x4){bf_lo(w.x), bf_hi(w.x), bf_lo(w.y), bf_hi(w.y)};
                ss += (yv[j][0] * yv[j][0] + yv[j][1] * yv[j][1]) + (yv[j][2] * yv[j][2] + yv[j][3] * yv[j][3]); }
            const float rs = rsqrtf(wave_sum(ss) * (1.0f / DM) + EPS);
#pragma unroll
            for (int j = 0; j < 4; ++j) { const f32x4 g = ((const f32x4*)gpost)[lane + 64 * j]; v[j] = v[j] + yv[j] * rs * g; }
        }
#pragma unroll
        for (int j = 0; j < 4; ++j) {
            if (OUT_F32) ((f32x4*)((float*)hout + (size_t)m * DM))[lane + 64 * j] = v[j];
            else { u32x2 w; w.x = cvt_pk_bf16(v[j][0], v[j][1]); w.y = cvt_pk_bf16(v[j][2], v[j][3]); ((u32x2*)((bf16_t*)hout + (size_t)m * DM))[lane + 64 * j] = w; } }
        if (gpre) {
            float ss = 0.f;
#pragma unroll
            for (int j = 0; j < 4; ++j) ss += (v[j][0] * v[j][0] + v[j][1] * v[j][1]) + (v[j][2] * v[j][2] + v[j][3] * v[j][3]);
            const float r2 = rsqrtf(wave_sum(ss) * (1.0f / DM) + EPS);
#pragma unroll
            for (int j = 0; j < 4; ++j) { const f32x4 o = v[j] * r2 * ((const f32x4*)gpre)[lane + 64 * j];
                u32x2 w; w.x = cvt_pk_bf16(o[0], o[1]); w.y = cvt_pk_bf16(o[2], o[3]); ((u32x2*)(xa + (size_t)m * DM))[lane + 64 * j] = w; }
        }
    }
}

__device__ __forceinline__ void qk_norm_rope(unsigned char* rbase, const float* __restrict__ gq, const float* __restrict__ gk, int gw, int NGW, int lane) {
    const int axis = lane >> 5, j = lane & 31, i1 = axis * 64 + j, i2 = i1 + 32;
    const float inv = __builtin_amdgcn_exp2f(-(float)j * (13.287712379549449f / 32.0f));
    const float gq1 = gq[i1], gq2 = gq[i2], gk1 = gk[i1], gk2 = gk[i2];
    for (int it = gw; it < TOK * 10; it += NGW) {
        const int t = it / 10, hs = it % 10;
        bf16_t* p = hs < 8 ? (bf16_t*)(rbase + R_Q) + (size_t)t * 1024 + hs * 128 : (bf16_t*)(rbase + R_K) + (size_t)t * 256 + (hs - 8) * 128;
        const float g1 = hs < 8 ? gq1 : gk1, g2 = hs < 8 ? gq2 : gk2;
        float x1 = bf_lo((unsigned)p[i1]), x2 = bf_lo((unsigned)p[i2]);
        const float rs = rsqrtf(wave_sum(x1 * x1 + x2 * x2) * (1.0f / 128.0f) + EPS);
        x1 = x1 * rs * g1; x2 = x2 * rs * g2;
        const int s = t & (SEQ - 1); const float pos = (float)(axis == 0 ? (s >> 6) : (s & 63));
        const float rev = pos * inv * 0.15915494309189535f;
        const float rf = __builtin_amdgcn_fractf(rev); const float c = __builtin_amdgcn_cosf(rf), sn = __builtin_amdgcn_sinf(rf);
        const float o1 = x1 * c - x2 * sn, o2 = x2 * c + x1 * sn;
        p[i1] = (bf16_t)(cvt_pk_bf16(o1, 0.f) & 0xffffu); p[i2] = (bf16_t)(cvt_pk_bf16(o2, 0.f) & 0xffffu);
    }
}

__device__ __forceinline__ void gla_post(bf16_t* of, const bf16_t* ob, const bf16_t* gg, const float* __restrict__ g, int gw, int NGW, int lane) {
    const f32x4 gv = ((const f32x4*)g)[lane];
    for (int it = gw; it < TOK * 4; it += NGW) {
        const size_t off = (size_t)it * 256 + 4 * lane;
        const u32x2 a = *(const u32x2*)(of + off), b = *(const u32x2*)(ob + off), c = *(const u32x2*)(gg + off);
        f32x4 o = (f32x4){bf_lo(a.x) + bf_lo(b.x), bf_hi(a.x) + bf_hi(b.x), bf_lo(a.y) + bf_lo(b.y), bf_hi(a.y) + bf_hi(b.y)};
        const float rs = rsqrtf(wave_sum((o[0] * o[0] + o[1] * o[1]) + (o[2] * o[2] + o[3] * o[3])) * (1.0f / 256.0f) + EPS);
        const f32x4 gt = (f32x4){bf_lo(c.x), bf_hi(c.x), bf_lo(c.y), bf_hi(c.y)};
#pragma unroll
        for (int k = 0; k < 4; ++k) o[k] = o[k] * rs * gv[k] * (gt[k] * sigmoidf_(gt[k]));
        u32x2 w; w.x = cvt_pk_bf16(o[0], o[1]); w.y = cvt_pk_bf16(o[2], o[3]); *(u32x2*)(of + off) = w;
    }
}
constexpr int GL_QD = 0, GL_KI = 17408, GL_KST = 34816, GL_VT = 53248, GL_STT = 62464, GL_EL = 79872, GL_RA = 80384, GL_TOT = 84480, GL_END = 88576;
constexpr int GS_Q = 272, GS_T = 144;
__device__ __forceinline__ void gla_unit(KA a, int L, int b, int h, int dir, int vs, LAS unsigned char* lds) {
    const int tid = opaque_tid(), lane = tid & 63, w = __builtin_amdgcn_readfirstlane(tid >> 6);
    unsigned char* rbase = a->ws + WS_R;
    const bf16_t* GQ = (const bf16_t*)(rbase + R_GQ); const bf16_t* GK = (const bf16_t*)(rbase + R_GK); const bf16_t* GV = (const bf16_t*)(rbase + R_GV); const float* RA = (const float*)(rbase + R_RA);
    bf16_t* O = (bf16_t*)(a->ws + (dir ? WS_OB : WS_OF));
    f32x2 wu[16];
    { const float* wup = a->in[4] + ((size_t)(L * 2 + dir) * 16) * 512 + h * 128 + 2 * lane;
#pragma unroll
      for (int j = 0; j < 16; ++j) wu[j] = *(const f32x2*)(wup + (size_t)j * 512); }
    const f32x2 bias = *(const f32x2*)(a->in[5] + (size_t)(L * 2 + dir) * 512 + h * 128 + 2 * lane);
    f32x4 st[4];
#pragma unroll
    for (int nb = 0; nb < 4; ++nb) st[nb] = (f32x4){0.f, 0.f, 0.f, 0.f};
    for (int i = tid; i < 17408 / 4; i += 512) ((LAS unsigned*)(lds + GL_STT))[i] = 0u;
    const int li = lane & 15, kq = lane >> 4, ib = w & 3, dh = w >> 2;
    const int vrow = tid >> 3, vc8 = tid & 7;
    unsigned qv[8], kv[8]; u32x4 vv; f32x2 rav;
#define GLA_LOAD(ci_) do { const size_t t0_ = (size_t)b * SEQ + (size_t)(ci_) * 64; \
        _Pragma("unroll") for (int r = 0; r < 8; ++r) { qv[r] = *(const unsigned*)(GQ + (t0_ + 8 * w + r) * 512 + h * 128 + 2 * lane); kv[r] = *(const unsigned*)(GK + (t0_ + 8 * w + r) * 512 + h * 128 + 2 * lane); } \
        vv = *(const u32x4*)(GV + (t0_ + vrow) * 1024 + h * 256 + vs * 64 + vc8 * 8); rav = *(const f32x2*)(RA + (t0_ + vrow) * 32 + dir * 16 + 2 * vc8); } while (0)
    GLA_LOAD(dir ? 63 : 0);
    for (int c = 0; c < 64; ++c) {
        const int ci = dir ? 63 - c : c; const size_t t0 = (size_t)b * SEQ + (size_t)ci * 64;
        *(LAS f32x2*)(lds + GL_RA + vrow * 64 + vc8 * 8) = rav;
        { const unsigned short e0 = vv.x & 0xffff, e1 = vv.x >> 16, e2 = vv.y & 0xffff, e3 = vv.y >> 16, e4 = vv.z & 0xffff, e5 = vv.z >> 16, e6 = vv.w & 0xffff, e7 = vv.w >> 16;
          LAS unsigned char* vt = lds + GL_VT + (vc8 * 8) * GS_T + vrow * 2;
          *(LAS unsigned short*)(vt + 0 * GS_T) = e0; *(LAS unsigned short*)(vt + 1 * GS_T) = e1; *(LAS unsigned short*)(vt + 2 * GS_T) = e2; *(LAS unsigned short*)(vt + 3 * GS_T) = e3;
          *(LAS unsigned short*)(vt + 4 * GS_T) = e4; *(LAS unsigned short*)(vt + 5 * GS_T) = e5; *(LAS unsigned short*)(vt + 6 * GS_T) = e6; *(LAS unsigned short*)(vt + 7 * GS_T) = e7; }
        unsigned qc[8], kc[8];
#pragma unroll
        for (int r = 0; r < 8; ++r) { qc[r] = qv[r]; kc[r] = kv[r]; }
        __syncthreads();
        if (c + 1 < 64) GLA_LOAD(dir ? 62 - c : c + 1);
        float la0[8], la1[8];
#pragma unroll
        for (int r = 0; r < 8; ++r) {
            const LAS f32x4* rr = (const LAS f32x4*)(lds + GL_RA + (8 * w + r) * 64);
            f32x2 x = bias;
#pragma unroll
            for (int q4 = 0; q4 < 4; ++q4) { const f32x4 t = rr[q4];
#pragma unroll
                for (int e = 0; e < 4; ++e) x = __builtin_elementwise_fma((f32x2){t[e], t[e]}, wu[4 * q4 + e], x); }
            const f32x2 xl = x * 1.4426950408889634f;
            la0[r] = (fminf(xl.x, 0.f) - __builtin_amdgcn_logf(1.0f + __builtin_amdgcn_exp2f(-fabsf(xl.x)))) * (1.0f / 16.0f);
            la1[r] = (fminf(xl.y, 0.f) - __builtin_amdgcn_logf(1.0f + __builtin_amdgcn_exp2f(-fabsf(xl.y)))) * (1.0f / 16.0f);
        }
        if (dir == 0) {
#pragma unroll
            for (int r = 1; r < 8; ++r) { la0[r] += la0[r - 1]; la1[r] += la1[r - 1]; }
        } else {
#pragma unroll
            for (int r = 6; r >= 0; --r) { la0[r] += la0[r + 1]; la1[r] += la1[r + 1]; }
        }
        *(LAS f32x2*)(lds + GL_TOT + w * 512 + lane * 8) = (f32x2){dir == 0 ? la0[7] : la0[0], dir == 0 ? la1[7] : la1[0]};
        __syncthreads();
        float off0 = 0.f, off1 = 0.f, last0 = 0.f, last1 = 0.f;
#pragma unroll
        for (int g = 0; g < 8; ++g) { const f32x2 t = *(const LAS f32x2*)(lds + GL_TOT + g * 512 + lane * 8); last0 += t.x; last1 += t.y;
            const bool before = dir == 0 ? (g < w) : (g > w); if (before) { off0 += t.x; off1 += t.y; } }
        const float el0 = __builtin_amdgcn_exp2f(last0), el1 = __builtin_amdgcn_exp2f(last1);
        unsigned ks0[4], ks1[4];
#pragma unroll
        for (int r = 0; r < 8; ++r) {
            const float c0 = la0[r] + off0, c1 = la1[r] + off1;
            const float q0 = bf_lo(qc[r]), q1 = bf_hi(qc[r]), k0 = bf_lo(kc[r]), k1 = bf_hi(kc[r]);
            const float eq0 = __builtin_amdgcn_exp2f(c0) * 0.088388347648318440f, eq1 = __builtin_amdgcn_exp2f(c1) * 0.088388347648318440f;
            const int row = 8 * w + r;
            const float ki0 = k0 * __builtin_amdgcn_exp2f(-c0), ki1 = k1 * __builtin_amdgcn_exp2f(-c1);
            *(LAS unsigned*)(lds + GL_QD + row * GS_Q + lane * 4) = cvt_pk_bf16(q0 * eq0, q1 * eq1);
            *(LAS unsigned*)(lds + GL_KI + row * GS_Q + lane * 4) = cvt_pk_bf16(ki0, ki1);
            const float s0 = ki0 * el0, s1 = ki1 * el1;
            if (r & 1) { ks0[r >> 1] = cvt_pk_bf16(__builtin_bit_cast(float, ks0[r >> 1]), s0); ks1[r >> 1] = cvt_pk_bf16(__builtin_bit_cast(float, ks1[r >> 1]), s1); }
            else { ks0[r >> 1] = __builtin_bit_cast(unsigned, s0); ks1[r >> 1] = __builtin_bit_cast(unsigned, s1); }
        }
        *(LAS u32x4*)(lds + GL_KST + (2 * lane) * GS_T + w * 16) = (u32x4){ks0[0], ks0[1], ks0[2], ks0[3]};
        *(LAS u32x4*)(lds + GL_KST + (2 * lane + 1) * GS_T + w * 16) = (u32x4){ks1[0], ks1[1], ks1[2], ks1[3]};
        if (w == 0) *(LAS f32x2*)(lds + GL_EL + lane * 8) = (f32x2){el0, el1};
        __syncthreads();
        bf16x8 qf[4];
#pragma unroll
        for (int kk = 0; kk < 4; ++kk) qf[kk] = *(const LAS bf16x8*)(lds + GL_QD + (16 * ib + li) * GS_Q + kk * 64 + kq * 16);
        unsigned pk[4][2];
#pragma unroll
        for (int sb = 0; sb < 4; ++sb) {
            if (dir == 0 ? (sb > ib) : (sb < ib)) { pk[sb][0] = 0u; pk[sb][1] = 0u; continue; }
            f32x4 sacc = (f32x4){0.f, 0.f, 0.f, 0.f};
#pragma unroll
            for (int kk = 0; kk < 4; ++kk) { const bf16x8 kf = *(const LAS bf16x8*)(lds + GL_KI + (16 * sb + li) * GS_Q + kk * 64 + kq * 16);
                sacc = __builtin_amdgcn_mfma_f32_16x16x32_bf16(kf, qf[kk], sacc, 0, 0, 0); }
            const int irow = 16 * ib + li;
#pragma unroll
            for (int j = 0; j < 4; ++j) { const int srow = 16 * sb + 4 * kq + j; const bool keep = dir == 0 ? (srow <= irow) : (srow >= irow); sacc[j] = keep ? sacc[j] : 0.f; }
            pk[sb][0] = cvt_pk_bf16(sacc[0], sacc[1]); pk[sb][1] = cvt_pk_bf16(sacc[2], sacc[3]);
        }
#pragma unroll
        for (int d2 = 0; d2 < 2; ++d2) { const int db = 2 * dh + d2;
            f32x4 oacc = (f32x4){0.f, 0.f, 0.f, 0.f};
#pragma unroll
            for (int kk = 0; kk < 4; ++kk) { const bf16x8 sf = *(const LAS bf16x8*)(lds + GL_STT + (16 * db + li) * GS_Q + kk * 64 + kq * 16);
                oacc = __builtin_amdgcn_mfma_f32_16x16x32_bf16(sf, qf[kk], oacc, 0, 0, 0); }
#pragma unroll
            for (int kc2 = 0; kc2 < 2; ++kc2) {
                const s16x4 lo = *(const LAS s16x4*)(lds + GL_VT + (16 * db + li) * GS_T + (32 * kc2 + 4 * kq) * 2);
                const s16x4 hi4 = *(const LAS s16x4*)(lds + GL_VT + (16 * db + li) * GS_T + (32 * kc2 + 16 + 4 * kq) * 2);
                const bf16x8 vf = (bf16x8){lo[0], lo[1], lo[2], lo[3], hi4[0], hi4[1], hi4[2], hi4[3]};
                const u32x4 pw = (u32x4){pk[2 * kc2][0], pk[2 * kc2][1], pk[2 * kc2 + 1][0], pk[2 * kc2 + 1][1]};
                oacc = __builtin_amdgcn_mfma_f32_16x16x32_bf16(vf, __builtin_bit_cast(bf16x8, pw), oacc, 0, 0, 0); }
            u32x2 ow; ow.x = cvt_pk_bf16(oacc[0], oacc[1]); ow.y = cvt_pk_bf16(oacc[2], oacc[3]);
            *(u32x2*)(O + (t0 + 16 * ib + li) * 1024 + h * 256 + vs * 64 + 16 * db + 4 * kq) = ow;
        }
        { const f32x4 el = *(const LAS f32x4*)(lds + GL_EL + (16 * w + 4 * kq) * 4);
#pragma unroll
          for (int nb = 0; nb < 4; ++nb) st[nb] = st[nb] * el;
#pragma unroll
          for (int kc2 = 0; kc2 < 2; ++kc2) { const bf16x8 af = *(const LAS bf16x8*)(lds + GL_KST + (16 * w + li) * GS_T + kc2 * 64 + kq * 16);
#pragma unroll
              for (int nb = 0; nb < 4; ++nb) { const bf16x8 bfv = *(const LAS bf16x8*)(lds + GL_VT + (16 * nb + li) * GS_T + kc2 * 64 + kq * 16);
                  st[nb] = __builtin_amdgcn_mfma_f32_16x16x32_bf16(af, bfv, st[nb], 0, 0, 0); } } }
        __syncthreads();
#pragma unroll
        for (int nb = 0; nb < 4; ++nb) { u32x2 sw; sw.x = cvt_pk_bf16(st[nb][0], st[nb][1]); sw.y = cvt_pk_bf16(st[nb][2], st[nb][3]);
            *(LAS u32x2*)(lds + GL_STT + (16 * nb + li) * GS_Q + (16 * w + 4 * kq) * 2) = sw; }
    }
#undef GLA_LOAD
    __syncthreads();
}
#ifndef PH_MASK
#define PH_MASK 0x3fff
#endif
#define EN(k) (((PH_MASK) >> (k)) & 1)
#ifndef PROBE_SYNC_REPS
#define PROBE_SYNC_REPS 1
#endif
#ifndef PROBE_GLA_REPS
#define PROBE_GLA_REPS 1
#endif
__global__ void __launch_bounds__(512) hybrid_fwd(Args a_) {
    extern __shared__ __attribute__((aligned(16))) unsigned char lds_raw[];
    LAS unsigned char* lds = (LAS unsigned char*)lds_raw;
    cg::grid_group grid = cg::this_grid();
    const int ph_lo = a_.ph_lo, ph_hi = a_.ph_hi;
    if (threadIdx.x < 2) ((LAS unsigned*)(lds + 131072))[threadIdx.x] = 0u;
    __syncthreads();
    const XcdBarrier xbar = xcd_barrier_post((unsigned*)(a_.ws + WS_CTL), (volatile LAS unsigned*)(lds + 131072));
    for (int ph = ph_lo; ph < ph_hi; ++ph) {
        const int tid = opaque_tid(), lane = tid & 63, wave = __builtin_amdgcn_readfirstlane(tid >> 6);
        int bx = blockIdx.x, G = gridDim.x; asm volatile("" : "+s"(bx), "+s"(G));
        const int vcu = (G % 8 == 0) ? (bx % 8) * (G / 8) + bx / 8 : bx;
        const int gw = vcu * 8 + wave, NGW = G * 8;
        KA a = (KA)__builtin_amdgcn_kernarg_segment_ptr(); asm volatile("" : "+s"(a));
        unsigned char* ws = a->ws; unsigned char* rbase = ws + WS_R; unsigned char* wsW = ws + WS_W;
        bf16_t* XA = (bf16_t*)(ws + WS_XA); bf16_t* OF = (bf16_t*)(ws + WS_OF); bf16_t* OB = (bf16_t*)(ws + WS_OB); bf16_t* GG = (bf16_t*)a->out; bf16_t* HB = (bf16_t*)(ws + WS_HB); bf16_t* PB = (bf16_t*)(ws + WS_PB);
        if (ph == 0) { if (EN(13)) {
            prep_layer(a, 0, lds, gw, NGW, wave, lane);
            row_pass<true, false>(a->in[0], HB, nullptr, nullptr, a->in[2], XA, gw, NGW, lane); }
        } else {
            const int L = (ph - 1) / NPH_LAYER, k = (ph - 1) % NPH_LAYER;
            if (k == 3) continue;
            int ngemm = 0; pg8::Gemm g0{}, g1{}; pg8::Epi e0{}, e1{};
            e0.rbase = rbase; e0.ggbase = (unsigned char*)a->out; e1.rbase = rbase; e1.ggbase = (unsigned char*)a->out;
            switch (k) {
            case 0: if (!EN(0)) break; ngemm = 1; g0 = pg8::Gemm{XA, (const bf16_t*)(wsW + W_INA), TOK, NA_PAD, DM}; e0.mode = pg8::EM_ROUTE_A; break;
            case 1: if (!EN(1)) break; for (int rep = 0; rep < PROBE_GLA_REPS; ++rep) for (int u = vcu; u < 256; u += G) gla_unit(a, L, u >> 5, (u >> 3) & 3, (u >> 2) & 1, u & 3, lds); break;
            case 2: if (!EN(2)) break; gla_post(OF, OB, GG, a->in[6] + (size_t)L * 256, gw, NGW, lane);
                    ngemm = 1; g0 = pg8::Gemm{XA, (const bf16_t*)(wsW + W_INB), TOK, NB_COLS, DM}; e0.mode = pg8::EM_ROUTE_B; e0.gqn = a->in[7] + (size_t)L * 128; e0.gkn = a->in[8] + (size_t)L * 128; e0.xlds = (LAS float*)(lds + 131072 + 1024); break;
            case 3: break;
            case 4: if (!EN(4)) break; for (int u = vcu; u < 1024; u += G) { const int qb = u & 15, hg = (u >> 4) & 3, kvh = (u >> 6) & 1, b = u >> 7, hq = kvh * 4 + hg;
                        bf16_t* Qb = (bf16_t*)(rbase + R_Q) + ((size_t)b * SEQ + (size_t)qb * 256) * 1024 + hq * 128;
                        const bf16_t* Kh = (const bf16_t*)(rbase + R_K) + (size_t)b * SEQ * 256 + kvh * 128; const bf16_t* Vh = (const bf16_t*)(rbase + R_V) + (size_t)b * SEQ * 256 + kvh * 128;
                        attn::attn_dense_body<attn::bf16>((const attn::bf16*)Qb, (const attn::bf16*)Kh, (const attn::bf16*)Vh, Qb, SEQ, (char*)lds_raw);
                        __syncthreads(); }
                    break;
            case 5: if (!EN(5)) break; ngemm = 2; g0 = pg8::Gemm{OF, (const bf16_t*)(wsW + W_OGLA), TOK, DM, DM}; e0.mode = pg8::EM_GATE1; e0.out = OB; e0.aux = (const bf16_t*)(rbase + R_GA);
                    g1 = pg8::Gemm{(const bf16_t*)(rbase + R_Q), (const bf16_t*)(wsW + W_OATT), TOK, DM, DM}; e1.mode = pg8::EM_GATE2; e1.out = OB; e1.aux = (const bf16_t*)(rbase + R_GB); break;
            case 6: if (!EN(6)) break; ngemm = 1; g0 = pg8::Gemm{OB, (const bf16_t*)(wsW + W_OUT), TOK, DM, DM}; e0.mode = pg8::EM_PLAIN; e0.out = OF; break;
            case 7: if (!EN(7)) break; row_pass<false, false>(HB, HB, OF, a->in[12] + (size_t)L * DM, a->in[13] + (size_t)L * DM, XA, gw, NGW, lane); break;
            case 8: if (!EN(8)) break; ngemm = 1; g0 = pg8::Gemm{XA, (const bf16_t*)(wsW + W_FIN), TOK, 2 * FFH, DM}; e0.mode = pg8::EM_SWIGLU; e0.out = (bf16_t*)rbase; break;
            case 9: if (!EN(9)) break; ngemm = 1; g0 = pg8::Gemm{(const bf16_t*)rbase, (const bf16_t*)(wsW + W_FOUT), TOK, DM, FFH}; e0.mode = pg8::EM_PLAIN; e0.out = OF; break;
            case 10: if (!EN(10)) break; row_pass<false, false>(HB, HB, OF, a->in[16] + (size_t)L * DM, nullptr, nullptr, gw, NGW, lane); break;
            case 11: if (!EN(11)) break; ngemm = 2; g0 = pg8::Gemm{PB, (const bf16_t*)(wsW + W_PP), TOK, DM, PLE}; e0.mode = pg8::EM_PLAIN; e0.out = (bf16_t*)rbase;
                     g1 = pg8::Gemm{HB, (const bf16_t*)(wsW + W_PG), TOK, DM, DM}; e1.mode = pg8::EM_PLE2; e1.out = OF; e1.aux = (const bf16_t*)rbase; break;
            default: if (!EN(12)) break; if (L + 1 < DEPTH) row_pass<false, false>(HB, HB, OF, a->in[19] + (size_t)L * DM, a->in[2] + (size_t)(L + 1) * DM, XA, gw, NGW, lane);
                     else row_pass<false, true>(HB, a->out, OF, a->in[19] + (size_t)L * DM, nullptr, nullptr, gw, NGW, lane);
                     if (L + 1 < DEPTH) prep_layer(a, L + 1, lds, gw, NGW, wave, lane);
                     break;
            }
            for (int gi = 0; gi < ngemm; ++gi) {
                const pg8::Gemm g = gi == 0 ? g0 : g1; const pg8::Epi E = gi == 0 ? e0 : e1;
                pg8::StaticOrder S; S.init(g.M, g.N, G, bx);
                pg8::gemm_phase<pg8::Epi, pg8::StaticOrder, true, true>(lds, g, S, E);
            }
        }
        if (ph + 1 < ph_hi) { if (ph == 0) grid.sync(); else xcd_barrier(xbar); }
    }
}

#if MK_DEBUG
struct DbgReg { unsigned long long off, bytes; int type, pad; };
struct DbgArgs { DbgReg r[3]; int scanH, ph, pass, pad; };
__global__ void __launch_bounds__(256) dbg_scan(unsigned char* ws, const float* out, DbgArgs d) {
    unsigned* nanw = (unsigned*)(ws + WS_CTL); unsigned long long* sums = (unsigned long long*)(ws + WS_CTL + 512 + d.pass * 512);
    unsigned long long s = 0; unsigned bad = 0;
#pragma unroll
    for (int ri = 0; ri < 3; ++ri) {
        const size_t n16 = d.r[ri].bytes / 16; const u32x4* p = (const u32x4*)(ws + d.r[ri].off); const int type = d.r[ri].type;
        for (size_t i = (size_t)blockIdx.x * 256 + threadIdx.x; i < n16; i += (size_t)gridDim.x * 256) {
            const u32x4 v = p[i]; s += (unsigned long long)v.x + v.y + v.z + v.w;
#pragma unroll
            for (int k = 0; k < 4; ++k) { const unsigned w = v[k]; if ((type == 0 && (w & 0x7f80u) == 0x7f80u) || (type <= 1 && (w & 0x7f800000u) == 0x7f800000u)) bad = 1; }
        }
    }
    if (d.scanH) { const size_t no = (size_t)TOK * DM / 4; const u32x4* q = (const u32x4*)out;
        for (size_t i = (size_t)blockIdx.x * 256 + threadIdx.x; i < no; i += (size_t)gridDim.x * 256) {
            const u32x4 v = q[i]; s += (unsigned long long)v.x + v.y + v.z + v.w;
#pragma unroll
            for (int k = 0; k < 4; ++k) if ((v[k] & 0x7f800000u) == 0x7f800000u) bad = 1; } }
    for (int o = 1; o < 64; o <<= 1) { s += __shfl_xor(s, o); bad |= __shfl_xor(bad, o); }
    if ((threadIdx.x & 63) == 0) { atomicAdd(&sums[d.ph], s); if (bad) atomicOr(&nanw[d.ph], 1u); }
}
__global__ void __launch_bounds__(64) dbg_check_gemm_a(unsigned char* ws) {
    unsigned* chk = (unsigned*)(ws + WS_CTL) + 56;
    const int i = blockIdx.x, lane = threadIdx.x;
    const int t = (int)(((long)i * 9973 + 17) % TOK), col = (i * 131 + 5) % NA_REAL;
    const bf16_t* xa = (const bf16_t*)(ws + WS_XA) + (size_t)t * DM; const bf16_t* wt = (const bf16_t*)(ws + WS_W + W_INA) + (size_t)col * DM;
    float acc = 0.f;
    for (int k = lane; k < DM; k += 64) acc += bf_lo((unsigned)xa[k]) * bf_lo((unsigned)wt[k]);
    acc = wave_sum(acc);
    unsigned char* rb = ws + WS_R; float got;
    if (col < 512) got = bf_lo((unsigned)((const bf16_t*)(rb + R_GQ))[(size_t)t * 512 + col]);
    else if (col < 1024) got = bf_lo((unsigned)((const bf16_t*)(rb + R_GK))[(size_t)t * 512 + col - 512]);
    else if (col < 2048) got = bf_lo((unsigned)((const bf16_t*)(rb + R_GV))[(size_t)t * 1024 + col - 1024]);
    else if (col < 3072) got = bf_lo((unsigned)((const bf16_t*)(ws + WS_GG))[(size_t)t * 1024 + col - 2048]);
    else got = ((const float*)(rb + R_RA))[(size_t)t * 32 + col - 3072];
    if (lane == 0) { if (!(fabsf(got - acc) <= 0.03f * fmaxf(1.f, fabsf(acc)))) { atomicOr(chk, fabsf(got) < 1e-9f ? 1u : 2u); if (atomicAdd(chk + 4, 1u) == 0u) { chk[2] = (unsigned)(t & 255) >> 2; chk[3] = (unsigned)(col & 255) >> 3; } } }
    float m = 0.f; const float* ra = (const float*)(rb + R_RA);
    for (int k = lane; k < 2048; k += 64) m = fmaxf(m, fabsf(ra[(size_t)i * 2048 + k]));
    for (int o = 1; o < 64; o <<= 1) m = fmaxf(m, __shfl_xor(m, o));

}
__global__ void __launch_bounds__(64) dbg_check_gemm_b(unsigned char* ws) {
    unsigned* chk = (unsigned*)(ws + WS_CTL) + 57;
    const int i = blockIdx.x, lane = threadIdx.x;
    const int t = (int)(((long)i * 9973 + 17) % TOK), col = (i * 131 + 5) % NB_COLS;
    const bf16_t* xa = (const bf16_t*)(ws + WS_XA) + (size_t)t * DM; const bf16_t* wt = (const bf16_t*)(ws + WS_W + W_INB) + (size_t)col * DM;
    float acc = 0.f;
    for (int k = lane; k < DM; k += 64) acc += bf_lo((unsigned)xa[k]) * bf_lo((unsigned)wt[k]);
    acc = wave_sum(acc);
    unsigned char* rb = ws + WS_R; float got; unsigned bit;
    if (col < 1024) { got = bf_lo((unsigned)((const bf16_t*)(rb + R_Q))[(size_t)t * 1024 + col]); bit = 1u; }
    else if (col < 1280) { got = bf_lo((unsigned)((const bf16_t*)(rb + R_K))[(size_t)t * 256 + col - 1024]); bit = 2u; }
    else if (col < 1536) { got = bf_lo((unsigned)((const bf16_t*)(rb + R_V))[(size_t)t * 256 + col - 1280]); bit = 2u; }
    else if (col < 2560) { got = bf_lo((unsigned)((const bf16_t*)(rb + R_GA))[(size_t)t * 1024 + col - 1536]); bit = 4u; }
    else { got = bf_lo((unsigned)((const bf16_t*)(rb + R_GB))[(size_t)t * 1024 + col - 2560]); bit = 4u; }
    if (lane == 0) { if (!(fabsf(got - acc) <= 0.03f * fmaxf(1.f, fabsf(acc)))) atomicOr(chk, bit); }
}
__global__ void __launch_bounds__(256) dbg_check_gla(unsigned char* ws) {
    unsigned* c58 = (unsigned*)(ws + WS_CTL) + 58; unsigned* c59 = c58 + 1;
    const bf16_t* of = (const bf16_t*)(ws + WS_OF); const bf16_t* ob = (const bf16_t*)(ws + WS_OB);
    unsigned mn = 99u, mx = 0u;
    for (size_t i = (size_t)blockIdx.x * 256 + threadIdx.x; i < (size_t)TOK * DM; i += (size_t)gridDim.x * 256) {
        const unsigned chunk = (unsigned)((i >> 10) & 4095) >> 6;
        if ((of[i] & 0x7f80u) == 0x7f80u) mn = chunk < mn ? chunk : mn;
        if ((ob[i] & 0x7f80u) == 0x7f80u) mx = chunk + 1 > mx ? chunk + 1 : mx;
    }
    if (mn != 99u) atomicMin(c58, mn); if (mx) atomicMax(c59, mx);
}
__global__ void __launch_bounds__(256) dbg_final(unsigned char* ws, float* out) {
    const unsigned* nanw = (const unsigned*)(ws + WS_CTL); const unsigned long long* sa = (const unsigned long long*)(ws + WS_CTL + 512); const unsigned long long* sb = sa + 64;
    int p1 = -1, p2 = -1;
    for (int i = NPHASES - 1; i >= 0; --i) { if (nanw[i]) p1 = i; if (sa[i] != sb[i]) p2 = i; }
    const unsigned chkA = nanw[56], chkB = nanw[57], g0 = nanw[58], g1 = nanw[59];
    if (p1 < 0 && p2 < 0 && chkA == 0 && chkB == 0) return;
    float c1; unsigned e;
    if (chkA | chkB) { c1 = 90.f + (chkA & 7); e = chkB & 7; }
    else if (p1 == 2) { c1 = 10.f + (g0 > 63 ? 70.f : (float)g0); e = g1 / 3; }
    else { c1 = p1 >= 0 ? 10.f + p1 : 40.f + p2; e = p1 >= 0 ? 25 : 30; }
    float code = c1 * 100.f; for (unsigned k = 0; k < e; ++k) code *= 10.f;
    for (size_t i = (size_t)blockIdx.x * 256 + threadIdx.x; i < (size_t)TOK * DM; i += (size_t)gridDim.x * 256) out[i] = i == 0 ? code : 0.f;
}
static DbgArgs dbg_args_for(int ph, int pass) {
    DbgArgs d{}; d.ph = ph; d.pass = pass; int n = 0;
    auto add = [&](size_t off, size_t bytes, int type) { d.r[n].off = off; d.r[n].bytes = bytes; d.r[n].type = type; ++n; };
    if (ph == 0) { add(WS_W, W_END, 0); add(WS_PB, 16 * MiB, 0); add(WS_XA, 64 * MiB, 0); d.scanH = 1; return d; }
    const int k = (ph - 1) % NPH_LAYER;
    switch (k) {
    case 0: add(WS_R, 128 * MiB, 0); add(WS_R + R_RA, 4 * MiB, 1); add(WS_GG, 64 * MiB, 0); break;
    case 1: add(WS_OF, 128 * MiB, 0); break;
    case 2: add(WS_OF, 64 * MiB, 0); add(WS_R, 224 * MiB, 0); break;
    case 3: add(WS_R + R_Q, 80 * MiB, 0); break;
    case 4: add(WS_R + R_Q, 64 * MiB, 0); break;
    case 5: add(WS_OB, 64 * MiB, 0); break;
    case 6: add(WS_OF, 64 * MiB, 0); break;
    case 7: add(WS_XA, 64 * MiB, 0); d.scanH = 1; break;
    case 8: add(WS_R, (size_t)TOK * FFH * 2, 0); break;
    case 9: add(WS_OF, 64 * MiB, 0); break;
    case 10: add(WS_XA, 64 * MiB, 0); d.scanH = 1; break;
    case 11: add(WS_R, 64 * MiB, 0); add(WS_OF, 64 * MiB, 0); break;
    default: add(WS_XA, 64 * MiB, 0); add(WS_W, W_END, 0); add(WS_PB, 16 * MiB, 0); d.scanH = 1; break;
    }
    return d;
}
#endif
extern "C" void kernel_launch(void* const* d_in, const int* in_sizes, int n_in, void* d_out, int out_size, void* d_ws, size_t ws_size, hipStream_t stream) {
    static int grid = 0;
    if (grid == 0) {
        if (n_in != 20 || in_sizes[0] != TOK * DM || out_size != TOK * DM || ws_size < WS_END) {
            fprintf(stderr, "kernel_launch: unexpected shapes (n_in %d, in0 %d, out %d, ws %zu, need %zu); nothing launched\n", n_in, n_in > 0 ? in_sizes[0] : -1, out_size, ws_size, (size_t)WS_END); grid = -1; return; }
        int dev = 0, cus = 0, per_cu = 0;
        if (hipGetDevice(&dev) != hipSuccess || hipDeviceGetAttribute(&cus, hipDeviceAttributeMultiprocessorCount, dev) != hipSuccess) { grid = -1; return; }
        if (hipFuncSetAttribute((const void*)hybrid_fwd, hipFuncAttributeMaxDynamicSharedMemorySize, LDS_BYTES) != hipSuccess) { fprintf(stderr, "kernel_launch: hipFuncSetAttribute failed\n"); grid = -1; return; }
        if (hipOccupancyMaxActiveBlocksPerMultiprocessor(&per_cu, (const void*)hybrid_fwd, 512, LDS_BYTES) != hipSuccess || per_cu < 1) { fprintf(stderr, "kernel_launch: occupancy query says %d\n", per_cu); per_cu = 1; }
        (void)hipGetLastError();
        grid = cus * 1;
        fprintf(stderr, "kernel_launch: grid %d (cus %d, per_cu %d), ws need %zu have %zu\n", grid, cus, per_cu, (size_t)WS_END, ws_size);
    }
    if (grid < 0) return;
    if (hipMemsetAsync((char*)d_ws + WS_CTL, 0, 16384, stream) != hipSuccess) { fprintf(stderr, "kernel_launch: memset failed\n"); return; }
    Args a{};
    for (int i = 0; i < 20; ++i) a.in[i] = (const float*)d_in[i];
    a.out = (float*)d_out; a.ws = (unsigned char*)d_ws;
#if MK_DEBUG
    hipMemsetAsync((char*)d_ws + WS_CTL, 0, 4096, stream); hipMemsetAsync((char*)d_ws + WS_CTL + 58 * 4, 0x63, 1, stream);
    for (int pass = 0; pass < 2; ++pass)
        for (int ph = 0; ph < NPHASES; ++ph) { a.ph_lo = ph; a.ph_hi = ph + 1; hipLaunchKernelGGL(hybrid_fwd, dim3(grid), dim3(512), LDS_BYTES, stream, a);
            hipLaunchKernelGGL(dbg_scan, dim3(2048), dim3(256), 0, stream, (unsigned char*)d_ws, (const float*)d_out, dbg_args_for(ph, pass));
            if (pass == 0 && ph == 1) { hipLaunchKernelGGL(dbg_check_gemm_a, dim3(512), dim3(64), 0, stream, (unsigned char*)d_ws); }
            if (pass == 0 && ph == 2) hipLaunchKernelGGL(dbg_check_gla, dim3(2048), dim3(256), 0, stream, (unsigned char*)d_ws);
            if (pass == 0 && ph == 3) hipLaunchKernelGGL(dbg_check_gemm_b, dim3(512), dim3(64), 0, stream, (unsigned char*)d_ws); }
    hipLaunchKernelGGL(dbg_final, dim3(2048), dim3(256), 0, stream, (unsigned char*)d_ws, (float*)d_out);
#elif MK_PER_PHASE
    for (int ph = 0; ph < NPHASES; ++ph) { a.ph_lo = ph; a.ph_hi = ph + 1; hipLaunchKernelGGL(hybrid_fwd, dim3(grid), dim3(512), LDS_BYTES, stream, a); }
#else
    a.ph_lo = 0; a.ph_hi = NPHASES;
    void* args[] = {&a};
    hipError_t e = hipLaunchCooperativeKernel((const void*)hybrid_fwd, dim3(grid), dim3(512), args, LDS_BYTES, stream);
    if (e != hipSuccess) fprintf(stderr, "kernel_launch: cooperative launch failed: %s (grid %d)\n", hipGetErrorString(e), grid);
#endif
}
```

```cpp
#include <hip/hip_runtime.h>
#include <hip/hip_bf16.h>
#include <hip/hip_cooperative_groups.h>
#include <cstdio>
#include <cstdint>
namespace cg = cooperative_groups;
#ifndef MK_DEBUG
#define MK_DEBUG 0
#endif
#ifndef MK_PER_PHASE
#define MK_PER_PHASE 0
#endif
__device__ __forceinline__ int opaque_tid() { int t = threadIdx.x; asm volatile("" : "+v"(t)); return t; }
#define LAS __attribute__((address_space(3)))
constexpr int TOK = 32768, DM = 1024, SEQ = 4096, NBATCH = 8, DEPTH = 4, INW = 6688, FFH = 2816, PLE = 256;
constexpr int NA_REAL = 3104, NA_PAD = 3328, NB_COLS = 3584;
constexpr float EPS = 1e-6f;
constexpr size_t MiB = 1048576;
constexpr size_t W_INA = 0, W_INB = W_INA + (size_t)NA_PAD * DM * 2, W_OGLA = W_INB + (size_t)NB_COLS * DM * 2, W_OATT = W_OGLA + 2 * MiB, W_OUT = W_OATT + 2 * MiB,
                 W_PG = W_OUT + 2 * MiB, W_FIN = W_PG + 2 * MiB, W_FOUT = W_FIN + (size_t)2 * FFH * DM * 2, W_PP = W_FOUT + (size_t)FFH * DM * 2, W_END = W_PP + (size_t)DM * PLE * 2;
constexpr size_t WS_CTL = 0, WS_W = 16384, WS_R = (WS_W + W_END + 4095) / 4096 * 4096;
constexpr size_t R_Q = 0, R_K = 64 * MiB, R_V = 80 * MiB, R_GA = 96 * MiB, R_GB = 160 * MiB, R_BYTES = 224 * MiB;
constexpr size_t R_GQ = 0, R_GK = 32 * MiB, R_GV = 64 * MiB, R_RA = 128 * MiB;
constexpr size_t WS_HB = WS_R + R_BYTES,   WS_GG_UNUSED = 0, WS_OF = WS_HB + 64 * MiB, WS_OB = WS_OF + 64 * MiB, WS_XA = WS_OB + 64 * MiB, WS_PB = WS_XA + 64 * MiB, WS_END = WS_PB + 16 * MiB;
constexpr int NPH_LAYER = 13, NPHASES = 1 + NPH_LAYER * DEPTH;
constexpr int LDS_BYTES = 131072 + 1024 + 8192;
namespace pg8 {
#define PG8_LAS __attribute__((address_space(3)))
typedef unsigned short bf16_t;
typedef short bf16x8 __attribute__((ext_vector_type(8)));
typedef float f32x4 __attribute__((ext_vector_type(4)));
typedef unsigned u32x4 __attribute__((ext_vector_type(4)));
constexpr int BM = 256, BK = 64, HALF = 128, HTB = HALF * BK * 2  , STAGE_BYTES = 8 * HTB, NXCD = 8, WGM = 8;

__host__ __device__ __forceinline__ int lds_byte(int r, int c) { const int st = (r >> 4) * 2 + (c >> 5), rr = r & 15, cc = c & 31, ob = rr * 64 + cc * 2; return st * 1024 + (ob ^ (((ob >> 9) & 1) << 5)); }
__host__ __device__ __forceinline__ void stage_rc(int b, int& R, int& C) { const int st = b / 1024, sb = b % 1024, swz = sb ^ (((sb >> 9) & 1) << 5); R = (st >> 1) * 16 + swz / 64; C = (st & 1) * 32 + (swz % 64) / 2; }
__host__ __device__ __forceinline__ int perm32(int rho) { const int n = rho >> 4, i = rho & 15; return 8 * (i >> 2) + 4 * n + (i & 3); }

struct Unit { int pm, pn; };
struct Gemm { const bf16_t* A; const bf16_t* Bt; int M, N, K; };

struct StaticOrder {
    int nM, nN, nwg, G, c;
    __host__ __device__ void init(int M, int N, int G_, int c_) { nM = M / BM; nN = N / BM; nwg = nM * nN; G = G_; c = c_; }
    __host__ __device__ bool next(int i, Unit& u) const {
        const long L = (long)i * G + c; if (L >= nwg) return false;
        int wgid = (int)L; { const int q = nwg / NXCD, r = nwg % NXCD, xcd = wgid % NXCD, off = wgid / NXCD; wgid = (xcd < r ? xcd * (q + 1) : r * (q + 1) + (xcd - r) * q) + off; }
        const int nig = WGM * nN, gid = wgid / nig, fm = gid * WGM, gsz = (nM - fm) < WGM ? (nM - fm) : WGM;
        u.pm = fm + ((wgid % nig) % gsz); u.pn = (wgid % nig) / gsz; return true;
    }
    __device__ __forceinline__ void a_ready(const Unit&) const {}
    __device__ __forceinline__ void done(const Unit&) const {}
};
typedef __bf16 bf16x2_t __attribute__((ext_vector_type(2)));
typedef float f32x2_t __attribute__((ext_vector_type(2)));
__device__ __forceinline__ unsigned cvt_pk_bf16(float lo, float hi) { const f32x2_t f = {lo, hi}; const bf16x2_t v = __builtin_convertvector(f, bf16x2_t); return __builtin_bit_cast(unsigned, v); }
__device__ __forceinline__ float bf_lo(unsigned w) { return __builtin_bit_cast(float, w << 16); }
__device__ __forceinline__ float bf_hi(unsigned w) { return __builtin_bit_cast(float, w & 0xffff0000u); }
__device__ __forceinline__ float sigmoidf_(float x) { return __builtin_amdgcn_rcpf(1.0f + __expf(-x)); }
enum { EM_ROUTE_A = 0, EM_ROUTE_B = 1, EM_GATE1 = 2, EM_GATE2 = 3, EM_PLAIN = 4, EM_SWIGLU = 5, EM_PLE2 = 6 };
struct Epi {
    static constexpr bool PERM = true, AFTER_DRAIN = false;
    int mode; unsigned char* rbase; unsigned char* ggbase; bf16_t* out; const bf16_t* aux; unsigned* dbgmark; const float* gqn; const float* gkn; PG8_LAS float* xlds;
    __device__ __forceinline__ void operator()(const f32x4 (&acc)[2][2][4][2], const Unit& u, int wr, int wc, int fr, int fq) const {
        const int row0 = u.pm * BM + wr * 64 + fr, lc0 = wc * 32 + 8 * fq;
#if MK_DEBUG
#endif
        if (mode == EM_SWIGLU) {
#pragma unroll
            for (int ai = 0; ai < 2; ++ai)
#pragma unroll
                for (int m = 0; m < 4; ++m) { const size_t row = (size_t)(row0 + ai * HALF + m * 16);
                    float o[8];
#pragma unroll
                    for (int n = 0; n < 2; ++n)
#pragma unroll
                        for (int j = 0; j < 4; ++j) { const float g = acc[ai][0][m][n][j], up = acc[ai][1][m][n][j]; o[4 * n + j] = g * sigmoidf_(g) * up; }
                    u32x4 w; w.x = cvt_pk_bf16(o[0], o[1]); w.y = cvt_pk_bf16(o[2], o[3]); w.z = cvt_pk_bf16(o[4], o[5]); w.w = cvt_pk_bf16(o[6], o[7]);
                    *(u32x4*)(out + row * 2816 + u.pn * 128 + lc0) = w; }
            return;
        }
        if (mode == EM_ROUTE_B && u.pn <= 4) {
            const bool isk = u.pn == 4; const float* g = isk ? gkn : gqn;
            bf16_t* qb = (bf16_t*)(rbase + (isk ? R_K : R_Q)); const int ldq = isk ? 256 : 1024, ctq = isk ? 0 : u.pn * 256;
            const int axis = wc >> 1, jb = 16 * (wc & 1) + 4 * fq;
            const f32x4 g1 = *(const f32x4*)(g + axis * 64 + jb), g2 = *(const f32x4*)(g + axis * 64 + 32 + jb);
            float inv[4];
#pragma unroll
            for (int e = 0; e < 4; ++e) inv[e] = __builtin_amdgcn_exp2f(-(float)(jb + e) * (13.287712379549449f / 32.0f)) * 0.15915494309189535f;
            const int rit = wr * 64 + fr;
#pragma unroll
            for (int ai = 0; ai < 2; ++ai)
#pragma unroll
                for (int m = 0; m < 4; ++m)
#pragma unroll
                    for (int bj = 0; bj < 2; ++bj) { const f32x4 a0 = acc[ai][bj][m][0], a1 = acc[ai][bj][m][1];
                        float ss = (a0[0] * a0[0] + a0[1] * a0[1]) + (a0[2] * a0[2] + a0[3] * a0[3]) + (a1[0] * a1[0] + a1[1] * a1[1]) + (a1[2] * a1[2] + a1[3] * a1[3]);
                        ss += __shfl_xor(ss, 16); ss += __shfl_xor(ss, 32);
                        if (fq == 0) xlds[((ai * HALF + m * 16 + rit) * 2 + bj) * 4 + wc] = ss; }
            asm volatile("s_waitcnt lgkmcnt(0)" ::: "memory"); __builtin_amdgcn_s_barrier(); asm volatile("" ::: "memory");
#pragma unroll
            for (int ai = 0; ai < 2; ++ai)
#pragma unroll
                for (int m = 0; m < 4; ++m) { const size_t row = (size_t)(row0 + ai * HALF + m * 16); const int sp = (int)row & 4095; const float pos = (float)(axis == 0 ? (sp >> 6) : (sp & 63));
                    float cs[4], sn[4];
#pragma unroll
                    for (int e = 0; e < 4; ++e) { const float rf = __builtin_amdgcn_fractf(pos * inv[e]); cs[e] = __builtin_amdgcn_cosf(rf); sn[e] = __builtin_amdgcn_sinf(rf); }
#pragma unroll
                    for (int bj = 0; bj < 2; ++bj) { const f32x4 pp = *(const PG8_LAS f32x4*)(xlds + ((ai * HALF + m * 16 + rit) * 2 + bj) * 4);
                        const float rs = rsqrtf(((pp[0] + pp[1]) + (pp[2] + pp[3])) * (1.0f / 128.0f) + 1e-6f);
                        const f32x4 x1 = acc[ai][bj][m][0] * rs * g1, x2 = acc[ai][bj][m][1] * rs * g2;
                        float o1[4], o2[4];
#pragma unroll
                        for (int e = 0; e < 4; ++e) { o1[e] = x1[e] * cs[e] - x2[e] * sn[e]; o2[e] = x2[e] * cs[e] + x1[e] * sn[e]; }
                        bf16_t* dst = qb + row * ldq + ctq + bj * HALF + axis * 64 + jb;
                        typedef unsigned u32x2e __attribute__((ext_vector_type(2)));
                        u32x2e w1, w2; w1.x = cvt_pk_bf16(o1[0], o1[1]); w1.y = cvt_pk_bf16(o1[2], o1[3]); w2.x = cvt_pk_bf16(o2[0], o2[1]); w2.y = cvt_pk_bf16(o2[2], o2[3]);
                        *(u32x2e*)dst = w1; *(u32x2e*)(dst + 32) = w2; } }
            return;
        }
        bf16_t* base = out; int ld = 1024, ct = u.pn * BM; bool is_ra = false;
        if (mode == EM_ROUTE_A) { const int pn = u.pn;
            if (pn < 2) { base = (bf16_t*)(rbase + R_GQ); ld = 512; ct = pn * 256; }
            else if (pn < 4) { base = (bf16_t*)(rbase + R_GK); ld = 512; ct = (pn - 2) * 256; }
            else if (pn < 8) { base = (bf16_t*)(rbase + R_GV); ld = 1024; ct = (pn - 4) * 256; }
            else if (pn < 12) { base = (bf16_t*)ggbase; ld = 1024; ct = (pn - 8) * 256; }
            else is_ra = true;
        } else if (mode == EM_ROUTE_B) { const int pn = u.pn;
            if (pn < 4) { base = (bf16_t*)(rbase + R_Q); ld = 1024; ct = pn * 256; }
            else if (pn == 4) { base = (bf16_t*)(rbase + R_K); ld = 256; ct = 0; }
            else if (pn == 5) { base = (bf16_t*)(rbase + R_V); ld = 256; ct = 0; }
            else if (pn < 10) { base = (bf16_t*)(rbase + R_GA); ld = 1024; ct = (pn - 6) * 256; }
            else { base = (bf16_t*)(rbase + R_GB); ld = 1024; ct = (pn - 10) * 256; }
        }
        if (is_ra) {
            if (wc == 0) { float* ra = (float*)(rbase + R_RA);
#pragma unroll
                for (int ai = 0; ai < 2; ++ai)
#pragma unroll
                    for (int m = 0; m < 4; ++m) { const size_t row = (size_t)(row0 + ai * HALF + m * 16);
                        *(f32x4*)(ra + row * 32 + 8 * fq) = acc[ai][0][m][0]; *(f32x4*)(ra + row * 32 + 8 * fq + 4) = acc[ai][0][m][1]; } }
            return;
        }
#pragma unroll
        for (int ai = 0; ai < 2; ++ai)
#pragma unroll
            for (int m = 0; m < 4; ++m) { const size_t row = (size_t)(row0 + ai * HALF + m * 16);
#pragma unroll
                for (int bj = 0; bj < 2; ++bj) { const int col = ct + bj * HALF + lc0;
                    float o[8];
#pragma unroll
                    for (int n = 0; n < 2; ++n)
#pragma unroll
                        for (int j = 0; j < 4; ++j) o[4 * n + j] = acc[ai][bj][m][n][j];
                    if (mode == EM_GATE1 || mode == EM_GATE2 || mode == EM_PLE2) {
                        const u32x4 a = *(const u32x4*)(aux + row * 1024 + col);
                        const float av[8] = {bf_lo(a.x), bf_hi(a.x), bf_lo(a.y), bf_hi(a.y), bf_lo(a.z), bf_hi(a.z), bf_lo(a.w), bf_hi(a.w)};
                        if (mode == EM_PLE2) {
#pragma unroll
                            for (int j = 0; j < 8; ++j) o[j] = sigmoidf_(o[j]) * av[j];
                        } else {
#pragma unroll
                            for (int j = 0; j < 8; ++j) o[j] = sigmoidf_(av[j]) * o[j];
                            if (mode == EM_GATE2) { const u32x4 p = *(const u32x4*)(base + row * ld + col);
                                o[0] += bf_lo(p.x); o[1] += bf_hi(p.x); o[2] += bf_lo(p.y); o[3] += bf_hi(p.y); o[4] += bf_lo(p.z); o[5] += bf_hi(p.z); o[6] += bf_lo(p.w); o[7] += bf_hi(p.w); }
                        }
                    }
                    u32x4 w; w.x = cvt_pk_bf16(o[0], o[1]); w.y = cvt_pk_bf16(o[2], o[3]); w.z = cvt_pk_bf16(o[4], o[5]); w.w = cvt_pk_bf16(o[6], o[7]);
                    *(u32x4*)(base + row * ld + col) = w;
#if MK_DEBUG
                    if (dbgmark && ai == 0 && m == 0 && bj == 0 && wr == 0 && wc == 0 && fr == 0 && fq == 0) { unsigned* mk = dbgmark + (u.pm * 32 + u.pn) * 4; const unsigned long long ad = (unsigned long long)(base + row * ld + col);
                        mk[0] = (unsigned)ad; mk[1] = (unsigned)(ad >> 32); mk[2] = w.x; mk[3] = 1u; }
#endif
                    } }
    }
};
template <class Epi, class Sched, bool ALIGN_EPI = false, bool SP2 = false>
__device__ __forceinline__ void gemm_phase(PG8_LAS unsigned char* lds, const Gemm g, const Sched& S, const Epi& E) {
    const int tid = opaque_tid(), wid = __builtin_amdgcn_readfirstlane(tid >> 6), lane = tid & 63, wr = wid >> 2, wc = wid & 3, fr = lane & 15, fq = lane >> 4;
    const int K = g.K, nt = K / BK;
    unsigned voffA[2], voffB[2];
#pragma unroll
    for (int i = 0; i < 2; ++i) { int R, C; stage_rc(tid * 16 + i * 8192, R, C); const int Rb = Epi::PERM ? ((R & ~31) + perm32(R & 31)) : R;
        voffA[i] = (unsigned)(R * K + C) * 2u; voffB[i] = (unsigned)(Rb * K + C) * 2u; }
    const size_t kstep = (size_t)(BK * 2);
    const size_t hstep = (size_t)HALF * K * 2;
    const size_t tstep = 2 * hstep;
    const unsigned ldsw = (unsigned)wid * 1024u;
    const int aoff = lds_byte(wr * 64 + fr, fq * 8), boff = lds_byte(wc * 32 + fr, fq * 8);
#define PG8_SA(b, h) (((b) * 2 + (h)) * HTB)
#define PG8_SB(b, h) ((4 + (b) * 2 + (h)) * HTB)
#define PG8_STAGE(bufoff, gbase, voff) do { _Pragma("unroll") for (int _i = 0; _i < 2; ++_i) \
        __builtin_amdgcn_global_load_lds((const unsigned*)((const char*)(gbase) + (voff)[_i]), (PG8_LAS unsigned*)(lds + (bufoff) + ldsw + _i * 8192), 16, 0, 0); } while (0)
#define PG8_LDA(dst, b, h) do { _Pragma("unroll") for (int m = 0; m < 4; ++m) _Pragma("unroll") for (int k = 0; k < 2; ++k) dst[m][k] = *(const PG8_LAS bf16x8*)(lds + PG8_SA(b, h) + aoff + m * 2048 + k * 1024); } while (0)
#define PG8_LDB(dst, b, h) do { _Pragma("unroll") for (int n = 0; n < 2; ++n) _Pragma("unroll") for (int k = 0; k < 2; ++k) dst[n][k] = *(const PG8_LAS bf16x8*)(lds + PG8_SB(b, h) + boff + n * 2048 + k * 1024); } while (0)
#define PG8_MMA(ai, bj, At, Bt) do { __builtin_amdgcn_s_setprio(1); _Pragma("unroll") for (int m = 0; m < 4; ++m) _Pragma("unroll") for (int n = 0; n < 2; ++n) _Pragma("unroll") for (int k = 0; k < 2; ++k) \
        acc[ai][bj][m][n] = __builtin_amdgcn_mfma_f32_16x16x32_bf16(Bt[n][k], At[m][k], acc[ai][bj][m][n], 0, 0, 0); __builtin_amdgcn_s_setprio(0); } while (0)
#define PG8_WAIT_V(n) asm volatile("s_waitcnt vmcnt(" #n ")" ::: "memory")
#define PG8_WAIT_L(n) asm volatile("s_waitcnt lgkmcnt(" #n ")" ::: "memory")
#define PG8_BAR __builtin_amdgcn_s_barrier()
#define PG8_SCHED __builtin_amdgcn_sched_barrier(0)
    Unit cur, nxt; int ui = 0;
    if (!S.next(0, cur)) return;
    f32x4 acc[2][2][4][2];
#pragma unroll
    for (int a = 0; a < 2; ++a)
#pragma unroll
        for (int b = 0; b < 2; ++b)
#pragma unroll
            for (int m = 0; m < 4; ++m)
#pragma unroll
                for (int n = 0; n < 2; ++n) acc[a][b][m][n] = (f32x4){0.f, 0.f, 0.f, 0.f};
    bf16x8 At[4][2], B0[2][2], B1[2][2];
    const char* cA = (const char*)g.A + (size_t)cur.pm * tstep; const char* cB = (const char*)g.Bt + (size_t)cur.pn * tstep;
    S.a_ready(cur);
    if constexpr (SP2) {
        PG8_STAGE(PG8_SB(0, 0), cB, voffB); PG8_STAGE(PG8_SB(0, 1), cB + hstep, voffB); PG8_STAGE(PG8_SA(0, 0), cA, voffA); PG8_STAGE(PG8_SA(0, 1), cA + hstep, voffA);
        if (wr == 1) PG8_BAR;
        PG8_WAIT_V(2); PG8_BAR;
        PG8_STAGE(PG8_SB(1, 0), cB + kstep, voffB); PG8_STAGE(PG8_SA(1, 0), cA + kstep, voffA); PG8_STAGE(PG8_SB(1, 1), cB + hstep + kstep, voffB);
        PG8_WAIT_V(6); PG8_BAR;
    } else {
        PG8_STAGE(PG8_SB(0, 0), cB, voffB); PG8_STAGE(PG8_SA(0, 0), cA, voffA); PG8_STAGE(PG8_SB(0, 1), cB + hstep, voffB); PG8_STAGE(PG8_SA(0, 1), cA + hstep, voffA);
        if (wr == 1) PG8_BAR;
        PG8_WAIT_V(4); PG8_BAR;
        PG8_STAGE(PG8_SB(1, 0), cB + kstep, voffB); PG8_STAGE(PG8_SA(1, 0), cA + kstep, voffA); PG8_STAGE(PG8_SB(1, 1), cB + hstep + kstep, voffB);
        PG8_WAIT_V(6); PG8_BAR;
    }
    for (;;) {
        const bool has_next = S.next(ui + 1, nxt);
        const char* nA = has_next ? (const char*)g.A + (size_t)nxt.pm * tstep : cA; const char* nB = has_next ? (const char*)g.Bt + (size_t)nxt.pn * tstep : cB;
        for (int t = 0; t < nt; t += 2) {
            const bool last = (t == nt - 2);
            const char* a1 = cA + (size_t)(t + 1) * kstep;
            const char* a2 = last ? nA : cA + (size_t)(t + 2) * kstep; const char* b2 = last ? nB : cB + (size_t)(t + 2) * kstep;
            const char* a3 = a2 + kstep; const char* b3 = b2 + kstep;
            if (last && has_next) S.a_ready(nxt);
            if constexpr (SP2) {
            PG8_LDB(B0, 0, 0); PG8_LDB(B1, 0, 1); PG8_SCHED; PG8_LDA(At, 0, 0); PG8_STAGE(PG8_SA(1, 1), a1 + hstep, voffA);
            PG8_WAIT_V(8); PG8_WAIT_L(0); PG8_BAR; PG8_MMA(0, 0, At, B0); PG8_MMA(0, 1, At, B1); PG8_BAR; PG8_SCHED;
            PG8_LDA(At, 0, 1); PG8_STAGE(PG8_SB(0, 0), b2, voffB); PG8_STAGE(PG8_SB(0, 1), b2 + hstep, voffB); PG8_STAGE(PG8_SA(0, 0), a2, voffA);
            PG8_WAIT_V(8); PG8_WAIT_L(0); PG8_BAR; PG8_MMA(1, 0, At, B0); PG8_MMA(1, 1, At, B1); PG8_BAR; PG8_SCHED;
            PG8_LDB(B0, 1, 0); PG8_LDB(B1, 1, 1); PG8_SCHED; PG8_LDA(At, 1, 0); PG8_STAGE(PG8_SA(0, 1), a2 + hstep, voffA);
            PG8_WAIT_V(8); PG8_WAIT_L(0); PG8_BAR; PG8_MMA(0, 0, At, B0); PG8_MMA(0, 1, At, B1); PG8_BAR; PG8_SCHED;
            PG8_LDA(At, 1, 1); PG8_STAGE(PG8_SB(1, 0), b3, voffB); PG8_STAGE(PG8_SB(1, 1), b3 + hstep, voffB); PG8_STAGE(PG8_SA(1, 0), a3, voffA);
            PG8_WAIT_V(8); PG8_WAIT_L(0); PG8_BAR; PG8_MMA(1, 0, At, B0); PG8_MMA(1, 1, At, B1); PG8_BAR; PG8_SCHED;
            } else {
            PG8_LDB(B0, 0, 0); PG8_SCHED; PG8_LDA(At, 0, 0); PG8_STAGE(PG8_SA(1, 1), a1 + hstep, voffA);
            PG8_WAIT_L(8); PG8_BAR; PG8_WAIT_L(0); PG8_MMA(0, 0, At, B0); PG8_BAR; PG8_SCHED;
            PG8_LDB(B1, 0, 1); PG8_STAGE(PG8_SB(0, 0), b2, voffB);
            PG8_BAR; PG8_WAIT_L(0); PG8_MMA(0, 1, At, B1); PG8_BAR;
            PG8_LDA(At, 0, 1); PG8_STAGE(PG8_SA(0, 0), a2, voffA);
            PG8_BAR; PG8_WAIT_L(0); PG8_MMA(1, 0, At, B0); PG8_BAR; PG8_SCHED;
            PG8_STAGE(PG8_SB(0, 1), b2 + hstep, voffB);
            PG8_WAIT_V(6); PG8_BAR; PG8_MMA(1, 1, At, B1); PG8_BAR;
            PG8_LDB(B0, 1, 0); PG8_SCHED; PG8_LDA(At, 1, 0); PG8_STAGE(PG8_SA(0, 1), a2 + hstep, voffA);
            PG8_WAIT_L(8); PG8_BAR; PG8_WAIT_L(0); PG8_MMA(0, 0, At, B0); PG8_BAR; PG8_SCHED;
            PG8_LDB(B1, 1, 1); PG8_STAGE(PG8_SB(1, 0), b3, voffB);
            PG8_BAR; PG8_WAIT_L(0); PG8_MMA(0, 1, At, B1); PG8_BAR;
            PG8_LDA(At, 1, 1); PG8_STAGE(PG8_SA(1, 0), a3, voffA);
            PG8_BAR; PG8_WAIT_L(0); PG8_MMA(1, 0, At, B0); PG8_BAR; PG8_SCHED;
            PG8_STAGE(PG8_SB(1, 1), b3 + hstep, voffB);
            PG8_WAIT_V(6); PG8_BAR; PG8_MMA(1, 1, At, B1); PG8_BAR;
            }
        }
        if constexpr (ALIGN_EPI) { if (wr == 0) PG8_BAR; }
        if constexpr (!Epi::AFTER_DRAIN) { E(acc, cur, wr, wc, fr, fq); S.done(cur); }
        if (!has_next) break;
#pragma unroll
        for (int a = 0; a < 2; ++a)
#pragma unroll
            for (int b = 0; b < 2; ++b)
#pragma unroll
                for (int m = 0; m < 4; ++m)
#pragma unroll
                    for (int n = 0; n < 2; ++n) acc[a][b][m][n] = (f32x4){0.f, 0.f, 0.f, 0.f};
        cur = nxt; cA = nA; cB = nB; ++ui;
        if constexpr (ALIGN_EPI) { if (wr == 1) PG8_BAR; }
    }
    PG8_WAIT_V(0);
    if constexpr (!ALIGN_EPI) { if (wr == 0) PG8_BAR; }
    PG8_BAR;
    if constexpr (Epi::AFTER_DRAIN) { E.fused(acc, cur, wr, wc, fr, fq, lds, wid, lane); S.done(cur); }
#undef PG8_SA
#undef PG8_SB
#undef PG8_STAGE
#undef PG8_LDA
#undef PG8_LDB
#undef PG8_MMA
#undef PG8_WAIT_V
#undef PG8_WAIT_L
#undef PG8_BAR
#undef PG8_SCHED
}
}
namespace attn {
using bf16 = __hip_bfloat16;
constexpr int   D = 128, NW = 8, QBLK = 32, KVBLK = 64;
constexpr float SCALE = 0.088388347648318440f;
constexpr float THR = 8.f;
constexpr int SDEPTH = 2;
constexpr int LDQ = 1024, LDK = 256, LDO = 1024;
constexpr size_t SHM_V = KVBLK * D * 2, SHM_K = KVBLK * D * 2, SHM_ATTN = 2 * SHM_V + 2 * SHM_K + NW * 64 * 4;
using bf16x8 = __attribute__((ext_vector_type(8))) short;
using s16x4  = __attribute__((ext_vector_type(4))) short;
using f32x16 = __attribute__((ext_vector_type(16))) float;
using f32x8  = __attribute__((ext_vector_type(8))) float;
using u32x4  = __attribute__((ext_vector_type(4))) unsigned;
#define KSWZ(row, colB) ((row) * 256 + ((colB) ^ (((row) & 7) << 4)))
#define SBAR() __builtin_amdgcn_sched_barrier(0)
__device__ __forceinline__ int crow(int r, int hi) { return (r & 3) + 8 * (r >> 2) + 4 * hi; }
__device__ __forceinline__ unsigned cvtpk(float lo, float hi) {
  unsigned r; asm volatile("v_cvt_pk_bf16_f32 %0, %1, %2" : "=v"(r) : "v"(lo), "v"(hi)); return r;
}
template <typename TIn> struct Stage;
template <> struct Stage<bf16>  { using T = bf16x8;
  __device__ static __forceinline__ T ld8(const bf16* p) { return *reinterpret_cast<const bf16x8*>(p); }
  __device__ static __forceinline__ bf16x8 tobf(T x) { return x; } };
template <> struct Stage<float> { using T = f32x8;
  __device__ static __forceinline__ T ld8(const float* p) { return *reinterpret_cast<const f32x8*>(p); }
  __device__ static __forceinline__ bf16x8 tobf(T x) {
    u32x4 w = {cvtpk(x[0], x[1]), cvtpk(x[2], x[3]), cvtpk(x[4], x[5]), cvtpk(x[6], x[7])}; return *reinterpret_cast<bf16x8*>(&w); } };

__device__ __forceinline__ void partialSM(f32x16& p0, f32x16& p1, float& m_reg, float& mn, float& alpha) {
  constexpr float C = SCALE * 1.4426950408889634f;
  float pmax = p0[0]; for (int r = 1; r < 16; ++r) pmax = fmaxf(pmax, p0[r]); for (int r = 0; r < 16; ++r) pmax = fmaxf(pmax, p1[r]);
  { auto rr = __builtin_amdgcn_permlane32_swap(__float_as_uint(pmax), __float_as_uint(pmax), false, false);
    pmax = fmaxf(__uint_as_float(rr[0]), __uint_as_float(rr[1])); }
  if (__builtin_expect(__all(pmax - m_reg <= THR / SCALE), 1)) { mn = m_reg; alpha = 1.f; }
  else { mn = fmaxf(m_reg, pmax); alpha = __builtin_amdgcn_exp2f((m_reg - mn) * C); m_reg = mn; }
  float mnC = -mn * C;
  for (int r = 0; r < 16; ++r) p0[r] = fmaf(p0[r], C, mnC); for (int r = 0; r < 16; ++r) p1[r] = fmaf(p1[r], C, mnC);
  for (int r = 0; r < 16; ++r) p0[r] = __builtin_amdgcn_exp2f(p0[r]);
}
__device__ __forceinline__ void finishSM(f32x16& p0, f32x16& p1, float alpha, float& l_reg, bf16x8& pa0, bf16x8& pa1, bf16x8& pa2, bf16x8& pa3) {
  for (int r = 0; r < 16; ++r) p1[r] = __builtin_amdgcn_exp2f(p1[r]);
  float ps = 0; for (int r = 0; r < 16; ++r) ps += p0[r]; for (int r = 0; r < 16; ++r) ps += p1[r];
  { auto rr = __builtin_amdgcn_permlane32_swap(__float_as_uint(ps), __float_as_uint(ps), false, false);
    ps = __uint_as_float(rr[0]) + __uint_as_float(rr[1]); }
  l_reg = l_reg * alpha + ps;
#define PK4(P, BASE, OUT) do { unsigned a0 = cvtpk(P[BASE + 0], P[BASE + 1]), a1 = cvtpk(P[BASE + 2], P[BASE + 3]);   \
    unsigned b0 = cvtpk(P[BASE + 4], P[BASE + 5]), b1 = cvtpk(P[BASE + 6], P[BASE + 7]);                              \
    auto r0 = __builtin_amdgcn_permlane32_swap(a0, b0, false, false); auto r1 = __builtin_amdgcn_permlane32_swap(a1, b1, false, false); \
    u32x4 w = {r0[0], r1[0], r0[1], r1[1]}; OUT = *reinterpret_cast<bf16x8*>(&w); } while (0)
  PK4(p0, 0, pa0); PK4(p0, 8, pa1); PK4(p1, 0, pa2); PK4(p1, 8, pa3);
#undef PK4
}
__device__ __forceinline__ void qkt(f32x16& p0, f32x16& p1, const bf16* Ks, const bf16x8* qr, int r32, int hi) {
  p0 = f32x16{}; p1 = f32x16{};
  for (int d0 = 0; d0 < 8; ++d0) { int cb = (d0 * 16 + hi * 8) * 2;
    bf16x8 b0 = *reinterpret_cast<const bf16x8*>((const char*)Ks + KSWZ(r32, cb));
    bf16x8 b1 = *reinterpret_cast<const bf16x8*>((const char*)Ks + KSWZ(32 + r32, cb));
    p0 = __builtin_amdgcn_mfma_f32_32x32x16_bf16(b0, qr[d0], p0, 0, 0, 0);
    p1 = __builtin_amdgcn_mfma_f32_32x32x16_bf16(b1, qr[d0], p1, 0, 0, 0); }
}
__device__ __forceinline__ int v_st(int k, int c) { const int kk = (k & ~0xC) | ((k & 4) << 1) | ((k & 8) >> 1); return ((kk >> 3) * 4 + (c >> 5)) * 512 + ((kk & 7) * 32 + (c & 31)) * 2; }
__device__ __forceinline__ int v_rd_base(int lane) { return ((lane & 3) << 3) | (((lane >> 2) & 3) << 6) | (((lane >> 4) & 1) << 5) | (((lane >> 5) & 1) << 8); }
constexpr int v_rd_off(int d0, int ks, int half) { return d0 * 512 + ks * 4096 + half * 2048; }
template <int OFF> __device__ __forceinline__ s16x4 tr_read(int vb) {
  s16x4 r; asm volatile("ds_read_b64_tr_b16 %0, %1 offset:%2" : "=&v"(r) : "v"(vb), "i"(OFF) : "memory"); return r;
}
template <int D0> __device__ __forceinline__ void pv_one(f32x16& od, int vb, bf16x8 pa0, bf16x8 pa1, bf16x8 pa2, bf16x8 pa3) {
  const s16x4 l0 = tr_read<v_rd_off(D0, 0, 0)>(vb), h0 = tr_read<v_rd_off(D0, 0, 1)>(vb), l1 = tr_read<v_rd_off(D0, 1, 0)>(vb), h1 = tr_read<v_rd_off(D0, 1, 1)>(vb);
  const s16x4 l2 = tr_read<v_rd_off(D0, 2, 0)>(vb), h2 = tr_read<v_rd_off(D0, 2, 1)>(vb), l3 = tr_read<v_rd_off(D0, 3, 0)>(vb), h3 = tr_read<v_rd_off(D0, 3, 1)>(vb);
  asm volatile("s_waitcnt lgkmcnt(0)" ::: "memory"); SBAR();
#define PK(L, H) (bf16x8){L[0], L[1], L[2], L[3], H[0], H[1], H[2], H[3]}
  od = __builtin_amdgcn_mfma_f32_32x32x16_bf16(pa0, PK(l0, h0), od, 0, 0, 0);
  od = __builtin_amdgcn_mfma_f32_32x32x16_bf16(pa1, PK(l1, h1), od, 0, 0, 0);
  od = __builtin_amdgcn_mfma_f32_32x32x16_bf16(pa2, PK(l2, h2), od, 0, 0, 0);
  od = __builtin_amdgcn_mfma_f32_32x32x16_bf16(pa3, PK(l3, h3), od, 0, 0, 0);
#undef PK
}
__device__ __forceinline__ void pv_d0(f32x16* o, int vb, bf16x8 pa0, bf16x8 pa1, bf16x8 pa2, bf16x8 pa3) {
  pv_one<0>(o[0], vb, pa0, pa1, pa2, pa3); pv_one<1>(o[1], vb, pa0, pa1, pa2, pa3); pv_one<2>(o[2], vb, pa0, pa1, pa2, pa3); pv_one<3>(o[3], vb, pa0, pa1, pa2, pa3);
}

template <typename TQ>
__device__ __forceinline__ void attn_dense_body(const TQ* Qb, const bf16* Kh, const bf16* Vh,
                                                unsigned short* Ob, int seq, char* lds) {
  using St = Stage<bf16>; using SQ = Stage<TQ>;
  const int tid = opaque_tid(), wid = tid >> 6, lane = tid & 63, r32 = lane & 31, hi = lane >> 5;
  bf16* V_lds = (bf16*)lds; bf16* K_lds = (bf16*)(lds + 2 * SHM_V);
  float* ws = (float*)(lds + 2 * SHM_V + 2 * SHM_K) + wid * 64; float* li_l = ws; float* al_l = ws + 32;
  float m_reg = -1e30f, l_reg = 0; f32x16 o[4] = {}; bf16x8 qr[8];
  const TQ* Qw = Qb + (long)(wid * QBLK + r32) * LDQ + hi * 8;
#pragma unroll
  for (int d0 = 0; d0 < 8; ++d0) qr[d0] = SQ::tobf(SQ::ld8(Qw + d0 * 16));
  const int sr = tid >> 4, sc = (tid & 15) * 8, vst0 = v_st(sr, sc), vst1 = v_st(32 + sr, sc);
  const int vb0 = (int)(uintptr_t)V_lds + v_rd_base(lane);
  struct { typename St::T vs0, vs1, ks0, ks1; } sr_[SDEPTH];
#define SLOAD(i, k0) do { sr_[i].vs0 = St::ld8(&Vh[(long)((k0) + sr) * LDK + sc]); sr_[i].vs1 = St::ld8(&Vh[(long)((k0) + 32 + sr) * LDK + sc]); \
    sr_[i].ks0 = St::ld8(&Kh[(long)((k0) + sr) * LDK + sc]); sr_[i].ks1 = St::ld8(&Kh[(long)((k0) + 32 + sr) * LDK + sc]); } while (0)
#define SWRITE(b, i) do { *(bf16x8*)((char*)V_lds + (b) * SHM_V + vst0) = St::tobf(sr_[i].vs0);          \
    *(bf16x8*)((char*)V_lds + (b) * SHM_V + vst1) = St::tobf(sr_[i].vs1); int kc = sc * 2;               \
    *(bf16x8*)((char*)K_lds + (b) * SHM_K + KSWZ(sr, kc)) = St::tobf(sr_[i].ks0);                       \
    *(bf16x8*)((char*)K_lds + (b) * SHM_K + KSWZ(32 + sr, kc)) = St::tobf(sr_[i].ks1); } while (0)
#define SWAIT() do { if constexpr (SDEPTH == 2) asm volatile("s_waitcnt vmcnt(4)" ::: "memory"); else asm volatile("s_waitcnt vmcnt(0)" ::: "memory"); } while (0)
#define RESC(a) do { if (__any((a) < 1.f)) { if (hi == 0) al_l[r32] = (a); asm volatile("s_waitcnt lgkmcnt(0)" ::: "memory"); \
    for (int d = 0; d < 4; ++d) for (int r = 0; r < 16; ++r) o[d][r] *= al_l[crow(r, hi)]; } } while (0)
  f32x16 pA0, pA1, pB0, pB1; float mnA, mnB, alA, alB; bf16x8 pa0, pa1, pa2, pa3; const int NT = seq / KVBLK;
  constexpr int SE = 0, SO = SDEPTH - 1;
  SLOAD(SE, 0); asm volatile("s_waitcnt vmcnt(0)" ::: "memory"); SWRITE(0, SE); __syncthreads();
  qkt(pA0, pA1, K_lds, qr, r32, hi); partialSM(pA0, pA1, m_reg, mnA, alA);
  SLOAD(SO, KVBLK); if constexpr (SDEPTH == 2) { if (2 < NT) SLOAD(SE, 2 * KVBLK); }
  SWAIT(); SWRITE(1, SO); __syncthreads();
  for (int j = 1; j + 1 < NT; j += 2) {
    SBAR(); qkt(pB0, pB1, (bf16*)((char*)K_lds + SHM_K), qr, r32, hi);
    finishSM(pA0, pA1, alA, l_reg, pa0, pa1, pa2, pa3); SBAR();
    SLOAD(SO, (j + SDEPTH) * KVBLK); SBAR();
    pv_d0(o, vb0, pa0, pa1, pa2, pa3); partialSM(pB0, pB1, m_reg, mnB, alB);
    __syncthreads(); SWAIT(); SWRITE(0, SE);
    RESC(alB); __syncthreads();
    SBAR(); qkt(pA0, pA1, K_lds, qr, r32, hi);
    finishSM(pB0, pB1, alB, l_reg, pa0, pa1, pa2, pa3); SBAR();
    if (SDEPTH == 1 || j + 3 < NT) SLOAD(SE, (j + 1 + SDEPTH) * KVBLK); SBAR();
    pv_d0(o, vb0 + (int)SHM_V, pa0, pa1, pa2, pa3); partialSM(pA0, pA1, m_reg, mnA, alA);
    __syncthreads(); SWAIT(); SWRITE(1, SO);
    RESC(alA); __syncthreads();
  }
  SBAR(); qkt(pB0, pB1, (bf16*)((char*)K_lds + SHM_K), qr, r32, hi);
  finishSM(pA0, pA1, alA, l_reg, pa0, pa1, pa2, pa3); SBAR();
  pv_d0(o, vb0, pa0, pa1, pa2, pa3); partialSM(pB0, pB1, m_reg, mnB, alB);
  __syncthreads(); RESC(alB);
  finishSM(pB0, pB1, alB, l_reg, pa0, pa1, pa2, pa3); SBAR();
  pv_d0(o, vb0 + (int)SHM_V, pa0, pa1, pa2, pa3);
  if (hi == 0) li_l[r32] = l_reg; asm volatile("s_waitcnt lgkmcnt(0)" ::: "memory");
  float rli[16];
#pragma unroll
  for (int r = 0; r < 16; ++r) rli[r] = __builtin_amdgcn_rcpf(li_l[crow(r, hi)]);
  unsigned short* Ow = Ob + (long)(wid * QBLK) * LDO;
#pragma unroll
  for (int r = 0; r < 16; ++r) { int orow = crow(r, hi);
    for (int d0 = 0; d0 < 4; ++d0) Ow[(long)orow * LDO + d0 * 32 + r32] = (unsigned short)(cvtpk(o[d0][r] * rli[r], 0.f) & 0xffffu); }
#undef SLOAD
#undef SWRITE
#undef SWAIT
#undef RESC
}
}
#define XB_TMO      128
#define XB_XCNT(j)  (256  + 64 * (j))
#define XB_XSUB(j)  (1280 + 64 * (j))
#define XB_XGEN(j)  (2304 + 64 * (j))
#define XB_TOP      3328
#define XB_TOPGEN   3392
#define XCD_BAR_WORDS 3456
#define XB_SPIN_CAP (1u << 18)

__device__ __forceinline__ unsigned xb_ld(unsigned* p)              { return __hip_atomic_load(p, __ATOMIC_RELAXED, __HIP_MEMORY_SCOPE_AGENT); }
__device__ __forceinline__ unsigned xb_add(unsigned* p, unsigned v) { return __hip_atomic_fetch_add(p, v, __ATOMIC_RELAXED, __HIP_MEMORY_SCOPE_AGENT); }
__device__ __forceinline__ unsigned xb_xcc_id() { return (unsigned)__builtin_amdgcn_s_getreg((3 << 11) | 20) & 0xFu; }
#define XB_SPIN(cond, bar) do { unsigned _sp = 0; while (cond) { __builtin_amdgcn_s_sleep(1); \
    if ((++_sp & 255u) == 0u) { if (xb_ld(&(bar)[XB_TMO])) break; if (_sp > XB_SPIN_CAP) { atomicAdd(&(bar)[XB_TMO], 1u); break; } } } } while (0)

struct XcdBarrier {
    unsigned* bar; unsigned x;
    volatile LAS unsigned* st;
};

__device__ __forceinline__ XcdBarrier xcd_barrier_post(unsigned* bar, volatile LAS unsigned* st) {
    XcdBarrier b; b.bar = bar; b.x = xb_xcc_id(); b.st = st;
    if (threadIdx.x == 0) (void)xb_add(&bar[XB_XCNT(b.x)], 1u);
    return b;
}
__device__ __forceinline__ void xcd_barrier_complete(unsigned* bar, unsigned x, unsigned& nloc, unsigned& nx) {
    const unsigned G = gridDim.x * gridDim.y * gridDim.z;
    unsigned sum, cnt, mine, sp = 0u;
    for (;;) {
        sum = 0u; cnt = 0u; mine = 0u;
#pragma unroll
        for (unsigned j = 0; j < 16; ++j) { const unsigned c = xb_ld(&bar[XB_XCNT(j)]); sum += c; cnt += (c > 0u) ? 1u : 0u; mine = (j == x) ? c : mine; }
        if (sum == G) break;
        __builtin_amdgcn_s_sleep(1);
        if ((++sp & 255u) == 0u) { if (xb_ld(&bar[XB_TMO])) break; if (sp > XB_SPIN_CAP) { atomicAdd(&bar[XB_TMO], 1u); break; } }
    }
    nloc = mine > 0u ? mine : 1u; nx = cnt > 0u ? cnt : 1u;
}

__device__ __forceinline__ void xcd_barrier(const XcdBarrier& b) {
    asm volatile("s_waitcnt vmcnt(0)" ::: "memory");
    __syncthreads();
    if (threadIdx.x == 0) {
        unsigned* bar = b.bar;
        __builtin_amdgcn_s_waitcnt(0);
        unsigned nloc = b.st[0], nx = b.st[1];
        if (nloc == 0u) { xcd_barrier_complete(bar, b.x, nloc, nx); b.st[0] = nloc; b.st[1] = nx; }
        const unsigned old = xb_add(&bar[XB_XSUB(b.x)], 1u);
        const unsigned gen = old / nloc;
        if (old + 1u == (gen + 1u) * nloc) {
            __builtin_amdgcn_fence(__ATOMIC_RELEASE, "agent");
            asm volatile("s_waitcnt vmcnt(0)" ::: "memory");
            const unsigned og = xb_add(&bar[XB_TOP], 1u);
            const unsigned tg = og / nx;
            if (og + 1u == (tg + 1u) * nx) xb_add(&bar[XB_TOPGEN], 1u);
            else XB_SPIN(xb_ld(&bar[XB_TOPGEN]) == tg, bar);
            __builtin_amdgcn_fence(__ATOMIC_ACQUIRE, "agent");
            xb_add(&bar[XB_XGEN(b.x)], 1u);
            asm volatile("s_waitcnt vmcnt(0)" ::: "memory");
        } else {
            XB_SPIN(xb_ld(&bar[XB_XGEN(b.x)]) == gen, bar);
            __builtin_amdgcn_fence(__ATOMIC_ACQUIRE, "agent");
            asm volatile("s_waitcnt vmcnt(0)" ::: "memory");
        }
    }
    __syncthreads();
}
#define LAS __attribute__((address_space(3)))
typedef unsigned short bf16_t;
typedef float f32x4 __attribute__((ext_vector_type(4)));
typedef float f32x2 __attribute__((ext_vector_type(2)));
typedef unsigned u32x4 __attribute__((ext_vector_type(4)));
typedef unsigned u32x2 __attribute__((ext_vector_type(2)));
typedef short bf16x8 __attribute__((ext_vector_type(8)));
typedef short s16x4 __attribute__((ext_vector_type(4)));
#define LDS_WAIT() asm volatile("s_waitcnt lgkmcnt(0)" ::: "memory")
using pg8::cvt_pk_bf16; using pg8::bf_lo; using pg8::bf_hi; using pg8::sigmoidf_;

__device__ __forceinline__ float wave_sum(float v) {
#pragma unroll
    for (int o = 1; o < 64; o <<= 1) v += __shfl_xor(v, o);
    return v;
}

__device__ __forceinline__ void transpose_item(const float* __restrict__ W, int ldW, int K, int src_n0, int k0, bf16_t* WT, int dst_row0, LAS float* scr, int lane, int pmode = -1) {
#pragma unroll 8
    for (int i = 0; i < 32; ++i) { const int kk = 2 * i + (lane >> 5); scr[kk * 33 + (lane & 31)] = W[(size_t)(k0 + kk) * ldW + src_n0 + (lane & 31)]; }
    LDS_WAIT(); asm volatile("" ::: "memory");
    const int c = lane & 7;
#pragma unroll
    for (int j = 0; j < 4; ++j) { const int n = (lane >> 3) + 8 * j; const LAS float* s = scr + (8 * c) * 33 + n;
        u32x4 o; o.x = cvt_pk_bf16(s[0 * 33], s[1 * 33]); o.y = cvt_pk_bf16(s[2 * 33], s[3 * 33]); o.z = cvt_pk_bf16(s[4 * 33], s[5 * 33]); o.w = cvt_pk_bf16(s[6 * 33], s[7 * 33]);
        const int nn = pmode < 0 ? n : 32 * (2 * (pmode >> 1) + (n >> 4)) + 8 * ((n >> 2) & 3) + 4 * (pmode & 1) + (n & 3);
        *(u32x4*)(WT + (size_t)(dst_row0 + nn) * K + k0 + 8 * c) = o; }
    LDS_WAIT(); asm volatile("" ::: "memory");
}

struct Args { const float* in[20]; float* out; unsigned char* ws; int ph_lo, ph_hi; };
typedef const __attribute__((address_space(4))) Args* KA;

__device__ __forceinline__ void prep_layer(KA a, int L, LAS unsigned char* lds, int gw, int NGW, int wave, int lane) {
    LAS float* scr = (LAS float*)(lds + wave * 8448);
    unsigned char* wsW = a->ws + WS_W;
    const float* w_in = a->in[3] + (size_t)L * DM * INW;
    const float* w_ogla = a->in[9] + (size_t)L * DM * DM; const float* w_oatt = a->in[10] + (size_t)L * DM * DM; const float* w_out = a->in[11] + (size_t)L * DM * DM;
    const float* w_fin = a->in[14] + (size_t)L * DM * 2 * FFH; const float* w_fout = a->in[15] + (size_t)L * FFH * DM;
    const float* w_pp = a->in[17] + (size_t)L * PLE * DM; const float* w_pg = a->in[18] + (size_t)L * DM * DM;
    constexpr int I_A = 16 * 97, I_B = 16 * 112, I_SQ = 16 * 32, I_FI = 16 * 176, I_FO = 44 * 32, I_PP = 4 * 32;
    constexpr int NITEMS = I_A + I_B + 4 * I_SQ + I_FI + I_FO + I_PP;
    for (int it = gw; it < NITEMS; it += NGW) {
        int r = it;
        if (r < I_A) { const int kb = r / 97, nb = r % 97; transpose_item(w_in, INW, DM, 32 * nb, 64 * kb, (bf16_t*)(wsW + W_INA), 32 * nb, scr, lane); continue; } r -= I_A;
        if (r < I_B) { const int kb = r / 112, nb = r % 112; const int d0 = (32 * nb) & 127;
            if (nb < 40) transpose_item(w_in, INW, DM, NA_REAL + 32 * nb, 64 * kb, (bf16_t*)(wsW + W_INB), 32 * nb - d0, scr, lane, (d0 >> 6) * 2 + ((d0 >> 5) & 1));
            else transpose_item(w_in, INW, DM, NA_REAL + 32 * nb, 64 * kb, (bf16_t*)(wsW + W_INB), 32 * nb, scr, lane);
            continue; } r -= I_B;
        if (r < 4 * I_SQ) { const int which = r / I_SQ, q = r % I_SQ, kb = q / 32, nb = q % 32;
            const float* src = which == 0 ? w_ogla : which == 1 ? w_oatt : which == 2 ? w_out : w_pg;
            const size_t dsto = which == 0 ? W_OGLA : which == 1 ? W_OATT : which == 2 ? W_OUT : W_PG;
            transpose_item(src, DM, DM, 32 * nb, 64 * kb, (bf16_t*)(wsW + dsto), 32 * nb, scr, lane); continue; } r -= 4 * I_SQ;
        if (r < I_FI) { const int kb = r / 176, nb = r % 176; const int n0 = 32 * nb; const int j = n0 < FFH ? n0 : n0 - FFH; const int dst = (j >> 7) * 256 + (n0 < FFH ? 0 : 128) + (j & 127);
            transpose_item(w_fin, 2 * FFH, DM, n0, 64 * kb, (bf16_t*)(wsW + W_FIN), dst, scr, lane); continue; } r -= I_FI;
        if (r < I_FO) { const int kb = r / 32, nb = r % 32; transpose_item(w_fout, DM, FFH, 32 * nb, 64 * kb, (bf16_t*)(wsW + W_FOUT), 32 * nb, scr, lane); continue; } r -= I_FO;
        { const int kb = r / 32, nb = r % 32; transpose_item(w_pp, DM, PLE, 32 * nb, 64 * kb, (bf16_t*)(wsW + W_PP), 32 * nb, scr, lane); }
    }
    { u32x4* z = (u32x4*)(wsW + W_INA + (size_t)NA_REAL * DM * 2); const int nz = (NA_PAD - NA_REAL) * DM * 2 / 16;
      for (int i = gw * 64 + lane; i < nz; i += NGW * 64) z[i] = (u32x4){0u, 0u, 0u, 0u}; }
    { const float* p = a->in[1] + (size_t)L * TOK * PLE; bf16_t* pb = (bf16_t*)(a->ws + WS_PB); const int n8 = TOK * PLE / 8;
      for (int i = gw * 64 + lane; i < n8; i += NGW * 64) { const f32x4 x0 = *(const f32x4*)(p + (size_t)i * 8), x1 = *(const f32x4*)(p + (size_t)i * 8 + 4);
          u32x4 o; o.x = cvt_pk_bf16(x0[0], x0[1]); o.y = cvt_pk_bf16(x0[2], x0[3]); o.z = cvt_pk_bf16(x1[0], x1[1]); o.w = cvt_pk_bf16(x1[2], x1[3]); *(u32x4*)(pb + (size_t)i * 8) = o; } }
}

template <bool IN_F32, bool OUT_F32>
__device__ __forceinline__ void row_pass(const void* hin, void* hout, const bf16_t* y, const float* __restrict__ gpost, const float* __restrict__ gpre, bf16_t* xa, int gw, int NGW, int lane) {
    for (int m = gw; m < TOK; m += NGW) {
        f32x4 v[4];
#pragma unroll
        for (int j = 0; j < 4; ++j) {
            if (IN_F32) v[j] = ((const f32x4*)((const float*)hin + (size_t)m * DM))[lane + 64 * j];
            else { const u32x2 w = ((const u32x2*)((const bf16_t*)hin + (size_t)m * DM))[lane + 64 * j]; v[j] = (f32x4){bf_lo(w.x), bf_hi(w.x), bf_lo(w.y), bf_hi(w.y)}; } }
        if (y) {
            f32x4 yv[4]; float ss = 0.f;
#pragma unroll
            for (int j = 0; j < 4; ++j) { const u32x2 w = ((const u32x2*)(y + (size_t)m * DM))[lane + 64 * j]; yv[j] = (f32x4){bf_lo(w.x), bf_hi(w.x), bf_lo(w.y), bf_hi(w.y)};
                ss += (yv[j][0] * yv[j][0] + yv[j][1] * yv[j][1]) + (yv[j][2] * yv[j][2] + yv[j][3] * yv[j][3]); }
            const float rs = rsqrtf(wave_sum(ss) * (1.0f / DM) + EPS);
#pragma unroll
            for (int j = 0; j < 4; ++j) { const f32x4 g = ((const f32x4*)gpost)[lane + 64 * j]; v[j] = v[j] + yv[j] * rs * g; }
        }
#pragma unroll
        for (int j = 0; j < 4; ++j) {
            if (OUT_F32) ((f32x4*)((float*)hout + (size_t)m * DM))[lane + 64 * j] = v[j];
            else { u32x2 w; w.x = cvt_pk_bf16(v[j][0], v[j][1]); w.y = cvt_pk_bf16(v[j][2], v[j][3]); ((u32x2*)((bf16_t*)hout + (size_t)m * DM))[lane + 64 * j] = w; } }
        if (gpre) {
            float ss = 0.f;
#pragma unroll
            for (int j = 0; j < 4; ++j) ss += (v[j][0] * v[j][0] + v[j][1] * v[j][1]) + (v[j][2] * v[j][2] + v[j][3] * v[j][3]);
            const float r2 = rsqrtf(wave_sum(ss) * (1.0f / DM) + EPS);
#pragma unroll
            for (int j = 0; j < 4; ++j) { const f32x4 o = v[j] * r2 * ((const f32x4*)gpre)[lane + 64 * j];
                u32x2 w; w.x = cvt_pk_bf16(o[0], o[1]); w.y = cvt_pk_bf16(o[2], o[3]); ((u32x2*)(xa + (size_t)m * DM))[lane + 64 * j] = w; }
        }
    }
}

__device__ __forceinline__ void qk_norm_rope(unsigned char* rbase, const float* __restrict__ gq, const float* __restrict__ gk, int gw, int NGW, int lane) {
    const int axis = lane >> 5, j = lane & 31, i1 = axis * 64 + j, i2 = i1 + 32;
    const float inv = __builtin_amdgcn_exp2f(-(float)j * (13.287712379549449f / 32.0f));
    const float gq1 = gq[i1], gq2 = gq[i2], gk1 = gk[i1], gk2 = gk[i2];
    for (int it = gw; it < TOK * 10; it += NGW) {
        const int t = it / 10, hs = it % 10;
        bf16_t* p = hs < 8 ? (bf16_t*)(rbase + R_Q) + (size_t)t * 1024 + hs * 128 : (bf16_t*)(rbase + R_K) + (size_t)t * 256 + (hs - 8) * 128;
        const float g1 = hs < 8 ? gq1 : gk1, g2 = hs < 8 ? gq2 : gk2;
        float x1 = bf_lo((unsigned)p[i1]), x2 = bf_lo((unsigned)p[i2]);
        const float rs = rsqrtf(wave_sum(x1 * x1 + x2 * x2) * (1.0f / 128.0f) + EPS);
        x1 = x1 * rs * g1; x2 = x2 * rs * g2;
        const int s = t & (SEQ - 1); const float pos = (float)(axis == 0 ? (s >> 6) : (s & 63));
        const float rev = pos * inv * 0.15915494309189535f;
        const float rf = __builtin_amdgcn_fractf(rev); const float c = __builtin_amdgcn_cosf(rf), sn = __builtin_amdgcn_sinf(rf);
        const float o1 = x1 * c - x2 * sn, o2 = x2 * c + x1 * sn;
        p[i1] = (bf16_t)(cvt_pk_bf16(o1, 0.f) & 0xffffu); p[i2] = (bf16_t)(cvt_pk_bf16(o2, 0.f) & 0xffffu);
    }
}

__device__ __forceinline__ void gla_post(bf16_t* of, const bf16_t* ob, const bf16_t* gg, const float* __restrict__ g, int gw, int NGW, int lane) {
    const f32x4 gv = ((const f32x4*)g)[lane];
    for (int it = gw; it < TOK * 4; it += NGW) {
        const size_t off = (size_t)it * 256 + 4 * lane;
        const u32x2 a = *(const u32x2*)(of + off), b = *(const u32x2*)(ob + off), c = *(const u32x2*)(gg + off);
        f32x4 o = (f32x4){bf_lo(a.x) + bf_lo(b.x), bf_hi(a.x) + bf_hi(b.x), bf_lo(a.y) + bf_lo(b.y), bf_hi(a.y) + bf_hi(b.y)};
        const float rs = rsqrtf(wave_sum((o[0] * o[0] + o[1] * o[1]) + (o[2] * o[2] + o[3] * o[3])) * (1.0f / 256.0f) + EPS);
        const f32x4 gt = (f32x4){bf_lo(c.x), bf_hi(c.x), bf_lo(c.y), bf_hi(c.y)};
#pragma unroll
        for (int k = 0; k < 4; ++k) o[k] = o[k] * rs * gv[k] * (gt[k] * sigmoidf_(gt[k]));
        u32x2 w; w.x = cvt_pk_bf16(o[0], o[1]); w.y = cvt_pk_bf16(o[2], o[3]); *(u32x2*)(of + off) = w;
    }
}
constexpr int GL_QD = 0, GL_KI = 17408, GL_KST = 34816, GL_VT = 53248, GL_STT = 62464, GL_EL = 79872, GL_RA = 80384, GL_TOT = 84480, GL_END = 88576;
constexpr int GS_Q = 272, GS_T = 144;
constexpr size_t R_QDF = 132 * MiB, R_KIF = 164 * MiB, R_EL = 196 * MiB;

__device__ __forceinline__ void gla_prep(KA a, int L, int b, int ci, int h, LAS unsigned char* lds) {
    const int tid = opaque_tid(), lane = tid & 63, w = __builtin_amdgcn_readfirstlane(tid >> 6);
    unsigned char* rbase = a->ws + WS_R;
    const bf16_t* GQ = (const bf16_t*)(rbase + R_GQ); const bf16_t* GK = (const bf16_t*)(rbase + R_GK); const float* RA = (const float*)(rbase + R_RA);
    const size_t t0 = (size_t)b * SEQ + (size_t)ci * 64; const int vrow = tid >> 3, vc8 = tid & 7;
    unsigned qc[8], kc[8];
#pragma unroll
    for (int r = 0; r < 8; ++r) { qc[r] = *(const unsigned*)(GQ + (t0 + 8 * w + r) * 512 + h * 128 + 2 * lane); kc[r] = *(const unsigned*)(GK + (t0 + 8 * w + r) * 512 + h * 128 + 2 * lane); }
#pragma unroll 1
    for (int dir = 0; dir < 2; ++dir) {
        bf16_t* QD = dir ? (bf16_t*)((unsigned char*)a->out + 64 * MiB) : (bf16_t*)(rbase + R_QDF);
        bf16_t* KI = dir ? (bf16_t*)((unsigned char*)a->out + 96 * MiB) : (bf16_t*)(rbase + R_KIF);
        float* EL = (float*)(rbase + R_EL) + ((size_t)dir * 512 + (size_t)b * 64 + ci) * 512;
        f32x2 wu[16];
        { const float* wup = a->in[4] + ((size_t)(L * 2 + dir) * 16) * 512 + h * 128 + 2 * lane;
#pragma unroll
          for (int j = 0; j < 16; ++j) wu[j] = *(const f32x2*)(wup + (size_t)j * 512); }
        const f32x2 bias = *(const f32x2*)(a->in[5] + (size_t)(L * 2 + dir) * 512 + h * 128 + 2 * lane);
        *(LAS f32x2*)(lds + GL_RA + vrow * 64 + vc8 * 8) = *(const f32x2*)(RA + (t0 + vrow) * 32 + dir * 16 + 2 * vc8);
        __syncthreads();
        float la0[8], la1[8];
#pragma unroll
        for (int r = 0; r < 8; ++r) {
            const LAS f32x4* rr = (const LAS f32x4*)(lds + GL_RA + (8 * w + r) * 64);
            f32x2 x = bias;
#pragma unroll
            for (int q4 = 0; q4 < 4; ++q4) { const f32x4 t = rr[q4];
#pragma unroll
                for (int e = 0; e < 4; ++e) x = __builtin_elementwise_fma((f32x2){t[e], t[e]}, wu[4 * q4 + e], x); }
            const f32x2 xl = x * 1.4426950408889634f;
            la0[r] = (fminf(xl.x, 0.f) - __builtin_amdgcn_logf(1.0f + __builtin_amdgcn_exp2f(-fabsf(xl.x)))) * (1.0f / 16.0f);
            la1[r] = (fminf(xl.y, 0.f) - __builtin_amdgcn_logf(1.0f + __builtin_amdgcn_exp2f(-fabsf(xl.y)))) * (1.0f / 16.0f);
        }
        if (dir == 0) {
#pragma unroll
            for (int r = 1; r < 8; ++r) { la0[r] += la0[r - 1]; la1[r] += la1[r - 1]; }
        } else {
#pragma unroll
            for (int r = 6; r >= 0; --r) { la0[r] += la0[r + 1]; la1[r] += la1[r + 1]; }
        }
        *(LAS f32x2*)(lds + GL_TOT + w * 512 + lane * 8) = (f32x2){dir == 0 ? la0[7] : la0[0], dir == 0 ? la1[7] : la1[0]};
        __syncthreads();
        float off0 = 0.f, off1 = 0.f, last0 = 0.f, last1 = 0.f;
#pragma unroll
        for (int g = 0; g < 8; ++g) { const f32x2 t = *(const LAS f32x2*)(lds + GL_TOT + g * 512 + lane * 8); last0 += t.x; last1 += t.y;
            const bool before = dir == 0 ? (g < w) : (g > w); if (before) { off0 += t.x; off1 += t.y; } }
#pragma unroll
        for (int r = 0; r < 8; ++r) {
            const float c0 = la0[r] + off0, c1 = la1[r] + off1;
            const float q0 = bf_lo(qc[r]), q1 = bf_hi(qc[r]), k0 = bf_lo(kc[r]), k1 = bf_hi(kc[r]);
            const float eq0 = __builtin_amdgcn_exp2f(c0) * 0.088388347648318440f, eq1 = __builtin_amdgcn_exp2f(c1) * 0.088388347648318440f;
            const size_t o = (t0 + 8 * w + r) * 512 + h * 128 + 2 * lane;
            *(unsigned*)(QD + o) = cvt_pk_bf16(q0 * eq0, q1 * eq1);
            *(unsigned*)(KI + o) = cvt_pk_bf16(k0 * __builtin_amdgcn_exp2f(-c0), k1 * __builtin_amdgcn_exp2f(-c1));
        }
        if (w == 0) *(f32x2*)(EL + h * 128 + 2 * lane) = (f32x2){__builtin_amdgcn_exp2f(last0), __builtin_amdgcn_exp2f(last1)};
        __syncthreads();
    }
}

__device__ __forceinline__ void gla_unit(KA a, int L, int b, int h, int dir, int vs, LAS unsigned char* lds) {
    const int tid = opaque_tid(), lane = tid & 63, w = __builtin_amdgcn_readfirstlane(tid >> 6);
    unsigned char* rbase = a->ws + WS_R;
    const bf16_t* QDg = dir ? (const bf16_t*)((unsigned char*)a->out + 64 * MiB) : (const bf16_t*)(rbase + R_QDF);
    const bf16_t* KIg = dir ? (const bf16_t*)((unsigned char*)a->out + 96 * MiB) : (const bf16_t*)(rbase + R_KIF);
    const float* ELg = (const float*)(rbase + R_EL) + ((size_t)dir * 512 + (size_t)b * 64) * 512 + h * 128;
    const bf16_t* GV = (const bf16_t*)(rbase + R_GV);
    bf16_t* O = (bf16_t*)(a->ws + (dir ? WS_OB : WS_OF));
    f32x4 st[4];
#pragma unroll
    for (int nb = 0; nb < 4; ++nb) st[nb] = (f32x4){0.f, 0.f, 0.f, 0.f};
    for (int i = tid; i < 17408 / 4; i += 512) ((LAS unsigned*)(lds + GL_STT))[i] = 0u;
    const int li = lane & 15, kq = lane >> 4, ib = w & 3, dh = w >> 2;
    const int vrow = tid >> 3, vc8 = tid & 7;
    const int tswz = (((vrow >> 3) ^ vc8) << 4) + (vrow & 7) * 2;
    const int fl = li >> 3;
    u32x4 qd0, qd1, ki0, ki1, vv; float elv = 0.f;
#define GLA_LOAD(ci_) do { const size_t t0_ = (size_t)b * SEQ + (size_t)(ci_) * 64; const size_t o_ = (t0_ + vrow) * 512 + h * 128 + vc8 * 8; \
        qd0 = *(const u32x4*)(QDg + o_); qd1 = *(const u32x4*)(QDg + o_ + 64); ki0 = *(const u32x4*)(KIg + o_); ki1 = *(const u32x4*)(KIg + o_ + 64); \
        vv = *(const u32x4*)(GV + (t0_ + vrow) * 1024 + h * 256 + vs * 64 + vc8 * 8); if (tid < 128) elv = ELg[(size_t)(ci_) * 512 + tid]; } while (0)
#define GLA_TR8(base_, v_) do { LAS unsigned char* p_ = (base_); const u32x4 x_ = (v_); \
        *(LAS unsigned short*)(p_ + 0 * GS_T) = (unsigned short)(x_.x & 0xffff); *(LAS unsigned short*)(p_ + 1 * GS_T) = (unsigned short)(x_.x >> 16); \
        *(LAS unsigned short*)(p_ + 2 * GS_T) = (unsigned short)(x_.y & 0xffff); *(LAS unsigned short*)(p_ + 3 * GS_T) = (unsigned short)(x_.y >> 16); \
        *(LAS unsigned short*)(p_ + 4 * GS_T) = (unsigned short)(x_.z & 0xffff); *(LAS unsigned short*)(p_ + 5 * GS_T) = (unsigned short)(x_.z >> 16); \
        *(LAS unsigned short*)(p_ + 6 * GS_T) = (unsigned short)(x_.w & 0xffff); *(LAS unsigned short*)(p_ + 7 * GS_T) = (unsigned short)(x_.w >> 16); } while (0)
    GLA_LOAD(dir ? 63 : 0);
    for (int c = 0; c < 64; ++c) {
        const int ci = dir ? 63 - c : c; const size_t t0 = (size_t)b * SEQ + (size_t)ci * 64;
        *(LAS u32x4*)(lds + GL_QD + vrow * GS_Q + vc8 * 16) = qd0; *(LAS u32x4*)(lds + GL_QD + vrow * GS_Q + 128 + vc8 * 16) = qd1;
        *(LAS u32x4*)(lds + GL_KI + vrow * GS_Q + vc8 * 16) = ki0; *(LAS u32x4*)(lds + GL_KI + vrow * GS_Q + 128 + vc8 * 16) = ki1;
        GLA_TR8(lds + GL_KST + (vc8 * 8) * GS_T + tswz, ki0); GLA_TR8(lds + GL_KST + (64 + vc8 * 8) * GS_T + tswz, ki1);
        GLA_TR8(lds + GL_VT + (vc8 * 8) * GS_T + tswz, vv);
        if (tid < 128) *(LAS float*)(lds + GL_EL + tid * 4) = elv;
        __syncthreads();
        if (c + 1 < 64) GLA_LOAD(dir ? 62 - c : c + 1);
        bf16x8 qf[4];
#pragma unroll
        for (int kk = 0; kk < 4; ++kk) qf[kk] = *(const LAS bf16x8*)(lds + GL_QD + (16 * ib + li) * GS_Q + kk * 64 + kq * 16);
        unsigned pk[4][2];
#pragma unroll
        for (int sb = 0; sb < 4; ++sb) {
            if (dir == 0 ? (sb > ib) : (sb < ib)) { pk[sb][0] = 0u; pk[sb][1] = 0u; continue; }
            f32x4 sacc = (f32x4){0.f, 0.f, 0.f, 0.f};
#pragma unroll
            for (int kk = 0; kk < 4; ++kk) { const bf16x8 kf = *(const LAS bf16x8*)(lds + GL_KI + (16 * sb + li) * GS_Q + kk * 64 + kq * 16);
                sacc = __builtin_amdgcn_mfma_f32_16x16x32_bf16(kf, qf[kk], sacc, 0, 0, 0); }
            const int irow = 16 * ib + li;
#pragma unroll
            for (int j = 0; j < 4; ++j) { const int srow = 16 * sb + 4 * kq + j; const bool keep = dir == 0 ? (srow <= irow) : (srow >= irow); sacc[j] = keep ? sacc[j] : 0.f; }
            pk[sb][0] = cvt_pk_bf16(sacc[0], sacc[1]); pk[sb][1] = cvt_pk_bf16(sacc[2], sacc[3]);
        }
#pragma unroll
        for (int d2 = 0; d2 < 2; ++d2) { const int db = 2 * dh + d2;
            f32x4 oacc = (f32x4){0.f, 0.f, 0.f, 0.f};
#pragma unroll
            for (int kk = 0; kk < 4; ++kk) { const bf16x8 sf = *(const LAS bf16x8*)(lds + GL_STT + (16 * db + li) * GS_Q + kk * 64 + kq * 16);
                oacc = __builtin_amdgcn_mfma_f32_16x16x32_bf16(sf, qf[kk], oacc, 0, 0, 0); }
#pragma unroll
            for (int kc2 = 0; kc2 < 2; ++kc2) {
                const int fv = (2 * db + fl) & 7;
                const s16x4 lo = *(const LAS s16x4*)(lds + GL_VT + (16 * db + li) * GS_T + (((4 * kc2 + (kq >> 1)) ^ fv) << 4) + (kq & 1) * 8);
                const s16x4 hi4 = *(const LAS s16x4*)(lds + GL_VT + (16 * db + li) * GS_T + (((4 * kc2 + 2 + (kq >> 1)) ^ fv) << 4) + (kq & 1) * 8);
                const bf16x8 vf = (bf16x8){lo[0], lo[1], lo[2], lo[3], hi4[0], hi4[1], hi4[2], hi4[3]};
                const u32x4 pw = (u32x4){pk[2 * kc2][0], pk[2 * kc2][1], pk[2 * kc2 + 1][0], pk[2 * kc2 + 1][1]};
                oacc = __builtin_amdgcn_mfma_f32_16x16x32_bf16(vf, __builtin_bit_cast(bf16x8, pw), oacc, 0, 0, 0); }
            u32x2 ow; ow.x = cvt_pk_bf16(oacc[0], oacc[1]); ow.y = cvt_pk_bf16(oacc[2], oacc[3]);
            *(u32x2*)(O + (t0 + 16 * ib + li) * 1024 + h * 256 + vs * 64 + 16 * db + 4 * kq) = ow;
        }
        { const f32x4 el = *(const LAS f32x4*)(lds + GL_EL + (16 * w + 4 * kq) * 4);
#pragma unroll
          for (int kc2 = 0; kc2 < 2; ++kc2) { const bf16x8 af = *(const LAS bf16x8*)(lds + GL_KST + (16 * w + li) * GS_T + (((4 * kc2 + kq) ^ ((2 * w + fl) & 7)) << 4));
#pragma unroll
              for (int nb = 0; nb < 4; ++nb) { const bf16x8 bfv = *(const LAS bf16x8*)(lds + GL_VT + (16 * nb + li) * GS_T + (((4 * kc2 + kq) ^ ((2 * nb + fl) & 7)) << 4));
                  st[nb] = __builtin_amdgcn_mfma_f32_16x16x32_bf16(af, bfv, st[nb], 0, 0, 0); } }
#pragma unroll
          for (int nb = 0; nb < 4; ++nb) st[nb] = st[nb] * el; }
        __syncthreads();
#pragma unroll
        for (int nb = 0; nb < 4; ++nb) { u32x2 sw; sw.x = cvt_pk_bf16(st[nb][0], st[nb][1]); sw.y = cvt_pk_bf16(st[nb][2], st[nb][3]);
            *(LAS u32x2*)(lds + GL_STT + (16 * nb + li) * GS_Q + (16 * w + 4 * kq) * 2) = sw; }
    }
#undef GLA_LOAD
#undef GLA_TR8
    __syncthreads();
}
#ifndef PH_MASK
#define PH_MASK 0x3fff
#endif
#define EN(k) (((PH_MASK) >> (k)) & 1)
#ifndef PROBE_SYNC_REPS
#define PROBE_SYNC_REPS 1
#endif
#ifndef PROBE_GLA_REPS
#define PROBE_GLA_REPS 1
#endif
__global__ void __launch_bounds__(512) hybrid_fwd(Args a_) {
    extern __shared__ __attribute__((aligned(16))) unsigned char lds_raw[];
    LAS unsigned char* lds = (LAS unsigned char*)lds_raw;
    cg::grid_group grid = cg::this_grid();
    const int ph_lo = a_.ph_lo, ph_hi = a_.ph_hi;
    if (threadIdx.x < 2) ((LAS unsigned*)(lds + 131072))[threadIdx.x] = 0u;
    __syncthreads();
    const XcdBarrier xbar = xcd_barrier_post((unsigned*)(a_.ws + WS_CTL), (volatile LAS unsigned*)(lds + 131072));
    for (int ph = ph_lo; ph < ph_hi; ++ph) {
        const int tid = opaque_tid(), lane = tid & 63, wave = __builtin_amdgcn_readfirstlane(tid >> 6);
        int bx = blockIdx.x, G = gridDim.x; asm volatile("" : "+s"(bx), "+s"(G));
        const int vcu = (G % 8 == 0) ? (bx % 8) * (G / 8) + bx / 8 : bx;
        const int gw = vcu * 8 + wave, NGW = G * 8;
        KA a = (KA)__builtin_amdgcn_kernarg_segment_ptr(); asm volatile("" : "+s"(a));
        unsigned char* ws = a->ws; unsigned char* rbase = ws + WS_R; unsigned char* wsW = ws + WS_W;
        bf16_t* XA = (bf16_t*)(ws + WS_XA); bf16_t* OF = (bf16_t*)(ws + WS_OF); bf16_t* OB = (bf16_t*)(ws + WS_OB); bf16_t* GG = (bf16_t*)a->out; bf16_t* HB = (bf16_t*)(ws + WS_HB); bf16_t* PB = (bf16_t*)(ws + WS_PB);
        if (ph == 0) { if (EN(13)) {
            prep_layer(a, 0, lds, gw, NGW, wave, lane);
            row_pass<true, false>(a->in[0], HB, nullptr, nullptr, a->in[2], XA, gw, NGW, lane); }
        } else {
            const int L = (ph - 1) / NPH_LAYER, k = (ph - 1) % NPH_LAYER;
            int ngemm = 0; pg8::Gemm g0{}, g1{}; pg8::Epi e0{}, e1{};
            e0.rbase = rbase; e0.ggbase = (unsigned char*)a->out; e1.rbase = rbase; e1.ggbase = (unsigned char*)a->out;
            switch (k) {
            case 0: if (!EN(0)) break; ngemm = 1; g0 = pg8::Gemm{XA, (const bf16_t*)(wsW + W_INA), TOK, NA_PAD, DM}; e0.mode = pg8::EM_ROUTE_A; break;
            case 1: if (!EN(1)) break; for (int u = vcu; u < 2048; u += G) gla_prep(a, L, u >> 8, (u >> 2) & 63, u & 3, lds); break;
            case 2: if (!EN(2)) break; for (int u = vcu; u < 256; u += G) gla_unit(a, L, u >> 5, (u >> 3) & 3, (u >> 2) & 1, u & 3, lds); break;
            case 3: if (!EN(3)) break; gla_post(OF, OB, GG, a->in[6] + (size_t)L * 256, gw, NGW, lane);
                    ngemm = 1; g0 = pg8::Gemm{XA, (const bf16_t*)(wsW + W_INB), TOK, NB_COLS, DM}; e0.mode = pg8::EM_ROUTE_B; e0.gqn = a->in[7] + (size_t)L * 128; e0.gkn = a->in[8] + (size_t)L * 128; e0.xlds = (LAS float*)(lds + 131072 + 1024); break;
            case 4: if (!EN(4)) break; for (int u = vcu; u < 1024; u += G) { const int qb = u & 15, hg = (u >> 4) & 3, kvh = (u >> 6) & 1, b = u >> 7, hq = kvh * 4 + hg;
                        bf16_t* Qb = (bf16_t*)(rbase + R_Q) + ((size_t)b * SEQ + (size_t)qb * 256) * 1024 + hq * 128;
                        const bf16_t* Kh = (const bf16_t*)(rbase + R_K) + (size_t)b * SEQ * 256 + kvh * 128; const bf16_t* Vh = (const bf16_t*)(rbase + R_V) + (size_t)b * SEQ * 256 + kvh * 128;
                        attn::attn_dense_body<attn::bf16>((const attn::bf16*)Qb, (const attn::bf16*)Kh, (const attn::bf16*)Vh, Qb, SEQ, (char*)lds_raw);
                        __syncthreads(); }
                    break;
            case 5: if (!EN(5)) break; ngemm = 2; g0 = pg8::Gemm{OF, (const bf16_t*)(wsW + W_OGLA), TOK, DM, DM}; e0.mode = pg8::EM_GATE1; e0.out = OB; e0.aux = (const bf16_t*)(rbase + R_GA);
                    g1 = pg8::Gemm{(const bf16_t*)(rbase + R_Q), (const bf16_t*)(wsW + W_OATT), TOK, DM, DM}; e1.mode = pg8::EM_GATE2; e1.out = OB; e1.aux = (const bf16_t*)(rbase + R_GB); break;
            case 6: if (!EN(6)) break; ngemm = 1; g0 = pg8::Gemm{OB, (const bf16_t*)(wsW + W_OUT), TOK, DM, DM}; e0.mode = pg8::EM_PLAIN; e0.out = OF; break;
            case 7: if (!EN(7)) break; row_pass<false, false>(HB, HB, OF, a->in[12] + (size_t)L * DM, a->in[13] + (size_t)L * DM, XA, gw, NGW, lane); break;
            case 8: if (!EN(8)) break; ngemm = 1; g0 = pg8::Gemm{XA, (const bf16_t*)(wsW + W_FIN), TOK, 2 * FFH, DM}; e0.mode = pg8::EM_SWIGLU; e0.out = (bf16_t*)rbase; break;
            case 9: if (!EN(9)) break; ngemm = 1; g0 = pg8::Gemm{(const bf16_t*)rbase, (const bf16_t*)(wsW + W_FOUT), TOK, DM, FFH}; e0.mode = pg8::EM_PLAIN; e0.out = OF; break;
            case 10: if (!EN(10)) break; row_pass<false, false>(HB, HB, OF, a->in[16] + (size_t)L * DM, nullptr, nullptr, gw, NGW, lane); break;
            case 11: if (!EN(11)) break; ngemm = 2; g0 = pg8::Gemm{PB, (const bf16_t*)(wsW + W_PP), TOK, DM, PLE}; e0.mode = pg8::EM_PLAIN; e0.out = (bf16_t*)rbase;
                     g1 = pg8::Gemm{HB, (const bf16_t*)(wsW + W_PG), TOK, DM, DM}; e1.mode = pg8::EM_PLE2; e1.out = OF; e1.aux = (const bf16_t*)rbase; break;
            default: if (!EN(12)) break; if (L + 1 < DEPTH) row_pass<false, false>(HB, HB, OF, a->in[19] + (size_t)L * DM, a->in[2] + (size_t)(L + 1) * DM, XA, gw, NGW, lane);
                     else row_pass<false, true>(HB, a->out, OF, a->in[19] + (size_t)L * DM, nullptr, nullptr, gw, NGW, lane);
                     if (L + 1 < DEPTH) prep_layer(a, L + 1, lds, gw, NGW, wave, lane);
                     break;
            }
            for (int gi = 0; gi < ngemm; ++gi) {
                const pg8::Gemm g = gi == 0 ? g0 : g1; const pg8::Epi E = gi == 0 ? e0 : e1;
                pg8::StaticOrder S; S.init(g.M, g.N, G, bx);
                pg8::gemm_phase<pg8::Epi, pg8::StaticOrder, true, true>(lds, g, S, E);
            }
        }
        if (ph + 1 < ph_hi) { if (ph == 0) grid.sync(); else xcd_barrier(xbar); }
    }
}

#if MK_DEBUG
struct DbgReg { unsigned long long off, bytes; int type, pad; };
struct DbgArgs { DbgReg r[3]; int scanH, ph, pass, pad; };
__global__ void __launch_bounds__(256) dbg_scan(unsigned char* ws, const float* out, DbgArgs d) {
    unsigned* nanw = (unsigned*)(ws + WS_CTL); unsigned long long* sums = (unsigned long long*)(ws + WS_CTL + 512 + d.pass * 512);
    unsigned long long s = 0; unsigned bad = 0;
#pragma unroll
    for (int ri = 0; ri < 3; ++ri) {
        const size_t n16 = d.r[ri].bytes / 16; const u32x4* p = (const u32x4*)(ws + d.r[ri].off); const int type = d.r[ri].type;
        for (size_t i = (size_t)blockIdx.x * 256 + threadIdx.x; i < n16; i += (size_t)gridDim.x * 256) {
            const u32x4 v = p[i]; s += (unsigned long long)v.x + v.y + v.z + v.w;
#pragma unroll
            for (int k = 0; k < 4; ++k) { const unsigned w = v[k]; if ((type == 0 && (w & 0x7f80u) == 0x7f80u) || (type <= 1 && (w & 0x7f800000u) == 0x7f800000u)) bad = 1; }
        }
    }
    if (d.scanH) { const size_t no = (size_t)TOK * DM / 4; const u32x4* q = (const u32x4*)out;
        for (size_t i = (size_t)blockIdx.x * 256 + threadIdx.x; i < no; i += (size_t)gridDim.x * 256) {
            const u32x4 v = q[i]; s += (unsigned long long)v.x + v.y + v.z + v.w;
#pragma unroll
            for (int k = 0; k < 4; ++k) if ((v[k] & 0x7f800000u) == 0x7f800000u) bad = 1; } }
    for (int o = 1; o < 64; o <<= 1) { s += __shfl_xor(s, o); bad |= __shfl_xor(bad, o); }
    if ((threadIdx.x & 63) == 0) { atomicAdd(&sums[d.ph], s); if (bad) atomicOr(&nanw[d.ph], 1u); }
}
__global__ void __launch_bounds__(64) dbg_check_gemm_a(unsigned char* ws) {
    unsigned* chk = (unsigned*)(ws + WS_CTL) + 56;
    const int i = blockIdx.x, lane = threadIdx.x;
    const int t = (int)(((long)i * 9973 + 17) % TOK), col = (i * 131 + 5) % NA_REAL;
    const bf16_t* xa = (const bf16_t*)(ws + WS_XA) + (size_t)t * DM; const bf16_t* wt = (const bf16_t*)(ws + WS_W + W_INA) + (size_t)col * DM;
    float acc = 0.f;
    for (int k = lane; k < DM; k += 64) acc += bf_lo((unsigned)xa[k]) * bf_lo((unsigned)wt[k]);
    acc = wave_sum(acc);
    unsigned char* rb = ws + WS_R; float got;
    if (col < 512) got = bf_lo((unsigned)((const bf16_t*)(rb + R_GQ))[(size_t)t * 512 + col]);
    else if (col < 1024) got = bf_lo((unsigned)((const bf16_t*)(rb + R_GK))[(size_t)t * 512 + col - 512]);
    else if (col < 2048) got = bf_lo((unsigned)((const bf16_t*)(rb + R_GV))[(size_t)t * 1024 + col - 1024]);
    else if (col < 3072) got = bf_lo((unsigned)((const bf16_t*)(ws + WS_GG))[(size_t)t * 1024 + col - 2048]);
    else got = ((const float*)(rb + R_RA))[(size_t)t * 32 + col - 3072];
    if (lane == 0) { if (!(fabsf(got - acc) <= 0.03f * fmaxf(1.f, fabsf(acc)))) { atomicOr(chk, fabsf(got) < 1e-9f ? 1u : 2u); if (atomicAdd(chk + 4, 1u) == 0u) { chk[2] = (unsigned)(t & 255) >> 2; chk[3] = (unsigned)(col & 255) >> 3; } } }
    float m = 0.f; const float* ra = (const float*)(rb + R_RA);
    for (int k = lane; k < 2048; k += 64) m = fmaxf(m, fabsf(ra[(size_t)i * 2048 + k]));
    for (int o = 1; o < 64; o <<= 1) m = fmaxf(m, __shfl_xor(m, o));

}
__global__ void __launch_bounds__(64) dbg_check_gemm_b(unsigned char* ws) {
    unsigned* chk = (unsigned*)(ws + WS_CTL) + 57;
    const int i = blockIdx.x, lane = threadIdx.x;
    const int t = (int)(((long)i * 9973 + 17) % TOK), col = (i * 131 + 5) % NB_COLS;
    const bf16_t* xa = (const bf16_t*)(ws + WS_XA) + (size_t)t * DM; const bf16_t* wt = (const bf16_t*)(ws + WS_W + W_INB) + (size_t)col * DM;
    float acc = 0.f;
    for (int k = lane; k < DM; k += 64) acc += bf_lo((unsigned)xa[k]) * bf_lo((unsigned)wt[k]);
    acc = wave_sum(acc);
    unsigned char* rb = ws + WS_R; float got; unsigned bit;
    if (col < 1024) { got = bf_lo((unsigned)((const bf16_t*)(rb + R_Q))[(size_t)t * 1024 + col]); bit = 1u; }
    else if (col < 1280) { got = bf_lo((unsigned)((const bf16_t*)(rb + R_K))[(size_t)t * 256 + col - 1024]); bit = 2u; }
    else if (col < 1536) { got = bf_lo((unsigned)((const bf16_t*)(rb + R_V))[(size_t)t * 256 + col - 1280]); bit = 2u; }
    else if (col < 2560) { got = bf_lo((unsigned)((const bf16_t*)(rb + R_GA))[(size_t)t * 1024 + col - 1536]); bit = 4u; }
    else { got = bf_lo((unsigned)((const bf16_t*)(rb + R_GB))[(size_t)t * 1024 + col - 2560]); bit = 4u; }
    if (lane == 0) { if (!(fabsf(got - acc) <= 0.03f * fmaxf(1.f, fabsf(acc)))) atomicOr(chk, bit); }
}
__global__ void __launch_bounds__(256) dbg_check_gla(unsigned char* ws) {
    unsigned* c58 = (unsigned*)(ws + WS_CTL) + 58; unsigned* c59 = c58 + 1;
    const bf16_t* of = (const bf16_t*)(ws + WS_OF); const bf16_t* ob = (const bf16_t*)(ws + WS_OB);
    unsigned mn = 99u, mx = 0u;
    for (size_t i = (size_t)blockIdx.x * 256 + threadIdx.x; i < (size_t)TOK * DM; i += (size_t)gridDim.x * 256) {
        const unsigned chunk = (unsigned)((i >> 10) & 4095) >> 6;
        if ((of[i] & 0x7f80u) == 0x7f80u) mn = chunk < mn ? chunk : mn;
        if ((ob[i] & 0x7f80u) == 0x7f80u) mx = chunk + 1 > mx ? chunk + 1 : mx;
    }
    if (mn != 99u) atomicMin(c58, mn); if (mx) atomicMax(c59, mx);
}
__global__ void __launch_bounds__(256) dbg_final(unsigned char* ws, float* out) {
    const unsigned* nanw = (const unsigned*)(ws + WS_CTL); const unsigned long long* sa = (const unsigned long long*)(ws + WS_CTL + 512); const unsigned long long* sb = sa + 64;
    int p1 = -1, p2 = -1;
    for (int i = NPHASES - 1; i >= 0; --i) { if (nanw[i]) p1 = i; if (sa[i] != sb[i]) p2 = i; }
    const unsigned chkA = nanw[56], chkB = nanw[57], g0 = nanw[58], g1 = nanw[59];
    if (p1 < 0 && p2 < 0 && chkA == 0 && chkB == 0) return;
    float c1; unsigned e;
    if (chkA | chkB) { c1 = 90.f + (chkA & 7); e = chkB & 7; }
    else if (p1 == 2) { c1 = 10.f + (g0 > 63 ? 70.f : (float)g0); e = g1 / 3; }
    else { c1 = p1 >= 0 ? 10.f + p1 : 40.f + p2; e = p1 >= 0 ? 25 : 30; }
    float code = c1 * 100.f; for (unsigned k = 0; k < e; ++k) code *= 10.f;
    for (size_t i = (size_t)blockIdx.x * 256 + threadIdx.x; i < (size_t)TOK * DM; i += (size_t)gridDim.x * 256) out[i] = i == 0 ? code : 0.f;
}
static DbgArgs dbg_args_for(int ph, int pass) {
    DbgArgs d{}; d.ph = ph; d.pass = pass; int n = 0;
    auto add = [&](size_t off, size_t bytes, int type) { d.r[n].off = off; d.r[n].bytes = bytes; d.r[n].type = type; ++n; };
    if (ph == 0) { add(WS_W, W_END, 0); add(WS_PB, 16 * MiB, 0); add(WS_XA, 64 * MiB, 0); d.scanH = 1; return d; }
    const int k = (ph - 1) % NPH_LAYER;
    switch (k) {
    case 0: add(WS_R, 128 * MiB, 0); add(WS_R + R_RA, 4 * MiB, 1); add(WS_GG, 64 * MiB, 0); break;
    case 1: add(WS_OF, 128 * MiB, 0); break;
    case 2: add(WS_OF, 64 * MiB, 0); add(WS_R, 224 * MiB, 0); break;
    case 3: add(WS_R + R_Q, 80 * MiB, 0); break;
    case 4: add(WS_R + R_Q, 64 * MiB, 0); break;
    case 5: add(WS_OB, 64 * MiB, 0); break;
    case 6: add(WS_OF, 64 * MiB, 0); break;
    case 7: add(WS_XA, 64 * MiB, 0); d.scanH = 1; break;
    case 8: add(WS_R, (size_t)TOK * FFH * 2, 0); break;
    case 9: add(WS_OF, 64 * MiB, 0); break;
    case 10: add(WS_XA, 64 * MiB, 0); d.scanH = 1; break;
    case 11: add(WS_R, 64 * MiB, 0); add(WS_OF, 64 * MiB, 0); break;
    default: add(WS_XA, 64 * MiB, 0); add(WS_W, W_END, 0); add(WS_PB, 16 * MiB, 0); d.scanH = 1; break;
    }
    return d;
}
#endif
extern "C" void kernel_launch(void* const* d_in, const int* in_sizes, int n_in, void* d_out, int out_size, void* d_ws, size_t ws_size, hipStream_t stream) {
    static int grid = 0;
    if (grid == 0) {
        if (n_in != 20 || in_sizes[0] != TOK * DM || out_size != TOK * DM || ws_size < WS_END) {
            fprintf(stderr, "kernel_launch: unexpected shapes (n_in %d, in0 %d, out %d, ws %zu, need %zu); nothing launched\n", n_in, n_in > 0 ? in_sizes[0] : -1, out_size, ws_size, (size_t)WS_END); grid = -1; return; }
        int dev = 0, cus = 0, per_cu = 0;
        if (hipGetDevice(&dev) != hipSuccess || hipDeviceGetAttribute(&cus, hipDeviceAttributeMultiprocessorCount, dev) != hipSuccess) { grid = -1; return; }
        if (hipFuncSetAttribute((const void*)hybrid_fwd, hipFuncAttributeMaxDynamicSharedMemorySize, LDS_BYTES) != hipSuccess) { fprintf(stderr, "kernel_launch: hipFuncSetAttribute failed\n"); grid = -1; return; }
        if (hipOccupancyMaxActiveBlocksPerMultiprocessor(&per_cu, (const void*)hybrid_fwd, 512, LDS_BYTES) != hipSuccess || per_cu < 1) { fprintf(stderr, "kernel_launch: occupancy query says %d\n", per_cu); per_cu = 1; }
        (void)hipGetLastError();
        grid = cus * 1;
        fprintf(stderr, "kernel_launch: grid %d (cus %d, per_cu %d), ws need %zu have %zu\n", grid, cus, per_cu, (size_t)WS_END, ws_size);
    }
    if (grid < 0) return;
    if (hipMemsetAsync((char*)d_ws + WS_CTL, 0, 16384, stream) != hipSuccess) { fprintf(stderr, "kernel_launch: memset failed\n"); return; }
    Args a{};
    for (int i = 0; i < 20; ++i) a.in[i] = (const float*)d_in[i];
    a.out = (float*)d_out; a.ws = (unsigned char*)d_ws;
#if MK_DEBUG
    hipMemsetAsync((char*)d_ws + WS_CTL, 0, 4096, stream); hipMemsetAsync((char*)d_ws + WS_CTL + 58 * 4, 0x63, 1, stream);
    for (int pass = 0; pass < 2; ++pass)
        for (int ph = 0; ph < NPHASES; ++ph) { a.ph_lo = ph; a.ph_hi = ph + 1; hipLaunchKernelGGL(hybrid_fwd, dim3(grid), dim3(512), LDS_BYTES, stream, a);
            hipLaunchKernelGGL(dbg_scan, dim3(2048), dim3(256), 0, stream, (unsigned char*)d_ws, (const float*)d_out, dbg_args_for(ph, pass));
            if (pass == 0 && ph == 1) { hipLaunchKernelGGL(dbg_check_gemm_a, dim3(512), dim3(64), 0, stream, (unsigned char*)d_ws); }
            if (pass == 0 && ph == 2) hipLaunchKernelGGL(dbg_check_gla, dim3(2048), dim3(256), 0, stream, (unsigned char*)d_ws);
            if (pass == 0 && ph == 3) hipLaunchKernelGGL(dbg_check_gemm_b, dim3(512), dim3(64), 0, stream, (unsigned char*)d_ws); }
    hipLaunchKernelGGL(dbg_final, dim3(2048), dim3(256), 0, stream, (unsigned char*)d_ws, (float*)d_out);
#elif MK_PER_PHASE
    for (int ph = 0; ph < NPHASES; ++ph) { a.ph_lo = ph; a.ph_hi = ph + 1; hipLaunchKernelGGL(hybrid_fwd, dim3(grid), dim3(512), LDS_BYTES, stream, a); }
#else
    a.ph_lo = 0; a.ph_hi = NPHASES;
    void* args[] = {&a};
    hipError_t e = hipLaunchCooperativeKernel((const void*)hybrid_fwd, dim3(grid), dim3(512), args, LDS_BYTES, stream);
    if (e != hipSuccess) fprintf(stderr, "kernel_launch: cooperative launch failed: %s (grid %d)\n", hipGetErrorString(e), grid);
#endif
}
```

```cpp
#include <hip/hip_runtime.h>
#include <hip/hip_bf16.h>
#include <hip/hip_cooperative_groups.h>
#include <cstdio>
#include <cstdint>
namespace cg = cooperative_groups;
#ifndef MK_DEBUG
#define MK_DEBUG 0
#endif
#ifndef MK_PER_PHASE
#define MK_PER_PHASE 0
#endif
__device__ __forceinline__ int opaque_tid() { int t = threadIdx.x; asm volatile("" : "+v"(t)); return t; }
#define LAS __attribute__((address_space(3)))
constexpr int TOK = 32768, DM = 1024, SEQ = 4096, NBATCH = 8, DEPTH = 4, INW = 6688, FFH = 2816, PLE = 256;
constexpr int NA_REAL = 3104, NA_PAD = 3328, NB_COLS = 3584;
constexpr float EPS = 1e-6f;
constexpr size_t MiB = 1048576;
constexpr size_t W_INA = 0, W_INB = W_INA + (size_t)NA_PAD * DM * 2, W_OGLA = W_INB + (size_t)NB_COLS * DM * 2, W_OATT = W_OGLA + 2 * MiB, W_OUT = W_OATT + 2 * MiB,
                 W_PG = W_OUT + 2 * MiB, W_FIN = W_PG + 2 * MiB, W_FOUT = W_FIN + (size_t)2 * FFH * DM * 2, W_PP = W_FOUT + (size_t)FFH * DM * 2, W_END = W_PP + (size_t)DM * PLE * 2;
constexpr size_t WS_CTL = 0, WS_W = 16384, WS_R = (WS_W + W_END + 4095) / 4096 * 4096;
constexpr size_t R_Q = 0, R_K = 64 * MiB, R_V = 80 * MiB, R_GA = 96 * MiB, R_GB = 160 * MiB, R_BYTES = 224 * MiB;
constexpr size_t R_GQ = 0, R_GK = 32 * MiB, R_GV = 64 * MiB, R_RA = 128 * MiB;
constexpr size_t WS_HB = WS_R + R_BYTES,   WS_GG_UNUSED = 0, WS_OF = WS_HB + 64 * MiB, WS_OB = WS_OF + 64 * MiB, WS_XA = WS_OB + 64 * MiB, WS_PB = WS_XA + 64 * MiB, WS_END = WS_PB + 16 * MiB;
constexpr int NPH_LAYER = 13, NPHASES = 1 + NPH_LAYER * DEPTH;
constexpr int LDS_BYTES = 131072 + 1024 + 8192;
namespace pg8 {
#define PG8_LAS __attribute__((address_space(3)))
typedef unsigned short bf16_t;
typedef short bf16x8 __attribute__((ext_vector_type(8)));
typedef float f32x4 __attribute__((ext_vector_type(4)));
typedef unsigned u32x4 __attribute__((ext_vector_type(4)));
constexpr int BM = 256, BK = 64, HALF = 128, HTB = HALF * BK * 2  , STAGE_BYTES = 8 * HTB, NXCD = 8, WGM = 8;

__host__ __device__ __forceinline__ int lds_byte(int r, int c) { const int st = (r >> 4) * 2 + (c >> 5), rr = r & 15, cc = c & 31, ob = rr * 64 + cc * 2; return st * 1024 + (ob ^ (((ob >> 9) & 1) << 5)); }
__host__ __device__ __forceinline__ void stage_rc(int b, int& R, int& C) { const int st = b / 1024, sb = b % 1024, swz = sb ^ (((sb >> 9) & 1) << 5); R = (st >> 1) * 16 + swz / 64; C = (st & 1) * 32 + (swz % 64) / 2; }
__host__ __device__ __forceinline__ int perm32(int rho) { const int n = rho >> 4, i = rho & 15; return 8 * (i >> 2) + 4 * n + (i & 3); }

struct Unit { int pm, pn; };
struct Gemm { const bf16_t* A; const bf16_t* Bt; int M, N, K; };

struct StaticOrder {
    int nM, nN, nwg, G, c;
    __host__ __device__ void init(int M, int N, int G_, int c_) { nM = M / BM; nN = N / BM; nwg = nM * nN; G = G_; c = c_; }
    __host__ __device__ bool next(int i, Unit& u) const {
        const long L = (long)i * G + c; if (L >= nwg) return false;
        int wgid = (int)L; { const int q = nwg / NXCD, r = nwg % NXCD, xcd = wgid % NXCD, off = wgid / NXCD; wgid = (xcd < r ? xcd * (q + 1) : r * (q + 1) + (xcd - r) * q) + off; }
        const int nig = WGM * nN, gid = wgid / nig, fm = gid * WGM, gsz = (nM - fm) < WGM ? (nM - fm) : WGM;
        u.pm = fm + ((wgid % nig) % gsz); u.pn = (wgid % nig) / gsz; return true;
    }
    __device__ __forceinline__ void a_ready(const Unit&) const {}
    __device__ __forceinline__ void done(const Unit&) const {}
};
typedef __bf16 bf16x2_t __attribute__((ext_vector_type(2)));
typedef float f32x2_t __attribute__((ext_vector_type(2)));
__device__ __forceinline__ unsigned cvt_pk_bf16(float lo, float hi) { const f32x2_t f = {lo, hi}; const bf16x2_t v = __builtin_convertvector(f, bf16x2_t); return __builtin_bit_cast(unsigned, v); }
__device__ __forceinline__ float bf_lo(unsigned w) { return __builtin_bit_cast(float, w << 16); }
__device__ __forceinline__ float bf_hi(unsigned w) { return __builtin_bit_cast(float, w & 0xffff0000u); }
__device__ __forceinline__ float sigmoidf_(float x) { return __builtin_amdgcn_rcpf(1.0f + __expf(-x)); }
enum { EM_ROUTE_A = 0, EM_ROUTE_B = 1, EM_GATE1 = 2, EM_GATE2 = 3, EM_PLAIN = 4, EM_SWIGLU = 5, EM_PLE2 = 6 };
struct Epi {
    static constexpr bool PERM = true, AFTER_DRAIN = false;
    int mode; unsigned char* rbase; unsigned char* ggbase; bf16_t* out; const bf16_t* aux; unsigned* dbgmark; const float* gqn; const float* gkn; PG8_LAS float* xlds;
    __device__ __forceinline__ void operator()(const f32x4 (&acc)[2][2][4][2], const Unit& u, int wr, int wc, int fr, int fq) const {
        const int row0 = u.pm * BM + wr * 64 + fr, lc0 = wc * 32 + 8 * fq;
#if MK_DEBUG
#endif
        if (mode == EM_SWIGLU) {
#pragma unroll
            for (int ai = 0; ai < 2; ++ai)
#pragma unroll
                for (int m = 0; m < 4; ++m) { const size_t row = (size_t)(row0 + ai * HALF + m * 16);
                    float o[8];
#pragma unroll
                    for (int n = 0; n < 2; ++n)
#pragma unroll
                        for (int j = 0; j < 4; ++j) { const float g = acc[ai][0][m][n][j], up = acc[ai][1][m][n][j]; o[4 * n + j] = g * sigmoidf_(g) * up; }
                    u32x4 w; w.x = cvt_pk_bf16(o[0], o[1]); w.y = cvt_pk_bf16(o[2], o[3]); w.z = cvt_pk_bf16(o[4], o[5]); w.w = cvt_pk_bf16(o[6], o[7]);
                    *(u32x4*)(out + row * 2816 + u.pn * 128 + lc0) = w; }
            return;
        }
        if (mode == EM_ROUTE_B && u.pn <= 4) {
            const bool isk = u.pn == 4; const float* g = isk ? gkn : gqn;
            bf16_t* qb = (bf16_t*)(rbase + (isk ? R_K : R_Q)); const int ldq = isk ? 256 : 1024, ctq = isk ? 0 : u.pn * 256;
            const int axis = wc >> 1, jb = 16 * (wc & 1) + 4 * fq;
            const f32x4 g1 = *(const f32x4*)(g + axis * 64 + jb), g2 = *(const f32x4*)(g + axis * 64 + 32 + jb);
            float inv[4];
#pragma unroll
            for (int e = 0; e < 4; ++e) inv[e] = __builtin_amdgcn_exp2f(-(float)(jb + e) * (13.287712379549449f / 32.0f)) * 0.15915494309189535f;
            const int rit = wr * 64 + fr;
#pragma unroll
            for (int ai = 0; ai < 2; ++ai)
#pragma unroll
                for (int m = 0; m < 4; ++m)
#pragma unroll
                    for (int bj = 0; bj < 2; ++bj) { const f32x4 a0 = acc[ai][bj][m][0], a1 = acc[ai][bj][m][1];
                        float ss = (a0[0] * a0[0] + a0[1] * a0[1]) + (a0[2] * a0[2] + a0[3] * a0[3]) + (a1[0] * a1[0] + a1[1] * a1[1]) + (a1[2] * a1[2] + a1[3] * a1[3]);
                        ss += __shfl_xor(ss, 16); ss += __shfl_xor(ss, 32);
                        if (fq == 0) xlds[((ai * HALF + m * 16 + rit) * 2 + bj) * 4 + wc] = ss; }
            asm volatile("s_waitcnt lgkmcnt(0)" ::: "memory"); __builtin_amdgcn_s_barrier(); asm volatile("" ::: "memory");
#pragma unroll
            for (int ai = 0; ai < 2; ++ai)
#pragma unroll
                for (int m = 0; m < 4; ++m) { const size_t row = (size_t)(row0 + ai * HALF + m * 16); const int sp = (int)row & 4095; const float pos = (float)(axis == 0 ? (sp >> 6) : (sp & 63));
                    float cs[4], sn[4];
#pragma unroll
                    for (int e = 0; e < 4; ++e) { const float rf = __builtin_amdgcn_fractf(pos * inv[e]); cs[e] = __builtin_amdgcn_cosf(rf); sn[e] = __builtin_amdgcn_sinf(rf); }
#pragma unroll
                    for (int bj = 0; bj < 2; ++bj) { const f32x4 pp = *(const PG8_LAS f32x4*)(xlds + ((ai * HALF + m * 16 + rit) * 2 + bj) * 4);
                        const float rs = rsqrtf(((pp[0] + pp[1]) + (pp[2] + pp[3])) * (1.0f / 128.0f) + 1e-6f);
                        const f32x4 x1 = acc[ai][bj][m][0] * rs * g1, x2 = acc[ai][bj][m][1] * rs * g2;
                        float o1[4], o2[4];
#pragma unroll
                        for (int e = 0; e < 4; ++e) { o1[e] = x1[e] * cs[e] - x2[e] * sn[e]; o2[e] = x2[e] * cs[e] + x1[e] * sn[e]; }
                        bf16_t* dst = qb + row * ldq + ctq + bj * HALF + axis * 64 + jb;
                        typedef unsigned u32x2e __attribute__((ext_vector_type(2)));
                        u32x2e w1, w2; w1.x = cvt_pk_bf16(o1[0], o1[1]); w1.y = cvt_pk_bf16(o1[2], o1[3]); w2.x = cvt_pk_bf16(o2[0], o2[1]); w2.y = cvt_pk_bf16(o2[2], o2[3]);
                        *(u32x2e*)dst = w1; *(u32x2e*)(dst + 32) = w2; } }
            return;
        }
        bf16_t* base = out; int ld = 1024, ct = u.pn * BM; bool is_ra = false;
        if (mode == EM_ROUTE_A) { const int pn = u.pn;
            if (pn < 2) { base = (bf16_t*)(rbase + R_GQ); ld = 512; ct = pn * 256; }
            else if (pn < 4) { base = (bf16_t*)(rbase + R_GK); ld = 512; ct = (pn - 2) * 256; }
            else if (pn < 8) { base = (bf16_t*)(rbase + R_GV); ld = 1024; ct = (pn - 4) * 256; }
            else if (pn < 12) { base = (bf16_t*)ggbase; ld = 1024; ct = (pn - 8) * 256; }
            else is_ra = true;
        } else if (mode == EM_ROUTE_B) { const int pn = u.pn;
            if (pn < 4) { base = (bf16_t*)(rbase + R_Q); ld = 1024; ct = pn * 256; }
            else if (pn == 4) { base = (bf16_t*)(rbase + R_K); ld = 256; ct = 0; }
            else if (pn == 5) { base = (bf16_t*)(rbase + R_V); ld = 256; ct = 0; }
            else if (pn < 10) { base = (bf16_t*)(rbase + R_GA); ld = 1024; ct = (pn - 6) * 256; }
            else { base = (bf16_t*)(rbase + R_GB); ld = 1024; ct = (pn - 10) * 256; }
        }
        if (is_ra) {
            if (wc == 0) { float* ra = (float*)(rbase + R_RA);
#pragma unroll
                for (int ai = 0; ai < 2; ++ai)
#pragma unroll
                    for (int m = 0; m < 4; ++m) { const size_t row = (size_t)(row0 + ai * HALF + m * 16);
                        *(f32x4*)(ra + row * 32 + 8 * fq) = acc[ai][0][m][0]; *(f32x4*)(ra + row * 32 + 8 * fq + 4) = acc[ai][0][m][1]; } }
            return;
        }
#pragma unroll
        for (int ai = 0; ai < 2; ++ai)
#pragma unroll
            for (int m = 0; m < 4; ++m) { const size_t row = (size_t)(row0 + ai * HALF + m * 16);
#pragma unroll
                for (int bj = 0; bj < 2; ++bj) { const int col = ct + bj * HALF + lc0;
                    float o[8];
#pragma unroll
                    for (int n = 0; n < 2; ++n)
#pragma unroll
                        for (int j = 0; j < 4; ++j) o[4 * n + j] = acc[ai][bj][m][n][j];
                    if (mode == EM_GATE1 || mode == EM_GATE2 || mode == EM_PLE2) {
                        const u32x4 a = *(const u32x4*)(aux + row * 1024 + col);
                        const float av[8] = {bf_lo(a.x), bf_hi(a.x), bf_lo(a.y), bf_hi(a.y), bf_lo(a.z), bf_hi(a.z), bf_lo(a.w), bf_hi(a.w)};
                        if (mode == EM_PLE2) {
#pragma unroll
                            for (int j = 0; j < 8; ++j) o[j] = sigmoidf_(o[j]) * av[j];
                        } else {
#pragma unroll
                            for (int j = 0; j < 8; ++j) o[j] = sigmoidf_(av[j]) * o[j];
                            if (mode == EM_GATE2) { const u32x4 p = *(const u32x4*)(base + row * ld + col);
                                o[0] += bf_lo(p.x); o[1] += bf_hi(p.x); o[2] += bf_lo(p.y); o[3] += bf_hi(p.y); o[4] += bf_lo(p.z); o[5] += bf_hi(p.z); o[6] += bf_lo(p.w); o[7] += bf_hi(p.w); }
                        }
                    }
                    u32x4 w; w.x = cvt_pk_bf16(o[0], o[1]); w.y = cvt_pk_bf16(o[2], o[3]); w.z = cvt_pk_bf16(o[4], o[5]); w.w = cvt_pk_bf16(o[6], o[7]);
                    *(u32x4*)(base + row * ld + col) = w;
#if MK_DEBUG
                    if (dbgmark && ai == 0 && m == 0 && bj == 0 && wr == 0 && wc == 0 && fr == 0 && fq == 0) { unsigned* mk = dbgmark + (u.pm * 32 + u.pn) * 4; const unsigned long long ad = (unsigned long long)(base + row * ld + col);
                        mk[0] = (unsigned)ad; mk[1] = (unsigned)(ad >> 32); mk[2] = w.x; mk[3] = 1u; }
#endif
                    } }
    }
};
template <class Epi, class Sched, bool ALIGN_EPI = false, bool SP2 = false>
__device__ __forceinline__ void gemm_phase(PG8_LAS unsigned char* lds, const Gemm g, const Sched& S, const Epi& E) {
    const int tid = opaque_tid(), wid = __builtin_amdgcn_readfirstlane(tid >> 6), lane = tid & 63, wr = wid >> 2, wc = wid & 3, fr = lane & 15, fq = lane >> 4;
    const int K = g.K, nt = K / BK;
    unsigned voffA[2], voffB[2];
#pragma unroll
    for (int i = 0; i < 2; ++i) { int R, C; stage_rc(tid * 16 + i * 8192, R, C); const int Rb = Epi::PERM ? ((R & ~31) + perm32(R & 31)) : R;
        voffA[i] = (unsigned)(R * K + C) * 2u; voffB[i] = (unsigned)(Rb * K + C) * 2u; }
    const size_t kstep = (size_t)(BK * 2);
    const size_t hstep = (size_t)HALF * K * 2;
    const size_t tstep = 2 * hstep;
    const unsigned ldsw = (unsigned)wid * 1024u;
    const int aoff = lds_byte(wr * 64 + fr, fq * 8), boff = lds_byte(wc * 32 + fr, fq * 8);
#define PG8_SA(b, h) (((b) * 2 + (h)) * HTB)
#define PG8_SB(b, h) ((4 + (b) * 2 + (h)) * HTB)
#define PG8_STAGE(bufoff, gbase, voff) do { _Pragma("unroll") for (int _i = 0; _i < 2; ++_i) \
        __builtin_amdgcn_global_load_lds((const unsigned*)((const char*)(gbase) + (voff)[_i]), (PG8_LAS unsigned*)(lds + (bufoff) + ldsw + _i * 8192), 16, 0, 0); } while (0)
#define PG8_LDA(dst, b, h) do { _Pragma("unroll") for (int m = 0; m < 4; ++m) _Pragma("unroll") for (int k = 0; k < 2; ++k) dst[m][k] = *(const PG8_LAS bf16x8*)(lds + PG8_SA(b, h) + aoff + m * 2048 + k * 1024); } while (0)
#define PG8_LDB(dst, b, h) do { _Pragma("unroll") for (int n = 0; n < 2; ++n) _Pragma("unroll") for (int k = 0; k < 2; ++k) dst[n][k] = *(const PG8_LAS bf16x8*)(lds + PG8_SB(b, h) + boff + n * 2048 + k * 1024); } while (0)
#define PG8_MMA(ai, bj, At, Bt) do { __builtin_amdgcn_s_setprio(1); _Pragma("unroll") for (int m = 0; m < 4; ++m) _Pragma("unroll") for (int n = 0; n < 2; ++n) _Pragma("unroll") for (int k = 0; k < 2; ++k) \
        acc[ai][bj][m][n] = __builtin_amdgcn_mfma_f32_16x16x32_bf16(Bt[n][k], At[m][k], acc[ai][bj][m][n], 0, 0, 0); __builtin_amdgcn_s_setprio(0); } while (0)
#define PG8_WAIT_V(n) asm volatile("s_waitcnt vmcnt(" #n ")" ::: "memory")
#define PG8_WAIT_L(n) asm volatile("s_waitcnt lgkmcnt(" #n ")" ::: "memory")
#define PG8_BAR __builtin_amdgcn_s_barrier()
#define PG8_SCHED __builtin_amdgcn_sched_barrier(0)
    Unit cur, nxt; int ui = 0;
    if (!S.next(0, cur)) return;
    f32x4 acc[2][2][4][2];
#pragma unroll
    for (int a = 0; a < 2; ++a)
#pragma unroll
        for (int b = 0; b < 2; ++b)
#pragma unroll
            for (int m = 0; m < 4; ++m)
#pragma unroll
                for (int n = 0; n < 2; ++n) acc[a][b][m][n] = (f32x4){0.f, 0.f, 0.f, 0.f};
    bf16x8 At[4][2], B0[2][2], B1[2][2];
    const char* cA = (const char*)g.A + (size_t)cur.pm * tstep; const char* cB = (const char*)g.Bt + (size_t)cur.pn * tstep;
    S.a_ready(cur);
    if constexpr (SP2) {
        PG8_STAGE(PG8_SB(0, 0), cB, voffB); PG8_STAGE(PG8_SB(0, 1), cB + hstep, voffB); PG8_STAGE(PG8_SA(0, 0), cA, voffA); PG8_STAGE(PG8_SA(0, 1), cA + hstep, voffA);
        if (wr == 1) PG8_BAR;
        PG8_WAIT_V(2); PG8_BAR;
        PG8_STAGE(PG8_SB(1, 0), cB + kstep, voffB); PG8_STAGE(PG8_SA(1, 0), cA + kstep, voffA); PG8_STAGE(PG8_SB(1, 1), cB + hstep + kstep, voffB);
        PG8_WAIT_V(6); PG8_BAR;
    } else {
        PG8_STAGE(PG8_SB(0, 0), cB, voffB); PG8_STAGE(PG8_SA(0, 0), cA, voffA); PG8_STAGE(PG8_SB(0, 1), cB + hstep, voffB); PG8_STAGE(PG8_SA(0, 1), cA + hstep, voffA);
        if (wr == 1) PG8_BAR;
        PG8_WAIT_V(4); PG8_BAR;
        PG8_STAGE(PG8_SB(1, 0), cB + kstep, voffB); PG8_STAGE(PG8_SA(1, 0), cA + kstep, voffA); PG8_STAGE(PG8_SB(1, 1), cB + hstep + kstep, voffB);
        PG8_WAIT_V(6); PG8_BAR;
    }
    for (;;) {
        const bool has_next = S.next(ui + 1, nxt);
        const char* nA = has_next ? (const char*)g.A + (size_t)nxt.pm * tstep : cA; const char* nB = has_next ? (const char*)g.Bt + (size_t)nxt.pn * tstep : cB;
        for (int t = 0; t < nt; t += 2) {
            const bool last = (t == nt - 2);
            const char* a1 = cA + (size_t)(t + 1) * kstep;
            const char* a2 = last ? nA : cA + (size_t)(t + 2) * kstep; const char* b2 = last ? nB : cB + (size_t)(t + 2) * kstep;
            const char* a3 = a2 + kstep; const char* b3 = b2 + kstep;
            if (last && has_next) S.a_ready(nxt);
            if constexpr (SP2) {
            PG8_LDB(B0, 0, 0); PG8_LDB(B1, 0, 1); PG8_SCHED; PG8_LDA(At, 0, 0); PG8_STAGE(PG8_SA(1, 1), a1 + hstep, voffA);
            PG8_WAIT_V(8); PG8_WAIT_L(0); PG8_BAR; PG8_MMA(0, 0, At, B0); PG8_MMA(0, 1, At, B1); PG8_BAR; PG8_SCHED;
            PG8_LDA(At, 0, 1); PG8_STAGE(PG8_SB(0, 0), b2, voffB); PG8_STAGE(PG8_SB(0, 1), b2 + hstep, voffB); PG8_STAGE(PG8_SA(0, 0), a2, voffA);
            PG8_WAIT_V(8); PG8_WAIT_L(0); PG8_BAR; PG8_MMA(1, 0, At, B0); PG8_MMA(1, 1, At, B1); PG8_BAR; PG8_SCHED;
            PG8_LDB(B0, 1, 0); PG8_LDB(B1, 1, 1); PG8_SCHED; PG8_LDA(At, 1, 0); PG8_STAGE(PG8_SA(0, 1), a2 + hstep, voffA);
            PG8_WAIT_V(8); PG8_WAIT_L(0); PG8_BAR; PG8_MMA(0, 0, At, B0); PG8_MMA(0, 1, At, B1); PG8_BAR; PG8_SCHED;
            PG8_LDA(At, 1, 1); PG8_STAGE(PG8_SB(1, 0), b3, voffB); PG8_STAGE(PG8_SB(1, 1), b3 + hstep, voffB); PG8_STAGE(PG8_SA(1, 0), a3, voffA);
            PG8_WAIT_V(8); PG8_WAIT_L(0); PG8_BAR; PG8_MMA(1, 0, At, B0); PG8_MMA(1, 1, At, B1); PG8_BAR; PG8_SCHED;
            } else {
            PG8_LDB(B0, 0, 0); PG8_SCHED; PG8_LDA(At, 0, 0); PG8_STAGE(PG8_SA(1, 1), a1 + hstep, voffA);
            PG8_WAIT_L(8); PG8_BAR; PG8_WAIT_L(0); PG8_MMA(0, 0, At, B0); PG8_BAR; PG8_SCHED;
            PG8_LDB(B1, 0, 1); PG8_STAGE(PG8_SB(0, 0), b2, voffB);
            PG8_BAR; PG8_WAIT_L(0); PG8_MMA(0, 1, At, B1); PG8_BAR;
            PG8_LDA(At, 0, 1); PG8_STAGE(PG8_SA(0, 0), a2, voffA);
            PG8_BAR; PG8_WAIT_L(0); PG8_MMA(1, 0, At, B0); PG8_BAR; PG8_SCHED;
            PG8_STAGE(PG8_SB(0, 1), b2 + hstep, voffB);
            PG8_WAIT_V(6); PG8_BAR; PG8_MMA(1, 1, At, B1); PG8_BAR;
            PG8_LDB(B0, 1, 0); PG8_SCHED; PG8_LDA(At, 1, 0); PG8_STAGE(PG8_SA(0, 1), a2 + hstep, voffA);
            PG8_WAIT_L(8); PG8_BAR; PG8_WAIT_L(0); PG8_MMA(0, 0, At, B0); PG8_BAR; PG8_SCHED;
            PG8_LDB(B1, 1, 1); PG8_STAGE(PG8_SB(1, 0), b3, voffB);
            PG8_BAR; PG8_WAIT_L(0); PG8_MMA(0, 1, At, B1); PG8_BAR;
            PG8_LDA(At, 1, 1); PG8_STAGE(PG8_SA(1, 0), a3, voffA);
            PG8_BAR; PG8_WAIT_L(0); PG8_MMA(1, 0, At, B0); PG8_BAR; PG8_SCHED;
            PG8_STAGE(PG8_SB(1, 1), b3 + hstep, voffB);
            PG8_WAIT_V(6); PG8_BAR; PG8_MMA(1, 1, At, B1); PG8_BAR;
            }
        }
        if constexpr (ALIGN_EPI) { if (wr == 0) PG8_BAR; }
        if constexpr (!Epi::AFTER_DRAIN) { E(acc, cur, wr, wc, fr, fq); S.done(cur); }
        if (!has_next) break;
#pragma unroll
        for (int a = 0; a < 2; ++a)
#pragma unroll
            for (int b = 0; b < 2; ++b)
#pragma unroll
                for (int m = 0; m < 4; ++m)
#pragma unroll
                    for (int n = 0; n < 2; ++n) acc[a][b][m][n] = (f32x4){0.f, 0.f, 0.f, 0.f};
        cur = nxt; cA = nA; cB = nB; ++ui;
        if constexpr (ALIGN_EPI) { if (wr == 1) PG8_BAR; }
    }
    PG8_WAIT_V(0);
    if constexpr (!ALIGN_EPI) { if (wr == 0) PG8_BAR; }
    PG8_BAR;
    if constexpr (Epi::AFTER_DRAIN) { E.fused(acc, cur, wr, wc, fr, fq, lds, wid, lane); S.done(cur); }
#undef PG8_SA
#undef PG8_SB
#undef PG8_STAGE
#undef PG8_LDA
#undef PG8_LDB
#undef PG8_MMA
#undef PG8_WAIT_V
#undef PG8_WAIT_L
#undef PG8_BAR
#undef PG8_SCHED
}
}
namespace attn {
using bf16 = __hip_bfloat16;
constexpr int   D = 128, NW = 8, QBLK = 32, KVBLK = 64;
constexpr float SCALE = 0.088388347648318440f;
constexpr float THR = 8.f;
constexpr int SDEPTH = 2;
constexpr int LDQ = 1024, LDK = 256, LDO = 1024;
constexpr size_t SHM_V = KVBLK * D * 2, SHM_K = KVBLK * D * 2, SHM_ATTN = 2 * SHM_V + 2 * SHM_K + NW * 64 * 4;
using bf16x8 = __attribute__((ext_vector_type(8))) short;
using s16x4  = __attribute__((ext_vector_type(4))) short;
using f32x16 = __attribute__((ext_vector_type(16))) float;
using f32x8  = __attribute__((ext_vector_type(8))) float;
using u32x4  = __attribute__((ext_vector_type(4))) unsigned;
#define KSWZ(row, colB) ((row) * 256 + ((colB) ^ (((row) & 7) << 4)))
#define SBAR() __builtin_amdgcn_sched_barrier(0)
__device__ __forceinline__ int crow(int r, int hi) { return (r & 3) + 8 * (r >> 2) + 4 * hi; }
__device__ __forceinline__ unsigned cvtpk(float lo, float hi) {
  unsigned r; asm volatile("v_cvt_pk_bf16_f32 %0, %1, %2" : "=v"(r) : "v"(lo), "v"(hi)); return r;
}
template <typename TIn> struct Stage;
template <> struct Stage<bf16>  { using T = bf16x8;
  __device__ static __forceinline__ T ld8(const bf16* p) { return *reinterpret_cast<const bf16x8*>(p); }
  __device__ static __forceinline__ bf16x8 tobf(T x) { return x; } };
template <> struct Stage<float> { using T = f32x8;
  __device__ static __forceinline__ T ld8(const float* p) { return *reinterpret_cast<const f32x8*>(p); }
  __device__ static __forceinline__ bf16x8 tobf(T x) {
    u32x4 w = {cvtpk(x[0], x[1]), cvtpk(x[2], x[3]), cvtpk(x[4], x[5]), cvtpk(x[6], x[7])}; return *reinterpret_cast<bf16x8*>(&w); } };

__device__ __forceinline__ void partialSM(f32x16& p0, f32x16& p1, float& m_reg, float& mn, float& alpha) {
  constexpr float C = SCALE * 1.4426950408889634f;
  float pmax = p0[0]; for (int r = 1; r < 16; ++r) pmax = fmaxf(pmax, p0[r]); for (int r = 0; r < 16; ++r) pmax = fmaxf(pmax, p1[r]);
  { auto rr = __builtin_amdgcn_permlane32_swap(__float_as_uint(pmax), __float_as_uint(pmax), false, false);
    pmax = fmaxf(__uint_as_float(rr[0]), __uint_as_float(rr[1])); }
  if (__builtin_expect(__all(pmax - m_reg <= THR / SCALE), 1)) { mn = m_reg; alpha = 1.f; }
  else { mn = fmaxf(m_reg, pmax); alpha = __builtin_amdgcn_exp2f((m_reg - mn) * C); m_reg = mn; }
  float mnC = -mn * C;
  for (int r = 0; r < 16; ++r) p0[r] = fmaf(p0[r], C, mnC); for (int r = 0; r < 16; ++r) p1[r] = fmaf(p1[r], C, mnC);
  for (int r = 0; r < 16; ++r) p0[r] = __builtin_amdgcn_exp2f(p0[r]);
}
__device__ __forceinline__ void finishSM(f32x16& p0, f32x16& p1, float alpha, float& l_reg, bf16x8& pa0, bf16x8& pa1, bf16x8& pa2, bf16x8& pa3) {
  for (int r = 0; r < 16; ++r) p1[r] = __builtin_amdgcn_exp2f(p1[r]);
  float ps = 0; for (int r = 0; r < 16; ++r) ps += p0[r]; for (int r = 0; r < 16; ++r) ps += p1[r];
  { auto rr = __builtin_amdgcn_permlane32_swap(__float_as_uint(ps), __float_as_uint(ps), false, false);
    ps = __uint_as_float(rr[0]) + __uint_as_float(rr[1]); }
  l_reg = l_reg * alpha + ps;
#define PK4(P, BASE, OUT) do { unsigned a0 = cvtpk(P[BASE + 0], P[BASE + 1]), a1 = cvtpk(P[BASE + 2], P[BASE + 3]);   \
    unsigned b0 = cvtpk(P[BASE + 4], P[BASE + 5]), b1 = cvtpk(P[BASE + 6], P[BASE + 7]);                              \
    auto r0 = __builtin_amdgcn_permlane32_swap(a0, b0, false, false); auto r1 = __builtin_amdgcn_permlane32_swap(a1, b1, false, false); \
    u32x4 w = {r0[0], r1[0], r0[1], r1[1]}; OUT = *reinterpret_cast<bf16x8*>(&w); } while (0)
  PK4(p0, 0, pa0); PK4(p0, 8, pa1); PK4(p1, 0, pa2); PK4(p1, 8, pa3);
#undef PK4
}
__device__ __forceinline__ void qkt(f32x16& p0, f32x16& p1, const bf16* Ks, const bf16x8* qr, int r32, int hi) {
  p0 = f32x16{}; p1 = f32x16{};
  for (int d0 = 0; d0 < 8; ++d0) { int cb = (d0 * 16 + hi * 8) * 2;
    bf16x8 b0 = *reinterpret_cast<const bf16x8*>((const char*)Ks + KSWZ(r32, cb));
    bf16x8 b1 = *reinterpret_cast<const bf16x8*>((const char*)Ks + KSWZ(32 + r32, cb));
    p0 = __builtin_amdgcn_mfma_f32_32x32x16_bf16(b0, qr[d0], p0, 0, 0, 0);
    p1 = __builtin_amdgcn_mfma_f32_32x32x16_bf16(b1, qr[d0], p1, 0, 0, 0); }
}
__device__ __forceinline__ int v_st(int k, int c) { const int kk = (k & ~0xC) | ((k & 4) << 1) | ((k & 8) >> 1); return ((kk >> 3) * 4 + (c >> 5)) * 512 + ((kk & 7) * 32 + (c & 31)) * 2; }
__device__ __forceinline__ int v_rd_base(int lane) { return ((lane & 3) << 3) | (((lane >> 2) & 3) << 6) | (((lane >> 4) & 1) << 5) | (((lane >> 5) & 1) << 8); }
constexpr int v_rd_off(int d0, int ks, int half) { return d0 * 512 + ks * 4096 + half * 2048; }
template <int OFF> __device__ __forceinline__ s16x4 tr_read(int vb) {
  s16x4 r; asm volatile("ds_read_b64_tr_b16 %0, %1 offset:%2" : "=&v"(r) : "v"(vb), "i"(OFF) : "memory"); return r;
}
template <int D0> __device__ __forceinline__ void pv_one(f32x16& od, int vb, bf16x8 pa0, bf16x8 pa1, bf16x8 pa2, bf16x8 pa3) {
  const s16x4 l0 = tr_read<v_rd_off(D0, 0, 0)>(vb), h0 = tr_read<v_rd_off(D0, 0, 1)>(vb), l1 = tr_read<v_rd_off(D0, 1, 0)>(vb), h1 = tr_read<v_rd_off(D0, 1, 1)>(vb);
  const s16x4 l2 = tr_read<v_rd_off(D0, 2, 0)>(vb), h2 = tr_read<v_rd_off(D0, 2, 1)>(vb), l3 = tr_read<v_rd_off(D0, 3, 0)>(vb), h3 = tr_read<v_rd_off(D0, 3, 1)>(vb);
  asm volatile("s_waitcnt lgkmcnt(0)" ::: "memory"); SBAR();
#define PK(L, H) (bf16x8){L[0], L[1], L[2], L[3], H[0], H[1], H[2], H[3]}
  od = __builtin_amdgcn_mfma_f32_32x32x16_bf16(pa0, PK(l0, h0), od, 0, 0, 0);
  od = __builtin_amdgcn_mfma_f32_32x32x16_bf16(pa1, PK(l1, h1), od, 0, 0, 0);
  od = __builtin_amdgcn_mfma_f32_32x32x16_bf16(pa2, PK(l2, h2), od, 0, 0, 0);
  od = __builtin_amdgcn_mfma_f32_32x32x16_bf16(pa3, PK(l3, h3), od, 0, 0, 0);
#undef PK
}
__device__ __forceinline__ void pv_d0(f32x16* o, int vb, bf16x8 pa0, bf16x8 pa1, bf16x8 pa2, bf16x8 pa3) {
  pv_one<0>(o[0], vb, pa0, pa1, pa2, pa3); pv_one<1>(o[1], vb, pa0, pa1, pa2, pa3); pv_one<2>(o[2], vb, pa0, pa1, pa2, pa3); pv_one<3>(o[3], vb, pa0, pa1, pa2, pa3);
}

template <typename TQ>
__device__ __forceinline__ void attn_dense_body(const TQ* Qb, const bf16* Kh, const bf16* Vh,
                                                unsigned short* Ob, int seq, char* lds) {
  using St = Stage<bf16>; using SQ = Stage<TQ>;
  const int tid = opaque_tid(), wid = tid >> 6, lane = tid & 63, r32 = lane & 31, hi = lane >> 5;
  bf16* V_lds = (bf16*)lds; bf16* K_lds = (bf16*)(lds + 2 * SHM_V);
  float* ws = (float*)(lds + 2 * SHM_V + 2 * SHM_K) + wid * 64; float* li_l = ws; float* al_l = ws + 32;
  float m_reg = -1e30f, l_reg = 0; f32x16 o[4] = {}; bf16x8 qr[8];
  const TQ* Qw = Qb + (long)(wid * QBLK + r32) * LDQ + hi * 8;
#pragma unroll
  for (int d0 = 0; d0 < 8; ++d0) qr[d0] = SQ::tobf(SQ::ld8(Qw + d0 * 16));
  const int sr = tid >> 4, sc = (tid & 15) * 8, vst0 = v_st(sr, sc), vst1 = v_st(32 + sr, sc);
  const int vb0 = (int)(uintptr_t)V_lds + v_rd_base(lane);
  struct { typename St::T vs0, vs1, ks0, ks1; } sr_[SDEPTH];
#define SLOAD(i, k0) do { sr_[i].vs0 = St::ld8(&Vh[(long)((k0) + sr) * LDK + sc]); sr_[i].vs1 = St::ld8(&Vh[(long)((k0) + 32 + sr) * LDK + sc]); \
    sr_[i].ks0 = St::ld8(&Kh[(long)((k0) + sr) * LDK + sc]); sr_[i].ks1 = St::ld8(&Kh[(long)((k0) + 32 + sr) * LDK + sc]); } while (0)
#define SWRITE(b, i) do { *(bf16x8*)((char*)V_lds + (b) * SHM_V + vst0) = St::tobf(sr_[i].vs0);          \
    *(bf16x8*)((char*)V_lds + (b) * SHM_V + vst1) = St::tobf(sr_[i].vs1); int kc = sc * 2;               \
    *(bf16x8*)((char*)K_lds + (b) * SHM_K + KSWZ(sr, kc)) = St::tobf(sr_[i].ks0);                       \
    *(bf16x8*)((char*)K_lds + (b) * SHM_K + KSWZ(32 + sr, kc)) = St::tobf(sr_[i].ks1); } while (0)
#define SWAIT() do { if constexpr (SDEPTH == 2) asm volatile("s_waitcnt vmcnt(4)" ::: "memory"); else asm volatile("s_waitcnt vmcnt(0)" ::: "memory"); } while (0)
#define RESC(a) do { if (__any((a) < 1.f)) { if (hi == 0) al_l[r32] = (a); asm volatile("s_waitcnt lgkmcnt(0)" ::: "memory"); \
    for (int d = 0; d < 4; ++d) for (int r = 0; r < 16; ++r) o[d][r] *= al_l[crow(r, hi)]; } } while (0)
  f32x16 pA0, pA1, pB0, pB1; float mnA, mnB, alA, alB; bf16x8 pa0, pa1, pa2, pa3; const int NT = seq / KVBLK;
  constexpr int SE = 0, SO = SDEPTH - 1;
  SLOAD(SE, 0); asm volatile("s_waitcnt vmcnt(0)" ::: "memory"); SWRITE(0, SE); __syncthreads();
  qkt(pA0, pA1, K_lds, qr, r32, hi); partialSM(pA0, pA1, m_reg, mnA, alA);
  SLOAD(SO, KVBLK); if constexpr (SDEPTH == 2) { if (2 < NT) SLOAD(SE, 2 * KVBLK); }
  SWAIT(); SWRITE(1, SO); __syncthreads();
  for (int j = 1; j + 1 < NT; j += 2) {
    SBAR(); qkt(pB0, pB1, (bf16*)((char*)K_lds + SHM_K), qr, r32, hi);
    finishSM(pA0, pA1, alA, l_reg, pa0, pa1, pa2, pa3); SBAR();
    SLOAD(SO, (j + SDEPTH) * KVBLK); SBAR();
    pv_d0(o, vb0, pa0, pa1, pa2, pa3); partialSM(pB0, pB1, m_reg, mnB, alB);
    __syncthreads(); SWAIT(); SWRITE(0, SE);
    RESC(alB); __syncthreads();
    SBAR(); qkt(pA0, pA1, K_lds, qr, r32, hi);
    finishSM(pB0, pB1, alB, l_reg, pa0, pa1, pa2, pa3); SBAR();
    if (SDEPTH == 1 || j + 3 < NT) SLOAD(SE, (j + 1 + SDEPTH) * KVBLK); SBAR();
    pv_d0(o, vb0 + (int)SHM_V, pa0, pa1, pa2, pa3); partialSM(pA0, pA1, m_reg, mnA, alA);
    __syncthreads(); SWAIT(); SWRITE(1, SO);
    RESC(alA); __syncthreads();
  }
  SBAR(); qkt(pB0, pB1, (bf16*)((char*)K_lds + SHM_K), qr, r32, hi);
  finishSM(pA0, pA1, alA, l_reg, pa0, pa1, pa2, pa3); SBAR();
  pv_d0(o, vb0, pa0, pa1, pa2, pa3); partialSM(pB0, pB1, m_reg, mnB, alB);
  __syncthreads(); RESC(alB);
  finishSM(pB0, pB1, alB, l_reg, pa0, pa1, pa2, pa3); SBAR();
  pv_d0(o, vb0 + (int)SHM_V, pa0, pa1, pa2, pa3);
  if (hi == 0) li_l[r32] = l_reg; asm volatile("s_waitcnt lgkmcnt(0)" ::: "memory");
  float rli[16];
#pragma unroll
  for (int r = 0; r < 16; ++r) rli[r] = __builtin_amdgcn_rcpf(li_l[crow(r, hi)]);
  unsigned short* Ow = Ob + (long)(wid * QBLK) * LDO;
#pragma unroll
  for (int r = 0; r < 16; ++r) { int orow = crow(r, hi);
    for (int d0 = 0; d0 < 4; ++d0) Ow[(long)orow * LDO + d0 * 32 + r32] = (unsigned short)(cvtpk(o[d0][r] * rli[r], 0.f) & 0xffffu); }
#undef SLOAD
#undef SWRITE
#undef SWAIT
#undef RESC
}
}
#define XB_TMO      128
#define XB_XCNT(j)  (256  + 64 * (j))
#define XB_XSUB(j)  (1280 + 64 * (j))
#define XB_XGEN(j)  (2304 + 64 * (j))
#define XB_TOP      3328
#define XB_TOPGEN   3392
#define XCD_BAR_WORDS 3456
#define XB_SPIN_CAP (1u << 18)

__device__ __forceinline__ unsigned xb_ld(unsigned* p)              { return __hip_atomic_load(p, __ATOMIC_RELAXED, __HIP_MEMORY_SCOPE_AGENT); }
__device__ __forceinline__ unsigned xb_add(unsigned* p, unsigned v) { return __hip_atomic_fetch_add(p, v, __ATOMIC_RELAXED, __HIP_MEMORY_SCOPE_AGENT); }
__device__ __forceinline__ unsigned xb_xcc_id() { return (unsigned)__builtin_amdgcn_s_getreg((3 << 11) | 20) & 0xFu; }
#define XB_SPIN(cond, bar) do { unsigned _sp = 0; while (cond) { __builtin_amdgcn_s_sleep(1); \
    if ((++_sp & 255u) == 0u) { if (xb_ld(&(bar)[XB_TMO])) break; if (_sp > XB_SPIN_CAP) { atomicAdd(&(bar)[XB_TMO], 1u); break; } } } } while (0)

struct XcdBarrier {
    unsigned* bar; unsigned x;
    volatile LAS unsigned* st;
};

__device__ __forceinline__ XcdBarrier xcd_barrier_post(unsigned* bar, volatile LAS unsigned* st) {
    XcdBarrier b; b.bar = bar; b.x = xb_xcc_id(); b.st = st;
    if (threadIdx.x == 0) (void)xb_add(&bar[XB_XCNT(b.x)], 1u);
    return b;
}
__device__ __forceinline__ void xcd_barrier_complete(unsigned* bar, unsigned x, unsigned& nloc, unsigned& nx) {
    const unsigned G = gridDim.x * gridDim.y * gridDim.z;
    unsigned sum, cnt, mine, sp = 0u;
    for (;;) {
        sum = 0u; cnt = 0u; mine = 0u;
#pragma unroll
        for (unsigned j = 0; j < 16; ++j) { const unsigned c = xb_ld(&bar[XB_XCNT(j)]); sum += c; cnt += (c > 0u) ? 1u : 0u; mine = (j == x) ? c : mine; }
        if (sum == G) break;
        __builtin_amdgcn_s_sleep(1);
        if ((++sp & 255u) == 0u) { if (xb_ld(&bar[XB_TMO])) break; if (sp > XB_SPIN_CAP) { atomicAdd(&bar[XB_TMO], 1u); break; } }
    }
    nloc = mine > 0u ? mine : 1u; nx = cnt > 0u ? cnt : 1u;
}

__device__ __forceinline__ void xcd_barrier(const XcdBarrier& b) {
    asm volatile("s_waitcnt vmcnt(0)" ::: "memory");
    __syncthreads();
    if (threadIdx.x == 0) {
        unsigned* bar = b.bar;
        __builtin_amdgcn_s_waitcnt(0);
        unsigned nloc = b.st[0], nx = b.st[1];
        if (nloc == 0u) { xcd_barrier_complete(bar, b.x, nloc, nx); b.st[0] = nloc; b.st[1] = nx; }
        const unsigned old = xb_add(&bar[XB_XSUB(b.x)], 1u);
        const unsigned gen = old / nloc;
        if (old + 1u == (gen + 1u) * nloc) {
            __builtin_amdgcn_fence(__ATOMIC_RELEASE, "agent");
            asm volatile("s_waitcnt vmcnt(0)" ::: "memory");
            const unsigned og = xb_add(&bar[XB_TOP], 1u);
            const unsigned tg = og / nx;
            if (og + 1u == (tg + 1u) * nx) xb_add(&bar[XB_TOPGEN], 1u);
            else XB_SPIN(xb_ld(&bar[XB_TOPGEN]) == tg, bar);
            __builtin_amdgcn_fence(__ATOMIC_ACQUIRE, "agent");
            xb_add(&bar[XB_XGEN(b.x)], 1u);
            asm volatile("s_waitcnt vmcnt(0)" ::: "memory");
        } else {
            XB_SPIN(xb_ld(&bar[XB_XGEN(b.x)]) == gen, bar);
            __builtin_amdgcn_fence(__ATOMIC_ACQUIRE, "agent");
            asm volatile("s_waitcnt vmcnt(0)" ::: "memory");
        }
    }
    __syncthreads();
}
#define LAS __attribute__((address_space(3)))
typedef unsigned short bf16_t;
typedef float f32x4 __attribute__((ext_vector_type(4)));
typedef float f32x2 __attribute__((ext_vector_type(2)));
typedef unsigned u32x4 __attribute__((ext_vector_type(4)));
typedef unsigned u32x2 __attribute__((ext_vector_type(2)));
typedef short bf16x8 __attribute__((ext_vector_type(8)));
typedef short s16x4 __attribute__((ext_vector_type(4)));
#define LDS_WAIT() asm volatile("s_waitcnt lgkmcnt(0)" ::: "memory")
using pg8::cvt_pk_bf16; using pg8::bf_lo; using pg8::bf_hi; using pg8::sigmoidf_;

__device__ __forceinline__ float wave_sum(float v) {
#pragma unroll
    for (int o = 1; o < 64; o <<= 1) v += __shfl_xor(v, o);
    return v;
}

__device__ __forceinline__ void transpose_item(const float* __restrict__ W, int ldW, int K, int src_n0, int k0, bf16_t* WT, int dst_row0, LAS float* scr, int lane, int pmode = -1) {
#pragma unroll 8
    for (int i = 0; i < 32; ++i) { const int kk = 2 * i + (lane >> 5); scr[kk * 33 + (lane & 31)] = W[(size_t)(k0 + kk) * ldW + src_n0 + (lane & 31)]; }
    LDS_WAIT(); asm volatile("" ::: "memory");
    const int c = lane & 7;
#pragma unroll
    for (int j = 0; j < 4; ++j) { const int n = (lane >> 3) + 8 * j; const LAS float* s = scr + (8 * c) * 33 + n;
        u32x4 o; o.x = cvt_pk_bf16(s[0 * 33], s[1 * 33]); o.y = cvt_pk_bf16(s[2 * 33], s[3 * 33]); o.z = cvt_pk_bf16(s[4 * 33], s[5 * 33]); o.w = cvt_pk_bf16(s[6 * 33], s[7 * 33]);
        const int nn = pmode < 0 ? n : 32 * (2 * (pmode >> 1) + (n >> 4)) + 8 * ((n >> 2) & 3) + 4 * (pmode & 1) + (n & 3);
        *(u32x4*)(WT + (size_t)(dst_row0 + nn) * K + k0 + 8 * c) = o; }
    LDS_WAIT(); asm volatile("" ::: "memory");
}

struct Args { const float* in[20]; float* out; unsigned char* ws; int ph_lo, ph_hi; };
typedef const __attribute__((address_space(4))) Args* KA;

__device__ __forceinline__ void prep_layer(KA a, int L, LAS unsigned char* lds, int gw, int NGW, int wave, int lane) {
    LAS float* scr = (LAS float*)(lds + wave * 8448);
    unsigned char* wsW = a->ws + WS_W;
    const float* w_in = a->in[3] + (size_t)L * DM * INW;
    const float* w_ogla = a->in[9] + (size_t)L * DM * DM; const float* w_oatt = a->in[10] + (size_t)L * DM * DM; const float* w_out = a->in[11] + (size_t)L * DM * DM;
    const float* w_fin = a->in[14] + (size_t)L * DM * 2 * FFH; const float* w_fout = a->in[15] + (size_t)L * FFH * DM;
    const float* w_pp = a->in[17] + (size_t)L * PLE * DM; const float* w_pg = a->in[18] + (size_t)L * DM * DM;
    constexpr int I_A = 16 * 97, I_B = 16 * 112, I_SQ = 16 * 32, I_FI = 16 * 176, I_FO = 44 * 32, I_PP = 4 * 32;
    constexpr int NITEMS = I_A + I_B + 4 * I_SQ + I_FI + I_FO + I_PP;
    for (int it = gw; it < NITEMS; it += NGW) {
        int r = it;
        if (r < I_A) { const int kb = r / 97, nb = r % 97; transpose_item(w_in, INW, DM, 32 * nb, 64 * kb, (bf16_t*)(wsW + W_INA), 32 * nb, scr, lane); continue; } r -= I_A;
        if (r < I_B) { const int kb = r / 112, nb = r % 112; const int d0 = (32 * nb) & 127;
            if (nb < 40) transpose_item(w_in, INW, DM, NA_REAL + 32 * nb, 64 * kb, (bf16_t*)(wsW + W_INB), 32 * nb - d0, scr, lane, (d0 >> 6) * 2 + ((d0 >> 5) & 1));
            else transpose_item(w_in, INW, DM, NA_REAL + 32 * nb, 64 * kb, (bf16_t*)(wsW + W_INB), 32 * nb, scr, lane);
            continue; } r -= I_B;
        if (r < 4 * I_SQ) { const int which = r / I_SQ, q = r % I_SQ, kb = q / 32, nb = q % 32;
            const float* src = which == 0 ? w_ogla : which == 1 ? w_oatt : which == 2 ? w_out : w_pg;
            const size_t dsto = which == 0 ? W_OGLA : which == 1 ? W_OATT : which == 2 ? W_OUT : W_PG;
            transpose_item(src, DM, DM, 32 * nb, 64 * kb, (bf16_t*)(wsW + dsto), 32 * nb, scr, lane); continue; } r -= 4 * I_SQ;
        if (r < I_FI) { const int kb = r / 176, nb = r % 176; const int n0 = 32 * nb; const int j = n0 < FFH ? n0 : n0 - FFH; const int dst = (j >> 7) * 256 + (n0 < FFH ? 0 : 128) + (j & 127);
            transpose_item(w_fin, 2 * FFH, DM, n0, 64 * kb, (bf16_t*)(wsW + W_FIN), dst, scr, lane); continue; } r -= I_FI;
        if (r < I_FO) { const int kb = r / 32, nb = r % 32; transpose_item(w_fout, DM, FFH, 32 * nb, 64 * kb, (bf16_t*)(wsW + W_FOUT), 32 * nb, scr, lane); continue; } r -= I_FO;
        { const int kb = r / 32, nb = r % 32; transpose_item(w_pp, DM, PLE, 32 * nb, 64 * kb, (bf16_t*)(wsW + W_PP), 32 * nb, scr, lane); }
    }
    { u32x4* z = (u32x4*)(wsW + W_INA + (size_t)NA_REAL * DM * 2); const int nz = (NA_PAD - NA_REAL) * DM * 2 / 16;
      for (int i = gw * 64 + lane; i < nz; i += NGW * 64) z[i] = (u32x4){0u, 0u, 0u, 0u}; }
    { const float* p = a->in[1] + (size_t)L * TOK * PLE; bf16_t* pb = (bf16_t*)(a->ws + WS_PB); const int n8 = TOK * PLE / 8;
      for (int i = gw * 64 + lane; i < n8; i += NGW * 64) { const f32x4 x0 = *(const f32x4*)(p + (size_t)i * 8), x1 = *(const f32x4*)(p + (size_t)i * 8 + 4);
          u32x4 o; o.x = cvt_pk_bf16(x0[0], x0[1]); o.y = cvt_pk_bf16(x0[2], x0[3]); o.z = cvt_pk_bf16(x1[0], x1[1]); o.w = cvt_pk_bf16(x1[2], x1[3]); *(u32x4*)(pb + (size_t)i * 8) = o; } }
}

template <bool IN_F32, bool OUT_F32>
__device__ __forceinline__ void row_pass(const void* hin, void* hout, const bf16_t* y, const float* __restrict__ gpost, const float* __restrict__ gpre, bf16_t* xa, int gw, int NGW, int lane) {
    for (int m0 = gw; m0 < TOK; m0 += 2 * NGW) {
        f32x4 v[2][4]; u32x2 yw[2][4];
#pragma unroll
        for (int r = 0; r < 2; ++r) { const size_t m = (size_t)m0 + (size_t)r * NGW;
#pragma unroll
            for (int j = 0; j < 4; ++j) {
                if (IN_F32) v[r][j] = ((const f32x4*)((const float*)hin + m * DM))[lane + 64 * j];
                else { const u32x2 w = ((const u32x2*)((const bf16_t*)hin + m * DM))[lane + 64 * j]; v[r][j] = (f32x4){bf_lo(w.x), bf_hi(w.x), bf_lo(w.y), bf_hi(w.y)}; }
                if (y) yw[r][j] = ((const u32x2*)(y + m * DM))[lane + 64 * j]; } }
#pragma unroll
        for (int r = 0; r < 2; ++r) { const size_t m = (size_t)m0 + (size_t)r * NGW;
            if (y) {
                f32x4 yv[4]; float ss = 0.f;
#pragma unroll
                for (int j = 0; j < 4; ++j) { const u32x2 w = yw[r][j]; yv[j] = (f32x4){bf_lo(w.x), bf_hi(w.x), bf_lo(w.y), bf_hi(w.y)};
                    ss += (yv[j][0] * yv[j][0] + yv[j][1] * yv[j][1]) + (yv[j][2] * yv[j][2] + yv[j][3] * yv[j][3]); }
                const float rs = rsqrtf(wave_sum(ss) * (1.0f / DM) + EPS);
#pragma unroll
                for (int j = 0; j < 4; ++j) { const f32x4 g = ((const f32x4*)gpost)[lane + 64 * j]; v[r][j] = v[r][j] + yv[j] * rs * g; }
            }
#pragma unroll
            for (int j = 0; j < 4; ++j) {
                if (OUT_F32) ((f32x4*)((float*)hout + m * DM))[lane + 64 * j] = v[r][j];
                else { u32x2 w; w.x = cvt_pk_bf16(v[r][j][0], v[r][j][1]); w.y = cvt_pk_bf16(v[r][j][2], v[r][j][3]); ((u32x2*)((bf16_t*)hout + m * DM))[lane + 64 * j] = w; } }
            if (gpre) {
                float ss = 0.f;
#pragma unroll
                for (int j = 0; j < 4; ++j) ss += (v[r][j][0] * v[r][j][0] + v[r][j][1] * v[r][j][1]) + (v[r][j][2] * v[r][j][2] + v[r][j][3] * v[r][j][3]);
                const float r2 = rsqrtf(wave_sum(ss) * (1.0f / DM) + EPS);
#pragma unroll
                for (int j = 0; j < 4; ++j) { const f32x4 o = v[r][j] * r2 * ((const f32x4*)gpre)[lane + 64 * j];
                    u32x2 w; w.x = cvt_pk_bf16(o[0], o[1]); w.y = cvt_pk_bf16(o[2], o[3]); ((u32x2*)(xa + m * DM))[lane + 64 * j] = w; }
            }
        }
    }
}

__device__ __forceinline__ void qk_norm_rope(unsigned char* rbase, const float* __restrict__ gq, const float* __restrict__ gk, int gw, int NGW, int lane) {
    const int axis = lane >> 5, j = lane & 31, i1 = axis * 64 + j, i2 = i1 + 32;
    const float inv = __builtin_amdgcn_exp2f(-(float)j * (13.287712379549449f / 32.0f));
    const float gq1 = gq[i1], gq2 = gq[i2], gk1 = gk[i1], gk2 = gk[i2];
    for (int it = gw; it < TOK * 10; it += NGW) {
        const int t = it / 10, hs = it % 10;
        bf16_t* p = hs < 8 ? (bf16_t*)(rbase + R_Q) + (size_t)t * 1024 + hs * 128 : (bf16_t*)(rbase + R_K) + (size_t)t * 256 + (hs - 8) * 128;
        const float g1 = hs < 8 ? gq1 : gk1, g2 = hs < 8 ? gq2 : gk2;
        float x1 = bf_lo((unsigned)p[i1]), x2 = bf_lo((unsigned)p[i2]);
        const float rs = rsqrtf(wave_sum(x1 * x1 + x2 * x2) * (1.0f / 128.0f) + EPS);
        x1 = x1 * rs * g1; x2 = x2 * rs * g2;
        const int s = t & (SEQ - 1); const float pos = (float)(axis == 0 ? (s >> 6) : (s & 63));
        const float rev = pos * inv * 0.15915494309189535f;
        const float rf = __builtin_amdgcn_fractf(rev); const float c = __builtin_amdgcn_cosf(rf), sn = __builtin_amdgcn_sinf(rf);
        const float o1 = x1 * c - x2 * sn, o2 = x2 * c + x1 * sn;
        p[i1] = (bf16_t)(cvt_pk_bf16(o1, 0.f) & 0xffffu); p[i2] = (bf16_t)(cvt_pk_bf16(o2, 0.f) & 0xffffu);
    }
}

__device__ __forceinline__ void gla_post(bf16_t* of, const bf16_t* ob, const bf16_t* gg, const float* __restrict__ g, int gw, int NGW, int lane) {
    const f32x4 gv = ((const f32x4*)g)[lane];
    for (int it0 = gw; it0 < TOK * 4; it0 += 2 * NGW) {
        u32x2 a[2], b[2], c[2];
#pragma unroll
        for (int r = 0; r < 2; ++r) { const size_t off = ((size_t)it0 + (size_t)r * NGW) * 256 + 4 * lane; a[r] = *(const u32x2*)(of + off); b[r] = *(const u32x2*)(ob + off); c[r] = *(const u32x2*)(gg + off); }
#pragma unroll
        for (int r = 0; r < 2; ++r) { const size_t off = ((size_t)it0 + (size_t)r * NGW) * 256 + 4 * lane;
            f32x4 o = (f32x4){bf_lo(a[r].x) + bf_lo(b[r].x), bf_hi(a[r].x) + bf_hi(b[r].x), bf_lo(a[r].y) + bf_lo(b[r].y), bf_hi(a[r].y) + bf_hi(b[r].y)};
            const float rs = rsqrtf(wave_sum((o[0] * o[0] + o[1] * o[1]) + (o[2] * o[2] + o[3] * o[3])) * (1.0f / 256.0f) + EPS);
            const f32x4 gt = (f32x4){bf_lo(c[r].x), bf_hi(c[r].x), bf_lo(c[r].y), bf_hi(c[r].y)};
#pragma unroll
            for (int k = 0; k < 4; ++k) o[k] = o[k] * rs * gv[k] * (gt[k] * sigmoidf_(gt[k]));
            u32x2 w; w.x = cvt_pk_bf16(o[0], o[1]); w.y = cvt_pk_bf16(o[2], o[3]); *(u32x2*)(of + off) = w; }
    }
}
constexpr int GL_QD = 0, GL_KI = 17408, GL_KST = 34816, GL_VT = 53248, GL_STT = 62464, GL_EL = 79872, GL_RA = 80384, GL_TOT = 84480, GL_END = 88576;
constexpr int GS_Q = 272, GS_T = 144;
constexpr size_t R_QDF = 132 * MiB, R_KIF = 164 * MiB, R_EL = 196 * MiB;

__device__ __forceinline__ void gla_prep(KA a, int L, int b, int ci, int h, LAS unsigned char* lds) {
    const int tid = opaque_tid(), lane = tid & 63, w = __builtin_amdgcn_readfirstlane(tid >> 6);
    unsigned char* rbase = a->ws + WS_R;
    const bf16_t* GQ = (const bf16_t*)(rbase + R_GQ); const bf16_t* GK = (const bf16_t*)(rbase + R_GK); const float* RA = (const float*)(rbase + R_RA);
    const size_t t0 = (size_t)b * SEQ + (size_t)ci * 64; const int vrow = tid >> 3, vc8 = tid & 7;
    unsigned qc[8], kc[8];
#pragma unroll
    for (int r = 0; r < 8; ++r) { qc[r] = *(const unsigned*)(GQ + (t0 + 8 * w + r) * 512 + h * 128 + 2 * lane); kc[r] = *(const unsigned*)(GK + (t0 + 8 * w + r) * 512 + h * 128 + 2 * lane); }
#pragma unroll 1
    for (int dir = 0; dir < 2; ++dir) {
        bf16_t* QD = dir ? (bf16_t*)((unsigned char*)a->out + 64 * MiB) : (bf16_t*)(rbase + R_QDF);
        bf16_t* KI = dir ? (bf16_t*)((unsigned char*)a->out + 96 * MiB) : (bf16_t*)(rbase + R_KIF);
        float* EL = (float*)(rbase + R_EL) + ((size_t)dir * 512 + (size_t)b * 64 + ci) * 512;
        f32x2 wu[16];
        { const float* wup = a->in[4] + ((size_t)(L * 2 + dir) * 16) * 512 + h * 128 + 2 * lane;
#pragma unroll
          for (int j = 0; j < 16; ++j) wu[j] = *(const f32x2*)(wup + (size_t)j * 512); }
        const f32x2 bias = *(const f32x2*)(a->in[5] + (size_t)(L * 2 + dir) * 512 + h * 128 + 2 * lane);
        *(LAS f32x2*)(lds + GL_RA + vrow * 64 + vc8 * 8) = *(const f32x2*)(RA + (t0 + vrow) * 32 + dir * 16 + 2 * vc8);
        __syncthreads();
        float la0[8], la1[8];
#pragma unroll
        for (int r = 0; r < 8; ++r) {
            const LAS f32x4* rr = (const LAS f32x4*)(lds + GL_RA + (8 * w + r) * 64);
            f32x2 x = bias;
#pragma unroll
            for (int q4 = 0; q4 < 4; ++q4) { const f32x4 t = rr[q4];
#pragma unroll
                for (int e = 0; e < 4; ++e) x = __builtin_elementwise_fma((f32x2){t[e], t[e]}, wu[4 * q4 + e], x); }
            const f32x2 xl = x * 1.4426950408889634f;
            la0[r] = (fminf(xl.x, 0.f) - __builtin_amdgcn_logf(1.0f + __builtin_amdgcn_exp2f(-fabsf(xl.x)))) * (1.0f / 16.0f);
            la1[r] = (fminf(xl.y, 0.f) - __builtin_amdgcn_logf(1.0f + __builtin_amdgcn_exp2f(-fabsf(xl.y)))) * (1.0f / 16.0f);
        }
        if (dir == 0) {
#pragma unroll
            for (int r = 1; r < 8; ++r) { la0[r] += la0[r - 1]; la1[r] += la1[r - 1]; }
        } else {
#pragma unroll
            for (int r = 6; r >= 0; --r) { la0[r] += la0[r + 1]; la1[r] += la1[r + 1]; }
        }
        *(LAS f32x2*)(lds + GL_TOT + w * 512 + lane * 8) = (f32x2){dir == 0 ? la0[7] : la0[0], dir == 0 ? la1[7] : la1[0]};
        __syncthreads();
        float off0 = 0.f, off1 = 0.f, last0 = 0.f, last1 = 0.f;
#pragma unroll
        for (int g = 0; g < 8; ++g) { const f32x2 t = *(const LAS f32x2*)(lds + GL_TOT + g * 512 + lane * 8); last0 += t.x; last1 += t.y;
            const bool before = dir == 0 ? (g < w) : (g > w); if (before) { off0 += t.x; off1 += t.y; } }
#pragma unroll
        for (int r = 0; r < 8; ++r) {
            const float c0 = la0[r] + off0, c1 = la1[r] + off1;
            const float q0 = bf_lo(qc[r]), q1 = bf_hi(qc[r]), k0 = bf_lo(kc[r]), k1 = bf_hi(kc[r]);
            const float eq0 = __builtin_amdgcn_exp2f(c0) * 0.088388347648318440f, eq1 = __builtin_amdgcn_exp2f(c1) * 0.088388347648318440f;
            const size_t o = (t0 + 8 * w + r) * 512 + h * 128 + 2 * lane;
            *(unsigned*)(QD + o) = cvt_pk_bf16(q0 * eq0, q1 * eq1);
            *(unsigned*)(KI + o) = cvt_pk_bf16(k0 * __builtin_amdgcn_exp2f(-c0), k1 * __builtin_amdgcn_exp2f(-c1));
        }
        if (w == 0) *(f32x2*)(EL + h * 128 + 2 * lane) = (f32x2){__builtin_amdgcn_exp2f(last0), __builtin_amdgcn_exp2f(last1)};
        __syncthreads();
    }
}

__device__ __forceinline__ void gla_unit(KA a, int L, int b, int h, int dir, int vs, LAS unsigned char* lds) {
    const int tid = opaque_tid(), lane = tid & 63, w = __builtin_amdgcn_readfirstlane(tid >> 6);
    unsigned char* rbase = a->ws + WS_R;
    const bf16_t* QDg = dir ? (const bf16_t*)((unsigned char*)a->out + 64 * MiB) : (const bf16_t*)(rbase + R_QDF);
    const bf16_t* KIg = dir ? (const bf16_t*)((unsigned char*)a->out + 96 * MiB) : (const bf16_t*)(rbase + R_KIF);
    const float* ELg = (const float*)(rbase + R_EL) + ((size_t)dir * 512 + (size_t)b * 64) * 512 + h * 128;
    const bf16_t* GV = (const bf16_t*)(rbase + R_GV);
    bf16_t* O = (bf16_t*)(a->ws + (dir ? WS_OB : WS_OF));
    f32x4 st[4];
#pragma unroll
    for (int nb = 0; nb < 4; ++nb) st[nb] = (f32x4){0.f, 0.f, 0.f, 0.f};
    for (int i = tid; i < 17408 / 4; i += 512) ((LAS unsigned*)(lds + GL_STT))[i] = 0u;
    const int li = lane & 15, kq = lane >> 4, ib = w & 3, dh = w >> 2;
    const int vrow = tid >> 3, vc8 = tid & 7;
    const int tswz = (((vrow >> 3) ^ vc8) << 4) + (vrow & 7) * 2;
    const int fl = li >> 3;
    u32x4 qd0, qd1, ki0, ki1, vv; float elv = 0.f;
#define GLA_LOAD(ci_) do { const size_t t0_ = (size_t)b * SEQ + (size_t)(ci_) * 64; const size_t o_ = (t0_ + vrow) * 512 + h * 128 + vc8 * 8; \
        qd0 = *(const u32x4*)(QDg + o_); qd1 = *(const u32x4*)(QDg + o_ + 64); ki0 = *(const u32x4*)(KIg + o_); ki1 = *(const u32x4*)(KIg + o_ + 64); \
        vv = *(const u32x4*)(GV + (t0_ + vrow) * 1024 + h * 256 + vs * 64 + vc8 * 8); if (tid < 128) elv = ELg[(size_t)(ci_) * 512 + tid]; } while (0)
#define GLA_TR8(base_, v_) do { LAS unsigned char* p_ = (base_); const u32x4 x_ = (v_); \
        *(LAS unsigned short*)(p_ + 0 * GS_T) = (unsigned short)(x_.x & 0xffff); *(LAS unsigned short*)(p_ + 1 * GS_T) = (unsigned short)(x_.x >> 16); \
        *(LAS unsigned short*)(p_ + 2 * GS_T) = (unsigned short)(x_.y & 0xffff); *(LAS unsigned short*)(p_ + 3 * GS_T) = (unsigned short)(x_.y >> 16); \
        *(LAS unsigned short*)(p_ + 4 * GS_T) = (unsigned short)(x_.z & 0xffff); *(LAS unsigned short*)(p_ + 5 * GS_T) = (unsigned short)(x_.z >> 16); \
        *(LAS unsigned short*)(p_ + 6 * GS_T) = (unsigned short)(x_.w & 0xffff); *(LAS unsigned short*)(p_ + 7 * GS_T) = (unsigned short)(x_.w >> 16); } while (0)
    GLA_LOAD(dir ? 63 : 0);
    for (int c = 0; c < 64; ++c) {
        const int ci = dir ? 63 - c : c; const size_t t0 = (size_t)b * SEQ + (size_t)ci * 64;
        *(LAS u32x4*)(lds + GL_QD + vrow * GS_Q + vc8 * 16) = qd0; *(LAS u32x4*)(lds + GL_QD + vrow * GS_Q + 128 + vc8 * 16) = qd1;
        *(LAS u32x4*)(lds + GL_KI + vrow * GS_Q + vc8 * 16) = ki0; *(LAS u32x4*)(lds + GL_KI + vrow * GS_Q + 128 + vc8 * 16) = ki1;
        GLA_TR8(lds + GL_KST + (vc8 * 8) * GS_T + tswz, ki0); GLA_TR8(lds + GL_KST + (64 + vc8 * 8) * GS_T + tswz, ki1);
        GLA_TR8(lds + GL_VT + (vc8 * 8) * GS_T + tswz, vv);
        if (tid < 128) *(LAS float*)(lds + GL_EL + tid * 4) = elv;
        asm volatile("s_waitcnt lgkmcnt(0)" ::: "memory"); __builtin_amdgcn_s_barrier(); asm volatile("" ::: "memory");
        if (c + 1 < 64) GLA_LOAD(dir ? 62 - c : c + 1);
        bf16x8 qf[4];
#pragma unroll
        for (int kk = 0; kk < 4; ++kk) qf[kk] = *(const LAS bf16x8*)(lds + GL_QD + (16 * ib + li) * GS_Q + kk * 64 + kq * 16);
        unsigned pk[4][2];
#pragma unroll
        for (int sb = 0; sb < 4; ++sb) {
            if (dir == 0 ? (sb > ib) : (sb < ib)) { pk[sb][0] = 0u; pk[sb][1] = 0u; continue; }
            f32x4 sacc = (f32x4){0.f, 0.f, 0.f, 0.f};
#pragma unroll
            for (int kk = 0; kk < 4; ++kk) { const bf16x8 kf = *(const LAS bf16x8*)(lds + GL_KI + (16 * sb + li) * GS_Q + kk * 64 + kq * 16);
                sacc = __builtin_amdgcn_mfma_f32_16x16x32_bf16(kf, qf[kk], sacc, 0, 0, 0); }
            const int irow = 16 * ib + li;
#pragma unroll
            for (int j = 0; j < 4; ++j) { const int srow = 16 * sb + 4 * kq + j; const bool keep = dir == 0 ? (srow <= irow) : (srow >= irow); sacc[j] = keep ? sacc[j] : 0.f; }
            pk[sb][0] = cvt_pk_bf16(sacc[0], sacc[1]); pk[sb][1] = cvt_pk_bf16(sacc[2], sacc[3]);
        }
#pragma unroll
        for (int d2 = 0; d2 < 2; ++d2) { const int db = 2 * dh + d2;
            f32x4 oacc = (f32x4){0.f, 0.f, 0.f, 0.f};
#pragma unroll
            for (int kk = 0; kk < 4; ++kk) { const bf16x8 sf = *(const LAS bf16x8*)(lds + GL_STT + (16 * db + li) * GS_Q + kk * 64 + kq * 16);
                oacc = __builtin_amdgcn_mfma_f32_16x16x32_bf16(sf, qf[kk], oacc, 0, 0, 0); }
#pragma unroll
            for (int kc2 = 0; kc2 < 2; ++kc2) {
                const int fv = (2 * db + fl) & 7;
                const s16x4 lo = *(const LAS s16x4*)(lds + GL_VT + (16 * db + li) * GS_T + (((4 * kc2 + (kq >> 1)) ^ fv) << 4) + (kq & 1) * 8);
                const s16x4 hi4 = *(const LAS s16x4*)(lds + GL_VT + (16 * db + li) * GS_T + (((4 * kc2 + 2 + (kq >> 1)) ^ fv) << 4) + (kq & 1) * 8);
                const bf16x8 vf = (bf16x8){lo[0], lo[1], lo[2], lo[3], hi4[0], hi4[1], hi4[2], hi4[3]};
                const u32x4 pw = (u32x4){pk[2 * kc2][0], pk[2 * kc2][1], pk[2 * kc2 + 1][0], pk[2 * kc2 + 1][1]};
                oacc = __builtin_amdgcn_mfma_f32_16x16x32_bf16(vf, __builtin_bit_cast(bf16x8, pw), oacc, 0, 0, 0); }
            u32x2 ow; ow.x = cvt_pk_bf16(oacc[0], oacc[1]); ow.y = cvt_pk_bf16(oacc[2], oacc[3]);
            *(u32x2*)(O + (t0 + 16 * ib + li) * 1024 + h * 256 + vs * 64 + 16 * db + 4 * kq) = ow;
        }
        { const f32x4 el = *(const LAS f32x4*)(lds + GL_EL + (16 * w + 4 * kq) * 4);
#pragma unroll
          for (int kc2 = 0; kc2 < 2; ++kc2) { const bf16x8 af = *(const LAS bf16x8*)(lds + GL_KST + (16 * w + li) * GS_T + (((4 * kc2 + kq) ^ ((2 * w + fl) & 7)) << 4));
#pragma unroll
              for (int nb = 0; nb < 4; ++nb) { const bf16x8 bfv = *(const LAS bf16x8*)(lds + GL_VT + (16 * nb + li) * GS_T + (((4 * kc2 + kq) ^ ((2 * nb + fl) & 7)) << 4));
                  st[nb] = __builtin_amdgcn_mfma_f32_16x16x32_bf16(af, bfv, st[nb], 0, 0, 0); } }
#pragma unroll
          for (int nb = 0; nb < 4; ++nb) st[nb] = st[nb] * el; }
        asm volatile("s_waitcnt lgkmcnt(0)" ::: "memory"); __builtin_amdgcn_s_barrier(); asm volatile("" ::: "memory");
#pragma unroll
        for (int nb = 0; nb < 4; ++nb) { u32x2 sw; sw.x = cvt_pk_bf16(st[nb][0], st[nb][1]); sw.y = cvt_pk_bf16(st[nb][2], st[nb][3]);
            *(LAS u32x2*)(lds + GL_STT + (16 * nb + li) * GS_Q + (16 * w + 4 * kq) * 2) = sw; }
    }
#undef GLA_LOAD
#undef GLA_TR8
    __syncthreads();
}
#ifndef PH_MASK
#define PH_MASK 0x3fff
#endif
#define EN(k) (((PH_MASK) >> (k)) & 1)
#ifndef PROBE_SYNC_REPS
#define PROBE_SYNC_REPS 1
#endif
#ifndef PROBE_GLA_REPS
#define PROBE_GLA_REPS 1
#endif
__global__ void __launch_bounds__(512) hybrid_fwd(Args a_) {
    extern __shared__ __attribute__((aligned(16))) unsigned char lds_raw[];
    LAS unsigned char* lds = (LAS unsigned char*)lds_raw;
    cg::grid_group grid = cg::this_grid();
    const int ph_lo = a_.ph_lo, ph_hi = a_.ph_hi;
    if (threadIdx.x < 2) ((LAS unsigned*)(lds + 131072))[threadIdx.x] = 0u;
    __syncthreads();
    const XcdBarrier xbar = xcd_barrier_post((unsigned*)(a_.ws + WS_CTL), (volatile LAS unsigned*)(lds + 131072));
    for (int ph = ph_lo; ph < ph_hi; ++ph) {
        const int tid = opaque_tid(), lane = tid & 63, wave = __builtin_amdgcn_readfirstlane(tid >> 6);
        int bx = blockIdx.x, G = gridDim.x; asm volatile("" : "+s"(bx), "+s"(G));
        const int vcu = (G % 8 == 0) ? (bx % 8) * (G / 8) + bx / 8 : bx;
        const int gw = vcu * 8 + wave, NGW = G * 8;
        KA a = (KA)__builtin_amdgcn_kernarg_segment_ptr(); asm volatile("" : "+s"(a));
        unsigned char* ws = a->ws; unsigned char* rbase = ws + WS_R; unsigned char* wsW = ws + WS_W;
        bf16_t* XA = (bf16_t*)(ws + WS_XA); bf16_t* OF = (bf16_t*)(ws + WS_OF); bf16_t* OB = (bf16_t*)(ws + WS_OB); bf16_t* GG = (bf16_t*)a->out; bf16_t* HB = (bf16_t*)(ws + WS_HB); bf16_t* PB = (bf16_t*)(ws + WS_PB);
        if (ph == 0) { if (EN(13)) {
            prep_layer(a, 0, lds, gw, NGW, wave, lane);
            row_pass<true, false>(a->in[0], HB, nullptr, nullptr, a->in[2], XA, gw, NGW, lane); }
        } else {
            const int L = (ph - 1) / NPH_LAYER, k = (ph - 1) % NPH_LAYER;
            int ngemm = 0; pg8::Gemm g0{}, g1{}; pg8::Epi e0{}, e1{};
            e0.rbase = rbase; e0.ggbase = (unsigned char*)a->out; e1.rbase = rbase; e1.ggbase = (unsigned char*)a->out;
            switch (k) {
            case 0: if (!EN(0)) break; ngemm = 1; g0 = pg8::Gemm{XA, (const bf16_t*)(wsW + W_INA), TOK, NA_PAD, DM}; e0.mode = pg8::EM_ROUTE_A; break;
            case 1: if (!EN(1)) break; for (int u = vcu; u < 2048; u += G) gla_prep(a, L, u >> 8, (u >> 2) & 63, u & 3, lds); break;
            case 2: if (!EN(2)) break; for (int u = vcu; u < 256; u += G) gla_unit(a, L, u >> 5, (u >> 3) & 3, (u >> 2) & 1, u & 3, lds); break;
            case 3: if (!EN(3)) break; gla_post(OF, OB, GG, a->in[6] + (size_t)L * 256, gw, NGW, lane);
                    ngemm = 1; g0 = pg8::Gemm{XA, (const bf16_t*)(wsW + W_INB), TOK, NB_COLS, DM}; e0.mode = pg8::EM_ROUTE_B; e0.gqn = a->in[7] + (size_t)L * 128; e0.gkn = a->in[8] + (size_t)L * 128; e0.xlds = (LAS float*)(lds + 131072 + 1024); break;
            case 4: if (!EN(4)) break; for (int u = vcu; u < 1024; u += G) { const int qb = u & 15, hg = (u >> 4) & 3, kvh = (u >> 6) & 1, b = u >> 7, hq = kvh * 4 + hg;
                        bf16_t* Qb = (bf16_t*)(rbase + R_Q) + ((size_t)b * SEQ + (size_t)qb * 256) * 1024 + hq * 128;
                        const bf16_t* Kh = (const bf16_t*)(rbase + R_K) + (size_t)b * SEQ * 256 + kvh * 128; const bf16_t* Vh = (const bf16_t*)(rbase + R_V) + (size_t)b * SEQ * 256 + kvh * 128;
                        attn::attn_dense_body<attn::bf16>((const attn::bf16*)Qb, (const attn::bf16*)Kh, (const attn::bf16*)Vh, Qb, SEQ, (char*)lds_raw);
                        __syncthreads(); }
                    break;
            case 5: if (!EN(5)) break; ngemm = 2; g0 = pg8::Gemm{OF, (const bf16_t*)(wsW + W_OGLA), TOK, DM, DM}; e0.mode = pg8::EM_GATE1; e0.out = OB; e0.aux = (const bf16_t*)(rbase + R_GA);
                    g1 = pg8::Gemm{(const bf16_t*)(rbase + R_Q), (const bf16_t*)(wsW + W_OATT), TOK, DM, DM}; e1.mode = pg8::EM_GATE2; e1.out = OB; e1.aux = (const bf16_t*)(rbase + R_GB); break;
            case 6: if (!EN(6)) break; ngemm = 1; g0 = pg8::Gemm{OB, (const bf16_t*)(wsW + W_OUT), TOK, DM, DM}; e0.mode = pg8::EM_PLAIN; e0.out = OF; break;
            case 7: if (!EN(7)) break; row_pass<false, false>(HB, HB, OF, a->in[12] + (size_t)L * DM, a->in[13] + (size_t)L * DM, XA, gw, NGW, lane); break;
            case 8: if (!EN(8)) break; ngemm = 1; g0 = pg8::Gemm{XA, (const bf16_t*)(wsW + W_FIN), TOK, 2 * FFH, DM}; e0.mode = pg8::EM_SWIGLU; e0.out = (bf16_t*)rbase; break;
            case 9: if (!EN(9)) break; ngemm = 1; g0 = pg8::Gemm{(const bf16_t*)rbase, (const bf16_t*)(wsW + W_FOUT), TOK, DM, FFH}; e0.mode = pg8::EM_PLAIN; e0.out = OF; break;
            case 10: if (!EN(10)) break; row_pass<false, false>(HB, HB, OF, a->in[16] + (size_t)L * DM, nullptr, nullptr, gw, NGW, lane); break;
            case 11: if (!EN(11)) break; ngemm = 2; g0 = pg8::Gemm{PB, (const bf16_t*)(wsW + W_PP), TOK, DM, PLE}; e0.mode = pg8::EM_PLAIN; e0.out = (bf16_t*)rbase;
                     g1 = pg8::Gemm{HB, (const bf16_t*)(wsW + W_PG), TOK, DM, DM}; e1.mode = pg8::EM_PLE2; e1.out = OF; e1.aux = (const bf16_t*)rbase; break;
            default: if (!EN(12)) break; if (L + 1 < DEPTH) row_pass<false, false>(HB, HB, OF, a->in[19] + (size_t)L * DM, a->in[2] + (size_t)(L + 1) * DM, XA, gw, NGW, lane);
                     else row_pass<false, true>(HB, a->out, OF, a->in[19] + (size_t)L * DM, nullptr, nullptr, gw, NGW, lane);
                     if (L + 1 < DEPTH) prep_layer(a, L + 1, lds, gw, NGW, wave, lane);
                     break;
            }
            for (int gi = 0; gi < ngemm; ++gi) {
                const pg8::Gemm g = gi == 0 ? g0 : g1; const pg8::Epi E = gi == 0 ? e0 : e1;
                pg8::StaticOrder S; S.init(g.M, g.N, G, bx);
                pg8::gemm_phase<pg8::Epi, pg8::StaticOrder, true, true>(lds, g, S, E);
            }
        }
        if (ph + 1 < ph_hi) { if (ph == 0) grid.sync(); else xcd_barrier(xbar); }
    }
}

#if MK_DEBUG
struct DbgReg { unsigned long long off, bytes; int type, pad; };
struct DbgArgs { DbgReg r[3]; int scanH, ph, pass, pad; };
__global__ void __launch_bounds__(256) dbg_scan(unsigned char* ws, const float* out, DbgArgs d) {
    unsigned* nanw = (unsigned*)(ws + WS_CTL); unsigned long long* sums = (unsigned long long*)(ws + WS_CTL + 512 + d.pass * 512);
    unsigned long long s = 0; unsigned bad = 0;
#pragma unroll
    for (int ri = 0; ri < 3; ++ri) {
        const size_t n16 = d.r[ri].bytes / 16; const u32x4* p = (const u32x4*)(ws + d.r[ri].off); const int type = d.r[ri].type;
        for (size_t i = (size_t)blockIdx.x * 256 + threadIdx.x; i < n16; i += (size_t)gridDim.x * 256) {
            const u32x4 v = p[i]; s += (unsigned long long)v.x + v.y + v.z + v.w;
#pragma unroll
            for (int k = 0; k < 4; ++k) { const unsigned w = v[k]; if ((type == 0 && (w & 0x7f80u) == 0x7f80u) || (type <= 1 && (w & 0x7f800000u) == 0x7f800000u)) bad = 1; }
        }
    }
    if (d.scanH) { const size_t no = (size_t)TOK * DM / 4; const u32x4* q = (const u32x4*)out;
        for (size_t i = (size_t)blockIdx.x * 256 + threadIdx.x; i < no; i += (size_t)gridDim.x * 256) {
            const u32x4 v = q[i]; s += (unsigned long long)v.x + v.y + v.z + v.w;
#pragma unroll
            for (int k = 0; k < 4; ++k) if ((v[k] & 0x7f800000u) == 0x7f800000u) bad = 1; } }
    for (int o = 1; o < 64; o <<= 1) { s += __shfl_xor(s, o); bad |= __shfl_xor(bad, o); }
    if ((threadIdx.x & 63) == 0) { atomicAdd(&sums[d.ph], s); if (bad) atomicOr(&nanw[d.ph], 1u); }
}
__global__ void __launch_bounds__(64) dbg_check_gemm_a(unsigned char* ws) {
    unsigned* chk = (unsigned*)(ws + WS_CTL) + 56;
    const int i = blockIdx.x, lane = threadIdx.x;
    const int t = (int)(((long)i * 9973 + 17) % TOK), col = (i * 131 + 5) % NA_REAL;
    const bf16_t* xa = (const bf16_t*)(ws + WS_XA) + (size_t)t * DM; const bf16_t* wt = (const bf16_t*)(ws + WS_W + W_INA) + (size_t)col * DM;
    float acc = 0.f;
    for (int k = lane; k < DM; k += 64) acc += bf_lo((unsigned)xa[k]) * bf_lo((unsigned)wt[k]);
    acc = wave_sum(acc);
    unsigned char* rb = ws + WS_R; float got;
    if (col < 512) got = bf_lo((unsigned)((const bf16_t*)(rb + R_GQ))[(size_t)t * 512 + col]);
    else if (col < 1024) got = bf_lo((unsigned)((const bf16_t*)(rb + R_GK))[(size_t)t * 512 + col - 512]);
    else if (col < 2048) got = bf_lo((unsigned)((const bf16_t*)(rb + R_GV))[(size_t)t * 1024 + col - 1024]);
    else if (col < 3072) got = bf_lo((unsigned)((const bf16_t*)(ws + WS_GG))[(size_t)t * 1024 + col - 2048]);
    else got = ((const float*)(rb + R_RA))[(size_t)t * 32 + col - 3072];
    if (lane == 0) { if (!(fabsf(got - acc) <= 0.03f * fmaxf(1.f, fabsf(acc)))) { atomicOr(chk, fabsf(got) < 1e-9f ? 1u : 2u); if (atomicAdd(chk + 4, 1u) == 0u) { chk[2] = (unsigned)(t & 255) >> 2; chk[3] = (unsigned)(col & 255) >> 3; } } }
    float m = 0.f; const float* ra = (const float*)(rb + R_RA);
    for (int k = lane; k < 2048; k += 64) m = fmaxf(m, fabsf(ra[(size_t)i * 2048 + k]));
    for (int o = 1; o < 64; o <<= 1) m = fmaxf(m, __shfl_xor(m, o));

}
__global__ void __launch_bounds__(64) dbg_check_gemm_b(unsigned char* ws) {
    unsigned* chk = (unsigned*)(ws + WS_CTL) + 57;
    const int i = blockIdx.x, lane = threadIdx.x;
    const int t = (int)(((long)i * 9973 + 17) % TOK), col = (i * 131 + 5) % NB_COLS;
    const bf16_t* xa = (const bf16_t*)(ws + WS_XA) + (size_t)t * DM; const bf16_t* wt = (const bf16_t*)(ws + WS_W + W_INB) + (size_t)col * DM;
    float acc = 0.f;
    for (int k = lane; k < DM; k += 64) acc += bf_lo((unsigned)xa[k]) * bf_lo((unsigned)wt[k]);
    acc = wave_sum(acc);
    unsigned char* rb = ws + WS_R; float got; unsigned bit;
    if (col < 1024) { got = bf_lo((unsigned)((const bf16_t*)(rb + R_Q))[(size_t)t * 1024 + col]); bit = 1u; }
    else if (col < 1280) { got = bf_lo((unsigned)((const bf16_t*)(rb + R_K))[(size_t)t * 256 + col - 1024]); bit = 2u; }
    else if (col < 1536) { got = bf_lo((unsigned)((const bf16_t*)(rb + R_V))[(size_t)t * 256 + col - 1280]); bit = 2u; }
    else if (col < 2560) { got = bf_lo((unsigned)((const bf16_t*)(rb + R_GA))[(size_t)t * 1024 + col - 1536]); bit = 4u; }
    else { got = bf_lo((unsigned)((const bf16_t*)(rb + R_GB))[(size_t)t * 1024 + col - 2560]); bit = 4u; }
    if (lane == 0) { if (!(fabsf(got - acc) <= 0.03f * fmaxf(1.f, fabsf(acc)))) atomicOr(chk, bit); }
}
__global__ void __launch_bounds__(256) dbg_check_gla(unsigned char* ws) {
    unsigned* c58 = (unsigned*)(ws + WS_CTL) + 58; unsigned* c59 = c58 + 1;
    const bf16_t* of = (const bf16_t*)(ws + WS_OF); const bf16_t* ob = (const bf16_t*)(ws + WS_OB);
    unsigned mn = 99u, mx = 0u;
    for (size_t i = (size_t)blockIdx.x * 256 + threadIdx.x; i < (size_t)TOK * DM; i += (size_t)gridDim.x * 256) {
        const unsigned chunk = (unsigned)((i >> 10) & 4095) >> 6;
        if ((of[i] & 0x7f80u) == 0x7f80u) mn = chunk < mn ? chunk : mn;
        if ((ob[i] & 0x7f80u) == 0x7f80u) mx = chunk + 1 > mx ? chunk + 1 : mx;
    }
    if (mn != 99u) atomicMin(c58, mn); if (mx) atomicMax(c59, mx);
}
__global__ void __launch_bounds__(256) dbg_final(unsigned char* ws, float* out) {
    const unsigned* nanw = (const unsigned*)(ws + WS_CTL); const unsigned long long* sa = (const unsigned long long*)(ws + WS_CTL + 512); const unsigned long long* sb = sa + 64;
    int p1 = -1, p2 = -1;
    for (int i = NPHASES - 1; i >= 0; --i) { if (nanw[i]) p1 = i; if (sa[i] != sb[i]) p2 = i; }
    const unsigned chkA = nanw[56], chkB = nanw[57], g0 = nanw[58], g1 = nanw[59];
    if (p1 < 0 && p2 < 0 && chkA == 0 && chkB == 0) return;
    float c1; unsigned e;
    if (chkA | chkB) { c1 = 90.f + (chkA & 7); e = chkB & 7; }
    else if (p1 == 2) { c1 = 10.f + (g0 > 63 ? 70.f : (float)g0); e = g1 / 3; }
    else { c1 = p1 >= 0 ? 10.f + p1 : 40.f + p2; e = p1 >= 0 ? 25 : 30; }
    float code = c1 * 100.f; for (unsigned k = 0; k < e; ++k) code *= 10.f;
    for (size_t i = (size_t)blockIdx.x * 256 + threadIdx.x; i < (size_t)TOK * DM; i += (size_t)gridDim.x * 256) out[i] = i == 0 ? code : 0.f;
}
static DbgArgs dbg_args_for(int ph, int pass) {
    DbgArgs d{}; d.ph = ph; d.pass = pass; int n = 0;
    auto add = [&](size_t off, size_t bytes, int type) { d.r[n].off = off; d.r[n].bytes = bytes; d.r[n].type = type; ++n; };
    if (ph == 0) { add(WS_W, W_END, 0); add(WS_PB, 16 * MiB, 0); add(WS_XA, 64 * MiB, 0); d.scanH = 1; return d; }
    const int k = (ph - 1) % NPH_LAYER;
    switch (k) {
    case 0: add(WS_R, 128 * MiB, 0); add(WS_R + R_RA, 4 * MiB, 1); add(WS_GG, 64 * MiB, 0); break;
    case 1: add(WS_OF, 128 * MiB, 0); break;
    case 2: add(WS_OF, 64 * MiB, 0); add(WS_R, 224 * MiB, 0); break;
    case 3: add(WS_R + R_Q, 80 * MiB, 0); break;
    case 4: add(WS_R + R_Q, 64 * MiB, 0); break;
    case 5: add(WS_OB, 64 * MiB, 0); break;
    case 6: add(WS_OF, 64 * MiB, 0); break;
    case 7: add(WS_XA, 64 * MiB, 0); d.scanH = 1; break;
    case 8: add(WS_R, (size_t)TOK * FFH * 2, 0); break;
    case 9: add(WS_OF, 64 * MiB, 0); break;
    case 10: add(WS_XA, 64 * MiB, 0); d.scanH = 1; break;
    case 11: add(WS_R, 64 * MiB, 0); add(WS_OF, 64 * MiB, 0); break;
    default: add(WS_XA, 64 * MiB, 0); add(WS_W, W_END, 0); add(WS_PB, 16 * MiB, 0); d.scanH = 1; break;
    }
    return d;
}
#endif
extern "C" void kernel_launch(void* const* d_in, const int* in_sizes, int n_in, void* d_out, int out_size, void* d_ws, size_t ws_size, hipStream_t stream) {
    static int grid = 0;
    if (grid == 0) {
        if (n_in != 20 || in_sizes[0] != TOK * DM || out_size != TOK * DM || ws_size < WS_END) {
            fprintf(stderr, "kernel_launch: unexpected shapes (n_in %d, in0 %d, out %d, ws %zu, need %zu); nothing launched\n", n_in, n_in > 0 ? in_sizes[0] : -1, out_size, ws_size, (size_t)WS_END); grid = -1; return; }
        int dev = 0, cus = 0, per_cu = 0;
        if (hipGetDevice(&dev) != hipSuccess || hipDeviceGetAttribute(&cus, hipDeviceAttributeMultiprocessorCount, dev) != hipSuccess) { grid = -1; return; }
        if (hipFuncSetAttribute((const void*)hybrid_fwd, hipFuncAttributeMaxDynamicSharedMemorySize, LDS_BYTES) != hipSuccess) { fprintf(stderr, "kernel_launch: hipFuncSetAttribute failed\n"); grid = -1; return; }
        if (hipOccupancyMaxActiveBlocksPerMultiprocessor(&per_cu, (const void*)hybrid_fwd, 512, LDS_BYTES) != hipSuccess || per_cu < 1) { fprintf(stderr, "kernel_launch: occupancy query says %d\n", per_cu); per_cu = 1; }
        (void)hipGetLastError();
        grid = cus * 1;
        fprintf(stderr, "kernel_launch: grid %d (cus %d, per_cu %d), ws need %zu have %zu\n", grid, cus, per_cu, (size_t)WS_END, ws_size);
    }
    if (grid < 0) return;
    if (hipMemsetAsync((char*)d_ws + WS_CTL, 0, 16384, stream) != hipSuccess) { fprintf(stderr, "kernel_launch: memset failed\n"); return; }
    Args a{};
    for (int i = 0; i < 20; ++i) a.in[i] = (const float*)d_in[i];
    a.out = (float*)d_out; a.ws = (unsigned char*)d_ws;
#if MK_DEBUG
    hipMemsetAsync((char*)d_ws + WS_CTL, 0, 4096, stream); hipMemsetAsync((char*)d_ws + WS_CTL + 58 * 4, 0x63, 1, stream);
    for (int pass = 0; pass < 2; ++pass)
        for (int ph = 0; ph < NPHASES; ++ph) { a.ph_lo = ph; a.ph_hi = ph + 1; hipLaunchKernelGGL(hybrid_fwd, dim3(grid), dim3(512), LDS_BYTES, stream, a);
            hipLaunchKernelGGL(dbg_scan, dim3(2048), dim3(256), 0, stream, (unsigned char*)d_ws, (const float*)d_out, dbg_args_for(ph, pass));
            if (pass == 0 && ph == 1) { hipLaunchKernelGGL(dbg_check_gemm_a, dim3(512), dim3(64), 0, stream, (unsigned char*)d_ws); }
            if (pass == 0 && ph == 2) hipLaunchKernelGGL(dbg_check_gla, dim3(2048), dim3(256), 0, stream, (unsigned char*)d_ws);
            if (pass == 0 && ph == 3) hipLaunchKernelGGL(dbg_check_gemm_b, dim3(512), dim3(64), 0, stream, (unsigned char*)d_ws); }
    hipLaunchKernelGGL(dbg_final, dim3(2048), dim3(256), 0, stream, (unsigned char*)d_ws, (float*)d_out);
#elif MK_PER_PHASE
    for (int ph = 0; ph < NPHASES; ++ph) { a.ph_lo = ph; a.ph_hi = ph + 1; hipLaunchKernelGGL(hybrid_fwd, dim3(grid), dim3(512), LDS_BYTES, stream, a); }
#else
    a.ph_lo = 0; a.ph_hi = NPHASES;
    void* args[] = {&a};
    hipError_t e = hipLaunchCooperativeKernel((const void*)hybrid_fwd, dim3(grid), dim3(512), args, LDS_BYTES, stream);
    if (e != hipSuccess) fprintf(stderr, "kernel_launch: cooperative launch failed: %s (grid %d)\n", hipGetErrorString(e), grid);
#endif
}
```

```cpp
#include <hip/hip_runtime.h>
#include <hip/hip_bf16.h>
#include <hip/hip_cooperative_groups.h>
#include <cstdio>
#include <cstdint>
namespace cg = cooperative_groups;
#ifndef MK_DEBUG
#define MK_DEBUG 0
#endif
#ifndef MK_PER_PHASE
#define MK_PER_PHASE 0
#endif
__device__ __forceinline__ int opaque_tid() { int t = threadIdx.x; asm volatile("" : "+v"(t)); return t; }
#define LAS __attribute__((address_space(3)))
constexpr int TOK = 32768, DM = 1024, SEQ = 4096, NBATCH = 8, DEPTH = 4, INW = 6688, FFH = 2816, PLE = 256;
constexpr int NA_REAL = 3104, NA_PAD = 3328, NB_COLS = 3584;
constexpr float EPS = 1e-6f;
constexpr size_t MiB = 1048576;
constexpr size_t W_INA = 0, W_INB = W_INA + (size_t)NA_PAD * DM * 2, W_OGLA = W_INB + (size_t)NB_COLS * DM * 2, W_OATT = W_OGLA + 2 * MiB, W_OUT = W_OATT + 2 * MiB,
                 W_PG = W_OUT + 2 * MiB, W_FIN = W_PG + 2 * MiB, W_FOUT = W_FIN + (size_t)2 * FFH * DM * 2, W_PP = W_FOUT + (size_t)FFH * DM * 2, W_END = W_PP + (size_t)DM * PLE * 2;
constexpr size_t WS_CTL = 0, WS_W = 16384, WS_R = (WS_W + W_END + 4095) / 4096 * 4096;
constexpr size_t R_Q = 0, R_K = 64 * MiB, R_V = 80 * MiB, R_GA = 96 * MiB, R_GB = 160 * MiB, R_BYTES = 224 * MiB;
constexpr size_t R_GQ = 0, R_GK = 32 * MiB, R_GV = 64 * MiB, R_RA = 128 * MiB;
constexpr size_t WS_HB = WS_R + R_BYTES,   WS_GG_UNUSED = 0, WS_OF = WS_HB + 64 * MiB, WS_OB = WS_OF + 64 * MiB, WS_XA = WS_OB + 64 * MiB, WS_PB = WS_XA + 64 * MiB, WS_END = WS_PB + 16 * MiB;
constexpr int NPH_LAYER = 13, NPHASES = 1 + NPH_LAYER * DEPTH;
constexpr int LDS_BYTES = 131072 + 1024 + 8192;
namespace pg8 {
#define PG8_LAS __attribute__((address_space(3)))
typedef unsigned short bf16_t;
typedef short bf16x8 __attribute__((ext_vector_type(8)));
typedef float f32x4 __attribute__((ext_vector_type(4)));
typedef unsigned u32x4 __attribute__((ext_vector_type(4)));
constexpr int BM = 256, BK = 64, HALF = 128, HTB = HALF * BK * 2  , STAGE_BYTES = 8 * HTB, NXCD = 8, WGM = 8;

__host__ __device__ __forceinline__ int lds_byte(int r, int c) { const int st = (r >> 4) * 2 + (c >> 5), rr = r & 15, cc = c & 31, ob = rr * 64 + cc * 2; return st * 1024 + (ob ^ (((ob >> 9) & 1) << 5)); }
__host__ __device__ __forceinline__ void stage_rc(int b, int& R, int& C) { const int st = b / 1024, sb = b % 1024, swz = sb ^ (((sb >> 9) & 1) << 5); R = (st >> 1) * 16 + swz / 64; C = (st & 1) * 32 + (swz % 64) / 2; }
__host__ __device__ __forceinline__ int perm32(int rho) { const int n = rho >> 4, i = rho & 15; return 8 * (i >> 2) + 4 * n + (i & 3); }

struct Unit { int pm, pn; };
struct Gemm { const bf16_t* A; const bf16_t* Bt; int M, N, K; };

struct StaticOrder {
    int nM, nN, nwg, G, c;
    __host__ __device__ void init(int M, int N, int G_, int c_) { nM = M / BM; nN = N / BM; nwg = nM * nN; G = G_; c = c_; }
    __host__ __device__ bool next(int i, Unit& u) const {
        const long L = (long)i * G + c; if (L >= nwg) return false;
        int wgid = (int)L; { const int q = nwg / NXCD, r = nwg % NXCD, xcd = wgid % NXCD, off = wgid / NXCD; wgid = (xcd < r ? xcd * (q + 1) : r * (q + 1) + (xcd - r) * q) + off; }
        const int nig = WGM * nN, gid = wgid / nig, fm = gid * WGM, gsz = (nM - fm) < WGM ? (nM - fm) : WGM;
        u.pm = fm + ((wgid % nig) % gsz); u.pn = (wgid % nig) / gsz; return true;
    }
    __device__ __forceinline__ void a_ready(const Unit&) const {}
    __device__ __forceinline__ void done(const Unit&) const {}
};
typedef __bf16 bf16x2_t __attribute__((ext_vector_type(2)));
typedef float f32x2_t __attribute__((ext_vector_type(2)));
__device__ __forceinline__ unsigned cvt_pk_bf16(float lo, float hi) { const f32x2_t f = {lo, hi}; const bf16x2_t v = __builtin_convertvector(f, bf16x2_t); return __builtin_bit_cast(unsigned, v); }
__device__ __forceinline__ float bf_lo(unsigned w) { return __builtin_bit_cast(float, w << 16); }
__device__ __forceinline__ float bf_hi(unsigned w) { return __builtin_bit_cast(float, w & 0xffff0000u); }
__device__ __forceinline__ float sigmoidf_(float x) { return __builtin_amdgcn_rcpf(1.0f + __expf(-x)); }
enum { EM_ROUTE_A = 0, EM_ROUTE_B = 1, EM_GATE1 = 2, EM_GATE2 = 3, EM_PLAIN = 4, EM_SWIGLU = 5, EM_PLE2 = 6 };
struct Epi {
    static constexpr bool PERM = true, AFTER_DRAIN = false;
    int mode; unsigned char* rbase; unsigned char* ggbase; bf16_t* out; const bf16_t* aux; unsigned* dbgmark; const float* gqn; const float* gkn; PG8_LAS float* xlds;
    __device__ __forceinline__ void operator()(const f32x4 (&acc)[2][2][4][2], const Unit& u, int wr, int wc, int fr, int fq) const {
        const int row0 = u.pm * BM + wr * 64 + fr, lc0 = wc * 32 + 8 * fq;
#if MK_DEBUG
#endif
        if (mode == EM_SWIGLU) {
#pragma unroll
            for (int ai = 0; ai < 2; ++ai)
#pragma unroll
                for (int m = 0; m < 4; ++m) { const size_t row = (size_t)(row0 + ai * HALF + m * 16);
                    float o[8];
#pragma unroll
                    for (int n = 0; n < 2; ++n)
#pragma unroll
                        for (int j = 0; j < 4; ++j) { const float g = acc[ai][0][m][n][j], up = acc[ai][1][m][n][j]; o[4 * n + j] = g * sigmoidf_(g) * up; }
                    u32x4 w; w.x = cvt_pk_bf16(o[0], o[1]); w.y = cvt_pk_bf16(o[2], o[3]); w.z = cvt_pk_bf16(o[4], o[5]); w.w = cvt_pk_bf16(o[6], o[7]);
                    *(u32x4*)(out + row * 2816 + u.pn * 128 + lc0) = w; }
            return;
        }
        if (mode == EM_ROUTE_B && u.pn <= 4) {
            const bool isk = u.pn == 4; const float* g = isk ? gkn : gqn;
            bf16_t* qb = (bf16_t*)(rbase + (isk ? R_K : R_Q)); const int ldq = isk ? 256 : 1024, ctq = isk ? 0 : u.pn * 256;
            const int axis = wc >> 1, jb = 16 * (wc & 1) + 4 * fq;
            const f32x4 g1 = *(const f32x4*)(g + axis * 64 + jb), g2 = *(const f32x4*)(g + axis * 64 + 32 + jb);
            float inv[4];
#pragma unroll
            for (int e = 0; e < 4; ++e) inv[e] = __builtin_amdgcn_exp2f(-(float)(jb + e) * (13.287712379549449f / 32.0f)) * 0.15915494309189535f;
            const int rit = wr * 64 + fr;
#pragma unroll
            for (int ai = 0; ai < 2; ++ai)
#pragma unroll
                for (int m = 0; m < 4; ++m)
#pragma unroll
                    for (int bj = 0; bj < 2; ++bj) { const f32x4 a0 = acc[ai][bj][m][0], a1 = acc[ai][bj][m][1];
                        float ss = (a0[0] * a0[0] + a0[1] * a0[1]) + (a0[2] * a0[2] + a0[3] * a0[3]) + (a1[0] * a1[0] + a1[1] * a1[1]) + (a1[2] * a1[2] + a1[3] * a1[3]);
                        ss += __shfl_xor(ss, 16); ss += __shfl_xor(ss, 32);
                        if (fq == 0) xlds[((ai * HALF + m * 16 + rit) * 2 + bj) * 4 + wc] = ss; }
            asm volatile("s_waitcnt lgkmcnt(0)" ::: "memory"); __builtin_amdgcn_s_barrier(); asm volatile("" ::: "memory");
#pragma unroll
            for (int ai = 0; ai < 2; ++ai)
#pragma unroll
                for (int m = 0; m < 4; ++m) { const size_t row = (size_t)(row0 + ai * HALF + m * 16); const int sp = (int)row & 4095; const float pos = (float)(axis == 0 ? (sp >> 6) : (sp & 63));
                    float cs[4], sn[4];
#pragma unroll
                    for (int e = 0; e < 4; ++e) { const float rf = __builtin_amdgcn_fractf(pos * inv[e]); cs[e] = __builtin_amdgcn_cosf(rf); sn[e] = __builtin_amdgcn_sinf(rf); }
#pragma unroll
                    for (int bj = 0; bj < 2; ++bj) { const f32x4 pp = *(const PG8_LAS f32x4*)(xlds + ((ai * HALF + m * 16 + rit) * 2 + bj) * 4);
                        const float rs = rsqrtf(((pp[0] + pp[1]) + (pp[2] + pp[3])) * (1.0f / 128.0f) + 1e-6f);
                        const f32x4 x1 = acc[ai][bj][m][0] * rs * g1, x2 = acc[ai][bj][m][1] * rs * g2;
                        float o1[4], o2[4];
#pragma unroll
                        for (int e = 0; e < 4; ++e) { o1[e] = x1[e] * cs[e] - x2[e] * sn[e]; o2[e] = x2[e] * cs[e] + x1[e] * sn[e]; }
                        bf16_t* dst = qb + row * ldq + ctq + bj * HALF + axis * 64 + jb;
                        typedef unsigned u32x2e __attribute__((ext_vector_type(2)));
                        u32x2e w1, w2; w1.x = cvt_pk_bf16(o1[0], o1[1]); w1.y = cvt_pk_bf16(o1[2], o1[3]); w2.x = cvt_pk_bf16(o2[0], o2[1]); w2.y = cvt_pk_bf16(o2[2], o2[3]);
                        *(u32x2e*)dst = w1; *(u32x2e*)(dst + 32) = w2; } }
            return;
        }
        bf16_t* base = out; int ld = 1024, ct = u.pn * BM; bool is_ra = false;
        if (mode == EM_ROUTE_A) { const int pn = u.pn;
            if (pn < 2) { base = (bf16_t*)(rbase + R_GQ); ld = 512; ct = pn * 256; }
            else if (pn < 4) { base = (bf16_t*)(rbase + R_GK); ld = 512; ct = (pn - 2) * 256; }
            else if (pn < 8) { base = (bf16_t*)(rbase + R_GV); ld = 1024; ct = (pn - 4) * 256; }
            else if (pn < 12) { base = (bf16_t*)ggbase; ld = 1024; ct = (pn - 8) * 256; }
            else is_ra = true;
        } else if (mode == EM_ROUTE_B) { const int pn = u.pn;
            if (pn < 4) { base = (bf16_t*)(rbase + R_Q); ld = 1024; ct = pn * 256; }
            else if (pn == 4) { base = (bf16_t*)(rbase + R_K); ld = 256; ct = 0; }
            else if (pn == 5) { base = (bf16_t*)(rbase + R_V); ld = 256; ct = 0; }
            else if (pn < 10) { base = (bf16_t*)(rbase + R_GA); ld = 1024; ct = (pn - 6) * 256; }
            else { base = (bf16_t*)(rbase + R_GB); ld = 1024; ct = (pn - 10) * 256; }
        }
        if (is_ra) {
            if (wc == 0) { float* ra = (float*)(rbase + R_RA);
#pragma unroll
                for (int ai = 0; ai < 2; ++ai)
#pragma unroll
                    for (int m = 0; m < 4; ++m) { const size_t row = (size_t)(row0 + ai * HALF + m * 16);
                        *(f32x4*)(ra + row * 32 + 8 * fq) = acc[ai][0][m][0]; *(f32x4*)(ra + row * 32 + 8 * fq + 4) = acc[ai][0][m][1]; } }
            return;
        }
#pragma unroll
        for (int ai = 0; ai < 2; ++ai)
#pragma unroll
            for (int m = 0; m < 4; ++m) { const size_t row = (size_t)(row0 + ai * HALF + m * 16);
#pragma unroll
                for (int bj = 0; bj < 2; ++bj) { const int col = ct + bj * HALF + lc0;
                    float o[8];
#pragma unroll
                    for (int n = 0; n < 2; ++n)
#pragma unroll
                        for (int j = 0; j < 4; ++j) o[4 * n + j] = acc[ai][bj][m][n][j];
                    if (mode == EM_GATE1 || mode == EM_GATE2 || mode == EM_PLE2) {
                        const u32x4 a = *(const u32x4*)(aux + row * 1024 + col);
                        const float av[8] = {bf_lo(a.x), bf_hi(a.x), bf_lo(a.y), bf_hi(a.y), bf_lo(a.z), bf_hi(a.z), bf_lo(a.w), bf_hi(a.w)};
                        if (mode == EM_PLE2) {
#pragma unroll
                            for (int j = 0; j < 8; ++j) o[j] = sigmoidf_(o[j]) * av[j];
                        } else {
#pragma unroll
                            for (int j = 0; j < 8; ++j) o[j] = sigmoidf_(av[j]) * o[j];
                            if (mode == EM_GATE2) { const u32x4 p = *(const u32x4*)(base + row * ld + col);
                                o[0] += bf_lo(p.x); o[1] += bf_hi(p.x); o[2] += bf_lo(p.y); o[3] += bf_hi(p.y); o[4] += bf_lo(p.z); o[5] += bf_hi(p.z); o[6] += bf_lo(p.w); o[7] += bf_hi(p.w); }
                        }
                    }
                    u32x4 w; w.x = cvt_pk_bf16(o[0], o[1]); w.y = cvt_pk_bf16(o[2], o[3]); w.z = cvt_pk_bf16(o[4], o[5]); w.w = cvt_pk_bf16(o[6], o[7]);
                    *(u32x4*)(base + row * ld + col) = w;
#if MK_DEBUG
                    if (dbgmark && ai == 0 && m == 0 && bj == 0 && wr == 0 && wc == 0 && fr == 0 && fq == 0) { unsigned* mk = dbgmark + (u.pm * 32 + u.pn) * 4; const unsigned long long ad = (unsigned long long)(base + row * ld + col);
                        mk[0] = (unsigned)ad; mk[1] = (unsigned)(ad >> 32); mk[2] = w.x; mk[3] = 1u; }
#endif
                    } }
    }
};
template <class Epi, class Sched, bool ALIGN_EPI = false, bool SP2 = false>
__device__ __forceinline__ void gemm_phase(PG8_LAS unsigned char* lds, const Gemm g, const Sched& S, const Epi& E) {
    const int tid = opaque_tid(), wid = __builtin_amdgcn_readfirstlane(tid >> 6), lane = tid & 63, wr = wid >> 2, wc = wid & 3, fr = lane & 15, fq = lane >> 4;
    const int K = g.K, nt = K / BK;
    unsigned voffA[2], voffB[2];
#pragma unroll
    for (int i = 0; i < 2; ++i) { int R, C; stage_rc(tid * 16 + i * 8192, R, C); const int Rb = Epi::PERM ? ((R & ~31) + perm32(R & 31)) : R;
        voffA[i] = (unsigned)(R * K + C) * 2u; voffB[i] = (unsigned)(Rb * K + C) * 2u; }
    const size_t kstep = (size_t)(BK * 2);
    const size_t hstep = (size_t)HALF * K * 2;
    const size_t tstep = 2 * hstep;
    const unsigned ldsw = (unsigned)wid * 1024u;
    const int aoff = lds_byte(wr * 64 + fr, fq * 8), boff = lds_byte(wc * 32 + fr, fq * 8);
#define PG8_SA(b, h) (((b) * 2 + (h)) * HTB)
#define PG8_SB(b, h) ((4 + (b) * 2 + (h)) * HTB)
#define PG8_STAGE(bufoff, gbase, voff) do { _Pragma("unroll") for (int _i = 0; _i < 2; ++_i) \
        __builtin_amdgcn_global_load_lds((const unsigned*)((const char*)(gbase) + (voff)[_i]), (PG8_LAS unsigned*)(lds + (bufoff) + ldsw + _i * 8192), 16, 0, 0); } while (0)
#define PG8_LDA(dst, b, h) do { _Pragma("unroll") for (int m = 0; m < 4; ++m) _Pragma("unroll") for (int k = 0; k < 2; ++k) dst[m][k] = *(const PG8_LAS bf16x8*)(lds + PG8_SA(b, h) + aoff + m * 2048 + k * 1024); } while (0)
#define PG8_LDB(dst, b, h) do { _Pragma("unroll") for (int n = 0; n < 2; ++n) _Pragma("unroll") for (int k = 0; k < 2; ++k) dst[n][k] = *(const PG8_LAS bf16x8*)(lds + PG8_SB(b, h) + boff + n * 2048 + k * 1024); } while (0)
#define PG8_MMA(ai, bj, At, Bt) do { __builtin_amdgcn_s_setprio(1); _Pragma("unroll") for (int m = 0; m < 4; ++m) _Pragma("unroll") for (int n = 0; n < 2; ++n) _Pragma("unroll") for (int k = 0; k < 2; ++k) \
        acc[ai][bj][m][n] = __builtin_amdgcn_mfma_f32_16x16x32_bf16(Bt[n][k], At[m][k], acc[ai][bj][m][n], 0, 0, 0); __builtin_amdgcn_s_setprio(0); } while (0)
#define PG8_WAIT_V(n) asm volatile("s_waitcnt vmcnt(" #n ")" ::: "memory")
#define PG8_WAIT_L(n) asm volatile("s_waitcnt lgkmcnt(" #n ")" ::: "memory")
#define PG8_BAR __builtin_amdgcn_s_barrier()
#define PG8_SCHED __builtin_amdgcn_sched_barrier(0)
    Unit cur, nxt; int ui = 0;
    if (!S.next(0, cur)) return;
    f32x4 acc[2][2][4][2];
#pragma unroll
    for (int a = 0; a < 2; ++a)
#pragma unroll
        for (int b = 0; b < 2; ++b)
#pragma unroll
            for (int m = 0; m < 4; ++m)
#pragma unroll
                for (int n = 0; n < 2; ++n) acc[a][b][m][n] = (f32x4){0.f, 0.f, 0.f, 0.f};
    bf16x8 At[4][2], B0[2][2], B1[2][2];
    const char* cA = (const char*)g.A + (size_t)cur.pm * tstep; const char* cB = (const char*)g.Bt + (size_t)cur.pn * tstep;
    S.a_ready(cur);
    if constexpr (SP2) {
        PG8_STAGE(PG8_SB(0, 0), cB, voffB); PG8_STAGE(PG8_SB(0, 1), cB + hstep, voffB); PG8_STAGE(PG8_SA(0, 0), cA, voffA); PG8_STAGE(PG8_SA(0, 1), cA + hstep, voffA);
        if (wr == 1) PG8_BAR;
        PG8_WAIT_V(2); PG8_BAR;
        PG8_STAGE(PG8_SB(1, 0), cB + kstep, voffB); PG8_STAGE(PG8_SA(1, 0), cA + kstep, voffA); PG8_STAGE(PG8_SB(1, 1), cB + hstep + kstep, voffB);
        PG8_WAIT_V(6); PG8_BAR;
    } else {
        PG8_STAGE(PG8_SB(0, 0), cB, voffB); PG8_STAGE(PG8_SA(0, 0), cA, voffA); PG8_STAGE(PG8_SB(0, 1), cB + hstep, voffB); PG8_STAGE(PG8_SA(0, 1), cA + hstep, voffA);
        if (wr == 1) PG8_BAR;
        PG8_WAIT_V(4); PG8_BAR;
        PG8_STAGE(PG8_SB(1, 0), cB + kstep, voffB); PG8_STAGE(PG8_SA(1, 0), cA + kstep, voffA); PG8_STAGE(PG8_SB(1, 1), cB + hstep + kstep, voffB);
        PG8_WAIT_V(6); PG8_BAR;
    }
    for (;;) {
        const bool has_next = S.next(ui + 1, nxt);
        const char* nA = has_next ? (const char*)g.A + (size_t)nxt.pm * tstep : cA; const char* nB = has_next ? (const char*)g.Bt + (size_t)nxt.pn * tstep : cB;
        for (int t = 0; t < nt; t += 2) {
            const bool last = (t == nt - 2);
            const char* a1 = cA + (size_t)(t + 1) * kstep;
            const char* a2 = last ? nA : cA + (size_t)(t + 2) * kstep; const char* b2 = last ? nB : cB + (size_t)(t + 2) * kstep;
            const char* a3 = a2 + kstep; const char* b3 = b2 + kstep;
            if (last && has_next) S.a_ready(nxt);
            if constexpr (SP2) {
            PG8_LDB(B0, 0, 0); PG8_LDB(B1, 0, 1); PG8_SCHED; PG8_LDA(At, 0, 0); PG8_STAGE(PG8_SA(1, 1), a1 + hstep, voffA);
            PG8_WAIT_V(8); PG8_WAIT_L(0); PG8_BAR; PG8_MMA(0, 0, At, B0); PG8_MMA(0, 1, At, B1); PG8_BAR; PG8_SCHED;
            PG8_LDA(At, 0, 1); PG8_STAGE(PG8_SB(0, 0), b2, voffB); PG8_STAGE(PG8_SB(0, 1), b2 + hstep, voffB); PG8_STAGE(PG8_SA(0, 0), a2, voffA);
            PG8_WAIT_V(8); PG8_WAIT_L(0); PG8_BAR; PG8_MMA(1, 0, At, B0); PG8_MMA(1, 1, At, B1); PG8_BAR; PG8_SCHED;
            PG8_LDB(B0, 1, 0); PG8_LDB(B1, 1, 1); PG8_SCHED; PG8_LDA(At, 1, 0); PG8_STAGE(PG8_SA(0, 1), a2 + hstep, voffA);
            PG8_WAIT_V(8); PG8_WAIT_L(0); PG8_BAR; PG8_MMA(0, 0, At, B0); PG8_MMA(0, 1, At, B1); PG8_BAR; PG8_SCHED;
            PG8_LDA(At, 1, 1); PG8_STAGE(PG8_SB(1, 0), b3, voffB); PG8_STAGE(PG8_SB(1, 1), b3 + hstep, voffB); PG8_STAGE(PG8_SA(1, 0), a3, voffA);
            PG8_WAIT_V(8); PG8_WAIT_L(0); PG8_BAR; PG8_MMA(1, 0, At, B0); PG8_MMA(1, 1, At, B1); PG8_BAR; PG8_SCHED;
            } else {
            PG8_LDB(B0, 0, 0); PG8_SCHED; PG8_LDA(At, 0, 0); PG8_STAGE(PG8_SA(1, 1), a1 + hstep, voffA);
            PG8_WAIT_L(8); PG8_BAR; PG8_WAIT_L(0); PG8_MMA(0, 0, At, B0); PG8_BAR; PG8_SCHED;
            PG8_LDB(B1, 0, 1); PG8_STAGE(PG8_SB(0, 0), b2, voffB);
            PG8_BAR; PG8_WAIT_L(0); PG8_MMA(0, 1, At, B1); PG8_BAR;
            PG8_LDA(At, 0, 1); PG8_STAGE(PG8_SA(0, 0), a2, voffA);
            PG8_BAR; PG8_WAIT_L(0); PG8_MMA(1, 0, At, B0); PG8_BAR; PG8_SCHED;
            PG8_STAGE(PG8_SB(0, 1), b2 + hstep, voffB);
            PG8_WAIT_V(6); PG8_BAR; PG8_MMA(1, 1, At, B1); PG8_BAR;
            PG8_LDB(B0, 1, 0); PG8_SCHED; PG8_LDA(At, 1, 0); PG8_STAGE(PG8_SA(0, 1), a2 + hstep, voffA);
            PG8_WAIT_L(8); PG8_BAR; PG8_WAIT_L(0); PG8_MMA(0, 0, At, B0); PG8_BAR; PG8_SCHED;
            PG8_LDB(B1, 1, 1); PG8_STAGE(PG8_SB(1, 0), b3, voffB);
            PG8_BAR; PG8_WAIT_L(0); PG8_MMA(0, 1, At, B1); PG8_BAR;
            PG8_LDA(At, 1, 1); PG8_STAGE(PG8_SA(1, 0), a3, voffA);
            PG8_BAR; PG8_WAIT_L(0); PG8_MMA(1, 0, At, B0); PG8_BAR; PG8_SCHED;
            PG8_STAGE(PG8_SB(1, 1), b3 + hstep, voffB);
            PG8_WAIT_V(6); PG8_BAR; PG8_MMA(1, 1, At, B1); PG8_BAR;
            }
        }
        if constexpr (ALIGN_EPI) { if (wr == 0) PG8_BAR; }
        if constexpr (!Epi::AFTER_DRAIN) { E(acc, cur, wr, wc, fr, fq); S.done(cur); }
        if (!has_next) break;
#pragma unroll
        for (int a = 0; a < 2; ++a)
#pragma unroll
            for (int b = 0; b < 2; ++b)
#pragma unroll
                for (int m = 0; m < 4; ++m)
#pragma unroll
                    for (int n = 0; n < 2; ++n) acc[a][b][m][n] = (f32x4){0.f, 0.f, 0.f, 0.f};
        cur = nxt; cA = nA; cB = nB; ++ui;
        if constexpr (ALIGN_EPI) { if (wr == 1) PG8_BAR; }
    }
    PG8_WAIT_V(0);
    if constexpr (!ALIGN_EPI) { if (wr == 0) PG8_BAR; }
    PG8_BAR;
    if constexpr (Epi::AFTER_DRAIN) { E.fused(acc, cur, wr, wc, fr, fq, lds, wid, lane); S.done(cur); }
#undef PG8_SA
#undef PG8_SB
#undef PG8_STAGE
#undef PG8_LDA
#undef PG8_LDB
#undef PG8_MMA
#undef PG8_WAIT_V
#undef PG8_WAIT_L
#undef PG8_BAR
#undef PG8_SCHED
}
}
namespace attn {
using bf16 = __hip_bfloat16;
constexpr int   D = 128, NW = 8, QBLK = 32, KVBLK = 64;
constexpr float SCALE = 0.088388347648318440f;
constexpr float THR = 8.f;
constexpr int SDEPTH = 2;
constexpr int LDQ = 1024, LDK = 256, LDO = 1024;
constexpr size_t SHM_V = KVBLK * D * 2, SHM_K = KVBLK * D * 2, SHM_ATTN = 2 * SHM_V + 2 * SHM_K + NW * 64 * 4;
using bf16x8 = __attribute__((ext_vector_type(8))) short;
using s16x4  = __attribute__((ext_vector_type(4))) short;
using f32x16 = __attribute__((ext_vector_type(16))) float;
using f32x8  = __attribute__((ext_vector_type(8))) float;
using u32x4  = __attribute__((ext_vector_type(4))) unsigned;
#define KSWZ(row, colB) ((row) * 256 + ((colB) ^ (((row) & 7) << 4)))
#define SBAR() __builtin_amdgcn_sched_barrier(0)
__device__ __forceinline__ int crow(int r, int hi) { return (r & 3) + 8 * (r >> 2) + 4 * hi; }
__device__ __forceinline__ unsigned cvtpk(float lo, float hi) {
  unsigned r; asm volatile("v_cvt_pk_bf16_f32 %0, %1, %2" : "=v"(r) : "v"(lo), "v"(hi)); return r;
}
template <typename TIn> struct Stage;
template <> struct Stage<bf16>  { using T = bf16x8;
  __device__ static __forceinline__ T ld8(const bf16* p) { return *reinterpret_cast<const bf16x8*>(p); }
  __device__ static __forceinline__ bf16x8 tobf(T x) { return x; } };
template <> struct Stage<float> { using T = f32x8;
  __device__ static __forceinline__ T ld8(const float* p) { return *reinterpret_cast<const f32x8*>(p); }
  __device__ static __forceinline__ bf16x8 tobf(T x) {
    u32x4 w = {cvtpk(x[0], x[1]), cvtpk(x[2], x[3]), cvtpk(x[4], x[5]), cvtpk(x[6], x[7])}; return *reinterpret_cast<bf16x8*>(&w); } };

__device__ __forceinline__ void partialSM(f32x16& p0, f32x16& p1, float& m_reg, float& mn, float& alpha) {
  constexpr float C = SCALE * 1.4426950408889634f;
  float pmax = p0[0]; for (int r = 1; r < 16; ++r) pmax = fmaxf(pmax, p0[r]); for (int r = 0; r < 16; ++r) pmax = fmaxf(pmax, p1[r]);
  { auto rr = __builtin_amdgcn_permlane32_swap(__float_as_uint(pmax), __float_as_uint(pmax), false, false);
    pmax = fmaxf(__uint_as_float(rr[0]), __uint_as_float(rr[1])); }
  if (__builtin_expect(__all(pmax - m_reg <= THR / SCALE), 1)) { mn = m_reg; alpha = 1.f; }
  else { mn = fmaxf(m_reg, pmax); alpha = __builtin_amdgcn_exp2f((m_reg - mn) * C); m_reg = mn; }
  float mnC = -mn * C;
  for (int r = 0; r < 16; ++r) p0[r] = fmaf(p0[r], C, mnC); for (int r = 0; r < 16; ++r) p1[r] = fmaf(p1[r], C, mnC);
  for (int r = 0; r < 16; ++r) p0[r] = __builtin_amdgcn_exp2f(p0[r]);
}
__device__ __forceinline__ void finishSM(f32x16& p0, f32x16& p1, float alpha, float& l_reg, bf16x8& pa0, bf16x8& pa1, bf16x8& pa2, bf16x8& pa3) {
  for (int r = 0; r < 16; ++r) p1[r] = __builtin_amdgcn_exp2f(p1[r]);
  float ps = 0; for (int r = 0; r < 16; ++r) ps += p0[r]; for (int r = 0; r < 16; ++r) ps += p1[r];
  { auto rr = __builtin_amdgcn_permlane32_swap(__float_as_uint(ps), __float_as_uint(ps), false, false);
    ps = __uint_as_float(rr[0]) + __uint_as_float(rr[1]); }
  l_reg = l_reg * alpha + ps;
#define PK4(P, BASE, OUT) do { unsigned a0 = cvtpk(P[BASE + 0], P[BASE + 1]), a1 = cvtpk(P[BASE + 2], P[BASE + 3]);   \
    unsigned b0 = cvtpk(P[BASE + 4], P[BASE + 5]), b1 = cvtpk(P[BASE + 6], P[BASE + 7]);                              \
    auto r0 = __builtin_amdgcn_permlane32_swap(a0, b0, false, false); auto r1 = __builtin_amdgcn_permlane32_swap(a1, b1, false, false); \
    u32x4 w = {r0[0], r1[0], r0[1], r1[1]}; OUT = *reinterpret_cast<bf16x8*>(&w); } while (0)
  PK4(p0, 0, pa0); PK4(p0, 8, pa1); PK4(p1, 0, pa2); PK4(p1, 8, pa3);
#undef PK4
}
__device__ __forceinline__ void qkt(f32x16& p0, f32x16& p1, const bf16* Ks, const bf16x8* qr, int r32, int hi) {
  p0 = f32x16{}; p1 = f32x16{};
  for (int d0 = 0; d0 < 8; ++d0) { int cb = (d0 * 16 + hi * 8) * 2;
    bf16x8 b0 = *reinterpret_cast<const bf16x8*>((const char*)Ks + KSWZ(r32, cb));
    bf16x8 b1 = *reinterpret_cast<const bf16x8*>((const char*)Ks + KSWZ(32 + r32, cb));
    p0 = __builtin_amdgcn_mfma_f32_32x32x16_bf16(b0, qr[d0], p0, 0, 0, 0);
    p1 = __builtin_amdgcn_mfma_f32_32x32x16_bf16(b1, qr[d0], p1, 0, 0, 0); }
}
__device__ __forceinline__ int v_st(int k, int c) { const int kk = (k & ~0xC) | ((k & 4) << 1) | ((k & 8) >> 1); return ((kk >> 3) * 4 + (c >> 5)) * 512 + ((kk & 7) * 32 + (c & 31)) * 2; }
__device__ __forceinline__ int v_rd_base(int lane) { return ((lane & 3) << 3) | (((lane >> 2) & 3) << 6) | (((lane >> 4) & 1) << 5) | (((lane >> 5) & 1) << 8); }
constexpr int v_rd_off(int d0, int ks, int half) { return d0 * 512 + ks * 4096 + half * 2048; }
template <int OFF> __device__ __forceinline__ s16x4 tr_read(int vb) {
  s16x4 r; asm volatile("ds_read_b64_tr_b16 %0, %1 offset:%2" : "=&v"(r) : "v"(vb), "i"(OFF) : "memory"); return r;
}
template <int D0> __device__ __forceinline__ void pv_one(f32x16& od, int vb, bf16x8 pa0, bf16x8 pa1, bf16x8 pa2, bf16x8 pa3) {
  const s16x4 l0 = tr_read<v_rd_off(D0, 0, 0)>(vb), h0 = tr_read<v_rd_off(D0, 0, 1)>(vb), l1 = tr_read<v_rd_off(D0, 1, 0)>(vb), h1 = tr_read<v_rd_off(D0, 1, 1)>(vb);
  const s16x4 l2 = tr_read<v_rd_off(D0, 2, 0)>(vb), h2 = tr_read<v_rd_off(D0, 2, 1)>(vb), l3 = tr_read<v_rd_off(D0, 3, 0)>(vb), h3 = tr_read<v_rd_off(D0, 3, 1)>(vb);
  asm volatile("s_waitcnt lgkmcnt(0)" ::: "memory"); SBAR();
#define PK(L, H) (bf16x8){L[0], L[1], L[2], L[3], H[0], H[1], H[2], H[3]}
  od = __builtin_amdgcn_mfma_f32_32x32x16_bf16(pa0, PK(l0, h0), od, 0, 0, 0);
  od = __builtin_amdgcn_mfma_f32_32x32x16_bf16(pa1, PK(l1, h1), od, 0, 0, 0);
  od = __builtin_amdgcn_mfma_f32_32x32x16_bf16(pa2, PK(l2, h2), od, 0, 0, 0);
  od = __builtin_amdgcn_mfma_f32_32x32x16_bf16(pa3, PK(l3, h3), od, 0, 0, 0);
#undef PK
}
__device__ __forceinline__ void pv_d0(f32x16* o, int vb, bf16x8 pa0, bf16x8 pa1, bf16x8 pa2, bf16x8 pa3) {
  pv_one<0>(o[0], vb, pa0, pa1, pa2, pa3); pv_one<1>(o[1], vb, pa0, pa1, pa2, pa3); pv_one<2>(o[2], vb, pa0, pa1, pa2, pa3); pv_one<3>(o[3], vb, pa0, pa1, pa2, pa3);
}

template <typename TQ>
__device__ __forceinline__ void attn_dense_body(const TQ* Qb, const bf16* Kh, const bf16* Vh,
                                                unsigned short* Ob, int seq, char* lds) {
  using St = Stage<bf16>; using SQ = Stage<TQ>;
  const int tid = opaque_tid(), wid = tid >> 6, lane = tid & 63, r32 = lane & 31, hi = lane >> 5;
  bf16* V_lds = (bf16*)lds; bf16* K_lds = (bf16*)(lds + 2 * SHM_V);
  float* ws = (float*)(lds + 2 * SHM_V + 2 * SHM_K) + wid * 64; float* li_l = ws; float* al_l = ws + 32;
  float m_reg = -1e30f, l_reg = 0; f32x16 o[4] = {}; bf16x8 qr[8];
  const TQ* Qw = Qb + (long)(wid * QBLK + r32) * LDQ + hi * 8;
#pragma unroll
  for (int d0 = 0; d0 < 8; ++d0) qr[d0] = SQ::tobf(SQ::ld8(Qw + d0 * 16));
  const int sr = tid >> 4, sc = (tid & 15) * 8, vst0 = v_st(sr, sc), vst1 = v_st(32 + sr, sc);
  const int vb0 = (int)(uintptr_t)V_lds + v_rd_base(lane);
  struct { typename St::T vs0, vs1, ks0, ks1; } sr_[SDEPTH];
#define SLOAD(i, k0) do { sr_[i].vs0 = St::ld8(&Vh[(long)((k0) + sr) * LDK + sc]); sr_[i].vs1 = St::ld8(&Vh[(long)((k0) + 32 + sr) * LDK + sc]); \
    sr_[i].ks0 = St::ld8(&Kh[(long)((k0) + sr) * LDK + sc]); sr_[i].ks1 = St::ld8(&Kh[(long)((k0) + 32 + sr) * LDK + sc]); } while (0)
#define SWRITE(b, i) do { *(bf16x8*)((char*)V_lds + (b) * SHM_V + vst0) = St::tobf(sr_[i].vs0);          \
    *(bf16x8*)((char*)V_lds + (b) * SHM_V + vst1) = St::tobf(sr_[i].vs1); int kc = sc * 2;               \
    *(bf16x8*)((char*)K_lds + (b) * SHM_K + KSWZ(sr, kc)) = St::tobf(sr_[i].ks0);                       \
    *(bf16x8*)((char*)K_lds + (b) * SHM_K + KSWZ(32 + sr, kc)) = St::tobf(sr_[i].ks1); } while (0)
#define SWAIT() do { if constexpr (SDEPTH == 2) asm volatile("s_waitcnt vmcnt(4)" ::: "memory"); else asm volatile("s_waitcnt vmcnt(0)" ::: "memory"); } while (0)
#define RESC(a) do { if (__any((a) < 1.f)) { if (hi == 0) al_l[r32] = (a); asm volatile("s_waitcnt lgkmcnt(0)" ::: "memory"); \
    for (int d = 0; d < 4; ++d) for (int r = 0; r < 16; ++r) o[d][r] *= al_l[crow(r, hi)]; } } while (0)
  f32x16 pA0, pA1, pB0, pB1; float mnA, mnB, alA, alB; bf16x8 pa0, pa1, pa2, pa3; const int NT = seq / KVBLK;
  constexpr int SE = 0, SO = SDEPTH - 1;
  SLOAD(SE, 0); asm volatile("s_waitcnt vmcnt(0)" ::: "memory"); SWRITE(0, SE); __syncthreads();
  qkt(pA0, pA1, K_lds, qr, r32, hi); partialSM(pA0, pA1, m_reg, mnA, alA);
  SLOAD(SO, KVBLK); if constexpr (SDEPTH == 2) { if (2 < NT) SLOAD(SE, 2 * KVBLK); }
  SWAIT(); SWRITE(1, SO); __syncthreads();
  for (int j = 1; j + 1 < NT; j += 2) {
    SBAR(); qkt(pB0, pB1, (bf16*)((char*)K_lds + SHM_K), qr, r32, hi);
    finishSM(pA0, pA1, alA, l_reg, pa0, pa1, pa2, pa3); SBAR();
    SLOAD(SO, (j + SDEPTH) * KVBLK); SBAR();
    pv_d0(o, vb0, pa0, pa1, pa2, pa3); partialSM(pB0, pB1, m_reg, mnB, alB);
    __syncthreads(); SWAIT(); SWRITE(0, SE);
    RESC(alB); __syncthreads();
    SBAR(); qkt(pA0, pA1, K_lds, qr, r32, hi);
    finishSM(pB0, pB1, alB, l_reg, pa0, pa1, pa2, pa3); SBAR();
    if (SDEPTH == 1 || j + 3 < NT) SLOAD(SE, (j + 1 + SDEPTH) * KVBLK); SBAR();
    pv_d0(o, vb0 + (int)SHM_V, pa0, pa1, pa2, pa3); partialSM(pA0, pA1, m_reg, mnA, alA);
    __syncthreads(); SWAIT(); SWRITE(1, SO);
    RESC(alA); __syncthreads();
  }
  SBAR(); qkt(pB0, pB1, (bf16*)((char*)K_lds + SHM_K), qr, r32, hi);
  finishSM(pA0, pA1, alA, l_reg, pa0, pa1, pa2, pa3); SBAR();
  pv_d0(o, vb0, pa0, pa1, pa2, pa3); partialSM(pB0, pB1, m_reg, mnB, alB);
  __syncthreads(); RESC(alB);
  finishSM(pB0, pB1, alB, l_reg, pa0, pa1, pa2, pa3); SBAR();
  pv_d0(o, vb0 + (int)SHM_V, pa0, pa1, pa2, pa3);
  if (hi == 0) li_l[r32] = l_reg; asm volatile("s_waitcnt lgkmcnt(0)" ::: "memory");
  float rli[16];
#pragma unroll
  for (int r = 0; r < 16; ++r) rli[r] = __builtin_amdgcn_rcpf(li_l[crow(r, hi)]);
  unsigned short* Ow = Ob + (long)(wid * QBLK) * LDO;
#pragma unroll
  for (int r = 0; r < 16; ++r) { int orow = crow(r, hi);
    for (int d0 = 0; d0 < 4; ++d0) Ow[(long)orow * LDO + d0 * 32 + r32] = (unsigned short)(cvtpk(o[d0][r] * rli[r], 0.f) & 0xffffu); }
#undef SLOAD
#undef SWRITE
#undef SWAIT
#undef RESC
}
}
#define XB_TMO      128
#define XB_XCNT(j)  (256  + 64 * (j))
#define XB_XSUB(j)  (1280 + 64 * (j))
#define XB_XGEN(j)  (2304 + 64 * (j))
#define XB_TOP      3328
#define XB_TOPGEN   3392
#define XCD_BAR_WORDS 3456
#define XB_SPIN_CAP (1u << 18)

__device__ __forceinline__ unsigned xb_ld(unsigned* p)              { return __hip_atomic_load(p, __ATOMIC_RELAXED, __HIP_MEMORY_SCOPE_AGENT); }
__device__ __forceinline__ unsigned xb_add(unsigned* p, unsigned v) { return __hip_atomic_fetch_add(p, v, __ATOMIC_RELAXED, __HIP_MEMORY_SCOPE_AGENT); }
__device__ __forceinline__ unsigned xb_xcc_id() { return (unsigned)__builtin_amdgcn_s_getreg((3 << 11) | 20) & 0xFu; }
#define XB_SPIN(cond, bar) do { unsigned _sp = 0; while (cond) { __builtin_amdgcn_s_sleep(1); \
    if ((++_sp & 255u) == 0u) { if (xb_ld(&(bar)[XB_TMO])) break; if (_sp > XB_SPIN_CAP) { atomicAdd(&(bar)[XB_TMO], 1u); break; } } } } while (0)

struct XcdBarrier {
    unsigned* bar; unsigned x;
    volatile LAS unsigned* st;
};

__device__ __forceinline__ XcdBarrier xcd_barrier_post(unsigned* bar, volatile LAS unsigned* st) {
    XcdBarrier b; b.bar = bar; b.x = xb_xcc_id(); b.st = st;
    if (threadIdx.x == 0) (void)xb_add(&bar[XB_XCNT(b.x)], 1u);
    return b;
}
__device__ __forceinline__ void xcd_barrier_complete(unsigned* bar, unsigned x, unsigned& nloc, unsigned& nx) {
    const unsigned G = gridDim.x * gridDim.y * gridDim.z;
    unsigned sum, cnt, mine, sp = 0u;
    for (;;) {
        sum = 0u; cnt = 0u; mine = 0u;
#pragma unroll
        for (unsigned j = 0; j < 16; ++j) { const unsigned c = xb_ld(&bar[XB_XCNT(j)]); sum += c; cnt += (c > 0u) ? 1u : 0u; mine = (j == x) ? c : mine; }
        if (sum == G) break;
        __builtin_amdgcn_s_sleep(1);
        if ((++sp & 255u) == 0u) { if (xb_ld(&bar[XB_TMO])) break; if (sp > XB_SPIN_CAP) { atomicAdd(&bar[XB_TMO], 1u); break; } }
    }
    nloc = mine > 0u ? mine : 1u; nx = cnt > 0u ? cnt : 1u;
}

__device__ __forceinline__ void xcd_barrier(const XcdBarrier& b) {
    asm volatile("s_waitcnt vmcnt(0)" ::: "memory");
    __syncthreads();
    if (threadIdx.x == 0) {
        unsigned* bar = b.bar;
        __builtin_amdgcn_s_waitcnt(0);
        unsigned nloc = b.st[0], nx = b.st[1];
        if (nloc == 0u) { xcd_barrier_complete(bar, b.x, nloc, nx); b.st[0] = nloc; b.st[1] = nx; }
        const unsigned old = xb_add(&bar[XB_XSUB(b.x)], 1u);
        const unsigned gen = old / nloc;
        if (old + 1u == (gen + 1u) * nloc) {
            __builtin_amdgcn_fence(__ATOMIC_RELEASE, "agent");
            asm volatile("s_waitcnt vmcnt(0)" ::: "memory");
            const unsigned og = xb_add(&bar[XB_TOP], 1u);
            const unsigned tg = og / nx;
            if (og + 1u == (tg + 1u) * nx) xb_add(&bar[XB_TOPGEN], 1u);
            else XB_SPIN(xb_ld(&bar[XB_TOPGEN]) == tg, bar);
            __builtin_amdgcn_fence(__ATOMIC_ACQUIRE, "agent");
            xb_add(&bar[XB_XGEN(b.x)], 1u);
            asm volatile("s_waitcnt vmcnt(0)" ::: "memory");
        } else {
            XB_SPIN(xb_ld(&bar[XB_XGEN(b.x)]) == gen, bar);
            __builtin_amdgcn_fence(__ATOMIC_ACQUIRE, "agent");
            asm volatile("s_waitcnt vmcnt(0)" ::: "memory");
        }
    }
    __syncthreads();
}
#define LAS __attribute__((address_space(3)))
typedef unsigned short bf16_t;
typedef float f32x4 __attribute__((ext_vector_type(4)));
typedef float f32x2 __attribute__((ext_vector_type(2)));
typedef unsigned u32x4 __attribute__((ext_vector_type(4)));
typedef unsigned u32x2 __attribute__((ext_vector_type(2)));
typedef short bf16x8 __attribute__((ext_vector_type(8)));
typedef short s16x4 __attribute__((ext_vector_type(4)));
#define LDS_WAIT() asm volatile("s_waitcnt lgkmcnt(0)" ::: "memory")
using pg8::cvt_pk_bf16; using pg8::bf_lo; using pg8::bf_hi; using pg8::sigmoidf_;

__device__ __forceinline__ float wave_sum(float v) {
#pragma unroll
    for (int o = 1; o < 64; o <<= 1) v += __shfl_xor(v, o);
    return v;
}

__device__ __forceinline__ void transpose_item(const float* __restrict__ W, int ldW, int K, int src_n0, int k0, bf16_t* WT, int dst_row0, LAS float* scr, int lane, int pmode = -1) {
#pragma unroll 8
    for (int i = 0; i < 32; ++i) { const int kk = 2 * i + (lane >> 5); scr[kk * 33 + (lane & 31)] = W[(size_t)(k0 + kk) * ldW + src_n0 + (lane & 31)]; }
    LDS_WAIT(); asm volatile("" ::: "memory");
    const int c = lane & 7;
#pragma unroll
    for (int j = 0; j < 4; ++j) { const int n = (lane >> 3) + 8 * j; const LAS float* s = scr + (8 * c) * 33 + n;
        u32x4 o; o.x = cvt_pk_bf16(s[0 * 33], s[1 * 33]); o.y = cvt_pk_bf16(s[2 * 33], s[3 * 33]); o.z = cvt_pk_bf16(s[4 * 33], s[5 * 33]); o.w = cvt_pk_bf16(s[6 * 33], s[7 * 33]);
        const int nn = pmode < 0 ? n : 32 * (2 * (pmode >> 1) + (n >> 4)) + 8 * ((n >> 2) & 3) + 4 * (pmode & 1) + (n & 3);
        *(u32x4*)(WT + (size_t)(dst_row0 + nn) * K + k0 + 8 * c) = o; }
    LDS_WAIT(); asm volatile("" ::: "memory");
}

struct Args { const float* in[20]; float* out; unsigned char* ws; int ph_lo, ph_hi; };
typedef const __attribute__((address_space(4))) Args* KA;

__device__ __forceinline__ void prep_layer(KA a, int L, LAS unsigned char* lds, int gw, int NGW, int wave, int lane) {
    LAS float* scr = (LAS float*)(lds + wave * 8448);
    unsigned char* wsW = a->ws + WS_W;
    const float* w_in = a->in[3] + (size_t)L * DM * INW;
    const float* w_ogla = a->in[9] + (size_t)L * DM * DM; const float* w_oatt = a->in[10] + (size_t)L * DM * DM; const float* w_out = a->in[11] + (size_t)L * DM * DM;
    const float* w_fin = a->in[14] + (size_t)L * DM * 2 * FFH; const float* w_fout = a->in[15] + (size_t)L * FFH * DM;
    const float* w_pp = a->in[17] + (size_t)L * PLE * DM; const float* w_pg = a->in[18] + (size_t)L * DM * DM;
    constexpr int I_A = 16 * 97, I_B = 16 * 112, I_SQ = 16 * 32, I_FI = 16 * 176, I_FO = 44 * 32, I_PP = 4 * 32;
    constexpr int NITEMS = I_A + I_B + 4 * I_SQ + I_FI + I_FO + I_PP;
    for (int it = gw; it < NITEMS; it += NGW) {
        int r = it;
        if (r < I_A) { const int kb = r / 97, nb = r % 97; transpose_item(w_in, INW, DM, 32 * nb, 64 * kb, (bf16_t*)(wsW + W_INA), 32 * nb, scr, lane); continue; } r -= I_A;
        if (r < I_B) { const int kb = r / 112, nb = r % 112; const int d0 = (32 * nb) & 127;
            if (nb < 40) transpose_item(w_in, INW, DM, NA_REAL + 32 * nb, 64 * kb, (bf16_t*)(wsW + W_INB), 32 * nb - d0, scr, lane, (d0 >> 6) * 2 + ((d0 >> 5) & 1));
            else transpose_item(w_in, INW, DM, NA_REAL + 32 * nb, 64 * kb, (bf16_t*)(wsW + W_INB), 32 * nb, scr, lane);
            continue; } r -= I_B;
        if (r < 4 * I_SQ) { const int which = r / I_SQ, q = r % I_SQ, kb = q / 32, nb = q % 32;
            const float* src = which == 0 ? w_ogla : which == 1 ? w_oatt : which == 2 ? w_out : w_pg;
            const size_t dsto = which == 0 ? W_OGLA : which == 1 ? W_OATT : which == 2 ? W_OUT : W_PG;
            transpose_item(src, DM, DM, 32 * nb, 64 * kb, (bf16_t*)(wsW + dsto), 32 * nb, scr, lane); continue; } r -= 4 * I_SQ;
        if (r < I_FI) { const int kb = r / 176, nb = r % 176; const int n0 = 32 * nb; const int j = n0 < FFH ? n0 : n0 - FFH; const int dst = (j >> 7) * 256 + (n0 < FFH ? 0 : 128) + (j & 127);
            transpose_item(w_fin, 2 * FFH, DM, n0, 64 * kb, (bf16_t*)(wsW + W_FIN), dst, scr, lane); continue; } r -= I_FI;
        if (r < I_FO) { const int kb = r / 32, nb = r % 32; transpose_item(w_fout, DM, FFH, 32 * nb, 64 * kb, (bf16_t*)(wsW + W_FOUT), 32 * nb, scr, lane); continue; } r -= I_FO;
        { const int kb = r / 32, nb = r % 32; transpose_item(w_pp, DM, PLE, 32 * nb, 64 * kb, (bf16_t*)(wsW + W_PP), 32 * nb, scr, lane); }
    }
    { u32x4* z = (u32x4*)(wsW + W_INA + (size_t)NA_REAL * DM * 2); const int nz = (NA_PAD - NA_REAL) * DM * 2 / 16;
      for (int i = gw * 64 + lane; i < nz; i += NGW * 64) z[i] = (u32x4){0u, 0u, 0u, 0u}; }
    { const float* p = a->in[1] + (size_t)L * TOK * PLE; bf16_t* pb = (bf16_t*)(a->ws + WS_PB); const int n8 = TOK * PLE / 8;
      for (int i = gw * 64 + lane; i < n8; i += NGW * 64) { const f32x4 x0 = *(const f32x4*)(p + (size_t)i * 8), x1 = *(const f32x4*)(p + (size_t)i * 8 + 4);
          u32x4 o; o.x = cvt_pk_bf16(x0[0], x0[1]); o.y = cvt_pk_bf16(x0[2], x0[3]); o.z = cvt_pk_bf16(x1[0], x1[1]); o.w = cvt_pk_bf16(x1[2], x1[3]); *(u32x4*)(pb + (size_t)i * 8) = o; } }
}

template <bool IN_F32, bool OUT_F32>
__device__ __forceinline__ void row_pass(const void* hin, void* hout, const bf16_t* y, const float* __restrict__ gpost, const float* __restrict__ gpre, bf16_t* xa, int gw, int NGW, int lane) {
    for (int m0 = gw; m0 < TOK; m0 += 2 * NGW) {
        f32x4 v[2][4]; u32x2 yw[2][4];
#pragma unroll
        for (int r = 0; r < 2; ++r) { const size_t m = (size_t)m0 + (size_t)r * NGW;
#pragma unroll
            for (int j = 0; j < 4; ++j) {
                if (IN_F32) v[r][j] = ((const f32x4*)((const float*)hin + m * DM))[lane + 64 * j];
                else { const u32x2 w = ((const u32x2*)((const bf16_t*)hin + m * DM))[lane + 64 * j]; v[r][j] = (f32x4){bf_lo(w.x), bf_hi(w.x), bf_lo(w.y), bf_hi(w.y)}; }
                if (y) yw[r][j] = ((const u32x2*)(y + m * DM))[lane + 64 * j]; } }
#pragma unroll
        for (int r = 0; r < 2; ++r) { const size_t m = (size_t)m0 + (size_t)r * NGW;
            if (y) {
                f32x4 yv[4]; float ss = 0.f;
#pragma unroll
                for (int j = 0; j < 4; ++j) { const u32x2 w = yw[r][j]; yv[j] = (f32x4){bf_lo(w.x), bf_hi(w.x), bf_lo(w.y), bf_hi(w.y)};
                    ss += (yv[j][0] * yv[j][0] + yv[j][1] * yv[j][1]) + (yv[j][2] * yv[j][2] + yv[j][3] * yv[j][3]); }
                const float rs = rsqrtf(wave_sum(ss) * (1.0f / DM) + EPS);
#pragma unroll
                for (int j = 0; j < 4; ++j) { const f32x4 g = ((const f32x4*)gpost)[lane + 64 * j]; v[r][j] = v[r][j] + yv[j] * rs * g; }
            }
#pragma unroll
            for (int j = 0; j < 4; ++j) {
                if (OUT_F32) ((f32x4*)((float*)hout + m * DM))[lane + 64 * j] = v[r][j];
                else { u32x2 w; w.x = cvt_pk_bf16(v[r][j][0], v[r][j][1]); w.y = cvt_pk_bf16(v[r][j][2], v[r][j][3]); ((u32x2*)((bf16_t*)hout + m * DM))[lane + 64 * j] = w; } }
            if (gpre) {
                float ss = 0.f;
#pragma unroll
                for (int j = 0; j < 4; ++j) ss += (v[r][j][0] * v[r][j][0] + v[r][j][1] * v[r][j][1]) + (v[r][j][2] * v[r][j][2] + v[r][j][3] * v[r][j][3]);
                const float r2 = rsqrtf(wave_sum(ss) * (1.0f / DM) + EPS);
#pragma unroll
                for (int j = 0; j < 4; ++j) { const f32x4 o = v[r][j] * r2 * ((const f32x4*)gpre)[lane + 64 * j];
                    u32x2 w; w.x = cvt_pk_bf16(o[0], o[1]); w.y = cvt_pk_bf16(o[2], o[3]); ((u32x2*)(xa + m * DM))[lane + 64 * j] = w; }
            }
        }
    }
}

__device__ __forceinline__ void qk_norm_rope(unsigned char* rbase, const float* __restrict__ gq, const float* __restrict__ gk, int gw, int NGW, int lane) {
    const int axis = lane >> 5, j = lane & 31, i1 = axis * 64 + j, i2 = i1 + 32;
    const float inv = __builtin_amdgcn_exp2f(-(float)j * (13.287712379549449f / 32.0f));
    const float gq1 = gq[i1], gq2 = gq[i2], gk1 = gk[i1], gk2 = gk[i2];
    for (int it = gw; it < TOK * 10; it += NGW) {
        const int t = it / 10, hs = it % 10;
        bf16_t* p = hs < 8 ? (bf16_t*)(rbase + R_Q) + (size_t)t * 1024 + hs * 128 : (bf16_t*)(rbase + R_K) + (size_t)t * 256 + (hs - 8) * 128;
        const float g1 = hs < 8 ? gq1 : gk1, g2 = hs < 8 ? gq2 : gk2;
        float x1 = bf_lo((unsigned)p[i1]), x2 = bf_lo((unsigned)p[i2]);
        const float rs = rsqrtf(wave_sum(x1 * x1 + x2 * x2) * (1.0f / 128.0f) + EPS);
        x1 = x1 * rs * g1; x2 = x2 * rs * g2;
        const int s = t & (SEQ - 1); const float pos = (float)(axis == 0 ? (s >> 6) : (s & 63));
        const float rev = pos * inv * 0.15915494309189535f;
        const float rf = __builtin_amdgcn_fractf(rev); const float c = __builtin_amdgcn_cosf(rf), sn = __builtin_amdgcn_sinf(rf);
        const float o1 = x1 * c - x2 * sn, o2 = x2 * c + x1 * sn;
        p[i1] = (bf16_t)(cvt_pk_bf16(o1, 0.f) & 0xffffu); p[i2] = (bf16_t)(cvt_pk_bf16(o2, 0.f) & 0xffffu);
    }
}

__device__ __forceinline__ void gla_post(bf16_t* of, const bf16_t* ob, const bf16_t* gg, const float* __restrict__ g, int gw, int NGW, int lane) {
    const f32x4 gv = ((const f32x4*)g)[lane];
    for (int it0 = gw; it0 < TOK * 4; it0 += 2 * NGW) {
        u32x2 a[2], b[2], c[2];
#pragma unroll
        for (int r = 0; r < 2; ++r) { const size_t off = ((size_t)it0 + (size_t)r * NGW) * 256 + 4 * lane; a[r] = *(const u32x2*)(of + off); b[r] = *(const u32x2*)(ob + off); c[r] = *(const u32x2*)(gg + off); }
#pragma unroll
        for (int r = 0; r < 2; ++r) { const size_t off = ((size_t)it0 + (size_t)r * NGW) * 256 + 4 * lane;
            f32x4 o = (f32x4){bf_lo(a[r].x) + bf_lo(b[r].x), bf_hi(a[r].x) + bf_hi(b[r].x), bf_lo(a[r].y) + bf_lo(b[r].y), bf_hi(a[r].y) + bf_hi(b[r].y)};
            const float rs = rsqrtf(wave_sum((o[0] * o[0] + o[1] * o[1]) + (o[2] * o[2] + o[3] * o[3])) * (1.0f / 256.0f) + EPS);
            const f32x4 gt = (f32x4){bf_lo(c[r].x), bf_hi(c[r].x), bf_lo(c[r].y), bf_hi(c[r].y)};
#pragma unroll
            for (int k = 0; k < 4; ++k) o[k] = o[k] * rs * gv[k] * (gt[k] * sigmoidf_(gt[k]));
            u32x2 w; w.x = cvt_pk_bf16(o[0], o[1]); w.y = cvt_pk_bf16(o[2], o[3]); *(u32x2*)(of + off) = w; }
    }
}
constexpr int GL_QD = 0, GL_KI = 17408, GL_KST = 34816, GL_VT = 53248, GL_STT = 62464, GL_EL = 79872, GL_RA = 80384, GL_TOT = 84480, GL_END = 88576;
constexpr int GS_Q = 272, GS_T = 144;
constexpr size_t R_QDF = 132 * MiB, R_KIF = 164 * MiB, R_EL = 196 * MiB;

__device__ __forceinline__ void gla_prep(KA a, int L, int b, int ci, int h, LAS unsigned char* lds) {
    const int tid = opaque_tid(), lane = tid & 63, w = __builtin_amdgcn_readfirstlane(tid >> 6);
    unsigned char* rbase = a->ws + WS_R;
    const bf16_t* GQ = (const bf16_t*)(rbase + R_GQ); const bf16_t* GK = (const bf16_t*)(rbase + R_GK); const float* RA = (const float*)(rbase + R_RA);
    const size_t t0 = (size_t)b * SEQ + (size_t)ci * 64; const int vrow = tid >> 3, vc8 = tid & 7;
    unsigned qc[8], kc[8];
#pragma unroll
    for (int r = 0; r < 8; ++r) { qc[r] = *(const unsigned*)(GQ + (t0 + 8 * w + r) * 512 + h * 128 + 2 * lane); kc[r] = *(const unsigned*)(GK + (t0 + 8 * w + r) * 512 + h * 128 + 2 * lane); }
#pragma unroll 1
    for (int dir = 0; dir < 2; ++dir) {
        bf16_t* QD = dir ? (bf16_t*)((unsigned char*)a->out + 64 * MiB) : (bf16_t*)(rbase + R_QDF);
        bf16_t* KI = dir ? (bf16_t*)((unsigned char*)a->out + 96 * MiB) : (bf16_t*)(rbase + R_KIF);
        float* EL = (float*)(rbase + R_EL) + ((size_t)dir * 512 + (size_t)b * 64 + ci) * 512;
        f32x2 wu[16];
        { const float* wup = a->in[4] + ((size_t)(L * 2 + dir) * 16) * 512 + h * 128 + 2 * lane;
#pragma unroll
          for (int j = 0; j < 16; ++j) wu[j] = *(const f32x2*)(wup + (size_t)j * 512); }
        const f32x2 bias = *(const f32x2*)(a->in[5] + (size_t)(L * 2 + dir) * 512 + h * 128 + 2 * lane);
        *(LAS f32x2*)(lds + GL_RA + vrow * 64 + vc8 * 8) = *(const f32x2*)(RA + (t0 + vrow) * 32 + dir * 16 + 2 * vc8);
        __syncthreads();
        float la0[8], la1[8];
#pragma unroll
        for (int r = 0; r < 8; ++r) {
            const LAS f32x4* rr = (const LAS f32x4*)(lds + GL_RA + (8 * w + r) * 64);
            f32x2 x = bias;
#pragma unroll
            for (int q4 = 0; q4 < 4; ++q4) { const f32x4 t = rr[q4];
#pragma unroll
                for (int e = 0; e < 4; ++e) x = __builtin_elementwise_fma((f32x2){t[e], t[e]}, wu[4 * q4 + e], x); }
            const f32x2 xl = x * 1.4426950408889634f;
            la0[r] = (fminf(xl.x, 0.f) - __builtin_amdgcn_logf(1.0f + __builtin_amdgcn_exp2f(-fabsf(xl.x)))) * (1.0f / 16.0f);
            la1[r] = (fminf(xl.y, 0.f) - __builtin_amdgcn_logf(1.0f + __builtin_amdgcn_exp2f(-fabsf(xl.y)))) * (1.0f / 16.0f);
        }
        if (dir == 0) {
#pragma unroll
            for (int r = 1; r < 8; ++r) { la0[r] += la0[r - 1]; la1[r] += la1[r - 1]; }
        } else {
#pragma unroll
            for (int r = 6; r >= 0; --r) { la0[r] += la0[r + 1]; la1[r] += la1[r + 1]; }
        }
        *(LAS f32x2*)(lds + GL_TOT + w * 512 + lane * 8) = (f32x2){dir == 0 ? la0[7] : la0[0], dir == 0 ? la1[7] : la1[0]};
        __syncthreads();
        float off0 = 0.f, off1 = 0.f, last0 = 0.f, last1 = 0.f;
#pragma unroll
        for (int g = 0; g < 8; ++g) { const f32x2 t = *(const LAS f32x2*)(lds + GL_TOT + g * 512 + lane * 8); last0 += t.x; last1 += t.y;
            const bool before = dir == 0 ? (g < w) : (g > w); if (before) { off0 += t.x; off1 += t.y; } }
#pragma unroll
        for (int r = 0; r < 8; ++r) {
            const float c0 = la0[r] + off0, c1 = la1[r] + off1;
            const float q0 = bf_lo(qc[r]), q1 = bf_hi(qc[r]), k0 = bf_lo(kc[r]), k1 = bf_hi(kc[r]);
            const float eq0 = __builtin_amdgcn_exp2f(c0) * 0.088388347648318440f, eq1 = __builtin_amdgcn_exp2f(c1) * 0.088388347648318440f;
            const size_t o = (t0 + 8 * w + r) * 512 + h * 128 + 2 * lane;
            *(unsigned*)(QD + o) = cvt_pk_bf16(q0 * eq0, q1 * eq1);
            *(unsigned*)(KI + o) = cvt_pk_bf16(k0 * __builtin_amdgcn_exp2f(-c0), k1 * __builtin_amdgcn_exp2f(-c1));
        }
        if (w == 0) *(f32x2*)(EL + h * 128 + 2 * lane) = (f32x2){__builtin_amdgcn_exp2f(last0), __builtin_amdgcn_exp2f(last1)};
        __syncthreads();
    }
}

__device__ __forceinline__ void gla_unit(KA a, int L, int b, int h, int dir, int vs, LAS unsigned char* lds) {
    const int tid = opaque_tid(), lane = tid & 63, w = __builtin_amdgcn_readfirstlane(tid >> 6);
    unsigned char* rbase = a->ws + WS_R;
    const bf16_t* QDg = dir ? (const bf16_t*)((unsigned char*)a->out + 64 * MiB) : (const bf16_t*)(rbase + R_QDF);
    const bf16_t* KIg = dir ? (const bf16_t*)((unsigned char*)a->out + 96 * MiB) : (const bf16_t*)(rbase + R_KIF);
    const float* ELg = (const float*)(rbase + R_EL) + ((size_t)dir * 512 + (size_t)b * 64) * 512 + h * 128;
    const bf16_t* GV = (const bf16_t*)(rbase + R_GV);
    bf16_t* O = (bf16_t*)(a->ws + (dir ? WS_OB : WS_OF));
    f32x4 st[4];
#pragma unroll
    for (int nb = 0; nb < 4; ++nb) st[nb] = (f32x4){0.f, 0.f, 0.f, 0.f};
    for (int i = tid; i < 17408 / 4; i += 512) ((LAS unsigned*)(lds + GL_STT))[i] = 0u;
    const int li = lane & 15, kq = lane >> 4, ib = w & 3, dh = w >> 2;
    const int vrow = tid >> 3, vc8 = tid & 7;
    const int tswz = (((vrow >> 3) ^ vc8) << 4) + (vrow & 7) * 2;
    const int fl = li >> 3;
    u32x4 qd0, qd1, ki0, ki1, vv; float elv = 0.f;
#define GLA_LOAD(ci_) do { const size_t t0_ = (size_t)b * SEQ + (size_t)(ci_) * 64; const size_t o_ = (t0_ + vrow) * 512 + h * 128 + vc8 * 8; \
        qd0 = *(const u32x4*)(QDg + o_); qd1 = *(const u32x4*)(QDg + o_ + 64); ki0 = *(const u32x4*)(KIg + o_); ki1 = *(const u32x4*)(KIg + o_ + 64); \
        vv = *(const u32x4*)(GV + (t0_ + vrow) * 1024 + h * 256 + vs * 64 + vc8 * 8); if (tid < 128) elv = ELg[(size_t)(ci_) * 512 + tid]; } while (0)
#define GLA_TR8(base_, v_) do { LAS unsigned char* p_ = (base_); const u32x4 x_ = (v_); \
        *(LAS unsigned short*)(p_ + 0 * GS_T) = (unsigned short)(x_.x & 0xffff); *(LAS unsigned short*)(p_ + 1 * GS_T) = (unsigned short)(x_.x >> 16); \
        *(LAS unsigned short*)(p_ + 2 * GS_T) = (unsigned short)(x_.y & 0xffff); *(LAS unsigned short*)(p_ + 3 * GS_T) = (unsigned short)(x_.y >> 16); \
        *(LAS unsigned short*)(p_ + 4 * GS_T) = (unsigned short)(x_.z & 0xffff); *(LAS unsigned short*)(p_ + 5 * GS_T) = (unsigned short)(x_.z >> 16); \
        *(LAS unsigned short*)(p_ + 6 * GS_T) = (unsigned short)(x_.w & 0xffff); *(LAS unsigned short*)(p_ + 7 * GS_T) = (unsigned short)(x_.w >> 16); } while (0)
    GLA_LOAD(dir ? 63 : 0);
    for (int c = 0; c < 64; ++c) {
        const int ci = dir ? 63 - c : c; const size_t t0 = (size_t)b * SEQ + (size_t)ci * 64;
        *(LAS u32x4*)(lds + GL_QD + vrow * GS_Q + vc8 * 16) = qd0; *(LAS u32x4*)(lds + GL_QD + vrow * GS_Q + 128 + vc8 * 16) = qd1;
        *(LAS u32x4*)(lds + GL_KI + vrow * GS_Q + vc8 * 16) = ki0; *(LAS u32x4*)(lds + GL_KI + vrow * GS_Q + 128 + vc8 * 16) = ki1;
        GLA_TR8(lds + GL_KST + (vc8 * 8) * GS_T + tswz, ki0); GLA_TR8(lds + GL_KST + (64 + vc8 * 8) * GS_T + tswz, ki1);
        GLA_TR8(lds + GL_VT + (vc8 * 8) * GS_T + tswz, vv);
        if (tid < 128) *(LAS float*)(lds + GL_EL + tid * 4) = elv;
        asm volatile("s_waitcnt lgkmcnt(0)" ::: "memory"); __builtin_amdgcn_s_barrier(); asm volatile("" ::: "memory");
        if (c + 1 < 64) GLA_LOAD(dir ? 62 - c : c + 1);
        bf16x8 qf[4];
#pragma unroll
        for (int kk = 0; kk < 4; ++kk) qf[kk] = *(const LAS bf16x8*)(lds + GL_QD + (16 * ib + li) * GS_Q + kk * 64 + kq * 16);
        unsigned pk[4][2];
#pragma unroll
        for (int sb = 0; sb < 4; ++sb) {
            if (dir == 0 ? (sb > ib) : (sb < ib)) { pk[sb][0] = 0u; pk[sb][1] = 0u; continue; }
            f32x4 sacc = (f32x4){0.f, 0.f, 0.f, 0.f};
#pragma unroll
            for (int kk = 0; kk < 4; ++kk) { const bf16x8 kf = *(const LAS bf16x8*)(lds + GL_KI + (16 * sb + li) * GS_Q + kk * 64 + kq * 16);
                sacc = __builtin_amdgcn_mfma_f32_16x16x32_bf16(kf, qf[kk], sacc, 0, 0, 0); }
            const int irow = 16 * ib + li;
#pragma unroll
            for (int j = 0; j < 4; ++j) { const int srow = 16 * sb + 4 * kq + j; const bool keep = dir == 0 ? (srow <= irow) : (srow >= irow); sacc[j] = keep ? sacc[j] : 0.f; }
            pk[sb][0] = cvt_pk_bf16(sacc[0], sacc[1]); pk[sb][1] = cvt_pk_bf16(sacc[2], sacc[3]);
        }
#pragma unroll
        for (int d2 = 0; d2 < 2; ++d2) { const int db = 2 * dh + d2;
            f32x4 oacc = (f32x4){0.f, 0.f, 0.f, 0.f};
#pragma unroll
            for (int kk = 0; kk < 4; ++kk) { const bf16x8 sf = *(const LAS bf16x8*)(lds + GL_STT + (16 * db + li) * GS_Q + kk * 64 + kq * 16);
                oacc = __builtin_amdgcn_mfma_f32_16x16x32_bf16(sf, qf[kk], oacc, 0, 0, 0); }
#pragma unroll
            for (int kc2 = 0; kc2 < 2; ++kc2) {
                const int fv = (2 * db + fl) & 7;
                const s16x4 lo = *(const LAS s16x4*)(lds + GL_VT + (16 * db + li) * GS_T + (((4 * kc2 + (kq >> 1)) ^ fv) << 4) + (kq & 1) * 8);
                const s16x4 hi4 = *(const LAS s16x4*)(lds + GL_VT + (16 * db + li) * GS_T + (((4 * kc2 + 2 + (kq >> 1)) ^ fv) << 4) + (kq & 1) * 8);
                const bf16x8 vf = (bf16x8){lo[0], lo[1], lo[2], lo[3], hi4[0], hi4[1], hi4[2], hi4[3]};
                const u32x4 pw = (u32x4){pk[2 * kc2][0], pk[2 * kc2][1], pk[2 * kc2 + 1][0], pk[2 * kc2 + 1][1]};
                oacc = __builtin_amdgcn_mfma_f32_16x16x32_bf16(vf, __builtin_bit_cast(bf16x8, pw), oacc, 0, 0, 0); }
            u32x2 ow; ow.x = cvt_pk_bf16(oacc[0], oacc[1]); ow.y = cvt_pk_bf16(oacc[2], oacc[3]);
            *(u32x2*)(O + (t0 + 16 * ib + li) * 1024 + h * 256 + vs * 64 + 16 * db + 4 * kq) = ow;
        }
        { const f32x4 el = *(const LAS f32x4*)(lds + GL_EL + (16 * w + 4 * kq) * 4);
#pragma unroll
          for (int kc2 = 0; kc2 < 2; ++kc2) { const bf16x8 af = *(const LAS bf16x8*)(lds + GL_KST + (16 * w + li) * GS_T + (((4 * kc2 + kq) ^ ((2 * w + fl) & 7)) << 4));
#pragma unroll
              for (int nb = 0; nb < 4; ++nb) { const bf16x8 bfv = *(const LAS bf16x8*)(lds + GL_VT + (16 * nb + li) * GS_T + (((4 * kc2 + kq) ^ ((2 * nb + fl) & 7)) << 4));
                  st[nb] = __builtin_amdgcn_mfma_f32_16x16x32_bf16(af, bfv, st[nb], 0, 0, 0); } }
#pragma unroll
          for (int nb = 0; nb < 4; ++nb) st[nb] = st[nb] * el; }
        asm volatile("s_waitcnt lgkmcnt(0)" ::: "memory"); __builtin_amdgcn_s_barrier(); asm volatile("" ::: "memory");
#pragma unroll
        for (int nb = 0; nb < 4; ++nb) { u32x2 sw; sw.x = cvt_pk_bf16(st[nb][0], st[nb][1]); sw.y = cvt_pk_bf16(st[nb][2], st[nb][3]);
            *(LAS u32x2*)(lds + GL_STT + (16 * nb + li) * GS_Q + (16 * w + 4 * kq) * 2) = sw; }
    }
#undef GLA_LOAD
#undef GLA_TR8
    __syncthreads();
}
#ifndef PH_MASK
#define PH_MASK 0x3fff
#endif
#define EN(k) (((PH_MASK) >> (k)) & 1)
#ifndef PROBE_SYNC_REPS
#define PROBE_SYNC_REPS 1
#endif
#ifndef PROBE_GLA_REPS
#define PROBE_GLA_REPS 1
#endif
__global__ void __launch_bounds__(512) hybrid_fwd(Args a_) {
    extern __shared__ __attribute__((aligned(16))) unsigned char lds_raw[];
    LAS unsigned char* lds = (LAS unsigned char*)lds_raw;
    cg::grid_group grid = cg::this_grid();
    const int ph_lo = a_.ph_lo, ph_hi = a_.ph_hi;
    if (threadIdx.x < 2) ((LAS unsigned*)(lds + 131072))[threadIdx.x] = 0u;
    __syncthreads();
    const XcdBarrier xbar = xcd_barrier_post((unsigned*)(a_.ws + WS_CTL), (volatile LAS unsigned*)(lds + 131072));
    for (int ph = ph_lo; ph < ph_hi; ++ph) {
        const int tid = opaque_tid(), lane = tid & 63, wave = __builtin_amdgcn_readfirstlane(tid >> 6);
        int bx = blockIdx.x, G = gridDim.x; asm volatile("" : "+s"(bx), "+s"(G));
        const int vcu = (G % 8 == 0) ? (bx % 8) * (G / 8) + bx / 8 : bx;
        const int gw = vcu * 8 + wave, NGW = G * 8;
        KA a = (KA)__builtin_amdgcn_kernarg_segment_ptr(); asm volatile("" : "+s"(a));
        unsigned char* ws = a->ws; unsigned char* rbase = ws + WS_R; unsigned char* wsW = ws + WS_W;
        bf16_t* XA = (bf16_t*)(ws + WS_XA); bf16_t* OF = (bf16_t*)(ws + WS_OF); bf16_t* OB = (bf16_t*)(ws + WS_OB); bf16_t* GG = (bf16_t*)a->out; bf16_t* HB = (bf16_t*)(ws + WS_HB); bf16_t* PB = (bf16_t*)(ws + WS_PB);
        if (ph == 0) { if (EN(13)) {
            prep_layer(a, 0, lds, gw, NGW, wave, lane);
            row_pass<true, false>(a->in[0], HB, nullptr, nullptr, a->in[2], XA, gw, NGW, lane); }
        } else {
            const int L = (ph - 1) / NPH_LAYER, k = (ph - 1) % NPH_LAYER;
            int ngemm = 0; pg8::Gemm g0{}, g1{}; pg8::Epi e0{}, e1{};
            e0.rbase = rbase; e0.ggbase = (unsigned char*)a->out; e1.rbase = rbase; e1.ggbase = (unsigned char*)a->out;
            switch (k) {
            case 0: if (!EN(0)) break; ngemm = 1; g0 = pg8::Gemm{XA, (const bf16_t*)(wsW + W_INA), TOK, NA_PAD, DM}; e0.mode = pg8::EM_ROUTE_A; break;
            case 1: if (!EN(1)) break; for (int u = vcu; u < 2048; u += G) gla_prep(a, L, u >> 8, (u >> 2) & 63, u & 3, lds); break;
            case 2: if (!EN(2)) break; for (int u = vcu; u < 256; u += G) gla_unit(a, L, u >> 5, (u >> 3) & 3, (u >> 2) & 1, u & 3, lds); break;
            case 3: if (!EN(3)) break; gla_post(OF, OB, GG, a->in[6] + (size_t)L * 256, gw, NGW, lane);
                    ngemm = 1; g0 = pg8::Gemm{XA, (const bf16_t*)(wsW + W_INB), TOK, NB_COLS, DM}; e0.mode = pg8::EM_ROUTE_B; e0.gqn = a->in[7] + (size_t)L * 128; e0.gkn = a->in[8] + (size_t)L * 128; e0.xlds = (LAS float*)(lds + 131072 + 1024); break;
            case 4: if (!EN(4)) break; for (int u = vcu; u < 1024; u += G) { const int qb = u & 15, hg = (u >> 4) & 3, kvh = (u >> 6) & 1, b = u >> 7, hq = kvh * 4 + hg;
                        bf16_t* Qb = (bf16_t*)(rbase + R_Q) + ((size_t)b * SEQ + (size_t)qb * 256) * 1024 + hq * 128;
                        const bf16_t* Kh = (const bf16_t*)(rbase + R_K) + (size_t)b * SEQ * 256 + kvh * 128; const bf16_t* Vh = (const bf16_t*)(rbase + R_V) + (size_t)b * SEQ * 256 + kvh * 128;
                        attn::attn_dense_body<attn::bf16>((const attn::bf16*)Qb, (const attn::bf16*)Kh, (const attn::bf16*)Vh, Qb, SEQ, (char*)lds_raw);
                        __syncthreads(); }
                    break;
            case 5: if (!EN(5)) break; ngemm = 2; g0 = pg8::Gemm{OF, (const bf16_t*)(wsW + W_OGLA), TOK, DM, DM}; e0.mode = pg8::EM_GATE1; e0.out = OB; e0.aux = (const bf16_t*)(rbase + R_GA);
                    g1 = pg8::Gemm{(const bf16_t*)(rbase + R_Q), (const bf16_t*)(wsW + W_OATT), TOK, DM, DM}; e1.mode = pg8::EM_GATE2; e1.out = OB; e1.aux = (const bf16_t*)(rbase + R_GB); break;
            case 6: if (!EN(6)) break; ngemm = 1; g0 = pg8::Gemm{OB, (const bf16_t*)(wsW + W_OUT), TOK, DM, DM}; e0.mode = pg8::EM_PLAIN; e0.out = OF; break;
            case 7: if (!EN(7)) break; row_pass<false, false>(HB, HB, OF, a->in[12] + (size_t)L * DM, a->in[13] + (size_t)L * DM, XA, gw, NGW, lane); break;
            case 8: if (!EN(8)) break; ngemm = 1; g0 = pg8::Gemm{XA, (const bf16_t*)(wsW + W_FIN), TOK, 2 * FFH, DM}; e0.mode = pg8::EM_SWIGLU; e0.out = (bf16_t*)rbase; break;
            case 9: if (!EN(9)) break; ngemm = 1; g0 = pg8::Gemm{(const bf16_t*)rbase, (const bf16_t*)(wsW + W_FOUT), TOK, DM, FFH}; e0.mode = pg8::EM_PLAIN; e0.out = OF; break;
            case 10: if (!EN(10)) break; row_pass<false, false>(HB, HB, OF, a->in[16] + (size_t)L * DM, nullptr, nullptr, gw, NGW, lane); break;
            case 11: if (!EN(11)) break; ngemm = 2; g0 = pg8::Gemm{PB, (const bf16_t*)(wsW + W_PP), TOK, DM, PLE}; e0.mode = pg8::EM_PLAIN; e0.out = (bf16_t*)rbase;
                     g1 = pg8::Gemm{HB, (const bf16_t*)(wsW + W_PG), TOK, DM, DM}; e1.mode = pg8::EM_PLE2; e1.out = OF; e1.aux = (const bf16_t*)rbase; break;
            default: if (!EN(12)) break; if (L + 1 < DEPTH) row_pass<false, false>(HB, HB, OF, a->in[19] + (size_t)L * DM, a->in[2] + (size_t)(L + 1) * DM, XA, gw, NGW, lane);
                     else row_pass<false, true>(HB, a->out, OF, a->in[19] + (size_t)L * DM, nullptr, nullptr, gw, NGW, lane);
                     if (L + 1 < DEPTH) prep_layer(a, L + 1, lds, gw, NGW, wave, lane);
                     break;
            }
            for (int gi = 0; gi < ngemm; ++gi) {
                const pg8::Gemm g = gi == 0 ? g0 : g1; const pg8::Epi E = gi == 0 ? e0 : e1;
                pg8::StaticOrder S; S.init(g.M, g.N, G, bx);
                pg8::gemm_phase<pg8::Epi, pg8::StaticOrder, true, true>(lds, g, S, E);
            }
        }
        if (ph + 1 < ph_hi) { if (ph < 0) grid.sync(); else xcd_barrier(xbar); }
    }
}

#if MK_DEBUG
struct DbgReg { unsigned long long off, bytes; int type, pad; };
struct DbgArgs { DbgReg r[3]; int scanH, ph, pass, pad; };
__global__ void __launch_bounds__(256) dbg_scan(unsigned char* ws, const float* out, DbgArgs d) {
    unsigned* nanw = (unsigned*)(ws + WS_CTL); unsigned long long* sums = (unsigned long long*)(ws + WS_CTL + 512 + d.pass * 512);
    unsigned long long s = 0; unsigned bad = 0;
#pragma unroll
    for (int ri = 0; ri < 3; ++ri) {
        const size_t n16 = d.r[ri].bytes / 16; const u32x4* p = (const u32x4*)(ws + d.r[ri].off); const int type = d.r[ri].type;
        for (size_t i = (size_t)blockIdx.x * 256 + threadIdx.x; i < n16; i += (size_t)gridDim.x * 256) {
            const u32x4 v = p[i]; s += (unsigned long long)v.x + v.y + v.z + v.w;
#pragma unroll
            for (int k = 0; k < 4; ++k) { const unsigned w = v[k]; if ((type == 0 && (w & 0x7f80u) == 0x7f80u) || (type <= 1 && (w & 0x7f800000u) == 0x7f800000u)) bad = 1; }
        }
    }
    if (d.scanH) { const size_t no = (size_t)TOK * DM / 4; const u32x4* q = (const u32x4*)out;
        for (size_t i = (size_t)blockIdx.x * 256 + threadIdx.x; i < no; i += (size_t)gridDim.x * 256) {
            const u32x4 v = q[i]; s += (unsigned long long)v.x + v.y + v.z + v.w;
#pragma unroll
            for (int k = 0; k < 4; ++k) if ((v[k] & 0x7f800000u) == 0x7f800000u) bad = 1; } }
    for (int o = 1; o < 64; o <<= 1) { s += __shfl_xor(s, o); bad |= __shfl_xor(bad, o); }
    if ((threadIdx.x & 63) == 0) { atomicAdd(&sums[d.ph], s); if (bad) atomicOr(&nanw[d.ph], 1u); }
}
__global__ void __launch_bounds__(64) dbg_check_gemm_a(unsigned char* ws) {
    unsigned* chk = (unsigned*)(ws + WS_CTL) + 56;
    const int i = blockIdx.x, lane = threadIdx.x;
    const int t = (int)(((long)i * 9973 + 17) % TOK), col = (i * 131 + 5) % NA_REAL;
    const bf16_t* xa = (const bf16_t*)(ws + WS_XA) + (size_t)t * DM; const bf16_t* wt = (const bf16_t*)(ws + WS_W + W_INA) + (size_t)col * DM;
    float acc = 0.f;
    for (int k = lane; k < DM; k += 64) acc += bf_lo((unsigned)xa[k]) * bf_lo((unsigned)wt[k]);
    acc = wave_sum(acc);
    unsigned char* rb = ws + WS_R; float got;
    if (col < 512) got = bf_lo((unsigned)((const bf16_t*)(rb + R_GQ))[(size_t)t * 512 + col]);
    else if (col < 1024) got = bf_lo((unsigned)((const bf16_t*)(rb + R_GK))[(size_t)t * 512 + col - 512]);
    else if (col < 2048) got = bf_lo((unsigned)((const bf16_t*)(rb + R_GV))[(size_t)t * 1024 + col - 1024]);
    else if (col < 3072) got = bf_lo((unsigned)((const bf16_t*)(ws + WS_GG))[(size_t)t * 1024 + col - 2048]);
    else got = ((const float*)(rb + R_RA))[(size_t)t * 32 + col - 3072];
    if (lane == 0) { if (!(fabsf(got - acc) <= 0.03f * fmaxf(1.f, fabsf(acc)))) { atomicOr(chk, fabsf(got) < 1e-9f ? 1u : 2u); if (atomicAdd(chk + 4, 1u) == 0u) { chk[2] = (unsigned)(t & 255) >> 2; chk[3] = (unsigned)(col & 255) >> 3; } } }
    float m = 0.f; const float* ra = (const float*)(rb + R_RA);
    for (int k = lane; k < 2048; k += 64) m = fmaxf(m, fabsf(ra[(size_t)i * 2048 + k]));
    for (int o = 1; o < 64; o <<= 1) m = fmaxf(m, __shfl_xor(m, o));

}
__global__ void __launch_bounds__(64) dbg_check_gemm_b(unsigned char* ws) {
    unsigned* chk = (unsigned*)(ws + WS_CTL) + 57;
    const int i = blockIdx.x, lane = threadIdx.x;
    const int t = (int)(((long)i * 9973 + 17) % TOK), col = (i * 131 + 5) % NB_COLS;
    const bf16_t* xa = (const bf16_t*)(ws + WS_XA) + (size_t)t * DM; const bf16_t* wt = (const bf16_t*)(ws + WS_W + W_INB) + (size_t)col * DM;
    float acc = 0.f;
    for (int k = lane; k < DM; k += 64) acc += bf_lo((unsigned)xa[k]) * bf_lo((unsigned)wt[k]);
    acc = wave_sum(acc);
    unsigned char* rb = ws + WS_R; float got; unsigned bit;
    if (col < 1024) { got = bf_lo((unsigned)((const bf16_t*)(rb + R_Q))[(size_t)t * 1024 + col]); bit = 1u; }
    else if (col < 1280) { got = bf_lo((unsigned)((const bf16_t*)(rb + R_K))[(size_t)t * 256 + col - 1024]); bit = 2u; }
    else if (col < 1536) { got = bf_lo((unsigned)((const bf16_t*)(rb + R_V))[(size_t)t * 256 + col - 1280]); bit = 2u; }
    else if (col < 2560) { got = bf_lo((unsigned)((const bf16_t*)(rb + R_GA))[(size_t)t * 1024 + col - 1536]); bit = 4u; }
    else { got = bf_lo((unsigned)((const bf16_t*)(rb + R_GB))[(size_t)t * 1024 + col - 2560]); bit = 4u; }
    if (lane == 0) { if (!(fabsf(got - acc) <= 0.03f * fmaxf(1.f, fabsf(acc)))) atomicOr(chk, bit); }
}
__global__ void __launch_bounds__(256) dbg_check_gla(unsigned char* ws) {
    unsigned* c58 = (unsigned*)(ws + WS_CTL) + 58; unsigned* c59 = c58 + 1;
    const bf16_t* of = (const bf16_t*)(ws + WS_OF); const bf16_t* ob = (const bf16_t*)(ws + WS_OB);
    unsigned mn = 99u, mx = 0u;
    for (size_t i = (size_t)blockIdx.x * 256 + threadIdx.x; i < (size_t)TOK * DM; i += (size_t)gridDim.x * 256) {
        const unsigned chunk = (unsigned)((i >> 10) & 4095) >> 6;
        if ((of[i] & 0x7f80u) == 0x7f80u) mn = chunk < mn ? chunk : mn;
        if ((ob[i] & 0x7f80u) == 0x7f80u) mx = chunk + 1 > mx ? chunk + 1 : mx;
    }
    if (mn != 99u) atomicMin(c58, mn); if (mx) atomicMax(c59, mx);
}
__global__ void __launch_bounds__(256) dbg_final(unsigned char* ws, float* out) {
    const unsigned* nanw = (const unsigned*)(ws + WS_CTL); const unsigned long long* sa = (const unsigned long long*)(ws + WS_CTL + 512); const unsigned long long* sb = sa + 64;
    int p1 = -1, p2 = -1;
    for (int i = NPHASES - 1; i >= 0; --i) { if (nanw[i]) p1 = i; if (sa[i] != sb[i]) p2 = i; }
    const unsigned chkA = nanw[56], chkB = nanw[57], g0 = nanw[58], g1 = nanw[59];
    if (p1 < 0 && p2 < 0 && chkA == 0 && chkB == 0) return;
    float c1; unsigned e;
    if (chkA | chkB) { c1 = 90.f + (chkA & 7); e = chkB & 7; }
    else if (p1 == 2) { c1 = 10.f + (g0 > 63 ? 70.f : (float)g0); e = g1 / 3; }
    else { c1 = p1 >= 0 ? 10.f + p1 : 40.f + p2; e = p1 >= 0 ? 25 : 30; }
    float code = c1 * 100.f; for (unsigned k = 0; k < e; ++k) code *= 10.f;
    for (size_t i = (size_t)blockIdx.x * 256 + threadIdx.x; i < (size_t)TOK * DM; i += (size_t)gridDim.x * 256) out[i] = i == 0 ? code : 0.f;
}
static DbgArgs dbg_args_for(int ph, int pass) {
    DbgArgs d{}; d.ph = ph; d.pass = pass; int n = 0;
    auto add = [&](size_t off, size_t bytes, int type) { d.r[n].off = off; d.r[n].bytes = bytes; d.r[n].type = type; ++n; };
    if (ph == 0) { add(WS_W, W_END, 0); add(WS_PB, 16 * MiB, 0); add(WS_XA, 64 * MiB, 0); d.scanH = 1; return d; }
    const int k = (ph - 1) % NPH_LAYER;
    switch (k) {
    case 0: add(WS_R, 128 * MiB, 0); add(WS_R + R_RA, 4 * MiB, 1); add(WS_GG, 64 * MiB, 0); break;
    case 1: add(WS_OF, 128 * MiB, 0); break;
    case 2: add(WS_OF, 64 * MiB, 0); add(WS_R, 224 * MiB, 0); break;
    case 3: add(WS_R + R_Q, 80 * MiB, 0); break;
    case 4: add(WS_R + R_Q, 64 * MiB, 0); break;
    case 5: add(WS_OB, 64 * MiB, 0); break;
    case 6: add(WS_OF, 64 * MiB, 0); break;
    case 7: add(WS_XA, 64 * MiB, 0); d.scanH = 1; break;
    case 8: add(WS_R, (size_t)TOK * FFH * 2, 0); break;
    case 9: add(WS_OF, 64 * MiB, 0); break;
    case 10: add(WS_XA, 64 * MiB, 0); d.scanH = 1; break;
    case 11: add(WS_R, 64 * MiB, 0); add(WS_OF, 64 * MiB, 0); break;
    default: add(WS_XA, 64 * MiB, 0); add(WS_W, W_END, 0); add(WS_PB, 16 * MiB, 0); d.scanH = 1; break;
    }
    return d;
}
#endif
extern "C" void kernel_launch(void* const* d_in, const int* in_sizes, int n_in, void* d_out, int out_size, void* d_ws, size_t ws_size, hipStream_t stream) {
    static int grid = 0;
    if (grid == 0) {
        if (n_in != 20 || in_sizes[0] != TOK * DM || out_size != TOK * DM || ws_size < WS_END) {
            fprintf(stderr, "kernel_launch: unexpected shapes (n_in %d, in0 %d, out %d, ws %zu, need %zu); nothing launched\n", n_in, n_in > 0 ? in_sizes[0] : -1, out_size, ws_size, (size_t)WS_END); grid = -1; return; }
        int dev = 0, cus = 0, per_cu = 0;
        if (hipGetDevice(&dev) != hipSuccess || hipDeviceGetAttribute(&cus, hipDeviceAttributeMultiprocessorCount, dev) != hipSuccess) { grid = -1; return; }
        if (hipFuncSetAttribute((const void*)hybrid_fwd, hipFuncAttributeMaxDynamicSharedMemorySize, LDS_BYTES) != hipSuccess) { fprintf(stderr, "kernel_launch: hipFuncSetAttribute failed\n"); grid = -1; return; }
        if (hipOccupancyMaxActiveBlocksPerMultiprocessor(&per_cu, (const void*)hybrid_fwd, 512, LDS_BYTES) != hipSuccess || per_cu < 1) { fprintf(stderr, "kernel_launch: occupancy query says %d\n", per_cu); per_cu = 1; }
        (void)hipGetLastError();
        grid = cus * 1;
        fprintf(stderr, "kernel_launch: grid %d (cus %d, per_cu %d), ws need %zu have %zu\n", grid, cus, per_cu, (size_t)WS_END, ws_size);
    }
    if (grid < 0) return;
    if (hipMemsetAsync((char*)d_ws + WS_CTL, 0, 16384, stream) != hipSuccess) { fprintf(stderr, "kernel_launch: memset failed\n"); return; }
    Args a{};
    for (int i = 0; i < 20; ++i) a.in[i] = (const float*)d_in[i];
    a.out = (float*)d_out; a.ws = (unsigned char*)d_ws;
#if MK_DEBUG
    hipMemsetAsync((char*)d_ws + WS_CTL, 0, 4096, stream); hipMemsetAsync((char*)d_ws + WS_CTL + 58 * 4, 0x63, 1, stream);
    for (int pass = 0; pass < 2; ++pass)
        for (int ph = 0; ph < NPHASES; ++ph) { a.ph_lo = ph; a.ph_hi = ph + 1; hipLaunchKernelGGL(hybrid_fwd, dim3(grid), dim3(512), LDS_BYTES, stream, a);
            hipLaunchKernelGGL(dbg_scan, dim3(2048), dim3(256), 0, stream, (unsigned char*)d_ws, (const float*)d_out, dbg_args_for(ph, pass));
            if (pass == 0 && ph == 1) { hipLaunchKernelGGL(dbg_check_gemm_a, dim3(512), dim3(64), 0, stream, (unsigned char*)d_ws); }
            if (pass == 0 && ph == 2) hipLaunchKernelGGL(dbg_check_gla, dim3(2048), dim3(256), 0, stream, (unsigned char*)d_ws);
            if (pass == 0 && ph == 3) hipLaunchKernelGGL(dbg_check_gemm_b, dim3(512), dim3(64), 0, stream, (unsigned char*)d_ws); }
    hipLaunchKernelGGL(dbg_final, dim3(2048), dim3(256), 0, stream, (unsigned char*)d_ws, (float*)d_out);
#elif MK_PER_PHASE
    for (int ph = 0; ph < NPHASES; ++ph) { a.ph_lo = ph; a.ph_hi = ph + 1; hipLaunchKernelGGL(hybrid_fwd, dim3(grid), dim3(512), LDS_BYTES, stream, a); }
#else
    a.ph_lo = 0; a.ph_hi = NPHASES;
    void* args[] = {&a};
    hipError_t e = hipLaunchCooperativeKernel((const void*)hybrid_fwd, dim3(grid), dim3(512), args, LDS_BYTES, stream);
    if (e != hipSuccess) fprintf(stderr, "kernel_launch: cooperative launch failed: %s (grid %d)\n", hipGetErrorString(e), grid);
#endif
}
```

```cpp
#include <hip/hip_runtime.h>
#include <hip/hip_bf16.h>
#include <hip/hip_cooperative_groups.h>
#include <cstdio>
#include <cstdint>
namespace cg = cooperative_groups;
#ifndef MK_DEBUG
#define MK_DEBUG 0
#endif
#ifndef MK_PER_PHASE
#define MK_PER_PHASE 0
#endif
__device__ __forceinline__ int opaque_tid() { int t = threadIdx.x; asm volatile("" : "+v"(t)); return t; }
#define LAS __attribute__((address_space(3)))
constexpr int TOK = 32768, DM = 1024, SEQ = 4096, NBATCH = 8, DEPTH = 4, INW = 6688, FFH = 2816, PLE = 256;
constexpr int NA_REAL = 3104, NA_PAD = 3328, NB_COLS = 3584;
constexpr float EPS = 1e-6f;
constexpr size_t MiB = 1048576;
constexpr size_t W_INA = 0, W_INB = W_INA + (size_t)NA_PAD * DM * 2, W_OGLA = W_INB + (size_t)NB_COLS * DM * 2, W_OATT = W_OGLA + 2 * MiB, W_OUT = W_OATT + 2 * MiB,
                 W_PG = W_OUT + 2 * MiB, W_FIN = W_PG + 2 * MiB, W_FOUT = W_FIN + (size_t)2 * FFH * DM * 2, W_PP = W_FOUT + (size_t)FFH * DM * 2, W_END = W_PP + (size_t)DM * PLE * 2;
constexpr size_t WS_CTL = 0, WS_W = 16384, WS_R = (WS_W + W_END + 4095) / 4096 * 4096;
constexpr size_t R_Q = 0, R_K = 64 * MiB, R_V = 80 * MiB, R_GA = 96 * MiB, R_GB = 160 * MiB, R_BYTES = 224 * MiB;
constexpr size_t R_GQ = 0, R_GK = 32 * MiB, R_GV = 64 * MiB, R_RA = 128 * MiB;
constexpr size_t WS_HB = WS_R + R_BYTES,   WS_GG_UNUSED = 0, WS_OF = WS_HB + 64 * MiB, WS_OB = WS_OF + 64 * MiB, WS_XA = WS_OB + 64 * MiB, WS_PB = WS_XA + 64 * MiB, WS_END = WS_PB + 16 * MiB;
constexpr int NPH_LAYER = 13, NPHASES = 1 + NPH_LAYER * DEPTH;
constexpr int LDS_BYTES = 131072 + 1024 + 8192;
namespace pg8 {
#define PG8_LAS __attribute__((address_space(3)))
typedef unsigned short bf16_t;
typedef short bf16x8 __attribute__((ext_vector_type(8)));
typedef float f32x4 __attribute__((ext_vector_type(4)));
typedef unsigned u32x4 __attribute__((ext_vector_type(4)));
constexpr int BM = 256, BK = 64, HALF = 128, HTB = HALF * BK * 2  , STAGE_BYTES = 8 * HTB, NXCD = 8, WGM = 8;

__host__ __device__ __forceinline__ int lds_byte(int r, int c) { const int st = (r >> 4) * 2 + (c >> 5), rr = r & 15, cc = c & 31, ob = rr * 64 + cc * 2; return st * 1024 + (ob ^ (((ob >> 9) & 1) << 5)); }
__host__ __device__ __forceinline__ void stage_rc(int b, int& R, int& C) { const int st = b / 1024, sb = b % 1024, swz = sb ^ (((sb >> 9) & 1) << 5); R = (st >> 1) * 16 + swz / 64; C = (st & 1) * 32 + (swz % 64) / 2; }
__host__ __device__ __forceinline__ int perm32(int rho) { const int n = rho >> 4, i = rho & 15; return 8 * (i >> 2) + 4 * n + (i & 3); }

struct Unit { int pm, pn; };
struct Gemm { const bf16_t* A; const bf16_t* Bt; int M, N, K; };

struct StaticOrder {
    int nM, nN, nwg, G, c;
    __host__ __device__ void init(int M, int N, int G_, int c_) { nM = M / BM; nN = N / BM; nwg = nM * nN; G = G_; c = c_; }
    __host__ __device__ bool next(int i, Unit& u) const {
        const long L = (long)i * G + c; if (L >= nwg) return false;
        int wgid = (int)L; { const int q = nwg / NXCD, r = nwg % NXCD, xcd = wgid % NXCD, off = wgid / NXCD; wgid = (xcd < r ? xcd * (q + 1) : r * (q + 1) + (xcd - r) * q) + off; }
        const int nig = WGM * nN, gid = wgid / nig, fm = gid * WGM, gsz = (nM - fm) < WGM ? (nM - fm) : WGM;
        u.pm = fm + ((wgid % nig) % gsz); u.pn = (wgid % nig) / gsz; return true;
    }
    __device__ __forceinline__ void a_ready(const Unit&) const {}
    __device__ __forceinline__ void done(const Unit&) const {}
};
typedef __bf16 bf16x2_t __attribute__((ext_vector_type(2)));
typedef float f32x2_t __attribute__((ext_vector_type(2)));
__device__ __forceinline__ unsigned cvt_pk_bf16(float lo, float hi) { const f32x2_t f = {lo, hi}; const bf16x2_t v = __builtin_convertvector(f, bf16x2_t); return __builtin_bit_cast(unsigned, v); }
__device__ __forceinline__ float bf_lo(unsigned w) { return __builtin_bit_cast(float, w << 16); }
__device__ __forceinline__ float bf_hi(unsigned w) { return __builtin_bit_cast(float, w & 0xffff0000u); }
__device__ __forceinline__ float sigmoidf_(float x) { return __builtin_amdgcn_rcpf(1.0f + __expf(-x)); }
enum { EM_ROUTE_A = 0, EM_ROUTE_B = 1, EM_GATE1 = 2, EM_GATE2 = 3, EM_PLAIN = 4, EM_SWIGLU = 5, EM_PLE2 = 6 };
struct Epi {
    static constexpr bool PERM = true, AFTER_DRAIN = false;
    int mode; unsigned char* rbase; unsigned char* ggbase; bf16_t* out; const bf16_t* aux; unsigned* dbgmark; const float* gqn; const float* gkn; PG8_LAS float* xlds;
    __device__ __forceinline__ void operator()(const f32x4 (&acc)[2][2][4][2], const Unit& u, int wr, int wc, int fr, int fq) const {
        const int row0 = u.pm * BM + wr * 64 + fr, lc0 = wc * 32 + 8 * fq;
#if MK_DEBUG
#endif
        if (mode == EM_SWIGLU) {
#pragma unroll
            for (int ai = 0; ai < 2; ++ai)
#pragma unroll
                for (int m = 0; m < 4; ++m) { const size_t row = (size_t)(row0 + ai * HALF + m * 16);
                    float o[8];
#pragma unroll
                    for (int n = 0; n < 2; ++n)
#pragma unroll
                        for (int j = 0; j < 4; ++j) { const float g = acc[ai][0][m][n][j], up = acc[ai][1][m][n][j]; o[4 * n + j] = g * sigmoidf_(g) * up; }
                    u32x4 w; w.x = cvt_pk_bf16(o[0], o[1]); w.y = cvt_pk_bf16(o[2], o[3]); w.z = cvt_pk_bf16(o[4], o[5]); w.w = cvt_pk_bf16(o[6], o[7]);
                    *(u32x4*)(out + row * 2816 + u.pn * 128 + lc0) = w; }
            return;
        }
        if (mode == EM_ROUTE_B && u.pn <= 4) {
            const bool isk = u.pn == 4; const float* g = isk ? gkn : gqn;
            bf16_t* qb = (bf16_t*)(rbase + (isk ? R_K : R_Q)); const int ldq = isk ? 256 : 1024, ctq = isk ? 0 : u.pn * 256;
            const int axis = wc >> 1, jb = 16 * (wc & 1) + 4 * fq;
            const f32x4 g1 = *(const f32x4*)(g + axis * 64 + jb), g2 = *(const f32x4*)(g + axis * 64 + 32 + jb);
            float inv[4];
#pragma unroll
            for (int e = 0; e < 4; ++e) inv[e] = __builtin_amdgcn_exp2f(-(float)(jb + e) * (13.287712379549449f / 32.0f)) * 0.15915494309189535f;
            const int rit = wr * 64 + fr;
#pragma unroll
            for (int ai = 0; ai < 2; ++ai)
#pragma unroll
                for (int m = 0; m < 4; ++m)
#pragma unroll
                    for (int bj = 0; bj < 2; ++bj) { const f32x4 a0 = acc[ai][bj][m][0], a1 = acc[ai][bj][m][1];
                        float ss = (a0[0] * a0[0] + a0[1] * a0[1]) + (a0[2] * a0[2] + a0[3] * a0[3]) + (a1[0] * a1[0] + a1[1] * a1[1]) + (a1[2] * a1[2] + a1[3] * a1[3]);
                        ss += __shfl_xor(ss, 16); ss += __shfl_xor(ss, 32);
                        if (fq == 0) xlds[((ai * HALF + m * 16 + rit) * 2 + bj) * 4 + wc] = ss; }
            asm volatile("s_waitcnt lgkmcnt(0)" ::: "memory"); __builtin_amdgcn_s_barrier(); asm volatile("" ::: "memory");
#pragma unroll
            for (int ai = 0; ai < 2; ++ai)
#pragma unroll
                for (int m = 0; m < 4; ++m) { const size_t row = (size_t)(row0 + ai * HALF + m * 16); const int sp = (int)row & 4095; const float pos = (float)(axis == 0 ? (sp >> 6) : (sp & 63));
                    float cs[4], sn[4];
#pragma unroll
                    for (int e = 0; e < 4; ++e) { const float rf = __builtin_amdgcn_fractf(pos * inv[e]); cs[e] = __builtin_amdgcn_cosf(rf); sn[e] = __builtin_amdgcn_sinf(rf); }
#pragma unroll
                    for (int bj = 0; bj < 2; ++bj) { const f32x4 pp = *(const PG8_LAS f32x4*)(xlds + ((ai * HALF + m * 16 + rit) * 2 + bj) * 4);
                        const float rs = rsqrtf(((pp[0] + pp[1]) + (pp[2] + pp[3])) * (1.0f / 128.0f) + 1e-6f);
                        const f32x4 x1 = acc[ai][bj][m][0] * rs * g1, x2 = acc[ai][bj][m][1] * rs * g2;
                        float o1[4], o2[4];
#pragma unroll
                        for (int e = 0; e < 4; ++e) { o1[e] = x1[e] * cs[e] - x2[e] * sn[e]; o2[e] = x2[e] * cs[e] + x1[e] * sn[e]; }
                        bf16_t* dst = qb + row * ldq + ctq + bj * HALF + axis * 64 + jb;
                        typedef unsigned u32x2e __attribute__((ext_vector_type(2)));
                        u32x2e w1, w2; w1.x = cvt_pk_bf16(o1[0], o1[1]); w1.y = cvt_pk_bf16(o1[2], o1[3]); w2.x = cvt_pk_bf16(o2[0], o2[1]); w2.y = cvt_pk_bf16(o2[2], o2[3]);
                        *(u32x2e*)dst = w1; *(u32x2e*)(dst + 32) = w2; } }
            return;
        }
        bf16_t* base = out; int ld = 1024, ct = u.pn * BM; bool is_ra = false;
        if (mode == EM_ROUTE_A) { const int pn = u.pn;
            if (pn < 2) { base = (bf16_t*)(rbase + R_GQ); ld = 512; ct = pn * 256; }
            else if (pn < 4) { base = (bf16_t*)(rbase + R_GK); ld = 512; ct = (pn - 2) * 256; }
            else if (pn < 8) { base = (bf16_t*)(rbase + R_GV); ld = 1024; ct = (pn - 4) * 256; }
            else if (pn < 12) { base = (bf16_t*)ggbase; ld = 1024; ct = (pn - 8) * 256; }
            else is_ra = true;
        } else if (mode == EM_ROUTE_B) { const int pn = u.pn;
            if (pn < 4) { base = (bf16_t*)(rbase + R_Q); ld = 1024; ct = pn * 256; }
            else if (pn == 4) { base = (bf16_t*)(rbase + R_K); ld = 256; ct = 0; }
            else if (pn == 5) { base = (bf16_t*)(rbase + R_V); ld = 256; ct = 0; }
            else if (pn < 10) { base = (bf16_t*)(rbase + R_GA); ld = 1024; ct = (pn - 6) * 256; }
            else { base = (bf16_t*)(rbase + R_GB); ld = 1024; ct = (pn - 10) * 256; }
        }
        if (is_ra) {
            if (wc == 0) { float* ra = (float*)(rbase + R_RA);
#pragma unroll
                for (int ai = 0; ai < 2; ++ai)
#pragma unroll
                    for (int m = 0; m < 4; ++m) { const size_t row = (size_t)(row0 + ai * HALF + m * 16);
                        *(f32x4*)(ra + row * 32 + 8 * fq) = acc[ai][0][m][0]; *(f32x4*)(ra + row * 32 + 8 * fq + 4) = acc[ai][0][m][1]; } }
            return;
        }
#pragma unroll
        for (int ai = 0; ai < 2; ++ai)
#pragma unroll
            for (int m = 0; m < 4; ++m) { const size_t row = (size_t)(row0 + ai * HALF + m * 16);
#pragma unroll
                for (int bj = 0; bj < 2; ++bj) { const int col = ct + bj * HALF + lc0;
                    float o[8];
#pragma unroll
                    for (int n = 0; n < 2; ++n)
#pragma unroll
                        for (int j = 0; j < 4; ++j) o[4 * n + j] = acc[ai][bj][m][n][j];
                    if (mode == EM_GATE1 || mode == EM_GATE2 || mode == EM_PLE2) {
                        const u32x4 a = *(const u32x4*)(aux + row * 1024 + col);
                        const float av[8] = {bf_lo(a.x), bf_hi(a.x), bf_lo(a.y), bf_hi(a.y), bf_lo(a.z), bf_hi(a.z), bf_lo(a.w), bf_hi(a.w)};
                        if (mode == EM_PLE2) {
#pragma unroll
                            for (int j = 0; j < 8; ++j) o[j] = sigmoidf_(o[j]) * av[j];
                        } else {
#pragma unroll
                            for (int j = 0; j < 8; ++j) o[j] = sigmoidf_(av[j]) * o[j];
                            if (mode == EM_GATE2) { const u32x4 p = *(const u32x4*)(base + row * ld + col);
                                o[0] += bf_lo(p.x); o[1] += bf_hi(p.x); o[2] += bf_lo(p.y); o[3] += bf_hi(p.y); o[4] += bf_lo(p.z); o[5] += bf_hi(p.z); o[6] += bf_lo(p.w); o[7] += bf_hi(p.w); }
                        }
                    }
                    u32x4 w; w.x = cvt_pk_bf16(o[0], o[1]); w.y = cvt_pk_bf16(o[2], o[3]); w.z = cvt_pk_bf16(o[4], o[5]); w.w = cvt_pk_bf16(o[6], o[7]);
                    *(u32x4*)(base + row * ld + col) = w;
#if MK_DEBUG
                    if (dbgmark && ai == 0 && m == 0 && bj == 0 && wr == 0 && wc == 0 && fr == 0 && fq == 0) { unsigned* mk = dbgmark + (u.pm * 32 + u.pn) * 4; const unsigned long long ad = (unsigned long long)(base + row * ld + col);
                        mk[0] = (unsigned)ad; mk[1] = (unsigned)(ad >> 32); mk[2] = w.x; mk[3] = 1u; }
#endif
                    } }
    }
};
template <class Epi, class Sched, bool ALIGN_EPI = false, bool SP2 = false>
__device__ __forceinline__ void gemm_phase(PG8_LAS unsigned char* lds, const Gemm g, const Sched& S, const Epi& E) {
    const int tid = opaque_tid(), wid = __builtin_amdgcn_readfirstlane(tid >> 6), lane = tid & 63, wr = wid >> 2, wc = wid & 3, fr = lane & 15, fq = lane >> 4;
    const int K = g.K, nt = K / BK;
    unsigned voffA[2], voffB[2];
#pragma unroll
    for (int i = 0; i < 2; ++i) { int R, C; stage_rc(tid * 16 + i * 8192, R, C); const int Rb = Epi::PERM ? ((R & ~31) + perm32(R & 31)) : R;
        voffA[i] = (unsigned)(R * K + C) * 2u; voffB[i] = (unsigned)(Rb * K + C) * 2u; }
    const size_t kstep = (size_t)(BK * 2);
    const size_t hstep = (size_t)HALF * K * 2;
    const size_t tstep = 2 * hstep;
    const unsigned ldsw = (unsigned)wid * 1024u;
    const int aoff = lds_byte(wr * 64 + fr, fq * 8), boff = lds_byte(wc * 32 + fr, fq * 8);
#define PG8_SA(b, h) (((b) * 2 + (h)) * HTB)
#define PG8_SB(b, h) ((4 + (b) * 2 + (h)) * HTB)
#define PG8_STAGE(bufoff, gbase, voff) do { _Pragma("unroll") for (int _i = 0; _i < 2; ++_i) \
        __builtin_amdgcn_global_load_lds((const unsigned*)((const char*)(gbase) + (voff)[_i]), (PG8_LAS unsigned*)(lds + (bufoff) + ldsw + _i * 8192), 16, 0, 0); } while (0)
#define PG8_LDA(dst, b, h) do { _Pragma("unroll") for (int m = 0; m < 4; ++m) _Pragma("unroll") for (int k = 0; k < 2; ++k) dst[m][k] = *(const PG8_LAS bf16x8*)(lds + PG8_SA(b, h) + aoff + m * 2048 + k * 1024); } while (0)
#define PG8_LDB(dst, b, h) do { _Pragma("unroll") for (int n = 0; n < 2; ++n) _Pragma("unroll") for (int k = 0; k < 2; ++k) dst[n][k] = *(const PG8_LAS bf16x8*)(lds + PG8_SB(b, h) + boff + n * 2048 + k * 1024); } while (0)
#define PG8_MMA(ai, bj, At, Bt) do { __builtin_amdgcn_s_setprio(1); _Pragma("unroll") for (int m = 0; m < 4; ++m) _Pragma("unroll") for (int n = 0; n < 2; ++n) _Pragma("unroll") for (int k = 0; k < 2; ++k) \
        acc[ai][bj][m][n] = __builtin_amdgcn_mfma_f32_16x16x32_bf16(Bt[n][k], At[m][k], acc[ai][bj][m][n], 0, 0, 0); __builtin_amdgcn_s_setprio(0); } while (0)
#define PG8_WAIT_V(n) asm volatile("s_waitcnt vmcnt(" #n ")" ::: "memory")
#define PG8_WAIT_L(n) asm volatile("s_waitcnt lgkmcnt(" #n ")" ::: "memory")
#define PG8_BAR __builtin_amdgcn_s_barrier()
#define PG8_SCHED __builtin_amdgcn_sched_barrier(0)
    Unit cur, nxt; int ui = 0;
    if (!S.next(0, cur)) return;
    f32x4 acc[2][2][4][2];
#pragma unroll
    for (int a = 0; a < 2; ++a)
#pragma unroll
        for (int b = 0; b < 2; ++b)
#pragma unroll
            for (int m = 0; m < 4; ++m)
#pragma unroll
                for (int n = 0; n < 2; ++n) acc[a][b][m][n] = (f32x4){0.f, 0.f, 0.f, 0.f};
    bf16x8 At[4][2], B0[2][2], B1[2][2];
    const char* cA = (const char*)g.A + (size_t)cur.pm * tstep; const char* cB = (const char*)g.Bt + (size_t)cur.pn * tstep;
    S.a_ready(cur);
    if constexpr (SP2) {
        PG8_STAGE(PG8_SB(0, 0), cB, voffB); PG8_STAGE(PG8_SB(0, 1), cB + hstep, voffB); PG8_STAGE(PG8_SA(0, 0), cA, voffA); PG8_STAGE(PG8_SA(0, 1), cA + hstep, voffA);
        if (wr == 1) PG8_BAR;
        PG8_WAIT_V(2); PG8_BAR;
        PG8_STAGE(PG8_SB(1, 0), cB + kstep, voffB); PG8_STAGE(PG8_SA(1, 0), cA + kstep, voffA); PG8_STAGE(PG8_SB(1, 1), cB + hstep + kstep, voffB);
        PG8_WAIT_V(6); PG8_BAR;
    } else {
        PG8_STAGE(PG8_SB(0, 0), cB, voffB); PG8_STAGE(PG8_SA(0, 0), cA, voffA); PG8_STAGE(PG8_SB(0, 1), cB + hstep, voffB); PG8_STAGE(PG8_SA(0, 1), cA + hstep, voffA);
        if (wr == 1) PG8_BAR;
        PG8_WAIT_V(4); PG8_BAR;
        PG8_STAGE(PG8_SB(1, 0), cB + kstep, voffB); PG8_STAGE(PG8_SA(1, 0), cA + kstep, voffA); PG8_STAGE(PG8_SB(1, 1), cB + hstep + kstep, voffB);
        PG8_WAIT_V(6); PG8_BAR;
    }
    for (;;) {
        const bool has_next = S.next(ui + 1, nxt);
        const char* nA = has_next ? (const char*)g.A + (size_t)nxt.pm * tstep : cA; const char* nB = has_next ? (const char*)g.Bt + (size_t)nxt.pn * tstep : cB;
        for (int t = 0; t < nt; t += 2) {
            const bool last = (t == nt - 2);
            const char* a1 = cA + (size_t)(t + 1) * kstep;
            const char* a2 = last ? nA : cA + (size_t)(t + 2) * kstep; const char* b2 = last ? nB : cB + (size_t)(t + 2) * kstep;
            const char* a3 = a2 + kstep; const char* b3 = b2 + kstep;
            if (last && has_next) S.a_ready(nxt);
            if constexpr (SP2) {
            PG8_LDB(B0, 0, 0); PG8_LDB(B1, 0, 1); PG8_SCHED; PG8_LDA(At, 0, 0); PG8_STAGE(PG8_SA(1, 1), a1 + hstep, voffA);
            PG8_WAIT_V(8); PG8_WAIT_L(0); PG8_BAR; PG8_MMA(0, 0, At, B0); PG8_MMA(0, 1, At, B1); PG8_BAR; PG8_SCHED;
            PG8_LDA(At, 0, 1); PG8_STAGE(PG8_SB(0, 0), b2, voffB); PG8_STAGE(PG8_SB(0, 1), b2 + hstep, voffB); PG8_STAGE(PG8_SA(0, 0), a2, voffA);
            PG8_WAIT_V(8); PG8_WAIT_L(0); PG8_BAR; PG8_MMA(1, 0, At, B0); PG8_MMA(1, 1, At, B1); PG8_BAR; PG8_SCHED;
            PG8_LDB(B0, 1, 0); PG8_LDB(B1, 1, 1); PG8_SCHED; PG8_LDA(At, 1, 0); PG8_STAGE(PG8_SA(0, 1), a2 + hstep, voffA);
            PG8_WAIT_V(8); PG8_WAIT_L(0); PG8_BAR; PG8_MMA(0, 0, At, B0); PG8_MMA(0, 1, At, B1); PG8_BAR; PG8_SCHED;
            PG8_LDA(At, 1, 1); PG8_STAGE(PG8_SB(1, 0), b3, voffB); PG8_STAGE(PG8_SB(1, 1), b3 + hstep, voffB); PG8_STAGE(PG8_SA(1, 0), a3, voffA);
            PG8_WAIT_V(8); PG8_WAIT_L(0); PG8_BAR; PG8_MMA(1, 0, At, B0); PG8_MMA(1, 1, At, B1); PG8_BAR; PG8_SCHED;
            } else {
            PG8_LDB(B0, 0, 0); PG8_SCHED; PG8_LDA(At, 0, 0); PG8_STAGE(PG8_SA(1, 1), a1 + hstep, voffA);
            PG8_WAIT_L(8); PG8_BAR; PG8_WAIT_L(0); PG8_MMA(0, 0, At, B0); PG8_BAR; PG8_SCHED;
            PG8_LDB(B1, 0, 1); PG8_STAGE(PG8_SB(0, 0), b2, voffB);
            PG8_BAR; PG8_WAIT_L(0); PG8_MMA(0, 1, At, B1); PG8_BAR;
            PG8_LDA(At, 0, 1); PG8_STAGE(PG8_SA(0, 0), a2, voffA);
            PG8_BAR; PG8_WAIT_L(0); PG8_MMA(1, 0, At, B0); PG8_BAR; PG8_SCHED;
            PG8_STAGE(PG8_SB(0, 1), b2 + hstep, voffB);
            PG8_WAIT_V(6); PG8_BAR; PG8_MMA(1, 1, At, B1); PG8_BAR;
            PG8_LDB(B0, 1, 0); PG8_SCHED; PG8_LDA(At, 1, 0); PG8_STAGE(PG8_SA(0, 1), a2 + hstep, voffA);
            PG8_WAIT_L(8); PG8_BAR; PG8_WAIT_L(0); PG8_MMA(0, 0, At, B0); PG8_BAR; PG8_SCHED;
            PG8_LDB(B1, 1, 1); PG8_STAGE(PG8_SB(1, 0), b3, voffB);
            PG8_BAR; PG8_WAIT_L(0); PG8_MMA(0, 1, At, B1); PG8_BAR;
            PG8_LDA(At, 1, 1); PG8_STAGE(PG8_SA(1, 0), a3, voffA);
            PG8_BAR; PG8_WAIT_L(0); PG8_MMA(1, 0, At, B0); PG8_BAR; PG8_SCHED;
            PG8_STAGE(PG8_SB(1, 1), b3 + hstep, voffB);
            PG8_WAIT_V(6); PG8_BAR; PG8_MMA(1, 1, At, B1); PG8_BAR;
            }
        }
        if constexpr (ALIGN_EPI) { if (wr == 0) PG8_BAR; }
        if constexpr (!Epi::AFTER_DRAIN) { E(acc, cur, wr, wc, fr, fq); S.done(cur); }
        if (!has_next) break;
#pragma unroll
        for (int a = 0; a < 2; ++a)
#pragma unroll
            for (int b = 0; b < 2; ++b)
#pragma unroll
                for (int m = 0; m < 4; ++m)
#pragma unroll
                    for (int n = 0; n < 2; ++n) acc[a][b][m][n] = (f32x4){0.f, 0.f, 0.f, 0.f};
        cur = nxt; cA = nA; cB = nB; ++ui;
        if constexpr (ALIGN_EPI) { if (wr == 1) PG8_BAR; }
    }
    PG8_WAIT_V(0);
    if constexpr (!ALIGN_EPI) { if (wr == 0) PG8_BAR; }
    PG8_BAR;
    if constexpr (Epi::AFTER_DRAIN) { E.fused(acc, cur, wr, wc, fr, fq, lds, wid, lane); S.done(cur); }
#undef PG8_SA
#undef PG8_SB
#undef PG8_STAGE
#undef PG8_LDA
#undef PG8_LDB
#undef PG8_MMA
#undef PG8_WAIT_V
#undef PG8_WAIT_L
#undef PG8_BAR
#undef PG8_SCHED
}
}
namespace attn {
using bf16 = __hip_bfloat16;
constexpr int   D = 128, NW = 8, QBLK = 32, KVBLK = 64;
constexpr float SCALE = 0.088388347648318440f;
constexpr float THR = 8.f;
constexpr int SDEPTH = 2;
constexpr int LDQ = 1024, LDK = 256, LDO = 1024;
constexpr size_t SHM_V = KVBLK * D * 2, SHM_K = KVBLK * D * 2, SHM_ATTN = 2 * SHM_V + 2 * SHM_K + NW * 64 * 4;
using bf16x8 = __attribute__((ext_vector_type(8))) short;
using s16x4  = __attribute__((ext_vector_type(4))) short;
using f32x16 = __attribute__((ext_vector_type(16))) float;
using f32x8  = __attribute__((ext_vector_type(8))) float;
using u32x4  = __attribute__((ext_vector_type(4))) unsigned;
#define KSWZ(row, colB) ((row) * 256 + ((colB) ^ (((row) & 7) << 4)))
#define SBAR() __builtin_amdgcn_sched_barrier(0)
__device__ __forceinline__ int crow(int r, int hi) { return (r & 3) + 8 * (r >> 2) + 4 * hi; }
__device__ __forceinline__ unsigned cvtpk(float lo, float hi) {
  unsigned r; asm volatile("v_cvt_pk_bf16_f32 %0, %1, %2" : "=v"(r) : "v"(lo), "v"(hi)); return r;
}
template <typename TIn> struct Stage;
template <> struct Stage<bf16>  { using T = bf16x8;
  __device__ static __forceinline__ T ld8(const bf16* p) { return *reinterpret_cast<const bf16x8*>(p); }
  __device__ static __forceinline__ bf16x8 tobf(T x) { return x; } };
template <> struct Stage<float> { using T = f32x8;
  __device__ static __forceinline__ T ld8(const float* p) { return *reinterpret_cast<const f32x8*>(p); }
  __device__ static __forceinline__ bf16x8 tobf(T x) {
    u32x4 w = {cvtpk(x[0], x[1]), cvtpk(x[2], x[3]), cvtpk(x[4], x[5]), cvtpk(x[6], x[7])}; return *reinterpret_cast<bf16x8*>(&w); } };

__device__ __forceinline__ void partialSM(f32x16& p0, f32x16& p1, float& m_reg, float& mn, float& alpha) {
  constexpr float C = SCALE * 1.4426950408889634f;
  float pmax = p0[0]; for (int r = 1; r < 16; ++r) pmax = fmaxf(pmax, p0[r]); for (int r = 0; r < 16; ++r) pmax = fmaxf(pmax, p1[r]);
  { auto rr = __builtin_amdgcn_permlane32_swap(__float_as_uint(pmax), __float_as_uint(pmax), false, false);
    pmax = fmaxf(__uint_as_float(rr[0]), __uint_as_float(rr[1])); }
  if (__builtin_expect(__all(pmax - m_reg <= THR / SCALE), 1)) { mn = m_reg; alpha = 1.f; }
  else { mn = fmaxf(m_reg, pmax); alpha = __builtin_amdgcn_exp2f((m_reg - mn) * C); m_reg = mn; }
  float mnC = -mn * C;
  for (int r = 0; r < 16; ++r) p0[r] = fmaf(p0[r], C, mnC); for (int r = 0; r < 16; ++r) p1[r] = fmaf(p1[r], C, mnC);
  for (int r = 0; r < 16; ++r) p0[r] = __builtin_amdgcn_exp2f(p0[r]);
}
__device__ __forceinline__ void finishSM(f32x16& p0, f32x16& p1, float alpha, float& l_reg, bf16x8& pa0, bf16x8& pa1, bf16x8& pa2, bf16x8& pa3) {
  for (int r = 0; r < 16; ++r) p1[r] = __builtin_amdgcn_exp2f(p1[r]);
  float ps = 0; for (int r = 0; r < 16; ++r) ps += p0[r]; for (int r = 0; r < 16; ++r) ps += p1[r];
  { auto rr = __builtin_amdgcn_permlane32_swap(__float_as_uint(ps), __float_as_uint(ps), false, false);
    ps = __uint_as_float(rr[0]) + __uint_as_float(rr[1]); }
  l_reg = l_reg * alpha + ps;
#define PK4(P, BASE, OUT) do { unsigned a0 = cvtpk(P[BASE + 0], P[BASE + 1]), a1 = cvtpk(P[BASE + 2], P[BASE + 3]);   \
    unsigned b0 = cvtpk(P[BASE + 4], P[BASE + 5]), b1 = cvtpk(P[BASE + 6], P[BASE + 7]);                              \
    auto r0 = __builtin_amdgcn_permlane32_swap(a0, b0, false, false); auto r1 = __builtin_amdgcn_permlane32_swap(a1, b1, false, false); \
    u32x4 w = {r0[0], r1[0], r0[1], r1[1]}; OUT = *reinterpret_cast<bf16x8*>(&w); } while (0)
  PK4(p0, 0, pa0); PK4(p0, 8, pa1); PK4(p1, 0, pa2); PK4(p1, 8, pa3);
#undef PK4
}
__device__ __forceinline__ void qkt(f32x16& p0, f32x16& p1, const bf16* Ks, const bf16x8* qr, int r32, int hi) {
  p0 = f32x16{}; p1 = f32x16{};
  for (int d0 = 0; d0 < 8; ++d0) { int cb = (d0 * 16 + hi * 8) * 2;
    bf16x8 b0 = *reinterpret_cast<const bf16x8*>((const char*)Ks + KSWZ(r32, cb));
    bf16x8 b1 = *reinterpret_cast<const bf16x8*>((const char*)Ks + KSWZ(32 + r32, cb));
    p0 = __builtin_amdgcn_mfma_f32_32x32x16_bf16(b0, qr[d0], p0, 0, 0, 0);
    p1 = __builtin_amdgcn_mfma_f32_32x32x16_bf16(b1, qr[d0], p1, 0, 0, 0); }
}
__device__ __forceinline__ int v_st(int k, int c) { const int kk = (k & ~0xC) | ((k & 4) << 1) | ((k & 8) >> 1); return ((kk >> 3) * 4 + (c >> 5)) * 512 + ((kk & 7) * 32 + (c & 31)) * 2; }
__device__ __forceinline__ int v_rd_base(int lane) { return ((lane & 3) << 3) | (((lane >> 2) & 3) << 6) | (((lane >> 4) & 1) << 5) | (((lane >> 5) & 1) << 8); }
constexpr int v_rd_off(int d0, int ks, int half) { return d0 * 512 + ks * 4096 + half * 2048; }
template <int OFF> __device__ __forceinline__ s16x4 tr_read(int vb) {
  s16x4 r; asm volatile("ds_read_b64_tr_b16 %0, %1 offset:%2" : "=&v"(r) : "v"(vb), "i"(OFF) : "memory"); return r;
}
template <int D0> __device__ __forceinline__ void pv_one(f32x16& od, int vb, bf16x8 pa0, bf16x8 pa1, bf16x8 pa2, bf16x8 pa3) {
  const s16x4 l0 = tr_read<v_rd_off(D0, 0, 0)>(vb), h0 = tr_read<v_rd_off(D0, 0, 1)>(vb), l1 = tr_read<v_rd_off(D0, 1, 0)>(vb), h1 = tr_read<v_rd_off(D0, 1, 1)>(vb);
  const s16x4 l2 = tr_read<v_rd_off(D0, 2, 0)>(vb), h2 = tr_read<v_rd_off(D0, 2, 1)>(vb), l3 = tr_read<v_rd_off(D0, 3, 0)>(vb), h3 = tr_read<v_rd_off(D0, 3, 1)>(vb);
  asm volatile("s_waitcnt lgkmcnt(0)" ::: "memory"); SBAR();
#define PK(L, H) (bf16x8){L[0], L[1], L[2], L[3], H[0], H[1], H[2], H[3]}
  od = __builtin_amdgcn_mfma_f32_32x32x16_bf16(pa0, PK(l0, h0), od, 0, 0, 0);
  od = __builtin_amdgcn_mfma_f32_32x32x16_bf16(pa1, PK(l1, h1), od, 0, 0, 0);
  od = __builtin_amdgcn_mfma_f32_32x32x16_bf16(pa2, PK(l2, h2), od, 0, 0, 0);
  od = __builtin_amdgcn_mfma_f32_32x32x16_bf16(pa3, PK(l3, h3), od, 0, 0, 0);
#undef PK
}
__device__ __forceinline__ void pv_d0(f32x16* o, int vb, bf16x8 pa0, bf16x8 pa1, bf16x8 pa2, bf16x8 pa3) {
  pv_one<0>(o[0], vb, pa0, pa1, pa2, pa3); pv_one<1>(o[1], vb, pa0, pa1, pa2, pa3); pv_one<2>(o[2], vb, pa0, pa1, pa2, pa3); pv_one<3>(o[3], vb, pa0, pa1, pa2, pa3);
}

template <typename TQ>
__device__ __forceinline__ void attn_dense_body(const TQ* Qb, const bf16* Kh, const bf16* Vh,
                                                unsigned short* Ob, int seq, char* lds) {
  using St = Stage<bf16>; using SQ = Stage<TQ>;
  const int tid = opaque_tid(), wid = tid >> 6, lane = tid & 63, r32 = lane & 31, hi = lane >> 5;
  bf16* V_lds = (bf16*)lds; bf16* K_lds = (bf16*)(lds + 2 * SHM_V);
  float* ws = (float*)(lds + 2 * SHM_V + 2 * SHM_K) + wid * 64; float* li_l = ws; float* al_l = ws + 32;
  float m_reg = -1e30f, l_reg = 0; f32x16 o[4] = {}; bf16x8 qr[8];
  const TQ* Qw = Qb + (long)(wid * QBLK + r32) * LDQ + hi * 8;
#pragma unroll
  for (int d0 = 0; d0 < 8; ++d0) qr[d0] = SQ::tobf(SQ::ld8(Qw + d0 * 16));
  const int sr = tid >> 4, sc = (tid & 15) * 8, vst0 = v_st(sr, sc), vst1 = v_st(32 + sr, sc);
  const int vb0 = (int)(uintptr_t)V_lds + v_rd_base(lane);
  struct { typename St::T vs0, vs1, ks0, ks1; } sr_[SDEPTH];
#define SLOAD(i, k0) do { sr_[i].vs0 = St::ld8(&Vh[(long)((k0) + sr) * LDK + sc]); sr_[i].vs1 = St::ld8(&Vh[(long)((k0) + 32 + sr) * LDK + sc]); \
    sr_[i].ks0 = St::ld8(&Kh[(long)((k0) + sr) * LDK + sc]); sr_[i].ks1 = St::ld8(&Kh[(long)((k0) + 32 + sr) * LDK + sc]); } while (0)
#define SWRITE(b, i) do { *(bf16x8*)((char*)V_lds + (b) * SHM_V + vst0) = St::tobf(sr_[i].vs0);          \
    *(bf16x8*)((char*)V_lds + (b) * SHM_V + vst1) = St::tobf(sr_[i].vs1); int kc = sc * 2;               \
    *(bf16x8*)((char*)K_lds + (b) * SHM_K + KSWZ(sr, kc)) = St::tobf(sr_[i].ks0);                       \
    *(bf16x8*)((char*)K_lds + (b) * SHM_K + KSWZ(32 + sr, kc)) = St::tobf(sr_[i].ks1); } while (0)
#define SWAIT() do { if constexpr (SDEPTH == 2) asm volatile("s_waitcnt vmcnt(4)" ::: "memory"); else asm volatile("s_waitcnt vmcnt(0)" ::: "memory"); } while (0)
#define RESC(a) do { if (__any((a) < 1.f)) { if (hi == 0) al_l[r32] = (a); asm volatile("s_waitcnt lgkmcnt(0)" ::: "memory"); \
    for (int d = 0; d < 4; ++d) for (int r = 0; r < 16; ++r) o[d][r] *= al_l[crow(r, hi)]; } } while (0)
  f32x16 pA0, pA1, pB0, pB1; float mnA, mnB, alA, alB; bf16x8 pa0, pa1, pa2, pa3; const int NT = seq / KVBLK;
  constexpr int SE = 0, SO = SDEPTH - 1;
  SLOAD(SE, 0); asm volatile("s_waitcnt vmcnt(0)" ::: "memory"); SWRITE(0, SE); __syncthreads();
  qkt(pA0, pA1, K_lds, qr, r32, hi); partialSM(pA0, pA1, m_reg, mnA, alA);
  SLOAD(SO, KVBLK); if constexpr (SDEPTH == 2) { if (2 < NT) SLOAD(SE, 2 * KVBLK); }
  SWAIT(); SWRITE(1, SO); __syncthreads();
  for (int j = 1; j + 1 < NT; j += 2) {
    SBAR(); qkt(pB0, pB1, (bf16*)((char*)K_lds + SHM_K), qr, r32, hi);
    finishSM(pA0, pA1, alA, l_reg, pa0, pa1, pa2, pa3); SBAR();
    SLOAD(SO, (j + SDEPTH) * KVBLK); SBAR();
    pv_d0(o, vb0, pa0, pa1, pa2, pa3); partialSM(pB0, pB1, m_reg, mnB, alB);
    __syncthreads(); SWAIT(); SWRITE(0, SE);
    RESC(alB); __syncthreads();
    SBAR(); qkt(pA0, pA1, K_lds, qr, r32, hi);
    finishSM(pB0, pB1, alB, l_reg, pa0, pa1, pa2, pa3); SBAR();
    if (SDEPTH == 1 || j + 3 < NT) SLOAD(SE, (j + 1 + SDEPTH) * KVBLK); SBAR();
    pv_d0(o, vb0 + (int)SHM_V, pa0, pa1, pa2, pa3); partialSM(pA0, pA1, m_reg, mnA, alA);
    __syncthreads(); SWAIT(); SWRITE(1, SO);
    RESC(alA); __syncthreads();
  }
  SBAR(); qkt(pB0, pB1, (bf16*)((char*)K_lds + SHM_K), qr, r32, hi);
  finishSM(pA0, pA1, alA, l_reg, pa0, pa1, pa2, pa3); SBAR();
  pv_d0(o, vb0, pa0, pa1, pa2, pa3); partialSM(pB0, pB1, m_reg, mnB, alB);
  __syncthreads(); RESC(alB);
  finishSM(pB0, pB1, alB, l_reg, pa0, pa1, pa2, pa3); SBAR();
  pv_d0(o, vb0 + (int)SHM_V, pa0, pa1, pa2, pa3);
  if (hi == 0) li_l[r32] = l_reg; asm volatile("s_waitcnt lgkmcnt(0)" ::: "memory");
  float rli[16];
#pragma unroll
  for (int r = 0; r < 16; ++r) rli[r] = __builtin_amdgcn_rcpf(li_l[crow(r, hi)]);
  unsigned short* Ow = Ob + (long)(wid * QBLK) * LDO;
#pragma unroll
  for (int r = 0; r < 16; ++r) { int orow = crow(r, hi);
    for (int d0 = 0; d0 < 4; ++d0) Ow[(long)orow * LDO + d0 * 32 + r32] = (unsigned short)(cvtpk(o[d0][r] * rli[r], 0.f) & 0xffffu); }
#undef SLOAD
#undef SWRITE
#undef SWAIT
#undef RESC
}
}
#define XB_TMO      128
#define XB_XCNT(j)  (256  + 64 * (j))
#define XB_XSUB(j)  (1280 + 64 * (j))
#define XB_XGEN(j)  (2304 + 64 * (j))
#define XB_TOP      3328
#define XB_TOPGEN   3392
#define XCD_BAR_WORDS 3456
#define XB_SPIN_CAP (1u << 18)

__device__ __forceinline__ unsigned xb_ld(unsigned* p)              { return __hip_atomic_load(p, __ATOMIC_RELAXED, __HIP_MEMORY_SCOPE_AGENT); }
__device__ __forceinline__ unsigned xb_add(unsigned* p, unsigned v) { return __hip_atomic_fetch_add(p, v, __ATOMIC_RELAXED, __HIP_MEMORY_SCOPE_AGENT); }
__device__ __forceinline__ unsigned xb_xcc_id() { return (unsigned)__builtin_amdgcn_s_getreg((3 << 11) | 20) & 0xFu; }
#define XB_SPIN(cond, bar) do { unsigned _sp = 0; while (cond) { __builtin_amdgcn_s_sleep(1); \
    if ((++_sp & 255u) == 0u) { if (xb_ld(&(bar)[XB_TMO])) break; if (_sp > XB_SPIN_CAP) { atomicAdd(&(bar)[XB_TMO], 1u); break; } } } } while (0)

struct XcdBarrier {
    unsigned* bar; unsigned x;
    volatile LAS unsigned* st;
};

__device__ __forceinline__ XcdBarrier xcd_barrier_post(unsigned* bar, volatile LAS unsigned* st) {
    XcdBarrier b; b.bar = bar; b.x = xb_xcc_id(); b.st = st;
    if (threadIdx.x == 0) (void)xb_add(&bar[XB_XCNT(b.x)], 1u);
    return b;
}
__device__ __forceinline__ void xcd_barrier_complete(unsigned* bar, unsigned x, unsigned& nloc, unsigned& nx) {
    const unsigned G = gridDim.x * gridDim.y * gridDim.z;
    unsigned sum, cnt, mine, sp = 0u;
    for (;;) {
        sum = 0u; cnt = 0u; mine = 0u;
#pragma unroll
        for (unsigned j = 0; j < 16; ++j) { const unsigned c = xb_ld(&bar[XB_XCNT(j)]); sum += c; cnt += (c > 0u) ? 1u : 0u; mine = (j == x) ? c : mine; }
        if (sum == G) break;
        __builtin_amdgcn_s_sleep(1);
        if ((++sp & 255u) == 0u) { if (xb_ld(&bar[XB_TMO])) break; if (sp > XB_SPIN_CAP) { atomicAdd(&bar[XB_TMO], 1u); break; } }
    }
    nloc = mine > 0u ? mine : 1u; nx = cnt > 0u ? cnt : 1u;
}

__device__ __forceinline__ void xcd_barrier(const XcdBarrier& b) {
    asm volatile("s_waitcnt vmcnt(0)" ::: "memory");
    __syncthreads();
    if (threadIdx.x == 0) {
        unsigned* bar = b.bar;
        __builtin_amdgcn_s_waitcnt(0);
        unsigned nloc = b.st[0], nx = b.st[1];
        if (nloc == 0u) { xcd_barrier_complete(bar, b.x, nloc, nx); b.st[0] = nloc; b.st[1] = nx; }
        const unsigned old = xb_add(&bar[XB_XSUB(b.x)], 1u);
        const unsigned gen = old / nloc;
        if (old + 1u == (gen + 1u) * nloc) {
            __builtin_amdgcn_fence(__ATOMIC_RELEASE, "agent");
            asm volatile("s_waitcnt vmcnt(0)" ::: "memory");
            const unsigned og = xb_add(&bar[XB_TOP], 1u);
            const unsigned tg = og / nx;
            if (og + 1u == (tg + 1u) * nx) xb_add(&bar[XB_TOPGEN], 1u);
            else XB_SPIN(xb_ld(&bar[XB_TOPGEN]) == tg, bar);
            __builtin_amdgcn_fence(__ATOMIC_ACQUIRE, "agent");
            xb_add(&bar[XB_XGEN(b.x)], 1u);
            asm volatile("s_waitcnt vmcnt(0)" ::: "memory");
        } else {
            XB_SPIN(xb_ld(&bar[XB_XGEN(b.x)]) == gen, bar);
            __builtin_amdgcn_fence(__ATOMIC_ACQUIRE, "agent");
            asm volatile("s_waitcnt vmcnt(0)" ::: "memory");
        }
    }
    __syncthreads();
}
#define LAS __attribute__((address_space(3)))
typedef unsigned short bf16_t;
typedef float f32x4 __attribute__((ext_vector_type(4)));
typedef float f32x2 __attribute__((ext_vector_type(2)));
typedef unsigned u32x4 __attribute__((ext_vector_type(4)));
typedef unsigned u32x2 __attribute__((ext_vector_type(2)));
typedef short bf16x8 __attribute__((ext_vector_type(8)));
typedef short s16x4 __attribute__((ext_vector_type(4)));
#define LDS_WAIT() asm volatile("s_waitcnt lgkmcnt(0)" ::: "memory")
using pg8::cvt_pk_bf16; using pg8::bf_lo; using pg8::bf_hi; using pg8::sigmoidf_;

__device__ __forceinline__ float wave_sum(float v) {
#pragma unroll
    for (int o = 1; o < 64; o <<= 1) v += __shfl_xor(v, o);
    return v;
}

__device__ __forceinline__ void transpose_item(const float* __restrict__ W, int ldW, int K, int src_n0, int k0, bf16_t* WT, int dst_row0, LAS float* scr, int lane, int pmode = -1) {
#pragma unroll 8
    for (int i = 0; i < 32; ++i) { const int kk = 2 * i + (lane >> 5); scr[kk * 33 + (lane & 31)] = W[(size_t)(k0 + kk) * ldW + src_n0 + (lane & 31)]; }
    LDS_WAIT(); asm volatile("" ::: "memory");
    const int c = lane & 7;
#pragma unroll
    for (int j = 0; j < 4; ++j) { const int n = (lane >> 3) + 8 * j; const LAS float* s = scr + (8 * c) * 33 + n;
        u32x4 o; o.x = cvt_pk_bf16(s[0 * 33], s[1 * 33]); o.y = cvt_pk_bf16(s[2 * 33], s[3 * 33]); o.z = cvt_pk_bf16(s[4 * 33], s[5 * 33]); o.w = cvt_pk_bf16(s[6 * 33], s[7 * 33]);
        const int nn = pmode < 0 ? n : 32 * (2 * (pmode >> 1) + (n >> 4)) + 8 * ((n >> 2) & 3) + 4 * (pmode & 1) + (n & 3);
        *(u32x4*)(WT + (size_t)(dst_row0 + nn) * K + k0 + 8 * c) = o; }
    LDS_WAIT(); asm volatile("" ::: "memory");
}

struct Args { const float* in[20]; float* out; unsigned char* ws; int ph_lo, ph_hi; };
typedef const __attribute__((address_space(4))) Args* KA;

__device__ __forceinline__ void prep_layer(KA a, int L, LAS unsigned char* lds, int gw, int NGW, int wave, int lane) {
    LAS float* scr = (LAS float*)(lds + wave * 8448);
    unsigned char* wsW = a->ws + WS_W;
    const float* w_in = a->in[3] + (size_t)L * DM * INW;
    const float* w_ogla = a->in[9] + (size_t)L * DM * DM; const float* w_oatt = a->in[10] + (size_t)L * DM * DM; const float* w_out = a->in[11] + (size_t)L * DM * DM;
    const float* w_fin = a->in[14] + (size_t)L * DM * 2 * FFH; const float* w_fout = a->in[15] + (size_t)L * FFH * DM;
    const float* w_pp = a->in[17] + (size_t)L * PLE * DM; const float* w_pg = a->in[18] + (size_t)L * DM * DM;
    constexpr int I_A = 16 * 97, I_B = 16 * 112, I_SQ = 16 * 32, I_FI = 16 * 176, I_FO = 44 * 32, I_PP = 4 * 32;
    constexpr int NITEMS = I_A + I_B + 4 * I_SQ + I_FI + I_FO + I_PP;
    for (int it = gw; it < NITEMS; it += NGW) {
        int r = it;
        if (r < I_A) { const int kb = r / 97, nb = r % 97; transpose_item(w_in, INW, DM, 32 * nb, 64 * kb, (bf16_t*)(wsW + W_INA), 32 * nb, scr, lane); continue; } r -= I_A;
        if (r < I_B) { const int kb = r / 112, nb = r % 112; const int d0 = (32 * nb) & 127;
            if (nb < 40) transpose_item(w_in, INW, DM, NA_REAL + 32 * nb, 64 * kb, (bf16_t*)(wsW + W_INB), 32 * nb - d0, scr, lane, (d0 >> 6) * 2 + ((d0 >> 5) & 1));
            else transpose_item(w_in, INW, DM, NA_REAL + 32 * nb, 64 * kb, (bf16_t*)(wsW + W_INB), 32 * nb, scr, lane);
            continue; } r -= I_B;
        if (r < 4 * I_SQ) { const int which = r / I_SQ, q = r % I_SQ, kb = q / 32, nb = q % 32;
            const float* src = which == 0 ? w_ogla : which == 1 ? w_oatt : which == 2 ? w_out : w_pg;
            const size_t dsto = which == 0 ? W_OGLA : which == 1 ? W_OATT : which == 2 ? W_OUT : W_PG;
            transpose_item(src, DM, DM, 32 * nb, 64 * kb, (bf16_t*)(wsW + dsto), 32 * nb, scr, lane); continue; } r -= 4 * I_SQ;
        if (r < I_FI) { const int kb = r / 176, nb = r % 176; const int n0 = 32 * nb; const int j = n0 < FFH ? n0 : n0 - FFH; const int dst = (j >> 7) * 256 + (n0 < FFH ? 0 : 128) + (j & 127);
            transpose_item(w_fin, 2 * FFH, DM, n0, 64 * kb, (bf16_t*)(wsW + W_FIN), dst, scr, lane); continue; } r -= I_FI;
        if (r < I_FO) { const int kb = r / 32, nb = r % 32; transpose_item(w_fout, DM, FFH, 32 * nb, 64 * kb, (bf16_t*)(wsW + W_FOUT), 32 * nb, scr, lane); continue; } r -= I_FO;
        { const int kb = r / 32, nb = r % 32; transpose_item(w_pp, DM, PLE, 32 * nb, 64 * kb, (bf16_t*)(wsW + W_PP), 32 * nb, scr, lane); }
    }
    { u32x4* z = (u32x4*)(wsW + W_INA + (size_t)NA_REAL * DM * 2); const int nz = (NA_PAD - NA_REAL) * DM * 2 / 16;
      for (int i = gw * 64 + lane; i < nz; i += NGW * 64) z[i] = (u32x4){0u, 0u, 0u, 0u}; }
    { const float* p = a->in[1] + (size_t)L * TOK * PLE; bf16_t* pb = (bf16_t*)(a->ws + WS_PB); const int n8 = TOK * PLE / 8;
      for (int i = gw * 64 + lane; i < n8; i += NGW * 64) { const f32x4 x0 = *(const f32x4*)(p + (size_t)i * 8), x1 = *(const f32x4*)(p + (size_t)i * 8 + 4);
          u32x4 o; o.x = cvt_pk_bf16(x0[0], x0[1]); o.y = cvt_pk_bf16(x0[2], x0[3]); o.z = cvt_pk_bf16(x1[0], x1[1]); o.w = cvt_pk_bf16(x1[2], x1[3]); *(u32x4*)(pb + (size_t)i * 8) = o; } }
}

template <bool IN_F32, bool OUT_F32>
__device__ __forceinline__ void row_pass(const void* hin, void* hout, const bf16_t* y, const float* __restrict__ gpost, const float* __restrict__ gpre, bf16_t* xa, int gw, int NGW, int lane) {
    for (int m0 = gw; m0 < TOK; m0 += 2 * NGW) {
        f32x4 v[2][4]; u32x2 yw[2][4];
#pragma unroll
        for (int r = 0; r < 2; ++r) { const size_t m = (size_t)m0 + (size_t)r * NGW;
#pragma unroll
            for (int j = 0; j < 4; ++j) {
                if (IN_F32) v[r][j] = ((const f32x4*)((const float*)hin + m * DM))[lane + 64 * j];
                else { const u32x2 w = ((const u32x2*)((const bf16_t*)hin + m * DM))[lane + 64 * j]; v[r][j] = (f32x4){bf_lo(w.x), bf_hi(w.x), bf_lo(w.y), bf_hi(w.y)}; }
                if (y) yw[r][j] = ((const u32x2*)(y + m * DM))[lane + 64 * j]; } }
#pragma unroll
        for (int r = 0; r < 2; ++r) { const size_t m = (size_t)m0 + (size_t)r * NGW;
            if (y) {
                f32x4 yv[4]; float ss = 0.f;
#pragma unroll
                for (int j = 0; j < 4; ++j) { const u32x2 w = yw[r][j]; yv[j] = (f32x4){bf_lo(w.x), bf_hi(w.x), bf_lo(w.y), bf_hi(w.y)};
                    ss += (yv[j][0] * yv[j][0] + yv[j][1] * yv[j][1]) + (yv[j][2] * yv[j][2] + yv[j][3] * yv[j][3]); }
                const float rs = rsqrtf(wave_sum(ss) * (1.0f / DM) + EPS);
#pragma unroll
                for (int j = 0; j < 4; ++j) { const f32x4 g = ((const f32x4*)gpost)[lane + 64 * j]; v[r][j] = v[r][j] + yv[j] * rs * g; }
            }
#pragma unroll
            for (int j = 0; j < 4; ++j) {
                if (OUT_F32) ((f32x4*)((float*)hout + m * DM))[lane + 64 * j] = v[r][j];
                else { u32x2 w; w.x = cvt_pk_bf16(v[r][j][0], v[r][j][1]); w.y = cvt_pk_bf16(v[r][j][2], v[r][j][3]); ((u32x2*)((bf16_t*)hout + m * DM))[lane + 64 * j] = w; } }
            if (gpre) {
                float ss = 0.f;
#pragma unroll
                for (int j = 0; j < 4; ++j) ss += (v[r][j][0] * v[r][j][0] + v[r][j][1] * v[r][j][1]) + (v[r][j][2] * v[r][j][2] + v[r][j][3] * v[r][j][3]);
                const float r2 = rsqrtf(wave_sum(ss) * (1.0f / DM) + EPS);
#pragma unroll
                for (int j = 0; j < 4; ++j) { const f32x4 o = v[r][j] * r2 * ((const f32x4*)gpre)[lane + 64 * j];
                    u32x2 w; w.x = cvt_pk_bf16(o[0], o[1]); w.y = cvt_pk_bf16(o[2], o[3]); ((u32x2*)(xa + m * DM))[lane + 64 * j] = w; }
            }
        }
    }
}

__device__ __forceinline__ void qk_norm_rope(unsigned char* rbase, const float* __restrict__ gq, const float* __restrict__ gk, int gw, int NGW, int lane) {
    const int axis = lane >> 5, j = lane & 31, i1 = axis * 64 + j, i2 = i1 + 32;
    const float inv = __builtin_amdgcn_exp2f(-(float)j * (13.287712379549449f / 32.0f));
    const float gq1 = gq[i1], gq2 = gq[i2], gk1 = gk[i1], gk2 = gk[i2];
    for (int it = gw; it < TOK * 10; it += NGW) {
        const int t = it / 10, hs = it % 10;
        bf16_t* p = hs < 8 ? (bf16_t*)(rbase + R_Q) + (size_t)t * 1024 + hs * 128 : (bf16_t*)(rbase + R_K) + (size_t)t * 256 + (hs - 8) * 128;
        const float g1 = hs < 8 ? gq1 : gk1, g2 = hs < 8 ? gq2 : gk2;
        float x1 = bf_lo((unsigned)p[i1]), x2 = bf_lo((unsigned)p[i2]);
        const float rs = rsqrtf(wave_sum(x1 * x1 + x2 * x2) * (1.0f / 128.0f) + EPS);
        x1 = x1 * rs * g1; x2 = x2 * rs * g2;
        const int s = t & (SEQ - 1); const float pos = (float)(axis == 0 ? (s >> 6) : (s & 63));
        const float rev = pos * inv * 0.15915494309189535f;
        const float rf = __builtin_amdgcn_fractf(rev); const float c = __builtin_amdgcn_cosf(rf), sn = __builtin_amdgcn_sinf(rf);
        const float o1 = x1 * c - x2 * sn, o2 = x2 * c + x1 * sn;
        p[i1] = (bf16_t)(cvt_pk_bf16(o1, 0.f) & 0xffffu); p[i2] = (bf16_t)(cvt_pk_bf16(o2, 0.f) & 0xffffu);
    }
}

__device__ __forceinline__ void gla_post(bf16_t* of, const bf16_t* ob, const bf16_t* gg, const float* __restrict__ g, int gw, int NGW, int lane) {
    const f32x4 gv = ((const f32x4*)g)[lane];
    for (int it0 = gw; it0 < TOK * 4; it0 += 2 * NGW) {
        u32x2 a[2], b[2], c[2];
#pragma unroll
        for (int r = 0; r < 2; ++r) { const size_t off = ((size_t)it0 + (size_t)r * NGW) * 256 + 4 * lane; a[r] = *(const u32x2*)(of + off); b[r] = *(const u32x2*)(ob + off); c[r] = *(const u32x2*)(gg + off); }
#pragma unroll
        for (int r = 0; r < 2; ++r) { const size_t off = ((size_t)it0 + (size_t)r * NGW) * 256 + 4 * lane;
            f32x4 o = (f32x4){bf_lo(a[r].x) + bf_lo(b[r].x), bf_hi(a[r].x) + bf_hi(b[r].x), bf_lo(a[r].y) + bf_lo(b[r].y), bf_hi(a[r].y) + bf_hi(b[r].y)};
            const float rs = rsqrtf(wave_sum((o[0] * o[0] + o[1] * o[1]) + (o[2] * o[2] + o[3] * o[3])) * (1.0f / 256.0f) + EPS);
            const f32x4 gt = (f32x4){bf_lo(c[r].x), bf_hi(c[r].x), bf_lo(c[r].y), bf_hi(c[r].y)};
#pragma unroll
            for (int k = 0; k < 4; ++k) o[k] = o[k] * rs * gv[k] * (gt[k] * sigmoidf_(gt[k]));
            u32x2 w; w.x = cvt_pk_bf16(o[0], o[1]); w.y = cvt_pk_bf16(o[2], o[3]); *(u32x2*)(of + off) = w; }
    }
}
constexpr int GL_QD = 0, GL_KI = 17408, GL_KST = 34816, GL_VT = 53248, GL_STT = 62464, GL_EL = 79872, GL_RA = 80384, GL_TOT = 84480, GL_END = 88576;
constexpr int GS_Q = 272, GS_T = 144;
constexpr size_t R_QDF = 132 * MiB, R_KIF = 164 * MiB, R_EL = 196 * MiB;

__device__ __forceinline__ void gla_prep(KA a, int L, int b, int ci, int h, LAS unsigned char* lds) {
    const int tid = opaque_tid(), lane = tid & 63, w = __builtin_amdgcn_readfirstlane(tid >> 6);
    unsigned char* rbase = a->ws + WS_R;
    const bf16_t* GQ = (const bf16_t*)(rbase + R_GQ); const bf16_t* GK = (const bf16_t*)(rbase + R_GK); const float* RA = (const float*)(rbase + R_RA);
    const size_t t0 = (size_t)b * SEQ + (size_t)ci * 64; const int vrow = tid >> 3, vc8 = tid & 7;
    unsigned qc[8], kc[8];
#pragma unroll
    for (int r = 0; r < 8; ++r) { qc[r] = *(const unsigned*)(GQ + (t0 + 8 * w + r) * 512 + h * 128 + 2 * lane); kc[r] = *(const unsigned*)(GK + (t0 + 8 * w + r) * 512 + h * 128 + 2 * lane); }
#pragma unroll 1
    for (int dir = 0; dir < 2; ++dir) {
        bf16_t* QD = dir ? (bf16_t*)((unsigned char*)a->out + 64 * MiB) : (bf16_t*)(rbase + R_QDF);
        bf16_t* KI = dir ? (bf16_t*)((unsigned char*)a->out + 96 * MiB) : (bf16_t*)(rbase + R_KIF);
        float* EL = (float*)(rbase + R_EL) + ((size_t)dir * 512 + (size_t)b * 64 + ci) * 512;
        f32x2 wu[16];
        { const float* wup = a->in[4] + ((size_t)(L * 2 + dir) * 16) * 512 + h * 128 + 2 * lane;
#pragma unroll
          for (int j = 0; j < 16; ++j) wu[j] = *(const f32x2*)(wup + (size_t)j * 512); }
        const f32x2 bias = *(const f32x2*)(a->in[5] + (size_t)(L * 2 + dir) * 512 + h * 128 + 2 * lane);
        *(LAS f32x2*)(lds + GL_RA + vrow * 64 + vc8 * 8) = *(const f32x2*)(RA + (t0 + vrow) * 32 + dir * 16 + 2 * vc8);
        __syncthreads();
        float la0[8], la1[8];
#pragma unroll
        for (int r = 0; r < 8; ++r) {
            const LAS f32x4* rr = (const LAS f32x4*)(lds + GL_RA + (8 * w + r) * 64);
            f32x2 x = bias;
#pragma unroll
            for (int q4 = 0; q4 < 4; ++q4) { const f32x4 t = rr[q4];
#pragma unroll
                for (int e = 0; e < 4; ++e) x = __builtin_elementwise_fma((f32x2){t[e], t[e]}, wu[4 * q4 + e], x); }
            const f32x2 xl = x * 1.4426950408889634f;
            la0[r] = (fminf(xl.x, 0.f) - __builtin_amdgcn_logf(1.0f + __builtin_amdgcn_exp2f(-fabsf(xl.x)))) * (1.0f / 16.0f);
            la1[r] = (fminf(xl.y, 0.f) - __builtin_amdgcn_logf(1.0f + __builtin_amdgcn_exp2f(-fabsf(xl.y)))) * (1.0f / 16.0f);
        }
        if (dir == 0) {
#pragma unroll
            for (int r = 1; r < 8; ++r) { la0[r] += la0[r - 1]; la1[r] += la1[r - 1]; }
        } else {
#pragma unroll
            for (int r = 6; r >= 0; --r) { la0[r] += la0[r + 1]; la1[r] += la1[r + 1]; }
        }
        *(LAS f32x2*)(lds + GL_TOT + w * 512 + lane * 8) = (f32x2){dir == 0 ? la0[7] : la0[0], dir == 0 ? la1[7] : la1[0]};
        __syncthreads();
        float off0 = 0.f, off1 = 0.f, last0 = 0.f, last1 = 0.f;
#pragma unroll
        for (int g = 0; g < 8; ++g) { const f32x2 t = *(const LAS f32x2*)(lds + GL_TOT + g * 512 + lane * 8); last0 += t.x; last1 += t.y;
            const bool before = dir == 0 ? (g < w) : (g > w); if (before) { off0 += t.x; off1 += t.y; } }
#pragma unroll
        for (int r = 0; r < 8; ++r) {
            const float c0 = la0[r] + off0, c1 = la1[r] + off1;
            const float q0 = bf_lo(qc[r]), q1 = bf_hi(qc[r]), k0 = bf_lo(kc[r]), k1 = bf_hi(kc[r]);
            const float eq0 = __builtin_amdgcn_exp2f(c0) * 0.088388347648318440f, eq1 = __builtin_amdgcn_exp2f(c1) * 0.088388347648318440f;
            const size_t o = (t0 + 8 * w + r) * 512 + h * 128 + 2 * lane;
            *(unsigned*)(QD + o) = cvt_pk_bf16(q0 * eq0, q1 * eq1);
            *(unsigned*)(KI + o) = cvt_pk_bf16(k0 * __builtin_amdgcn_exp2f(-c0), k1 * __builtin_amdgcn_exp2f(-c1));
        }
        if (w == 0) *(f32x2*)(EL + h * 128 + 2 * lane) = (f32x2){__builtin_amdgcn_exp2f(last0), __builtin_amdgcn_exp2f(last1)};
        __syncthreads();
    }
}

__device__ __forceinline__ void gla_unit(KA a, int L, int b, int h, int dir, int vs, LAS unsigned char* lds) {
    const int tid = opaque_tid(), lane = tid & 63, w = __builtin_amdgcn_readfirstlane(tid >> 6);
    unsigned char* rbase = a->ws + WS_R;
    const bf16_t* QDg = dir ? (const bf16_t*)((unsigned char*)a->out + 64 * MiB) : (const bf16_t*)(rbase + R_QDF);
    const bf16_t* KIg = dir ? (const bf16_t*)((unsigned char*)a->out + 96 * MiB) : (const bf16_t*)(rbase + R_KIF);
    const float* ELg = (const float*)(rbase + R_EL) + ((size_t)dir * 512 + (size_t)b * 64) * 512 + h * 128;
    const bf16_t* GV = (const bf16_t*)(rbase + R_GV);
    bf16_t* O = (bf16_t*)(a->ws + (dir ? WS_OB : WS_OF));
    f32x4 st[4];
#pragma unroll
    for (int nb = 0; nb < 4; ++nb) st[nb] = (f32x4){0.f, 0.f, 0.f, 0.f};
    for (int i = tid; i < 17408 / 4; i += 512) ((LAS unsigned*)(lds + GL_STT))[i] = 0u;
    const int li = lane & 15, kq = lane >> 4, ib = w & 3, dh = w >> 2;
    const int vrow = tid >> 3, vc8 = tid & 7;
    const int tswz = (((vrow >> 3) ^ vc8) << 4) + (vrow & 7) * 2;
    const int fl = li >> 3;
    u32x4 qd0, qd1, ki0, ki1, vv; float elv = 0.f;
#define GLA_LOAD(ci_) do { const size_t t0_ = (size_t)b * SEQ + (size_t)(ci_) * 64; const size_t o_ = (t0_ + vrow) * 512 + h * 128 + vc8 * 8; \
        qd0 = *(const u32x4*)(QDg + o_); qd1 = *(const u32x4*)(QDg + o_ + 64); ki0 = *(const u32x4*)(KIg + o_); ki1 = *(const u32x4*)(KIg + o_ + 64); \
        vv = *(const u32x4*)(GV + (t0_ + vrow) * 1024 + h * 256 + vs * 64 + vc8 * 8); if (tid < 128) elv = ELg[(size_t)(ci_) * 512 + tid]; } while (0)
#define GLA_TR8(base_, v_) do { LAS unsigned char* p_ = (base_); const u32x4 x_ = (v_); \
        *(LAS unsigned short*)(p_ + 0 * GS_T) = (unsigned short)(x_.x & 0xffff); *(LAS unsigned short*)(p_ + 1 * GS_T) = (unsigned short)(x_.x >> 16); \
        *(LAS unsigned short*)(p_ + 2 * GS_T) = (unsigned short)(x_.y & 0xffff); *(LAS unsigned short*)(p_ + 3 * GS_T) = (unsigned short)(x_.y >> 16); \
        *(LAS unsigned short*)(p_ + 4 * GS_T) = (unsigned short)(x_.z & 0xffff); *(LAS unsigned short*)(p_ + 5 * GS_T) = (unsigned short)(x_.z >> 16); \
        *(LAS unsigned short*)(p_ + 6 * GS_T) = (unsigned short)(x_.w & 0xffff); *(LAS unsigned short*)(p_ + 7 * GS_T) = (unsigned short)(x_.w >> 16); } while (0)
    GLA_LOAD(dir ? 63 : 0);
    for (int c = 0; c < 64; ++c) {
        const int ci = dir ? 63 - c : c; const size_t t0 = (size_t)b * SEQ + (size_t)ci * 64;
        *(LAS u32x4*)(lds + GL_QD + vrow * GS_Q + vc8 * 16) = qd0; *(LAS u32x4*)(lds + GL_QD + vrow * GS_Q + 128 + vc8 * 16) = qd1;
        *(LAS u32x4*)(lds + GL_KI + vrow * GS_Q + vc8 * 16) = ki0; *(LAS u32x4*)(lds + GL_KI + vrow * GS_Q + 128 + vc8 * 16) = ki1;
        GLA_TR8(lds + GL_KST + (vc8 * 8) * GS_T + tswz, ki0); GLA_TR8(lds + GL_KST + (64 + vc8 * 8) * GS_T + tswz, ki1);
        GLA_TR8(lds + GL_VT + (vc8 * 8) * GS_T + tswz, vv);
        if (tid < 128) *(LAS float*)(lds + GL_EL + tid * 4) = elv;
        asm volatile("s_waitcnt lgkmcnt(0)" ::: "memory"); __builtin_amdgcn_s_barrier(); asm volatile("" ::: "memory");
        if (c + 1 < 64) GLA_LOAD(dir ? 62 - c : c + 1);
        bf16x8 qf[4];
#pragma unroll
        for (int kk = 0; kk < 4; ++kk) qf[kk] = *(const LAS bf16x8*)(lds + GL_QD + (16 * ib + li) * GS_Q + kk * 64 + kq * 16);
        unsigned pk[4][2];
#pragma unroll
        for (int sb = 0; sb < 4; ++sb) {
            if (dir == 0 ? (sb > ib) : (sb < ib)) { pk[sb][0] = 0u; pk[sb][1] = 0u; continue; }
            f32x4 sacc = (f32x4){0.f, 0.f, 0.f, 0.f};
#pragma unroll
            for (int kk = 0; kk < 4; ++kk) { const bf16x8 kf = *(const LAS bf16x8*)(lds + GL_KI + (16 * sb + li) * GS_Q + kk * 64 + kq * 16);
                sacc = __builtin_amdgcn_mfma_f32_16x16x32_bf16(kf, qf[kk], sacc, 0, 0, 0); }
            const int irow = 16 * ib + li;
#pragma unroll
            for (int j = 0; j < 4; ++j) { const int srow = 16 * sb + 4 * kq + j; const bool keep = dir == 0 ? (srow <= irow) : (srow >= irow); sacc[j] = keep ? sacc[j] : 0.f; }
            pk[sb][0] = cvt_pk_bf16(sacc[0], sacc[1]); pk[sb][1] = cvt_pk_bf16(sacc[2], sacc[3]);
        }
#pragma unroll
        for (int d2 = 0; d2 < 2; ++d2) { const int db = 2 * dh + d2;
            f32x4 oacc = (f32x4){0.f, 0.f, 0.f, 0.f};
#pragma unroll
            for (int kk = 0; kk < 4; ++kk) { const bf16x8 sf = *(const LAS bf16x8*)(lds + GL_STT + (16 * db + li) * GS_Q + kk * 64 + kq * 16);
                oacc = __builtin_amdgcn_mfma_f32_16x16x32_bf16(sf, qf[kk], oacc, 0, 0, 0); }
#pragma unroll
            for (int kc2 = 0; kc2 < 2; ++kc2) {
                const int fv = (2 * db + fl) & 7;
                const s16x4 lo = *(const LAS s16x4*)(lds + GL_VT + (16 * db + li) * GS_T + (((4 * kc2 + (kq >> 1)) ^ fv) << 4) + (kq & 1) * 8);
                const s16x4 hi4 = *(const LAS s16x4*)(lds + GL_VT + (16 * db + li) * GS_T + (((4 * kc2 + 2 + (kq >> 1)) ^ fv) << 4) + (kq & 1) * 8);
                const bf16x8 vf = (bf16x8){lo[0], lo[1], lo[2], lo[3], hi4[0], hi4[1], hi4[2], hi4[3]};
                const u32x4 pw = (u32x4){pk[2 * kc2][0], pk[2 * kc2][1], pk[2 * kc2 + 1][0], pk[2 * kc2 + 1][1]};
                oacc = __builtin_amdgcn_mfma_f32_16x16x32_bf16(vf, __builtin_bit_cast(bf16x8, pw), oacc, 0, 0, 0); }
            u32x2 ow; ow.x = cvt_pk_bf16(oacc[0], oacc[1]); ow.y = cvt_pk_bf16(oacc[2], oacc[3]);
            *(u32x2*)(O + (t0 + 16 * ib + li) * 1024 + h * 256 + vs * 64 + 16 * db + 4 * kq) = ow;
        }
        { const f32x4 el = *(const LAS f32x4*)(lds + GL_EL + (16 * w + 4 * kq) * 4);
#pragma unroll
          for (int kc2 = 0; kc2 < 2; ++kc2) { const bf16x8 af = *(const LAS bf16x8*)(lds + GL_KST + (16 * w + li) * GS_T + (((4 * kc2 + kq) ^ ((2 * w + fl) & 7)) << 4));
#pragma unroll
              for (int nb = 0; nb < 4; ++nb) { const bf16x8 bfv = *(const LAS bf16x8*)(lds + GL_VT + (16 * nb + li) * GS_T + (((4 * kc2 + kq) ^ ((2 * nb + fl) & 7)) << 4));
                  st[nb] = __builtin_amdgcn_mfma_f32_16x16x32_bf16(af, bfv, st[nb], 0, 0, 0); } }
#pragma unroll
          for (int nb = 0; nb < 4; ++nb) st[nb] = st[nb] * el; }
        asm volatile("s_waitcnt lgkmcnt(0)" ::: "memory"); __builtin_amdgcn_s_barrier(); asm volatile("" ::: "memory");
#pragma unroll
        for (int nb = 0; nb < 4; ++nb) { u32x2 sw; sw.x = cvt_pk_bf16(st[nb][0], st[nb][1]); sw.y = cvt_pk_bf16(st[nb][2], st[nb][3]);
            *(LAS u32x2*)(lds + GL_STT + (16 * nb + li) * GS_Q + (16 * w + 4 * kq) * 2) = sw; }
    }
#undef GLA_LOAD
#undef GLA_TR8
    __syncthreads();
}
#ifndef PH_MASK
#define PH_MASK 0x3fff
#endif
#define EN(k) (((PH_MASK) >> (k)) & 1)
#ifndef PROBE_SYNC_REPS
#define PROBE_SYNC_REPS 1
#endif
#ifndef PROBE_GLA_REPS
#define PROBE_GLA_REPS 1
#endif
__global__ void __launch_bounds__(512) hybrid_fwd(Args a_) {
    extern __shared__ __attribute__((aligned(16))) unsigned char lds_raw[];
    LAS unsigned char* lds = (LAS unsigned char*)lds_raw;
    cg::grid_group grid = cg::this_grid();
    const int ph_lo = a_.ph_lo, ph_hi = a_.ph_hi;
    if (threadIdx.x < 2) ((LAS unsigned*)(lds + 131072))[threadIdx.x] = 0u;
    __syncthreads();
    const XcdBarrier xbar = xcd_barrier_post((unsigned*)(a_.ws + WS_CTL), (volatile LAS unsigned*)(lds + 131072));
    if (threadIdx.x == 0) { const unsigned xcc = xb_xcc_id(); ((LAS unsigned*)(lds + 131072))[4] = atomicAdd((unsigned*)(a_.ws + WS_CTL) + 3584 + 16 * xcc, 1u); ((LAS unsigned*)(lds + 131072))[5] = 0xffffffffu; ((LAS unsigned*)(lds + 131072))[6] = xcc; }
    __syncthreads();
    for (int ph = ph_lo; ph < ph_hi; ++ph) {
        const int tid = opaque_tid(), lane = tid & 63, wave = __builtin_amdgcn_readfirstlane(tid >> 6);
        int bx = blockIdx.x, G = gridDim.x;
        { const unsigned lg = ((volatile LAS unsigned*)(lds + 131072))[5]; if (lg != 0xffffffffu) bx = (int)__builtin_amdgcn_readfirstlane(lg); }
        asm volatile("" : "+s"(bx), "+s"(G));
        const int vcu = (G % 8 == 0) ? (bx % 8) * (G / 8) + bx / 8 : bx;
        const int gw = vcu * 8 + wave, NGW = G * 8;
        KA a = (KA)__builtin_amdgcn_kernarg_segment_ptr(); asm volatile("" : "+s"(a));
        unsigned char* ws = a->ws; unsigned char* rbase = ws + WS_R; unsigned char* wsW = ws + WS_W;
        bf16_t* XA = (bf16_t*)(ws + WS_XA); bf16_t* OF = (bf16_t*)(ws + WS_OF); bf16_t* OB = (bf16_t*)(ws + WS_OB); bf16_t* GG = (bf16_t*)a->out; bf16_t* HB = (bf16_t*)(ws + WS_HB); bf16_t* PB = (bf16_t*)(ws + WS_PB);
        if (ph == 0) { if (EN(13)) {
            prep_layer(a, 0, lds, gw, NGW, wave, lane);
            row_pass<true, false>(a->in[0], HB, nullptr, nullptr, a->in[2], XA, gw, NGW, lane); }
        } else {
            const int L = (ph - 1) / NPH_LAYER, k = (ph - 1) % NPH_LAYER;
            int ngemm = 0; pg8::Gemm g0{}, g1{}; pg8::Epi e0{}, e1{};
            e0.rbase = rbase; e0.ggbase = (unsigned char*)a->out; e1.rbase = rbase; e1.ggbase = (unsigned char*)a->out;
            switch (k) {
            case 0: if (!EN(0)) break; ngemm = 1; g0 = pg8::Gemm{XA, (const bf16_t*)(wsW + W_INA), TOK, NA_PAD, DM}; e0.mode = pg8::EM_ROUTE_A; break;
            case 1: if (!EN(1)) break; for (int u = vcu; u < 2048; u += G) gla_prep(a, L, u >> 8, (u >> 2) & 63, u & 3, lds); break;
            case 2: if (!EN(2)) break; for (int u = vcu; u < 256; u += G) gla_unit(a, L, u >> 5, (u >> 3) & 3, (u >> 2) & 1, u & 3, lds); break;
            case 3: if (!EN(3)) break; gla_post(OF, OB, GG, a->in[6] + (size_t)L * 256, gw, NGW, lane);
                    ngemm = 1; g0 = pg8::Gemm{XA, (const bf16_t*)(wsW + W_INB), TOK, NB_COLS, DM}; e0.mode = pg8::EM_ROUTE_B; e0.gqn = a->in[7] + (size_t)L * 128; e0.gkn = a->in[8] + (size_t)L * 128; e0.xlds = (LAS float*)(lds + 131072 + 1024); break;
            case 4: if (!EN(4)) break; for (int u = vcu; u < 1024; u += G) { const int qb = u & 15, hg = (u >> 4) & 3, kvh = (u >> 6) & 1, b = u >> 7, hq = kvh * 4 + hg;
                        bf16_t* Qb = (bf16_t*)(rbase + R_Q) + ((size_t)b * SEQ + (size_t)qb * 256) * 1024 + hq * 128;
                        const bf16_t* Kh = (const bf16_t*)(rbase + R_K) + (size_t)b * SEQ * 256 + kvh * 128; const bf16_t* Vh = (const bf16_t*)(rbase + R_V) + (size_t)b * SEQ * 256 + kvh * 128;
                        attn::attn_dense_body<attn::bf16>((const attn::bf16*)Qb, (const attn::bf16*)Kh, (const attn::bf16*)Vh, Qb, SEQ, (char*)lds_raw);
                        __syncthreads(); }
                    break;
            case 5: if (!EN(5)) break; ngemm = 2; g0 = pg8::Gemm{OF, (const bf16_t*)(wsW + W_OGLA), TOK, DM, DM}; e0.mode = pg8::EM_GATE1; e0.out = OB; e0.aux = (const bf16_t*)(rbase + R_GA);
                    g1 = pg8::Gemm{(const bf16_t*)(rbase + R_Q), (const bf16_t*)(wsW + W_OATT), TOK, DM, DM}; e1.mode = pg8::EM_GATE2; e1.out = OB; e1.aux = (const bf16_t*)(rbase + R_GB); break;
            case 6: if (!EN(6)) break; ngemm = 1; g0 = pg8::Gemm{OB, (const bf16_t*)(wsW + W_OUT), TOK, DM, DM}; e0.mode = pg8::EM_PLAIN; e0.out = OF; break;
            case 7: if (!EN(7)) break; row_pass<false, false>(HB, HB, OF, a->in[12] + (size_t)L * DM, a->in[13] + (size_t)L * DM, XA, gw, NGW, lane); break;
            case 8: if (!EN(8)) break; ngemm = 1; g0 = pg8::Gemm{XA, (const bf16_t*)(wsW + W_FIN), TOK, 2 * FFH, DM}; e0.mode = pg8::EM_SWIGLU; e0.out = (bf16_t*)rbase; break;
            case 9: if (!EN(9)) break; ngemm = 1; g0 = pg8::Gemm{(const bf16_t*)rbase, (const bf16_t*)(wsW + W_FOUT), TOK, DM, FFH}; e0.mode = pg8::EM_PLAIN; e0.out = OF; break;
            case 10: if (!EN(10)) break; row_pass<false, false>(HB, HB, OF, a->in[16] + (size_t)L * DM, nullptr, nullptr, gw, NGW, lane); break;
            case 11: if (!EN(11)) break; ngemm = 2; g0 = pg8::Gemm{PB, (const bf16_t*)(wsW + W_PP), TOK, DM, PLE}; e0.mode = pg8::EM_PLAIN; e0.out = (bf16_t*)rbase;
                     g1 = pg8::Gemm{HB, (const bf16_t*)(wsW + W_PG), TOK, DM, DM}; e1.mode = pg8::EM_PLE2; e1.out = OF; e1.aux = (const bf16_t*)rbase; break;
            default: if (!EN(12)) break; if (L + 1 < DEPTH) row_pass<false, false>(HB, HB, OF, a->in[19] + (size_t)L * DM, a->in[2] + (size_t)(L + 1) * DM, XA, gw, NGW, lane);
                     else row_pass<false, true>(HB, a->out, OF, a->in[19] + (size_t)L * DM, nullptr, nullptr, gw, NGW, lane);
                     if (L + 1 < DEPTH) prep_layer(a, L + 1, lds, gw, NGW, wave, lane);
                     break;
            }
            for (int gi = 0; gi < ngemm; ++gi) {
                const pg8::Gemm g = gi == 0 ? g0 : g1; const pg8::Epi E = gi == 0 ? e0 : e1;
                pg8::StaticOrder S; S.init(g.M, g.N, G, bx);
                pg8::gemm_phase<pg8::Epi, pg8::StaticOrder, true, true>(lds, g, S, E);
            }
        }
        if (ph + 1 < ph_hi) { if (ph == 0) grid.sync(); else xcd_barrier(xbar); }
        if (ph == 0 && ph + 1 < ph_hi) {
            if (threadIdx.x == 0) { const unsigned* cn = (const unsigned*)(a->ws + WS_CTL) + 3584; const unsigned Gq = (unsigned)gridDim.x / 8u; bool even = (gridDim.x % 8u) == 0u;
                for (int j = 0; j < 16; ++j) { const unsigned cj = __hip_atomic_load(cn + 16 * j, __ATOMIC_RELAXED, __HIP_MEMORY_SCOPE_AGENT); if (cj != (j < 8 ? Gq : 0u)) even = false; }
                const unsigned rk = ((LAS unsigned*)(lds + 131072))[4], xc = ((LAS unsigned*)(lds + 131072))[6];
                ((LAS unsigned*)(lds + 131072))[5] = even ? xc + 8u * rk : (unsigned)blockIdx.x; }
            __syncthreads();
        }
    }
}

#if MK_DEBUG
struct DbgReg { unsigned long long off, bytes; int type, pad; };
struct DbgArgs { DbgReg r[3]; int scanH, ph, pass, pad; };
__global__ void __launch_bounds__(256) dbg_scan(unsigned char* ws, const float* out, DbgArgs d) {
    unsigned* nanw = (unsigned*)(ws + WS_CTL); unsigned long long* sums = (unsigned long long*)(ws + WS_CTL + 512 + d.pass * 512);
    unsigned long long s = 0; unsigned bad = 0;
#pragma unroll
    for (int ri = 0; ri < 3; ++ri) {
        const size_t n16 = d.r[ri].bytes / 16; const u32x4* p = (const u32x4*)(ws + d.r[ri].off); const int type = d.r[ri].type;
        for (size_t i = (size_t)blockIdx.x * 256 + threadIdx.x; i < n16; i += (size_t)gridDim.x * 256) {
            const u32x4 v = p[i]; s += (unsigned long long)v.x + v.y + v.z + v.w;
#pragma unroll
            for (int k = 0; k < 4; ++k) { const unsigned w = v[k]; if ((type == 0 && (w & 0x7f80u) == 0x7f80u) || (type <= 1 && (w & 0x7f800000u) == 0x7f800000u)) bad = 1; }
        }
    }
    if (d.scanH) { const size_t no = (size_t)TOK * DM / 4; const u32x4* q = (const u32x4*)out;
        for (size_t i = (size_t)blockIdx.x * 256 + threadIdx.x; i < no; i += (size_t)gridDim.x * 256) {
            const u32x4 v = q[i]; s += (unsigned long long)v.x + v.y + v.z + v.w;
#pragma unroll
            for (int k = 0; k < 4; ++k) if ((v[k] & 0x7f800000u) == 0x7f800000u) bad = 1; } }
    for (int o = 1; o < 64; o <<= 1) { s += __shfl_xor(s, o); bad |= __shfl_xor(bad, o); }
    if ((threadIdx.x & 63) == 0) { atomicAdd(&sums[d.ph], s); if (bad) atomicOr(&nanw[d.ph], 1u); }
}
__global__ void __launch_bounds__(64) dbg_check_gemm_a(unsigned char* ws) {
    unsigned* chk = (unsigned*)(ws + WS_CTL) + 56;
    const int i = blockIdx.x, lane = threadIdx.x;
    const int t = (int)(((long)i * 9973 + 17) % TOK), col = (i * 131 + 5) % NA_REAL;
    const bf16_t* xa = (const bf16_t*)(ws + WS_XA) + (size_t)t * DM; const bf16_t* wt = (const bf16_t*)(ws + WS_W + W_INA) + (size_t)col * DM;
    float acc = 0.f;
    for (int k = lane; k < DM; k += 64) acc += bf_lo((unsigned)xa[k]) * bf_lo((unsigned)wt[k]);
    acc = wave_sum(acc);
    unsigned char* rb = ws + WS_R; float got;
    if (col < 512) got = bf_lo((unsigned)((const bf16_t*)(rb + R_GQ))[(size_t)t * 512 + col]);
    else if (col < 1024) got = bf_lo((unsigned)((const bf16_t*)(rb + R_GK))[(size_t)t * 512 + col - 512]);
    else if (col < 2048) got = bf_lo((unsigned)((const bf16_t*)(rb + R_GV))[(size_t)t * 1024 + col - 1024]);
    else if (col < 3072) got = bf_lo((unsigned)((const bf16_t*)(ws + WS_GG))[(size_t)t * 1024 + col - 2048]);
    else got = ((const float*)(rb + R_RA))[(size_t)t * 32 + col - 3072];
    if (lane == 0) { if (!(fabsf(got - acc) <= 0.03f * fmaxf(1.f, fabsf(acc)))) { atomicOr(chk, fabsf(got) < 1e-9f ? 1u : 2u); if (atomicAdd(chk + 4, 1u) == 0u) { chk[2] = (unsigned)(t & 255) >> 2; chk[3] = (unsigned)(col & 255) >> 3; } } }
    float m = 0.f; const float* ra = (const float*)(rb + R_RA);
    for (int k = lane; k < 2048; k += 64) m = fmaxf(m, fabsf(ra[(size_t)i * 2048 + k]));
    for (int o = 1; o < 64; o <<= 1) m = fmaxf(m, __shfl_xor(m, o));

}
__global__ void __launch_bounds__(64) dbg_check_gemm_b(unsigned char* ws) {
    unsigned* chk = (unsigned*)(ws + WS_CTL) + 57;
    const int i = blockIdx.x, lane = threadIdx.x;
    const int t = (int)(((long)i * 9973 + 17) % TOK), col = (i * 131 + 5) % NB_COLS;
    const bf16_t* xa = (const bf16_t*)(ws + WS_XA) + (size_t)t * DM; const bf16_t* wt = (const bf16_t*)(ws + WS_W + W_INB) + (size_t)col * DM;
    float acc = 0.f;
    for (int k = lane; k < DM; k += 64) acc += bf_lo((unsigned)xa[k]) * bf_lo((unsigned)wt[k]);
    acc = wave_sum(acc);
    unsigned char* rb = ws + WS_R; float got; unsigned bit;
    if (col < 1024) { got = bf_lo((unsigned)((const bf16_t*)(rb + R_Q))[(size_t)t * 1024 + col]); bit = 1u; }
    else if (col < 1280) { got = bf_lo((unsigned)((const bf16_t*)(rb + R_K))[(size_t)t * 256 + col - 1024]); bit = 2u; }
    else if (col < 1536) { got = bf_lo((unsigned)((const bf16_t*)(rb + R_V))[(size_t)t * 256 + col - 1280]); bit = 2u; }
    else if (col < 2560) { got = bf_lo((unsigned)((const bf16_t*)(rb + R_GA))[(size_t)t * 1024 + col - 1536]); bit = 4u; }
    else { got = bf_lo((unsigned)((const bf16_t*)(rb + R_GB))[(size_t)t * 1024 + col - 2560]); bit = 4u; }
    if (lane == 0) { if (!(fabsf(got - acc) <= 0.03f * fmaxf(1.f, fabsf(acc)))) atomicOr(chk, bit); }
}
__global__ void __launch_bounds__(256) dbg_check_gla(unsigned char* ws) {
    unsigned* c58 = (unsigned*)(ws + WS_CTL) + 58; unsigned* c59 = c58 + 1;
    const bf16_t* of = (const bf16_t*)(ws + WS_OF); const bf16_t* ob = (const bf16_t*)(ws + WS_OB);
    unsigned mn = 99u, mx = 0u;
    for (size_t i = (size_t)blockIdx.x * 256 + threadIdx.x; i < (size_t)TOK * DM; i += (size_t)gridDim.x * 256) {
        const unsigned chunk = (unsigned)((i >> 10) & 4095) >> 6;
        if ((of[i] & 0x7f80u) == 0x7f80u) mn = chunk < mn ? chunk : mn;
        if ((ob[i] & 0x7f80u) == 0x7f80u) mx = chunk + 1 > mx ? chunk + 1 : mx;
    }
    if (mn != 99u) atomicMin(c58, mn); if (mx) atomicMax(c59, mx);
}
__global__ void __launch_bounds__(256) dbg_final(unsigned char* ws, float* out) {
    const unsigned* nanw = (const unsigned*)(ws + WS_CTL); const unsigned long long* sa = (const unsigned long long*)(ws + WS_CTL + 512); const unsigned long long* sb = sa + 64;
    int p1 = -1, p2 = -1;
    for (int i = NPHASES - 1; i >= 0; --i) { if (nanw[i]) p1 = i; if (sa[i] != sb[i]) p2 = i; }
    const unsigned chkA = nanw[56], chkB = nanw[57], g0 = nanw[58], g1 = nanw[59];
    if (p1 < 0 && p2 < 0 && chkA == 0 && chkB == 0) return;
    float c1; unsigned e;
    if (chkA | chkB) { c1 = 90.f + (chkA & 7); e = chkB & 7; }
    else if (p1 == 2) { c1 = 10.f + (g0 > 63 ? 70.f : (float)g0); e = g1 / 3; }
    else { c1 = p1 >= 0 ? 10.f + p1 : 40.f + p2; e = p1 >= 0 ? 25 : 30; }
    float code = c1 * 100.f; for (unsigned k = 0; k < e; ++k) code *= 10.f;
    for (size_t i = (size_t)blockIdx.x * 256 + threadIdx.x; i < (size_t)TOK * DM; i += (size_t)gridDim.x * 256) out[i] = i == 0 ? code : 0.f;
}
static DbgArgs dbg_args_for(int ph, int pass) {
    DbgArgs d{}; d.ph = ph; d.pass = pass; int n = 0;
    auto add = [&](size_t off, size_t bytes, int type) { d.r[n].off = off; d.r[n].bytes = bytes; d.r[n].type = type; ++n; };
    if (ph == 0) { add(WS_W, W_END, 0); add(WS_PB, 16 * MiB, 0); add(WS_XA, 64 * MiB, 0); d.scanH = 1; return d; }
    const int k = (ph - 1) % NPH_LAYER;
    switch (k) {
    case 0: add(WS_R, 128 * MiB, 0); add(WS_R + R_RA, 4 * MiB, 1); add(WS_GG, 64 * MiB, 0); break;
    case 1: add(WS_OF, 128 * MiB, 0); break;
    case 2: add(WS_OF, 64 * MiB, 0); add(WS_R, 224 * MiB, 0); break;
    case 3: add(WS_R + R_Q, 80 * MiB, 0); break;
    case 4: add(WS_R + R_Q, 64 * MiB, 0); break;
    case 5: add(WS_OB, 64 * MiB, 0); break;
    case 6: add(WS_OF, 64 * MiB, 0); break;
    case 7: add(WS_XA, 64 * MiB, 0); d.scanH = 1; break;
    case 8: add(WS_R, (size_t)TOK * FFH * 2, 0); break;
    case 9: add(WS_OF, 64 * MiB, 0); break;
    case 10: add(WS_XA, 64 * MiB, 0); d.scanH = 1; break;
    case 11: add(WS_R, 64 * MiB, 0); add(WS_OF, 64 * MiB, 0); break;
    default: add(WS_XA, 64 * MiB, 0); add(WS_W, W_END, 0); add(WS_PB, 16 * MiB, 0); d.scanH = 1; break;
    }
    return d;
}
#endif
extern "C" void kernel_launch(void* const* d_in, const int* in_sizes, int n_in, void* d_out, int out_size, void* d_ws, size_t ws_size, hipStream_t stream) {
    static int grid = 0;
    if (grid == 0) {
        if (n_in != 20 || in_sizes[0] != TOK * DM || out_size != TOK * DM || ws_size < WS_END) {
            fprintf(stderr, "kernel_launch: unexpected shapes (n_in %d, in0 %d, out %d, ws %zu, need %zu); nothing launched\n", n_in, n_in > 0 ? in_sizes[0] : -1, out_size, ws_size, (size_t)WS_END); grid = -1; return; }
        int dev = 0, cus = 0, per_cu = 0;
        if (hipGetDevice(&dev) != hipSuccess || hipDeviceGetAttribute(&cus, hipDeviceAttributeMultiprocessorCount, dev) != hipSuccess) { grid = -1; return; }
        if (hipFuncSetAttribute((const void*)hybrid_fwd, hipFuncAttributeMaxDynamicSharedMemorySize, LDS_BYTES) != hipSuccess) { fprintf(stderr, "kernel_launch: hipFuncSetAttribute failed\n"); grid = -1; return; }
        if (hipOccupancyMaxActiveBlocksPerMultiprocessor(&per_cu, (const void*)hybrid_fwd, 512, LDS_BYTES) != hipSuccess || per_cu < 1) { fprintf(stderr, "kernel_launch: occupancy query says %d\n", per_cu); per_cu = 1; }
        (void)hipGetLastError();
        grid = cus * 1;
        fprintf(stderr, "kernel_launch: grid %d (cus %d, per_cu %d), ws need %zu have %zu\n", grid, cus, per_cu, (size_t)WS_END, ws_size);
    }
    if (grid < 0) return;
    if (hipMemsetAsync((char*)d_ws + WS_CTL, 0, 16384, stream) != hipSuccess) { fprintf(stderr, "kernel_launch: memset failed\n"); return; }
    Args a{};
    for (int i = 0; i < 20; ++i) a.in[i] = (const float*)d_in[i];
    a.out = (float*)d_out; a.ws = (unsigned char*)d_ws;
#if MK_DEBUG
    hipMemsetAsync((char*)d_ws + WS_CTL, 0, 4096, stream); hipMemsetAsync((char*)d_ws + WS_CTL + 58 * 4, 0x63, 1, stream);
    for (int pass = 0; pass < 2; ++pass)
        for (int ph = 0; ph < NPHASES; ++ph) { a.ph_lo = ph; a.ph_hi = ph + 1; hipLaunchKernelGGL(hybrid_fwd, dim3(grid), dim3(512), LDS_BYTES, stream, a);
            hipLaunchKernelGGL(dbg_scan, dim3(2048), dim3(256), 0, stream, (unsigned char*)d_ws, (const float*)d_out, dbg_args_for(ph, pass));
            if (pass == 0 && ph == 1) { hipLaunchKernelGGL(dbg_check_gemm_a, dim3(512), dim3(64), 0, stream, (unsigned char*)d_ws); }
            if (pass == 0 && ph == 2) hipLaunchKernelGGL(dbg_check_gla, dim3(2048), dim3(256), 0, stream, (unsigned char*)d_ws);
            if (pass == 0 && ph == 3) hipLaunchKernelGGL(dbg_check_gemm_b, dim3(512), dim3(64), 0, stream, (unsigned char*)d_ws); }
    hipLaunchKernelGGL(dbg_final, dim3(2048), dim3(256), 0, stream, (unsigned char*)d_ws, (float*)d_out);
#elif MK_PER_PHASE
    for (int ph = 0; ph < NPHASES; ++ph) { a.ph_lo = ph; a.ph_hi = ph + 1; hipLaunchKernelGGL(hybrid_fwd, dim3(grid), dim3(512), LDS_BYTES, stream, a); }
#else
    a.ph_lo = 0; a.ph_hi = NPHASES;
    void* args[] = {&a};
    hipError_t e = hipLaunchCooperativeKernel((const void*)hybrid_fwd, dim3(grid), dim3(512), args, LDS_BYTES, stream);
    if (e != hipSuccess) fprintf(stderr, "kernel_launch: cooperative launch failed: %s (grid %d)\n", hipGetErrorString(e), grid);
#endif
}
```
